# Optimizing an MI355X kernel written in HIP

```python
import jax
import jax.numpy as jnp
from jax import lax
import numpy as np

D_MODEL = 1024
BATCH = 32
SEQ = 256
DEPTH = 1
DEC_BATCH = 8
DEC_SEQ = 2048
PAST_LEN = 512

GRID_W = 64
HEAD_DIM = 64
N_Q_HEADS = 8
N_KV_HEADS = 2
GQA_GROUP = N_Q_HEADS // N_KV_HEADS
ATTN_WIDTH = N_Q_HEADS * HEAD_DIM
KV_WIDTH = N_KV_HEADS * HEAD_DIM
WINDOW = 128
BLOCK = 128
ROPE_BASE = 10000.0
ROPE_PAIRS = HEAD_DIM // 4
RWKV_HEADS = 8
RWKV_HEAD_SIZE = 64
RWKV_WIDTH = RWKV_HEADS * RWKV_HEAD_SIZE
N_DIR = 2
DECAY_RANK = 64
ICLR_RANK = 64
GATE_RANK = 128
RW_SHIFT_COLS = 3 * RWKV_WIDTH + N_DIR * DECAY_RANK + N_DIR * ICLR_RANK + GATE_RANK
W_IN_COLS = ATTN_WIDTH + 2 * KV_WIDTH + 2 * D_MODEL + RW_SHIFT_COLS
IN_SPLIT_IDX = (ATTN_WIDTH, ATTN_WIDTH + KV_WIDTH, ATTN_WIDTH + 2 * KV_WIDTH,
                ATTN_WIDTH + 2 * KV_WIDTH + D_MODEL, ATTN_WIDTH + 2 * KV_WIDTH + 2 * D_MODEL)
RW_SPLIT_IDX = (RWKV_WIDTH, 2 * RWKV_WIDTH, 3 * RWKV_WIDTH,
                3 * RWKV_WIDTH + N_DIR * DECAY_RANK,
                3 * RWKV_WIDTH + N_DIR * (DECAY_RANK + ICLR_RANK))
D_FF = 2816
CONV_W = 3
NORM_EPS = 1e-6
GN_EPS = 64e-5
MASK_VALUE = -1e30

kernel_name = 'hybrid_dit_window_gqa_rwkv7_step'


def rms_norm(x, g):
    xf = x.astype(jnp.float32)
    return xf * lax.rsqrt(jnp.mean(xf * xf, axis=-1, keepdims=True) + NORM_EPS) * g.astype(jnp.float32)


def modulation(cond, w_ada, b_ada):
    m = jax.nn.silu(cond) @ w_ada + b_ada
    return jnp.split(m[:, None, :], 6, axis=-1)


def neighbours(h):
    hp = jnp.pad(h, ((0, 0), (1, 1), (0, 0)))
    return hp[:, :-2], hp[:, 2:]


def axial_rope(x):
    T = x.shape[1]
    rows = T // GRID_W
    row = jnp.repeat(jnp.arange(rows), GRID_W).astype(jnp.float32)
    col = jnp.tile(jnp.arange(GRID_W), rows).astype(jnp.float32)
    freqs = ROPE_BASE ** (-jnp.arange(ROPE_PAIRS, dtype=jnp.float32) / ROPE_PAIRS)

    def rotate(xh, pos):
        ang = (pos[:, None] * freqs)[:, None, :]
        cos, sin = jnp.cos(ang), jnp.sin(ang)
        x1, x2 = jnp.split(xh.astype(jnp.float32), 2, axis=-1)
        return jnp.concatenate([x1 * cos - x2 * sin, x2 * cos + x1 * sin], axis=-1)

    x_row, x_col = jnp.split(x, 2, axis=-1)
    return jnp.concatenate([rotate(x_row, row), rotate(x_col, col)], axis=-1).astype(x.dtype)


def dense_context_attention(q, k, v, sink):
    B, T = q.shape[:2]
    qg = q.reshape(B, T, N_KV_HEADS, GQA_GROUP, HEAD_DIM)
    s = jnp.einsum('btkgd,bskd->bkgts', qg, k).astype(jnp.float32) * (HEAD_DIM ** -0.5)
    sk = jnp.broadcast_to(sink.reshape(N_KV_HEADS, GQA_GROUP, 1, 1).astype(jnp.float32),
                          (B, N_KV_HEADS, GQA_GROUP, T, 1))
    p = jax.nn.softmax(jnp.concatenate([s, sk], axis=-1), axis=-1)[..., :-1]
    o = jnp.einsum('bkgts,bskd->btkgd', p, v)
    return o.reshape(B, T, ATTN_WIDTH)


def banded_latent_attention(q, k, v, k_ctx, v_ctx, sink):
    B, T = q.shape[:2]
    NB = T // BLOCK
    P = k_ctx.shape[1]
    qb = q.reshape(B, NB, BLOCK, N_KV_HEADS, GQA_GROUP, HEAD_DIM)
    pad = ((0, 0), (BLOCK, BLOCK), (0, 0), (0, 0))
    kp = jnp.pad(k, pad).reshape(B, NB + 2, BLOCK, N_KV_HEADS, HEAD_DIM)
    vp = jnp.pad(v, pad).reshape(B, NB + 2, BLOCK, N_KV_HEADS, HEAD_DIM)
    kw = jnp.concatenate([kp[:, :NB], kp[:, 1:NB + 1], kp[:, 2:]], axis=2)
    vw = jnp.concatenate([vp[:, :NB], vp[:, 1:NB + 1], vp[:, 2:]], axis=2)
    blk = jnp.arange(NB)[:, None, None]
    qi = blk * BLOCK + jnp.arange(BLOCK)[None, :, None]
    kj = (blk - 1) * BLOCK + jnp.arange(3 * BLOCK)[None, None, :]
    valid = (jnp.abs(kj - qi) <= WINDOW) & (kj >= 0) & (kj < T)
    scale = HEAD_DIM ** -0.5
    s_lat = jnp.einsum('bnqkgd,bnskd->bnkgqs', qb, kw).astype(jnp.float32) * scale
    s_lat = jnp.where(valid[None, :, None, None], s_lat, MASK_VALUE)
    s_ctx = jnp.einsum('bnqkgd,bskd->bnkgqs', qb, k_ctx).astype(jnp.float32) * scale
    sk = jnp.broadcast_to(sink.reshape(1, 1, N_KV_HEADS, GQA_GROUP, 1, 1).astype(jnp.float32),
                          (B, NB, N_KV_HEADS, GQA_GROUP, BLOCK, 1))
    p = jax.nn.softmax(jnp.concatenate([s_lat, s_ctx, sk], axis=-1), axis=-1)
    p_lat = p[..., :3 * BLOCK]
    p_ctx = p[..., 3 * BLOCK:3 * BLOCK + P]
    o = (jnp.einsum('bnkgqs,bnskd->bnqkgd', p_lat, vw)
         + jnp.einsum('bnkgqs,bskd->bnqkgd', p_ctx, v_ctx))
    return o.reshape(B, T, ATTN_WIDTH)


def rwkv7_bidirectional(zr, state0, p):
    B, T = zr.shape[:2]
    f32 = jnp.float32
    mu = p['rwkv_mu']
    prev, nxt = neighbours(zr)
    zr = zr + mu[0] * (prev - zr) + mu[1] * (nxt - zr)
    r, k, v, zw, za, zg = jnp.split(zr, RW_SPLIT_IDX, axis=-1)
    zw = zw.reshape(B, T, N_DIR, DECAY_RANK)
    za = za.reshape(B, T, N_DIR, ICLR_RANK)
    logit = (p['rwkv_w0'] + jnp.einsum('btdr,drc->btdc', jnp.tanh(zw), p['rwkv_w2'])).astype(f32)
    decay = jnp.exp(-jnp.exp(-jax.nn.softplus(-logit) - 0.5))
    a = jax.nn.sigmoid(p['rwkv_a0'] + jnp.einsum('btdr,drc->btdc', za, p['rwkv_a2']))
    g = jax.nn.sigmoid(zg) @ p['rwkv_g2']

    def heads(t):
        return t.reshape(t.shape[:-1] + (RWKV_HEADS, RWKV_HEAD_SIZE))

    kk = heads(k * p['rwkv_k_k']).astype(f32)
    kk = kk / jnp.maximum(jnp.sqrt(jnp.sum(kk * kk, axis=-1, keepdims=True)), 1e-12)
    k_dir = heads(k[:, :, None, :] * (1.0 + (a - 1.0) * p['rwkv_k_a']))
    b_dir = heads(a) * kk[:, :, None]
    r_h, v_h = heads(r), heads(v)

    def two(t):
        return jnp.broadcast_to(t[:, :, None], (B, T, N_DIR) + t.shape[2:])

    def scan_order(t):
        return jnp.stack([t[:, :, 0], jnp.flip(t[:, :, 1], axis=1)], axis=2)

    xs = tuple(jnp.moveaxis(scan_order(t).astype(f32), 1, 0)
               for t in (heads(decay), k_dir, two(v_h), two(r_h), two(-kk), b_dir))

    def step(S, inp):
        w_t, k_t, v_t, r_t, a_t, b_t = inp
        sa = jnp.einsum('bdhij,bdhj->bdhi', S, a_t)
        S = S * w_t[..., None, :] + sa[..., None] * b_t[..., None, :] + v_t[..., None] * k_t[..., None, :]
        return S, jnp.einsum('bdhij,bdhj->bdhi', S, r_t)

    s_final, ys = lax.scan(step, state0.astype(f32), xs)
    ys = jnp.moveaxis(ys, 0, 1)
    y = ys[:, :, 0] + jnp.flip(ys[:, :, 1], axis=1)
    mean = jnp.mean(y, axis=-1, keepdims=True)
    var = jnp.mean(jnp.square(y - mean), axis=-1, keepdims=True)
    y = ((y - mean) * lax.rsqrt(var + GN_EPS)).reshape(B, T, RWKV_WIDTH) * p['rwkv_ln_g'] + p['rwkv_ln_b']
    bonus = jnp.sum(jnp.sum(r_h[:, :, None] * k_dir * p['rwkv_r_k'], axis=-1, keepdims=True), axis=2) * v_h
    out = (y + bonus.reshape(B, T, RWKV_WIDTH)) * g
    return out, s_final


def conv_ffn(h, w_up, conv_w, conv_b, w_down):
    u = h @ w_up
    prev, nxt = neighbours(u)
    u = prev * conv_w[0] + u * conv_w[1] + nxt * conv_w[2] + conv_b
    val, gate = jnp.split(u, 2, axis=-1)
    return (jax.nn.silu(gate) * val) @ w_down


def trunk_layer(x, cond, p, ctx):
    shift1, scale1, gate1, shift2, scale2, gate2 = modulation(cond, p['w_ada'], p['b_ada'])
    B, T = x.shape[:2]
    h = rms_norm(x, p['g_norm1']) * (1.0 + scale1) + shift1
    z = h @ p['w_in']
    q, k, v, ga, gb, zr = jnp.split(z, IN_SPLIT_IDX, axis=-1)
    q = q.reshape(B, T, N_Q_HEADS, HEAD_DIM)
    k = k.reshape(B, T, N_KV_HEADS, HEAD_DIM)
    v = v.reshape(B, T, N_KV_HEADS, HEAD_DIM)
    if ctx is None:
        attn = dense_context_attention(q, k, v, p['attn_sink'])
        state0 = jnp.zeros((B, N_DIR, RWKV_HEADS, RWKV_HEAD_SIZE, RWKV_HEAD_SIZE), jnp.float32)
    else:
        k_ctx, v_ctx, state0 = ctx
        k = axial_rope(k)
        attn = banded_latent_attention(axial_rope(q), k, v, k_ctx, v_ctx, p['attn_sink'])
    rw, s_final = rwkv7_bidirectional(zr, state0, p)
    merged = jax.nn.sigmoid(ga) * (attn @ p['w_proj_a']) + jax.nn.sigmoid(gb) * (rw @ p['w_proj_b'])
    x = x + gate1 * (merged @ p['w_out'])
    h2 = rms_norm(x, p['g_norm2']) * (1.0 + scale2) + shift2
    x = x + gate2 * conv_ffn(h2, p['w_ffn_up'], p['ffn_conv_w'], p['ffn_conv_b'], p['w_ffn_down'])
    return x, (k, v, s_final)


def setup_inputs(seed: int = 0) -> dict:
    key = jax.random.key(seed)
    ks = iter(jax.random.split(key, 40))
    f32 = jnp.float32

    def nrm(shape, scale):
        return jax.random.normal(next(ks), shape, f32) * scale

    L = DEPTH
    return {
        'x_prompt': nrm((BATCH, SEQ, D_MODEL), 1.0),
        'x_sample': nrm((DEC_BATCH, DEC_SEQ, D_MODEL), 1.0),
        'c': nrm((DEC_BATCH, D_MODEL), 1.0),
        'cache_k': nrm((DEC_BATCH, L, PAST_LEN, N_KV_HEADS, HEAD_DIM), 1.0),
        'cache_v': nrm((DEC_BATCH, L, PAST_LEN, N_KV_HEADS, HEAD_DIM), 1.0),
        'state_rwkv': nrm((DEC_BATCH, L, N_DIR, RWKV_HEADS, RWKV_HEAD_SIZE, RWKV_HEAD_SIZE), 0.3),
        'c_ctx': nrm((D_MODEL,), 1.0),
        'w_ada': nrm((L, D_MODEL, 6 * D_MODEL), 0.5 * D_MODEL ** -0.5),
        'b_ada': nrm((L, 6 * D_MODEL), 0.01),
        'g_norm1': 1.0 + nrm((L, D_MODEL), 0.02),
        'w_in': nrm((L, D_MODEL, W_IN_COLS), D_MODEL ** -0.5),
        'attn_sink': nrm((L, N_Q_HEADS), 0.5),
        'w_proj_a': nrm((L, ATTN_WIDTH, D_MODEL), ATTN_WIDTH ** -0.5),
        'w_proj_b': nrm((L, RWKV_WIDTH, D_MODEL), RWKV_WIDTH ** -0.5),
        'rwkv_mu': jax.random.uniform(next(ks), (L, 2, RW_SHIFT_COLS), f32, 0.0, 0.5),
        'rwkv_w0': -1.0 + nrm((L, N_DIR, RWKV_WIDTH), 0.5),
        'rwkv_w2': nrm((L, N_DIR, DECAY_RANK, RWKV_WIDTH), 0.1),
        'rwkv_a0': nrm((L, N_DIR, RWKV_WIDTH), 0.5),
        'rwkv_a2': nrm((L, N_DIR, ICLR_RANK, RWKV_WIDTH), 0.1),
        'rwkv_k_k': 0.85 + nrm((L, RWKV_WIDTH), 0.1),
        'rwkv_k_a': 1.0 + nrm((L, RWKV_WIDTH), 0.1),
        'rwkv_r_k': nrm((L, RWKV_HEADS, RWKV_HEAD_SIZE), 0.1),
        'rwkv_g2': nrm((L, GATE_RANK, RWKV_WIDTH), GATE_RANK ** -0.5),
        'rwkv_ln_g': 1.0 + nrm((L, RWKV_WIDTH), 0.02),
        'rwkv_ln_b': nrm((L, RWKV_WIDTH), 0.01),
        'w_out': nrm((L, D_MODEL, D_MODEL), D_MODEL ** -0.5),
        'g_norm2': 1.0 + nrm((L, D_MODEL), 0.02),
        'w_ffn_up': nrm((L, D_MODEL, 2 * D_FF), D_MODEL ** -0.5),
        'ffn_conv_w': nrm((L, CONV_W, 2 * D_FF), CONV_W ** -0.5),
        'ffn_conv_b': nrm((L, 2 * D_FF), 0.01),
        'w_ffn_down': nrm((L, D_FF, D_MODEL), D_FF ** -0.5),
        'g_final': 1.0 + nrm((D_MODEL,), 0.02),
    }


def reference(x_prompt, x_sample, c, cache_k, cache_v, state_rwkv, c_ctx, w_ada, b_ada, g_norm1,
              w_in, attn_sink, w_proj_a, w_proj_b, rwkv_mu, rwkv_w0, rwkv_w2, rwkv_a0, rwkv_a2,
              rwkv_k_k, rwkv_k_a, rwkv_r_k, rwkv_g2, rwkv_ln_g, rwkv_ln_b, w_out, g_norm2,
              w_ffn_up, ffn_conv_w, ffn_conv_b, w_ffn_down, g_final):
    hp, hs = x_prompt, x_sample
    new_k, new_v, new_s = [], [], []
    for l in range(DEPTH):
        p = dict(w_ada=w_ada[l], b_ada=b_ada[l], g_norm1=g_norm1[l], w_in=w_in[l],
                 attn_sink=attn_sink[l], w_proj_a=w_proj_a[l], w_proj_b=w_proj_b[l],
                 rwkv_mu=rwkv_mu[l], rwkv_w0=rwkv_w0[l], rwkv_w2=rwkv_w2[l], rwkv_a0=rwkv_a0[l],
                 rwkv_a2=rwkv_a2[l], rwkv_k_k=rwkv_k_k[l], rwkv_k_a=rwkv_k_a[l], rwkv_r_k=rwkv_r_k[l],
                 rwkv_g2=rwkv_g2[l], rwkv_ln_g=rwkv_ln_g[l], rwkv_ln_b=rwkv_ln_b[l], w_out=w_out[l],
                 g_norm2=g_norm2[l], w_ffn_up=w_ffn_up[l], ffn_conv_w=ffn_conv_w[l],
                 ffn_conv_b=ffn_conv_b[l], w_ffn_down=w_ffn_down[l])
        hp, (kc, vc, sc) = trunk_layer(hp, c_ctx[None, :], p, None)
        new_k.append(kc)
        new_v.append(vc)
        new_s.append(sc)
        hs, _ = trunk_layer(hs, c, p, (cache_k[:, l], cache_v[:, l], state_rwkv[:, l]))
    y_prompt = rms_norm(hp, g_final).astype(x_prompt.dtype)
    y_sample = rms_norm(hs, g_final).astype(x_sample.dtype)
    new_cache_k = jnp.stack(new_k, axis=1)
    new_cache_v = jnp.stack(new_v, axis=1)
    new_state_rwkv = jnp.stack(new_s, axis=1)
    return (y_prompt, y_sample, new_cache_k, new_cache_v, new_state_rwkv)
```

```cpp
#include <hip/hip_runtime.h>
#include <hip/hip_cooperative_groups.h>
#include <cstdio>
namespace cg = cooperative_groups;

#define DI __device__ __forceinline__
typedef unsigned short bf16_t;
typedef short bf16x8 __attribute__((ext_vector_type(8)));
typedef short s16x4 __attribute__((ext_vector_type(4)));
typedef float f32x4 __attribute__((ext_vector_type(4)));
typedef float f32x2 __attribute__((ext_vector_type(2)));
typedef float f32x16 __attribute__((ext_vector_type(16)));
typedef unsigned u32x4 __attribute__((ext_vector_type(4)));
typedef unsigned u32x2 __attribute__((ext_vector_type(2)));

#ifndef N_LAUNCH_SPLIT
#define N_LAUNCH_SPLIT 0
#endif

constexpr int NTHR = 512;
constexpr int D = 1024;
constexpr int MC = 8192;
constexpr int ML = 16384;
constexpr int M = MC + ML;
constexpr int WIN = 4736;
constexpr int ZRC = 1920;
constexpr int DFF = 2816;
constexpr int LDS_BYTES = 98304;
constexpr float LOG2E = 1.4426950408889634f;

constexpr size_t al256(size_t x) { return (x + 255) & ~(size_t)255; }
constexpr size_t OFF_WUP   = 0;
constexpr size_t OFF_WDN   = OFF_WUP + al256((size_t)5632 * 1024 * 2);
constexpr size_t OFF_MOD   = OFF_WDN + al256((size_t)1024 * 2816 * 2);
constexpr size_t OFF_ROPE  = OFF_MOD + al256((size_t)9 * 6144 * 4);
constexpr size_t OFF_W2T   = OFF_ROPE + al256((size_t)64 * 16 * 8);
constexpr size_t OFF_A2T   = OFF_W2T + al256((size_t)2 * 512 * 64 * 2);
constexpr size_t OFF_G2T   = OFF_A2T + al256((size_t)2 * 512 * 64 * 2);
constexpr size_t OFF_KC    = OFF_G2T + al256((size_t)512 * 128 * 2);
constexpr size_t OFF_VCT   = OFF_KC + al256((size_t)8 * 512 * 128 * 2);
constexpr size_t OFF_H     = OFF_VCT + al256((size_t)8 * 512 * 128 * 2);
constexpr size_t OFF_X     = OFF_H + al256((size_t)M * 1024 * 2);
constexpr size_t OFF_WIN   = OFF_X;
constexpr size_t OFF_WPA   = OFF_WIN + al256((size_t)WIN * 1024 * 2);
constexpr size_t OFF_WPB   = OFF_WPA + al256((size_t)1024 * 512 * 2);
constexpr size_t OFF_WOUT  = OFF_WPB + al256((size_t)1024 * 512 * 2);
constexpr size_t OFF_Q     = OFF_WOUT + al256((size_t)1024 * 1024 * 2);
constexpr size_t OFF_RW    = OFF_Q;
constexpr size_t OFF_KB    = OFF_Q + al256((size_t)M * 512 * 2);
constexpr size_t OFF_VT    = OFF_KB + al256((size_t)M * 128 * 2);
constexpr size_t OFF_ATTN  = OFF_VT + al256((size_t)M * 128 * 2);
constexpr size_t OFF_SG    = OFF_ATTN + al256((size_t)M * 512 * 2);
constexpr size_t OFF_BN    = OFF_SG + al256((size_t)M * 128 * 2);
constexpr size_t OFF_YS    = OFF_BN + al256((size_t)M * 16 * 4);
constexpr size_t OFF_MRG   = OFF_YS;
constexpr size_t END_EARLY = OFF_YS + al256((size_t)2 * M * 512 * 4);
constexpr size_t OFF_ACT   = OFF_X;
constexpr size_t OFF_U     = OFF_ACT + al256((size_t)M * DFF * 2);
constexpr size_t END_FFN   = OFF_U + al256((size_t)4096 * 5632 * 2);
constexpr size_t WS_NEED   = END_EARLY > END_FFN ? END_EARLY : END_FFN;
static_assert(WS_NEED <= (size_t)256 * 1024 * 1024, "workspace over 256 MiB");

constexpr size_t OUT_Y  = 0;
constexpr size_t OUT_K  = (size_t)M * 1024;
constexpr size_t OUT_V  = OUT_K + (size_t)MC * 128;
constexpr size_t OUT_S  = OUT_V + (size_t)MC * 128;

struct Params {
    const float *x_prompt, *x_sample, *c, *cache_k, *cache_v, *state_rwkv, *c_ctx, *w_ada, *b_ada, *g_norm1, *w_in, *attn_sink,
        *w_proj_a, *w_proj_b, *rwkv_mu, *rwkv_w0, *rwkv_w2, *rwkv_a0, *rwkv_a2, *rwkv_k_k, *rwkv_k_a, *rwkv_r_k, *rwkv_g2,
        *rwkv_ln_g, *rwkv_ln_b, *w_out, *g_norm2, *w_ffn_up, *ffn_conv_w, *ffn_conv_b, *w_ffn_down, *g_final;
    float* out;
    unsigned char* ws;
    int ph_lo, ph_hi;
};

DI bf16_t f2bf(float f) { unsigned u = __float_as_uint(f); u += 0x7fffu + ((u >> 16) & 1u); return (bf16_t)(u >> 16); }
DI float bf2f(unsigned b) { return __uint_as_float(b << 16); }
DI unsigned pack2(float lo, float hi) { return (unsigned)f2bf(lo) | ((unsigned)f2bf(hi) << 16); }
DI u32x2 pack4(f32x4 v) { u32x2 r; r.x = pack2(v[0], v[1]); r.y = pack2(v[2], v[3]); return r; }
DI f32x4 unpack4(u32x2 v) { f32x4 r; r[0] = bf2f(v.x & 0xffffu); r[1] = bf2f(v.x >> 16); r[2] = bf2f(v.y & 0xffffu); r[3] = bf2f(v.y >> 16); return r; }
DI float sigmoidf_(float x) { return 1.0f / (1.0f + __expf(-x)); }
DI const float* xrow(const Params& p, int r) { return r < MC ? p.x_prompt + (size_t)r * D : p.x_sample + (size_t)(r - MC) * D; }
DI int cond_of(int r) { return r < MC ? 0 : 1 + ((r - MC) >> 11); }
DI void seq_of(int r, int& r0, int& T) { if (r < MC) { r0 = r & ~255; T = 256; } else { r0 = MC + ((r - MC) & ~2047); T = 2048; } }
DI float wave_sum(float v) {
#pragma unroll
    for (int o = 32; o >= 1; o >>= 1) v += __shfl_xor(v, o);
    return v;
}

DI void transpose_tile(const float* __restrict__ src, int K, int N, bf16_t* __restrict__ dst, int kt, int nt, float* tile, int tid) {
    const int k0 = kt * 64, n0 = nt * 64;
#pragma unroll
    for (int i = 0; i < 8; ++i) { const int k = (tid >> 6) + 8 * i, n = tid & 63; tile[k * 65 + n] = src[(size_t)(k0 + k) * N + n0 + n]; }
    __syncthreads();
#pragma unroll
    for (int i = 0; i < 8; ++i) { const int n = (tid >> 6) + 8 * i, k = tid & 63; dst[(size_t)(n0 + n) * K + k0 + k] = f2bf(tile[k * 65 + n]); }
    __syncthreads();
}

DI void phase_prep(const Params& p, char* smem) {
    const int tid = threadIdx.x, nb = gridDim.x, bid = blockIdx.x;
    unsigned char* ws = p.ws;
    {
        float* tile = (float*)smem;
        const int cnt[11] = {16 * 74, 8 * 16, 8 * 16, 16 * 16, 16 * 88, 44 * 16, 8, 8, 8, 8, 16};
        int total = 0;
#pragma unroll
        for (int i = 0; i < 11; ++i) total += cnt[i];
        for (int it = bid; it < total; it += nb) {
            int i = it, mi = 0;
#pragma unroll
            for (int q = 0; q < 10; ++q) { if (mi == q && i >= cnt[q]) { i -= cnt[q]; mi = q + 1; } }
            const float* src; bf16_t* dst; int K, N;
            switch (mi) {
                case 0: src = p.w_in; K = 1024; N = WIN; dst = (bf16_t*)(ws + OFF_WIN); break;
                case 1: src = p.w_proj_a; K = 512; N = 1024; dst = (bf16_t*)(ws + OFF_WPA); break;
                case 2: src = p.w_proj_b; K = 512; N = 1024; dst = (bf16_t*)(ws + OFF_WPB); break;
                case 3: src = p.w_out; K = 1024; N = 1024; dst = (bf16_t*)(ws + OFF_WOUT); break;
                case 4: src = p.w_ffn_up; K = 1024; N = 5632; dst = (bf16_t*)(ws + OFF_WUP); break;
                case 5: src = p.w_ffn_down; K = 2816; N = 1024; dst = (bf16_t*)(ws + OFF_WDN); break;
                case 6: src = p.rwkv_w2; K = 64; N = 512; dst = (bf16_t*)(ws + OFF_W2T); break;
                case 7: src = p.rwkv_w2 + 64 * 512; K = 64; N = 512; dst = (bf16_t*)(ws + OFF_W2T) + 512 * 64; break;
                case 8: src = p.rwkv_a2; K = 64; N = 512; dst = (bf16_t*)(ws + OFF_A2T); break;
                case 9: src = p.rwkv_a2 + 64 * 512; K = 64; N = 512; dst = (bf16_t*)(ws + OFF_A2T) + 512 * 64; break;
                default: src = p.rwkv_g2; K = 128; N = 512; dst = (bf16_t*)(ws + OFF_G2T); break;
            }
            const int ntn = N / 64;
            transpose_tile(src, K, N, dst, i / ntn, i % ntn, tile, tid);
        }
    }
    {
        bf16_t* kc = (bf16_t*)(ws + OFF_KC); bf16_t* vct = (bf16_t*)(ws + OFF_VCT);
        for (int i = bid * NTHR + tid; i < 8 * 512 * 128; i += nb * NTHR) {
            kc[i] = f2bf(p.cache_k[i]);
            const int key = i & 511, d = (i >> 9) & 63, kvh = (i >> 15) & 1, b = i >> 16;
            vct[i] = f2bf(p.cache_v[((size_t)(b * 512 + key) * 2 + kvh) * 64 + d]);
        }
    }
    {
        f32x2* tab = (f32x2*)(ws + OFF_ROPE);
        for (int i = bid * NTHR + tid; i < 1024; i += nb * NTHR) {
            const int pos = i >> 4, fi = i & 15;
            const double fr = pow(10000.0, -(double)fi / 16.0), ang = (double)pos * fr;
            f32x2 v; v.x = (float)cos(ang); v.y = (float)sin(ang); tab[i] = v;
        }
    }
    {
        float* s = (float*)smem;
        float* red = (float*)(smem + 36864);
        float* mod = (float*)(ws + OFF_MOD);
        for (int it = bid; it < 96; it += nb) {
            __syncthreads();
            for (int i = tid; i < 9 * 1024; i += NTHR) {
                const int ci = i >> 10, k = i & 1023;
                const float v = ci == 0 ? p.c_ctx[k] : p.c[(ci - 1) * 1024 + k];
                s[i] = v / (1.0f + __expf(-v));
            }
            __syncthreads();
            const int n = tid & 63, kq = tid >> 6, n0 = it * 64;
            float acc[9];
#pragma unroll
            for (int ci = 0; ci < 9; ++ci) acc[ci] = 0.f;
            for (int k = kq * 128; k < kq * 128 + 128; ++k) {
                const float w = p.w_ada[(size_t)k * 6144 + n0 + n];
#pragma unroll
                for (int ci = 0; ci < 9; ++ci) acc[ci] += s[ci * 1024 + k] * w;
            }
#pragma unroll
            for (int ci = 0; ci < 9; ++ci) red[(kq * 9 + ci) * 64 + n] = acc[ci];
            __syncthreads();
            for (int i = tid; i < 9 * 64; i += NTHR) {
                const int ci = i >> 6, nn = i & 63;
                float v = p.b_ada[n0 + nn];
#pragma unroll
                for (int q = 0; q < 8; ++q) v += red[(q * 9 + ci) * 64 + nn];
                mod[ci * 6144 + n0 + nn] = v;
            }
        }
        __syncthreads();
    }
}

template <int WHICH> DI void phase_norm(const Params& p) {
    const int tid = threadIdx.x, lane = tid & 63, wv = tid >> 6;
    const float* mod = (const float*)(p.ws + OFF_MOD);
    bf16_t* hb = (bf16_t*)(p.ws + OFF_H);
    const int ntask = M / 8;
    for (int task = blockIdx.x * 8 + wv; task < ntask; task += gridDim.x * 8) {
        const int r_first = task * 8, ci = cond_of(r_first);
        f32x4 fa[4], fb[4];
#pragma unroll
        for (int i = 0; i < 4; ++i) {
            const int col = i * 256 + lane * 4;
            if (WHICH == 3) { fa[i] = *(const f32x4*)(p.g_final + col); fb[i] = (f32x4){0.f, 0.f, 0.f, 0.f}; }
            else {
                const f32x4 g = *(const f32x4*)((WHICH == 1 ? p.g_norm1 : p.g_norm2) + col);
                const f32x4 sc = *(const f32x4*)(mod + ci * 6144 + (WHICH == 1 ? 1024 : 4096) + col);
                fb[i] = *(const f32x4*)(mod + ci * 6144 + (WHICH == 1 ? 0 : 3072) + col);
                fa[i] = g * (sc + 1.0f);
            }
        }
        for (int rr = 0; rr < 8; ++rr) {
            const int r = r_first + rr;
            const float* src = WHICH == 1 ? xrow(p, r) : p.out + OUT_Y + (size_t)r * D;
            f32x4 v[4]; float ss = 0.f;
#pragma unroll
            for (int i = 0; i < 4; ++i) { v[i] = *(const f32x4*)(src + i * 256 + lane * 4); ss += v[i][0] * v[i][0] + v[i][1] * v[i][1] + v[i][2] * v[i][2] + v[i][3] * v[i][3]; }
            ss = wave_sum(ss);
            const float rstd = 1.0f / sqrtf(ss * (1.0f / 1024.0f) + 1e-6f);
#pragma unroll
            for (int i = 0; i < 4; ++i) {
                const f32x4 o = v[i] * rstd * fa[i] + fb[i];
                if (WHICH == 3) *(f32x4*)(p.out + OUT_Y + (size_t)r * D + i * 256 + lane * 4) = o;
                else *(u32x2*)(hb + (size_t)r * D + i * 256 + lane * 4) = pack4(o);
            }
        }
    }
}

template <int NB> DI void gemm_stage(const bf16_t* A, int lda, const bf16_t* Bt, int ldb, int k0, char* sbuf, int tid) {
#pragma unroll
    for (int i = 0; i < 4; ++i) {
        const int c = tid + i * 512, row = c >> 3, pos = c & 7, kc = pos ^ ((row >> 1) & 7);
        __builtin_amdgcn_global_load_lds((const unsigned*)(A + (size_t)row * lda + k0 + kc * 8), (unsigned*)(sbuf + c * 16), 16, 0, 0);
    }
#pragma unroll
    for (int i = 0; i < NB / 2; ++i) {
        const int c = tid + i * 512, row = c >> 3, pos = c & 7, kc = pos ^ ((row >> 1) & 7);
        __builtin_amdgcn_global_load_lds((const unsigned*)(Bt + (size_t)row * ldb + k0 + kc * 8), (unsigned*)(sbuf + 32768 + c * 16), 16, 0, 0);
    }
}
template <int NB> DI void gemm_acc(f32x4 (&acc)[4][NB], const bf16_t* A, int lda, const bf16_t* Bt, int ldb, int K, char* smem, int tid) {
    const int wid = tid >> 6, lane = tid & 63, fr = lane & 15, fq = lane >> 4, wr = wid >> 1, wc = wid & 1;
    const int swz = (fr >> 1) & 7;
    const int nk = K >> 6;
    __syncthreads();
    gemm_stage<NB>(A, lda, Bt, ldb, 0, smem, tid);
#pragma unroll 1
    for (int t = 0; t < nk; ++t) {
        asm volatile("s_waitcnt vmcnt(0)" ::: "memory");
        __syncthreads();
        if (t + 1 < nk) gemm_stage<NB>(A, lda, Bt, ldb, (t + 1) * 64, smem + ((t + 1) & 1) * 49152, tid);
        const char* sA = smem + (t & 1) * 49152;
        const char* sB = sA + 32768;
#pragma unroll
        for (int ks = 0; ks < 2; ++ks) {
            bf16x8 af[4], bfr[NB];
            const int coff = ((ks * 4 + fq) ^ swz) << 4;
#pragma unroll
            for (int mb = 0; mb < 4; ++mb) af[mb] = *(const bf16x8*)(sA + (wr * 64 + mb * 16 + fr) * 128 + coff);
#pragma unroll
            for (int nb = 0; nb < NB; ++nb) bfr[nb] = *(const bf16x8*)(sB + (wc * 16 * NB + nb * 16 + fr) * 128 + coff);
#pragma unroll
            for (int mb = 0; mb < 4; ++mb)
#pragma unroll
                for (int nb = 0; nb < NB; ++nb) acc[mb][nb] = __builtin_amdgcn_mfma_f32_16x16x32_bf16(bfr[nb], af[mb], acc[mb][nb], 0, 0, 0);
        }
    }
}
template <int NB> DI void zero_acc(f32x4 (&acc)[4][NB]) {
#pragma unroll
    for (int a = 0; a < 4; ++a)
#pragma unroll
        for (int b = 0; b < NB; ++b) acc[a][b] = (f32x4){0.f, 0.f, 0.f, 0.f};
}
DI void tile_coords(int t, int MT, int NT, int& mt, int& nt) {
    const int x = t & 7, u = t >> 3, mpx = MT >> 3;
    const int bm = (mpx % 4 == 0) ? 4 : ((mpx % 2 == 0) ? 2 : 1);
    const int per_band = bm * NT, band = u / per_band, rem = u - band * per_band;
    nt = rem / bm; mt = x * mpx + band * bm + (rem % bm);
}

DI void phase_p1(const Params& p, char* smem) {
    const int tid = threadIdx.x, wid = tid >> 6, lane = tid & 63, fr = lane & 15, fq = lane >> 4, wr = wid >> 1, wc = wid & 1;
    unsigned char* ws = p.ws;
    const bf16_t* hb = (const bf16_t*)(ws + OFF_H);
    const bf16_t* wt = (const bf16_t*)(ws + OFF_WIN);
    const f32x2* tab = (const f32x2*)(ws + OFF_ROPE);
    bf16_t* qb = (bf16_t*)(ws + OFF_Q); bf16_t* kb = (bf16_t*)(ws + OFF_KB); bf16_t* vT = (bf16_t*)(ws + OFF_VT);
    bf16_t* zr = (bf16_t*)(p.out + OUT_Y);
    const int MT = M / 256, NT = 21;
    for (int t = blockIdx.x; t < MT * NT; t += gridDim.x) {
        int mt, nt; tile_coords(t, MT, NT, mt, nt);
        const int row0 = mt * 256, ncol0 = nt < 6 ? nt * 128 : 2816 + (nt - 6) * 128;
        f32x4 acc[4][4]; zero_acc<4>(acc);
        gemm_acc<4>(acc, hb + (size_t)row0 * 1024, 1024, wt + (size_t)ncol0 * 1024, 1024, 1024, smem, tid);
        const bool latent = row0 >= MC;
#pragma unroll
        for (int mb = 0; mb < 4; ++mb) {
            const int m = row0 + wr * 64 + mb * 16 + fr;
            if (nt < 5 && latent) {
                const int tt = (m - MC) & 2047, prow = tt >> 6, pcol = tt & 63;
#pragma unroll
                for (int j = 0; j < 4; ++j) {
                    const f32x2 cr = tab[prow * 16 + fq * 4 + j], cc = tab[pcol * 16 + fq * 4 + j];
                    const float a1 = acc[mb][0][j], a2 = acc[mb][1][j], b1 = acc[mb][2][j], b2 = acc[mb][3][j];
                    acc[mb][0][j] = a1 * cr.x - a2 * cr.y; acc[mb][1][j] = a2 * cr.x + a1 * cr.y;
                    acc[mb][2][j] = b1 * cc.x - b2 * cc.y; acc[mb][3][j] = b2 * cc.x + b1 * cc.y;
                }
            }
#pragma unroll
            for (int nb = 0; nb < 4; ++nb) {
                const int nl = wc * 64 + nb * 16 + fq * 4;
                const f32x4 v = acc[mb][nb];
                if (nt < 4) { *(u32x2*)(qb + (size_t)m * 512 + nt * 128 + nl) = pack4(v); }
                else if (nt == 4) {
                    if (!latent) *(f32x4*)(p.out + OUT_K + (size_t)m * 128 + nl) = v;
                    *(u32x2*)(kb + (size_t)m * 128 + nl) = pack4(v);
                } else if (nt == 5) {
                    if (!latent) *(f32x4*)(p.out + OUT_V + (size_t)m * 128 + nl) = v;
                    int r0, T; seq_of(m, r0, T);
#pragma unroll
                    for (int j = 0; j < 4; ++j) vT[(size_t)r0 * 128 + (size_t)(nl + j) * T + (m - r0)] = f2bf(v[j]);
                } else { *(u32x2*)(zr + (size_t)m * ZRC + (nt - 6) * 128 + nl) = pack4(v); }
            }
        }
    }
}

#define MFMA32(a, b, c) __builtin_amdgcn_mfma_f32_32x32x16_bf16((a), (b), (c), 0, 0, 0)
DI int crow(int i, int h) { return (i & 3) + 8 * (i >> 2) + 4 * h; }

DI void phase_attn(const Params& p, char* smem) {
    const int tid = threadIdx.x, wv = tid >> 6, lane = tid & 63, r = lane & 31, hh = lane >> 5;
    unsigned char* ws = p.ws;
    const bf16_t* qb = (const bf16_t*)(ws + OFF_Q); const bf16_t* kb = (const bf16_t*)(ws + OFF_KB); const bf16_t* vT = (const bf16_t*)(ws + OFF_VT);
    const bf16_t* kc = (const bf16_t*)(ws + OFF_KC); const bf16_t* vct = (const bf16_t*)(ws + OFF_VCT);
    bf16_t* ab = (bf16_t*)(ws + OFF_ATTN);
    bf16_t* Ks = (bf16_t*)smem;
    bf16_t* Vt = (bf16_t*)(smem + 9216);
    const float SC = 0.125f * LOG2E;
    for (int it = blockIdx.x; it < 768; it += gridDim.x) {
        int r0, T, q0, kvh, bl;
        const bool lat = it < 512;
        if (lat) { bl = it >> 6; const int rem = it & 63; q0 = (rem >> 1) * 64; kvh = rem & 1; r0 = MC + bl * 2048; T = 2048; }
        else { const int i2 = it - 512; bl = 0; const int s = i2 >> 3, rem = i2 & 7; q0 = (rem >> 1) * 64; kvh = rem & 1; r0 = s * 256; T = 256; }
        const int head = kvh * 4 + (wv & 3), sub = wv >> 2, qs = q0 + 32 * sub;
        bf16x8 qf[4];
#pragma unroll
        for (int kk = 0; kk < 4; ++kk) qf[kk] = *(const bf16x8*)(qb + (size_t)(r0 + qs + r) * 512 + head * 64 + 16 * kk + 8 * hh);
        const float sinkl = p.attn_sink[head] * LOG2E;
        float mrun = sinkl, lrun = hh == 0 ? 1.0f : 0.0f;
        f32x16 o0, o1;
#pragma unroll
        for (int i = 0; i < 16; ++i) { o0[i] = 0.f; o1[i] = 0.f; }
        const int nwin = lat ? 5 : 4, ntile = lat ? 13 : 4;
        for (int ti = 0; ti < ntile; ++ti) {
            const bf16_t* ksrc; const bf16_t* vsrc; int vstride, ks0; bool window;
            if (ti < nwin) {
                ks0 = lat ? q0 - 128 + 64 * ti : 64 * ti; window = lat;
                if (ks0 < 0 || ks0 >= T) continue;
                ksrc = kb + (size_t)(r0 + ks0) * 128 + kvh * 64; vsrc = vT + (size_t)r0 * 128 + (size_t)(kvh * 64) * T + ks0; vstride = T;
            } else {
                ks0 = 64 * (ti - nwin); window = false;
                ksrc = kc + (size_t)(bl * 512 + ks0) * 128 + kvh * 64; vsrc = vct + (size_t)((bl * 2 + kvh) * 64) * 512 + ks0; vstride = 512;
            }
            __syncthreads();
            {
                const int rw_ = tid >> 3, ch = tid & 7;
                *(u32x4*)(Ks + rw_ * 72 + ch * 8) = *(const u32x4*)(ksrc + (size_t)rw_ * 128 + ch * 8);
                *(u32x4*)(Vt + rw_ * 72 + ch * 8) = *(const u32x4*)(vsrc + (size_t)rw_ * vstride + ch * 8);
            }
            __syncthreads();
#pragma unroll
            for (int sk = 0; sk < 2; ++sk) {
                const int kb0 = ks0 + 32 * sk;
                bool need_mask = false;
                if (window) {
                    if (kb0 > qs + 31 + 128 || kb0 + 31 < qs - 128) continue;
                    need_mask = (kb0 < qs + 31 - 128) || (kb0 + 31 > qs + 128);
                }
                f32x16 x;
#pragma unroll
                for (int i = 0; i < 16; ++i) x[i] = 0.f;
#pragma unroll
                for (int kk = 0; kk < 4; ++kk) {
                    const bf16x8 kf = *(const bf16x8*)(Ks + (32 * sk + r) * 72 + 16 * kk + 8 * hh);
                    x = MFMA32(kf, qf[kk], x);
                }
                float mx = -3.0e38f;
#pragma unroll
                for (int i = 0; i < 16; ++i) {
                    float s = x[i] * SC;
                    if (need_mask) { const int dk = kb0 + crow(i, hh) - (qs + r); if (dk > 128 || dk < -128) s = -3.0e38f; }
                    x[i] = s; mx = fmaxf(mx, s);
                }
                mx = fmaxf(mx, __shfl_xor(mx, 32));
                const float mnew = fmaxf(mrun, mx), alpha = exp2f(mrun - mnew);
                mrun = mnew;
                float ps = 0.f;
#pragma unroll
                for (int i = 0; i < 16; ++i) { const float pv = exp2f(x[i] - mnew); x[i] = pv; ps += pv; }
                lrun = lrun * alpha + ps;
#pragma unroll
                for (int i = 0; i < 16; ++i) { o0[i] *= alpha; o1[i] *= alpha; }
#pragma unroll
                for (int s = 0; s < 2; ++s) {
                    u32x4 pk;
                    pk[0] = pack2(x[8 * s + 0], x[8 * s + 1]); pk[1] = pack2(x[8 * s + 2], x[8 * s + 3]);
                    pk[2] = pack2(x[8 * s + 4], x[8 * s + 5]); pk[3] = pack2(x[8 * s + 6], x[8 * s + 7]);
                    const bf16x8 pf = __builtin_bit_cast(bf16x8, pk);
                    {
                        const s16x4 lo = *(const s16x4*)(Vt + r * 72 + 32 * sk + 16 * s + 4 * hh);
                        const s16x4 hi = *(const s16x4*)(Vt + r * 72 + 32 * sk + 16 * s + 8 + 4 * hh);
                        const bf16x8 vf = __builtin_shufflevector(lo, hi, 0, 1, 2, 3, 4, 5, 6, 7);
                        o0 = MFMA32(vf, pf, o0);
                    }
                    {
                        const s16x4 lo = *(const s16x4*)(Vt + (32 + r) * 72 + 32 * sk + 16 * s + 4 * hh);
                        const s16x4 hi = *(const s16x4*)(Vt + (32 + r) * 72 + 32 * sk + 16 * s + 8 + 4 * hh);
                        const bf16x8 vf = __builtin_shufflevector(lo, hi, 0, 1, 2, 3, 4, 5, 6, 7);
                        o1 = MFMA32(vf, pf, o1);
                    }
                }
            }
        }
        const float ltot = lrun + __shfl_xor(lrun, 32), inv = 1.0f / ltot;
        bf16_t* orow = ab + (size_t)(r0 + qs + r) * 512 + head * 64;
#pragma unroll
        for (int g = 0; g < 4; ++g) {
            f32x4 a, b;
#pragma unroll
            for (int j = 0; j < 4; ++j) { a[j] = o0[4 * g + j] * inv; b[j] = o1[4 * g + j] * inv; }
            *(u32x2*)(orow + 8 * g + 4 * hh) = pack4(a);
            *(u32x2*)(orow + 32 + 8 * g + 4 * hh) = pack4(b);
        }
    }
    {
        const bf16_t* zr = (const bf16_t*)(p.out + OUT_Y);
        bf16_t* sg = (bf16_t*)(ws + OFF_SG);
        const float* mu0 = p.rwkv_mu; const float* mu1 = p.rwkv_mu + ZRC;
        for (int i = blockIdx.x * NTHR + tid; i < M * 32; i += gridDim.x * NTHR) {
            const int m = i >> 5, c = (i & 31) * 4;
            int r0, T; seq_of(m, r0, T);
            const bf16_t* zp = zr + (size_t)m * ZRC + 1792 + c;
            const f32x4 z = unpack4(*(const u32x2*)zp);
            f32x4 zprev = (f32x4){0.f, 0.f, 0.f, 0.f}, znext = zprev;
            if (m > r0) zprev = unpack4(*(const u32x2*)(zp - ZRC));
            if (m < r0 + T - 1) znext = unpack4(*(const u32x2*)(zp + ZRC));
            const f32x4 a0 = *(const f32x4*)(mu0 + 1792 + c), a1 = *(const f32x4*)(mu1 + 1792 + c);
            f32x4 o;
#pragma unroll
            for (int j = 0; j < 4; ++j) { const float zs = z[j] + a0[j] * (zprev[j] - z[j]) + a1[j] * (znext[j] - z[j]); o[j] = sigmoidf_(zs); }
            *(u32x2*)(sg + (size_t)m * 128 + c) = pack4(o);
        }
    }
}

constexpr int SC_OPW = 0, SC_OPK = 8192, SC_OPA = 16384, SC_OPB = 24576, SC_OPR = 32768, SC_OPV = 40960;
constexpr int SC_AW = 49152, SC_AA = SC_AW + 32 * 144;
constexpr int SC_LO = SC_AA + 32 * 144;
constexpr int SC_YB = SC_LO + 2 * 32 * 68 * 4;
static_assert(SC_YB + 8192 <= LDS_BYTES, "scan LDS");

DI void scan_item(const Params& p, char* smem, int r0, int T, int dsel, int h, const float* state0, float* state_out) {
    const int tid = threadIdx.x, wv = tid >> 6, lane = tid & 63;
    unsigned char* ws = p.ws;
    const bf16_t* zr = (const bf16_t*)(p.out + OUT_Y);
    float* ys = (float*)(ws + OFF_YS) + (size_t)dsel * M * 512;
    float* bn = (float*)(ws + OFF_BN);
    float* opW = (float*)(smem + SC_OPW); float* opK = (float*)(smem + SC_OPK); float* opA = (float*)(smem + SC_OPA);
    float* opB = (float*)(smem + SC_OPB); float* opR = (float*)(smem + SC_OPR); float* opV = (float*)(smem + SC_OPV);
    bf16_t* Aw = (bf16_t*)(smem + SC_AW); bf16_t* Aa = (bf16_t*)(smem + SC_AA);
    float* Lo = (float*)(smem + SC_LO); float* yb = (float*)(smem + SC_YB);

    const int rr = lane & 7, jp = lane >> 3, irow = 8 * wv + rr;
    float S[8];
    if (state0) {
        const f32x4 a = *(const f32x4*)(state0 + irow * 64 + 8 * jp), b = *(const f32x4*)(state0 + irow * 64 + 8 * jp + 4);
        S[0] = a[0]; S[1] = a[1]; S[2] = a[2]; S[3] = a[3]; S[4] = b[0]; S[5] = b[1]; S[6] = b[2]; S[7] = b[3];
    } else {
#pragma unroll
        for (int e = 0; e < 8; ++e) S[e] = 0.f;
    }
    const int tt = tid >> 4, cg4 = (tid & 15) * 4;
    const int segc[5] = {h * 64 + cg4, 512 + h * 64 + cg4, 1024 + h * 64 + cg4, 1536 + dsel * 64 + cg4, 1664 + dsel * 64 + cg4};
    f32x4 mu0[5], mu1[5];
#pragma unroll
    for (int s = 0; s < 5; ++s) { mu0[s] = *(const f32x4*)(p.rwkv_mu + segc[s]); mu1[s] = *(const f32x4*)(p.rwkv_mu + ZRC + segc[s]); }
    const f32x4 w0v = *(const f32x4*)(p.rwkv_w0 + dsel * 512 + h * 64 + cg4), a0v = *(const f32x4*)(p.rwkv_a0 + dsel * 512 + h * 64 + cg4);
    const f32x4 kkv = *(const f32x4*)(p.rwkv_k_k + h * 64 + cg4), kav = *(const f32x4*)(p.rwkv_k_a + h * 64 + cg4), rkv = *(const f32x4*)(p.rwkv_r_k + h * 64 + cg4);
    bf16x8 wfrag[4];
    {
        const int L = (wv >> 1) & 1, nbk = wv & 1, r = lane & 31, hh = lane >> 5;
        const bf16_t* wt = (const bf16_t*)(ws + (L == 0 ? OFF_W2T : OFF_A2T)) + (size_t)(dsel * 512 + h * 64 + nbk * 32 + r) * 64;
#pragma unroll
        for (int ks = 0; ks < 4; ++ks) wfrag[ks] = *(const bf16x8*)(wt + 16 * ks + 8 * hh);
    }
    u32x2 zc[5], zp[5], zn[5];
    auto load_chunk = [&](int c) {
        const int st = 32 * c + tt, tok = dsel ? T - 1 - st : st;
        const bf16_t* base = zr + (size_t)(r0 + tok) * ZRC;
#pragma unroll
        for (int s = 0; s < 5; ++s) {
            zc[s] = *(const u32x2*)(base + segc[s]);
            zp[s] = (u32x2){0u, 0u}; zn[s] = (u32x2){0u, 0u};
            if (tok > 0) zp[s] = *(const u32x2*)(base - ZRC + segc[s]);
            if (tok < T - 1) zn[s] = *(const u32x2*)(base + ZRC + segc[s]);
        }
    };
    const int nchunk = T >> 5;
    load_chunk(0);
    for (int c = 0; c < nchunk; ++c) {
        const int st = 32 * c + tt, tok = dsel ? T - 1 - st : st, m = r0 + tok;
        f32x4 zs[5];
#pragma unroll
        for (int s = 0; s < 5; ++s) {
            const f32x4 z = unpack4(zc[s]), a = unpack4(zp[s]), b = unpack4(zn[s]);
            zs[s] = z + mu0[s] * (a - z) + mu1[s] * (b - z);
        }
        f32x4 kk = zs[1] * kkv;
        float n2 = kk[0] * kk[0] + kk[1] * kk[1] + kk[2] * kk[2] + kk[3] * kk[3];
        n2 += __shfl_xor(n2, 1); n2 += __shfl_xor(n2, 2); n2 += __shfl_xor(n2, 4); n2 += __shfl_xor(n2, 8);
        kk = kk * (1.0f / fmaxf(sqrtf(n2), 1e-12f));
        {
            f32x4 tw; tw[0] = tanhf(zs[3][0]); tw[1] = tanhf(zs[3][1]); tw[2] = tanhf(zs[3][2]); tw[3] = tanhf(zs[3][3]);
            *(u32x2*)(Aw + tt * 72 + cg4) = pack4(tw);
            *(u32x2*)(Aa + tt * 72 + cg4) = pack4(zs[4]);
            *(f32x4*)(opR + tt * 64 + cg4) = zs[0];
            *(f32x4*)(opV + tt * 64 + cg4) = zs[2];
            *(f32x4*)(opA + tt * 64 + cg4) = -kk;
        }
        __syncthreads();
        if (wv < 4) {
            const int L = wv >> 1, nbk = wv & 1, r = lane & 31, hh = lane >> 5;
            const bf16_t* As = L == 0 ? Aw : Aa;
            f32x16 x;
#pragma unroll
            for (int i = 0; i < 16; ++i) x[i] = 0.f;
#pragma unroll
            for (int ks = 0; ks < 4; ++ks) {
                const bf16x8 af = *(const bf16x8*)(As + r * 72 + 16 * ks + 8 * hh);
                x = MFMA32(af, wfrag[ks], x);
            }
#pragma unroll
            for (int i = 0; i < 16; ++i) Lo[(L * 32 + crow(i, hh)) * 68 + nbk * 32 + r] = x[i];
        }
        __syncthreads();
        {
            const f32x4 lw = *(const f32x4*)(Lo + tt * 68 + cg4), la = *(const f32x4*)(Lo + (32 + tt) * 68 + cg4);
            f32x4 wd, kd, bb; float bs = 0.f;
#pragma unroll
            for (int j = 0; j < 4; ++j) {
                wd[j] = __expf(-0.6065306597126334f * sigmoidf_(w0v[j] + lw[j]));
                const float a = sigmoidf_(a0v[j] + la[j]);
                kd[j] = zs[1][j] * (1.0f + (a - 1.0f) * kav[j]);
                bb[j] = a * kk[j];
                bs += zs[0][j] * kd[j] * rkv[j];
            }
            *(f32x4*)(opW + tt * 64 + cg4) = wd;
            *(f32x4*)(opK + tt * 64 + cg4) = kd;
            *(f32x4*)(opB + tt * 64 + cg4) = bb;
            bs += __shfl_xor(bs, 1); bs += __shfl_xor(bs, 2); bs += __shfl_xor(bs, 4); bs += __shfl_xor(bs, 8);
            if ((tid & 15) == 0) bn[(size_t)m * 16 + dsel * 8 + h] = bs;
        }
        __syncthreads();
        if (c + 1 < nchunk) load_chunk(c + 1);
#pragma unroll 2
        for (int s = 0; s < 32; ++s) {
            const f32x4 wa = *(const f32x4*)(opW + s * 64 + 8 * jp), wb = *(const f32x4*)(opW + s * 64 + 8 * jp + 4);
            const f32x4 ka = *(const f32x4*)(opK + s * 64 + 8 * jp), kb_ = *(const f32x4*)(opK + s * 64 + 8 * jp + 4);
            const f32x4 aa = *(const f32x4*)(opA + s * 64 + 8 * jp), ab_ = *(const f32x4*)(opA + s * 64 + 8 * jp + 4);
            const f32x4 ba = *(const f32x4*)(opB + s * 64 + 8 * jp), bb_ = *(const f32x4*)(opB + s * 64 + 8 * jp + 4);
            const f32x4 ra = *(const f32x4*)(opR + s * 64 + 8 * jp), rb_ = *(const f32x4*)(opR + s * 64 + 8 * jp + 4);
            const float vv = opV[s * 64 + irow];
            const float wq[8] = {wa[0], wa[1], wa[2], wa[3], wb[0], wb[1], wb[2], wb[3]};
            const float kq[8] = {ka[0], ka[1], ka[2], ka[3], kb_[0], kb_[1], kb_[2], kb_[3]};
            const float aq[8] = {aa[0], aa[1], aa[2], aa[3], ab_[0], ab_[1], ab_[2], ab_[3]};
            const float bq[8] = {ba[0], ba[1], ba[2], ba[3], bb_[0], bb_[1], bb_[2], bb_[3]};
            const float rq[8] = {ra[0], ra[1], ra[2], ra[3], rb_[0], rb_[1], rb_[2], rb_[3]};
            float sa0 = 0.f, sa1 = 0.f;
#pragma unroll
            for (int e = 0; e < 8; e += 2) { sa0 += S[e] * aq[e]; sa1 += S[e + 1] * aq[e + 1]; }
            float sa = sa0 + sa1;
            sa += __shfl_xor(sa, 8); sa += __shfl_xor(sa, 16); sa += __shfl_xor(sa, 32);
            float y0 = 0.f, y1 = 0.f;
#pragma unroll
            for (int e = 0; e < 8; e += 2) {
                float t0 = sa * bq[e]; t0 += vv * kq[e]; t0 += S[e] * wq[e]; S[e] = t0; y0 += t0 * rq[e];
                float t1 = sa * bq[e + 1]; t1 += vv * kq[e + 1]; t1 += S[e + 1] * wq[e + 1]; S[e + 1] = t1; y1 += t1 * rq[e + 1];
            }
            float y = y0 + y1;
            y += __shfl_xor(y, 8); y += __shfl_xor(y, 16); y += __shfl_xor(y, 32);
            if (jp == 0) yb[s * 64 + irow] = y;
        }
        __syncthreads();
        *(f32x4*)(ys + (size_t)m * 512 + h * 64 + cg4) = *(const f32x4*)(yb + tt * 64 + cg4);
    }
    if (state_out) {
        f32x4 a, b; a[0] = S[0]; a[1] = S[1]; a[2] = S[2]; a[3] = S[3]; b[0] = S[4]; b[1] = S[5]; b[2] = S[6]; b[3] = S[7];
        *(f32x4*)(state_out + irow * 64 + 8 * jp) = a; *(f32x4*)(state_out + irow * 64 + 8 * jp + 4) = b;
    }
    __syncthreads();
}

DI void scan_dispatch(const Params& p, char* smem, int it) {
    if (it < 128) {
        const int b = it >> 4, dsel = (it >> 3) & 1, h = it & 7;
        scan_item(p, smem, MC + b * 2048, 2048, dsel, h, p.state_rwkv + (size_t)((b * 2 + dsel) * 8 + h) * 4096, nullptr);
    } else {
        const int i2 = it - 128, s = i2 >> 4, dsel = (i2 >> 3) & 1, h = i2 & 7;
        scan_item(p, smem, s * 256, 256, dsel, h, nullptr, p.out + OUT_S + (size_t)((s * 2 + dsel) * 8 + h) * 4096);
    }
}
DI void phase_scan(const Params& p, char* smem) {
    const int nb = gridDim.x, bid = blockIdx.x;
    if (nb >= 256) {
        if (bid < 128) scan_dispatch(p, smem, bid);
        else for (int it = 128 + (bid - 128); it < 640; it += nb - 128) scan_dispatch(p, smem, it);
    } else {
        for (int it = bid; it < 640; it += nb) scan_dispatch(p, smem, it);
    }
}

DI void phase_post(const Params& p, char* smem) {
    const int tid = threadIdx.x, wid = tid >> 6, lane = tid & 63, fr = lane & 15, fq = lane >> 4, wr = wid >> 1, wc = wid & 1;
    unsigned char* ws = p.ws;
    const bf16_t* sg = (const bf16_t*)(ws + OFF_SG); const bf16_t* g2t = (const bf16_t*)(ws + OFF_G2T);
    const float* ys0 = (const float*)(ws + OFF_YS); const float* ys1 = ys0 + (size_t)M * 512;
    const float* bn = (const float*)(ws + OFF_BN);
    const bf16_t* zr = (const bf16_t*)(p.out + OUT_Y);
    bf16_t* rw = (bf16_t*)(ws + OFF_RW);
    const int MT = M / 256, NT = 4;
    for (int t = blockIdx.x; t < MT * NT; t += gridDim.x) {
        int mt, nt; tile_coords(t, MT, NT, mt, nt);
        const int row0 = mt * 256;
        f32x4 acc[4][4]; zero_acc<4>(acc);
        gemm_acc<4>(acc, sg + (size_t)row0 * 128, 128, g2t + (size_t)(nt * 128) * 128, 128, 128, smem, tid);
        const int head = nt * 2 + wc;
#pragma unroll
        for (int mb = 0; mb < 4; ++mb) {
            const int m = row0 + wr * 64 + mb * 16 + fr;
            int r0, T; seq_of(m, r0, T);
            f32x4 y[4]; float s1 = 0.f;
#pragma unroll
            for (int nb = 0; nb < 4; ++nb) {
                const size_t o = (size_t)m * 512 + head * 64 + nb * 16 + fq * 4;
                y[nb] = *(const f32x4*)(ys0 + o) + *(const f32x4*)(ys1 + o);
                s1 += y[nb][0] + y[nb][1] + y[nb][2] + y[nb][3];
            }
            s1 += __shfl_xor(s1, 16); s1 += __shfl_xor(s1, 32);
            const float mean = s1 * (1.0f / 64.0f);
            float s2 = 0.f;
#pragma unroll
            for (int nb = 0; nb < 4; ++nb) { const f32x4 dlt = y[nb] - mean; s2 += dlt[0] * dlt[0] + dlt[1] * dlt[1] + dlt[2] * dlt[2] + dlt[3] * dlt[3]; }
            s2 += __shfl_xor(s2, 16); s2 += __shfl_xor(s2, 32);
            const float rstd = 1.0f / sqrtf(s2 * (1.0f / 64.0f) + 64e-5f);
            const float bonus = bn[(size_t)m * 16 + head] + bn[(size_t)m * 16 + 8 + head];
#pragma unroll
            for (int nb = 0; nb < 4; ++nb) {
                const int c = head * 64 + nb * 16 + fq * 4;
                const bf16_t* zp = zr + (size_t)m * ZRC + 1024 + c;
                const f32x4 z = unpack4(*(const u32x2*)zp);
                f32x4 zprev = (f32x4){0.f, 0.f, 0.f, 0.f}, znext = zprev;
                if (m > r0) zprev = unpack4(*(const u32x2*)(zp - ZRC));
                if (m < r0 + T - 1) znext = unpack4(*(const u32x2*)(zp + ZRC));
                const f32x4 a0 = *(const f32x4*)(p.rwkv_mu + 1024 + c), a1 = *(const f32x4*)(p.rwkv_mu + ZRC + 1024 + c);
                const f32x4 v = z + a0 * (zprev - z) + a1 * (znext - z);
                const f32x4 lg = *(const f32x4*)(p.rwkv_ln_g + c), lb = *(const f32x4*)(p.rwkv_ln_b + c);
                const f32x4 yn = (y[nb] - mean) * rstd * lg + lb;
                const f32x4 o = (yn + v * bonus) * acc[mb][nb];
                *(u32x2*)(rw + (size_t)m * 512 + c) = pack4(o);
            }
        }
    }
}

DI void phase_merge(const Params& p, char* smem) {
    const int tid = threadIdx.x, wid = tid >> 6, lane = tid & 63, fr = lane & 15, fq = lane >> 4, wr = wid >> 1, wc = wid & 1;
    unsigned char* ws = p.ws;
    const bf16_t* hb = (const bf16_t*)(ws + OFF_H); const bf16_t* wt = (const bf16_t*)(ws + OFF_WIN);
    const bf16_t* ab = (const bf16_t*)(ws + OFF_ATTN); const bf16_t* rw = (const bf16_t*)(ws + OFF_RW);
    const bf16_t* wpa = (const bf16_t*)(ws + OFF_WPA); const bf16_t* wpb = (const bf16_t*)(ws + OFF_WPB);
    bf16_t* mg = (bf16_t*)(ws + OFF_MRG);
    const int MT = M / 256, NT = 16;
    for (int t = blockIdx.x; t < MT * NT; t += gridDim.x) {
        int mt, nt; tile_coords(t, MT, NT, mt, nt);
        const int row0 = mt * 256, n0 = nt * 64;
        f32x4 acc[4][2], res[4][2], gate[4][2];
        zero_acc<2>(acc);
        gemm_acc<2>(acc, hb + (size_t)row0 * 1024, 1024, wt + (size_t)(768 + n0) * 1024, 1024, 1024, smem, tid);
#pragma unroll
        for (int a = 0; a < 4; ++a)
#pragma unroll
            for (int b = 0; b < 2; ++b)
#pragma unroll
                for (int j = 0; j < 4; ++j) gate[a][b][j] = sigmoidf_(acc[a][b][j]);
        zero_acc<2>(acc);
        gemm_acc<2>(acc, ab + (size_t)row0 * 512, 512, wpa + (size_t)n0 * 512, 512, 512, smem, tid);
#pragma unroll
        for (int a = 0; a < 4; ++a)
#pragma unroll
            for (int b = 0; b < 2; ++b) res[a][b] = gate[a][b] * acc[a][b];
        zero_acc<2>(acc);
        gemm_acc<2>(acc, hb + (size_t)row0 * 1024, 1024, wt + (size_t)(1792 + n0) * 1024, 1024, 1024, smem, tid);
#pragma unroll
        for (int a = 0; a < 4; ++a)
#pragma unroll
            for (int b = 0; b < 2; ++b)
#pragma unroll
                for (int j = 0; j < 4; ++j) gate[a][b][j] = sigmoidf_(acc[a][b][j]);
        zero_acc<2>(acc);
        gemm_acc<2>(acc, rw + (size_t)row0 * 512, 512, wpb + (size_t)n0 * 512, 512, 512, smem, tid);
#pragma unroll
        for (int mb = 0; mb < 4; ++mb) {
            const int m = row0 + wr * 64 + mb * 16 + fr;
#pragma unroll
            for (int nb = 0; nb < 2; ++nb) {
                const f32x4 o = res[mb][nb] + gate[mb][nb] * acc[mb][nb];
                *(u32x2*)(mg + (size_t)m * 1024 + n0 + wc * 32 + nb * 16 + fq * 4) = pack4(o);
            }
        }
    }
}

DI void phase_out(const Params& p, char* smem) {
    const int tid = threadIdx.x, wid = tid >> 6, lane = tid & 63, fr = lane & 15, fq = lane >> 4, wr = wid >> 1, wc = wid & 1;
    unsigned char* ws = p.ws;
    const bf16_t* mg = (const bf16_t*)(ws + OFF_MRG); const bf16_t* wo = (const bf16_t*)(ws + OFF_WOUT);
    const float* mod = (const float*)(ws + OFF_MOD);
    const int MT = M / 256, NT = 8;
    for (int t = blockIdx.x; t < MT * NT; t += gridDim.x) {
        int mt, nt; tile_coords(t, MT, NT, mt, nt);
        const int row0 = mt * 256, n0 = nt * 128;
        f32x4 acc[4][4]; zero_acc<4>(acc);
        gemm_acc<4>(acc, mg + (size_t)row0 * 1024, 1024, wo + (size_t)n0 * 1024, 1024, 1024, smem, tid);
        const int ci = cond_of(row0);
#pragma unroll
        for (int nb = 0; nb < 4; ++nb) {
            const int n = n0 + wc * 64 + nb * 16 + fq * 4;
            const f32x4 g1 = *(const f32x4*)(mod + ci * 6144 + 2048 + n);
#pragma unroll
            for (int mb = 0; mb < 4; ++mb) {
                const int m = row0 + wr * 64 + mb * 16 + fr;
                const f32x4 xv = *(const f32x4*)(xrow(p, m) + n);
                *(f32x4*)(p.out + OUT_Y + (size_t)m * D + n) = xv + g1 * acc[mb][nb];
            }
        }
    }
}

DI void phase_up(const Params& p, char* smem, int ch) {
    const int tid = threadIdx.x, wid = tid >> 6, lane = tid & 63, fr = lane & 15, fq = lane >> 4, wr = wid >> 1, wc = wid & 1;
    unsigned char* ws = p.ws;
    const bf16_t* hb = (const bf16_t*)(ws + OFF_H); const bf16_t* wu = (const bf16_t*)(ws + OFF_WUP);
    bf16_t* ub = (bf16_t*)(ws + OFF_U);
    const int MT = 16, NT = 44;
    for (int t = blockIdx.x; t < MT * NT; t += gridDim.x) {
        int mt, nt; tile_coords(t, MT, NT, mt, nt);
        const int lrow0 = mt * 256, row0 = ch * 4096 + lrow0, n0 = nt * 128;
        f32x4 acc[4][4]; zero_acc<4>(acc);
        gemm_acc<4>(acc, hb + (size_t)row0 * 1024, 1024, wu + (size_t)n0 * 1024, 1024, 1024, smem, tid);
#pragma unroll
        for (int mb = 0; mb < 4; ++mb) {
            const int ml = lrow0 + wr * 64 + mb * 16 + fr;
#pragma unroll
            for (int nb = 0; nb < 4; ++nb) *(u32x2*)(ub + (size_t)ml * 5632 + n0 + wc * 64 + nb * 16 + fq * 4) = pack4(acc[mb][nb]);
        }
    }
}
DI void phase_conv(const Params& p, int ch) {
    const int tid = threadIdx.x;
    unsigned char* ws = p.ws;
    const bf16_t* ub = (const bf16_t*)(ws + OFF_U);
    bf16_t* act = (bf16_t*)(ws + OFF_ACT);
    const float* cw = p.ffn_conv_w; const float* cb = p.ffn_conv_b;
    const int per_row = DFF / 4;
    for (int i = blockIdx.x * NTHR + tid; i < 4096 * per_row; i += gridDim.x * NTHR) {
        const int ml = i / per_row, c = (i - ml * per_row) * 4, m = ch * 4096 + ml;
        int r0, T; seq_of(m, r0, T);
        const bool hp = m > r0, hn = m < r0 + T - 1;
        f32x4 res[2];
#pragma unroll
        for (int part = 0; part < 2; ++part) {
            const int cc = c + part * DFF;
            const bf16_t* up = ub + (size_t)ml * 5632 + cc;
            const f32x4 u0 = unpack4(*(const u32x2*)up);
            f32x4 um = (f32x4){0.f, 0.f, 0.f, 0.f}, upn = um;
            if (hp) um = unpack4(*(const u32x2*)(up - 5632));
            if (hn) upn = unpack4(*(const u32x2*)(up + 5632));
            const f32x4 w0 = *(const f32x4*)(cw + cc), w1 = *(const f32x4*)(cw + 5632 + cc), w2 = *(const f32x4*)(cw + 2 * 5632 + cc), bb = *(const f32x4*)(cb + cc);
            res[part] = um * w0 + u0 * w1 + upn * w2 + bb;
        }
        f32x4 o;
#pragma unroll
        for (int j = 0; j < 4; ++j) { const float g = res[1][j]; o[j] = g / (1.0f + __expf(-g)) * res[0][j]; }
        *(u32x2*)(act + (size_t)m * DFF + c) = pack4(o);
    }
}
DI void phase_down(const Params& p, char* smem) {
    const int tid = threadIdx.x, wid = tid >> 6, lane = tid & 63, fr = lane & 15, fq = lane >> 4, wr = wid >> 1, wc = wid & 1;
    unsigned char* ws = p.ws;
    const bf16_t* act = (const bf16_t*)(ws + OFF_ACT); const bf16_t* wd = (const bf16_t*)(ws + OFF_WDN);
    const float* mod = (const float*)(ws + OFF_MOD);
    const int MT = M / 256, NT = 8;
    for (int t = blockIdx.x; t < MT * NT; t += gridDim.x) {
        int mt, nt; tile_coords(t, MT, NT, mt, nt);
        const int row0 = mt * 256, n0 = nt * 128;
        f32x4 acc[4][4]; zero_acc<4>(acc);
        gemm_acc<4>(acc, act + (size_t)row0 * DFF, DFF, wd + (size_t)n0 * DFF, DFF, DFF, smem, tid);
        const int ci = cond_of(row0);
#pragma unroll
        for (int nb = 0; nb < 4; ++nb) {
            const int n = n0 + wc * 64 + nb * 16 + fq * 4;
            const f32x4 g2 = *(const f32x4*)(mod + ci * 6144 + 5120 + n);
#pragma unroll
            for (int mb = 0; mb < 4; ++mb) {
                const int m = row0 + wr * 64 + mb * 16 + fr;
                float* px = p.out + OUT_Y + (size_t)m * D + n;
                *(f32x4*)px = *(const f32x4*)px + g2 * acc[mb][nb];
            }
        }
    }
}

constexpr int N_PHASES = 23;
__global__ void __launch_bounds__(NTHR) fwd_kernel(Params p) {
    extern __shared__ __attribute__((aligned(16))) char smem[];
#ifndef PH_MASK
#define PH_MASK 0xffff
#endif
#define RUN_PHASE(ph, bit, call) if (p.ph_lo <= (ph) && (ph) < p.ph_hi) { if ((ph) > p.ph_lo) cg::this_grid().sync(); if (PH_MASK & (bit)) { call; } }
    RUN_PHASE(0, 1, phase_prep(p, smem))
    RUN_PHASE(1, 2, phase_norm<1>(p))
    RUN_PHASE(2, 4, phase_p1(p, smem))
    RUN_PHASE(3, 8, phase_attn(p, smem))
    RUN_PHASE(4, 16, phase_scan(p, smem))
    RUN_PHASE(5, 32, phase_post(p, smem))
    RUN_PHASE(6, 64, phase_merge(p, smem))
    RUN_PHASE(7, 128, phase_out(p, smem))
    RUN_PHASE(8, 256, phase_norm<2>(p))
#pragma unroll 1
    for (int ch = 0; ch < 6; ++ch) {
        RUN_PHASE(9 + 2 * ch, 512, phase_up(p, smem, ch))
        RUN_PHASE(10 + 2 * ch, 1024, phase_conv(p, ch))
    }
    RUN_PHASE(21, 2048, phase_down(p, smem))
    RUN_PHASE(22, 4096, phase_norm<3>(p))
}

extern "C" void kernel_launch(void* const* d_in, const int* in_sizes, int n_in, void* d_out, int out_size, void* d_ws, size_t ws_size, hipStream_t stream) {
    static int grid = 0;
    if (grid == 0) {
        if (n_in != 32 || ws_size < WS_NEED) { fprintf(stderr, "kernel_launch: unexpected inputs (n_in %d, ws %zu, need %zu)\n", n_in, ws_size, (size_t)WS_NEED); grid = -1; return; }
        int dev = 0, cus = 0, per_cu = 0;
        hipGetDevice(&dev);
        hipDeviceGetAttribute(&cus, hipDeviceAttributeMultiprocessorCount, dev);
        hipFuncSetAttribute((const void*)fwd_kernel, hipFuncAttributeMaxDynamicSharedMemorySize, LDS_BYTES);
        hipOccupancyMaxActiveBlocksPerMultiprocessor(&per_cu, (const void*)fwd_kernel, NTHR, LDS_BYTES);
        if (per_cu < 1) { fprintf(stderr, "kernel_launch: occupancy query says %d blocks per CU\n", per_cu); grid = -1; return; }
        grid = cus;
        grid &= ~7;
    }
    if (grid < 0) return;
    Params p{};
    const float** pp = (const float**)&p;
    for (int i = 0; i < 32; ++i) pp[i] = (const float*)d_in[i];
    p.out = (float*)d_out; p.ws = (unsigned char*)d_ws;
#if N_LAUNCH_SPLIT
    for (int ph = 0; ph < N_PHASES; ++ph) {
        p.ph_lo = ph; p.ph_hi = ph + 1;
        hipLaunchKernelGGL(fwd_kernel, dim3(grid), dim3(NTHR), LDS_BYTES, stream, p);
    }
#else
    p.ph_lo = 0; p.ph_hi = N_PHASES;
    void* args[] = {&p};
    hipError_t e = hipLaunchCooperativeKernel((const void*)fwd_kernel, dim3(grid), dim3(NTHR), args, LDS_BYTES, stream);
    if (e != hipSuccess) fprintf(stderr, "cooperative launch failed: %s (grid %d)\n", hipGetErrorString(e), grid);
#endif
}
```

```cpp
#include <hip/hip_runtime.h>
#include <hip/hip_cooperative_groups.h>
#include <cstdio>
namespace cg = cooperative_groups;

#define DI __device__ __forceinline__
typedef unsigned short bf16_t;
typedef short bf16x8 __attribute__((ext_vector_type(8)));
typedef short s16x4 __attribute__((ext_vector_type(4)));
typedef float f32x4 __attribute__((ext_vector_type(4)));
typedef float f32x2 __attribute__((ext_vector_type(2)));
typedef float f32x16 __attribute__((ext_vector_type(16)));
typedef unsigned u32x4 __attribute__((ext_vector_type(4)));
typedef unsigned u32x2 __attribute__((ext_vector_type(2)));

#ifndef N_LAUNCH_SPLIT
#define N_LAUNCH_SPLIT 0
#endif

constexpr int NTHR = 512;
constexpr int D = 1024;
constexpr int MC = 8192;
constexpr int ML = 16384;
constexpr int M = MC + ML;
constexpr int WIN = 4736;
constexpr int ZRC = 1920;
constexpr int DFF = 2816;
constexpr int LDS_MAIN = 98304;
constexpr int LDS_BYTES = LDS_MAIN + 16;
constexpr float LOG2E = 1.4426950408889634f;

constexpr size_t al256(size_t x) { return (x + 255) & ~(size_t)255; }
constexpr size_t OFF_WUP   = 0;
constexpr size_t OFF_WDN   = OFF_WUP + al256((size_t)5632 * 1024 * 2);
constexpr size_t OFF_MOD   = OFF_WDN + al256((size_t)1024 * 2816 * 2);
constexpr size_t OFF_ROPE  = OFF_MOD + al256((size_t)9 * 6144 * 4);
constexpr size_t OFF_W2T   = OFF_ROPE + al256((size_t)64 * 16 * 8);
constexpr size_t OFF_A2T   = OFF_W2T + al256((size_t)2 * 512 * 64 * 2);
constexpr size_t OFF_G2T   = OFF_A2T + al256((size_t)2 * 512 * 64 * 2);
constexpr size_t OFF_KC    = OFF_G2T + al256((size_t)512 * 128 * 2);
constexpr size_t OFF_VCT   = OFF_KC + al256((size_t)8 * 512 * 128 * 2);
constexpr size_t OFF_BAR   = OFF_VCT + al256((size_t)8 * 512 * 128 * 2);
constexpr size_t OFF_H     = OFF_BAR + al256((size_t)3456 * 4);
constexpr size_t OFF_X     = OFF_H + al256((size_t)M * 1024 * 2);
constexpr size_t OFF_WIN   = OFF_X;
constexpr size_t OFF_WPA   = OFF_WIN + al256((size_t)WIN * 1024 * 2);
constexpr size_t OFF_WPB   = OFF_WPA + al256((size_t)1024 * 512 * 2);
constexpr size_t OFF_WOUT  = OFF_WPB + al256((size_t)1024 * 512 * 2);
constexpr size_t OFF_Q     = OFF_WOUT + al256((size_t)1024 * 1024 * 2);
constexpr size_t OFF_RW    = OFF_Q;
constexpr size_t OFF_KB    = OFF_Q + al256((size_t)M * 512 * 2);
constexpr size_t OFF_VT    = OFF_KB + al256((size_t)M * 128 * 2);
constexpr size_t OFF_ATTN  = OFF_VT + al256((size_t)M * 128 * 2);
constexpr size_t OFF_SG    = OFF_ATTN + al256((size_t)M * 512 * 2);
constexpr size_t OFF_BN    = OFF_SG + al256((size_t)M * 128 * 2);
constexpr size_t OFF_YS    = OFF_BN + al256((size_t)M * 16 * 4);
constexpr size_t OFF_MRG   = OFF_YS;
constexpr size_t END_EARLY = OFF_YS + al256((size_t)2 * M * 512 * 4);
constexpr size_t OFF_ACT   = OFF_X;
constexpr size_t OFF_U     = OFF_ACT + al256((size_t)M * DFF * 2);
constexpr size_t END_FFN   = OFF_U + al256((size_t)4096 * 5632 * 2);
constexpr size_t WS_NEED   = END_EARLY > END_FFN ? END_EARLY : END_FFN;
static_assert(WS_NEED <= (size_t)256 * 1024 * 1024, "workspace over 256 MiB");

constexpr size_t OUT_Y  = 0;
constexpr size_t OUT_K  = (size_t)M * 1024;
constexpr size_t OUT_V  = OUT_K + (size_t)MC * 128;
constexpr size_t OUT_S  = OUT_V + (size_t)MC * 128;

struct Params {
    const float *x_prompt, *x_sample, *c, *cache_k, *cache_v, *state_rwkv, *c_ctx, *w_ada, *b_ada, *g_norm1, *w_in, *attn_sink,
        *w_proj_a, *w_proj_b, *rwkv_mu, *rwkv_w0, *rwkv_w2, *rwkv_a0, *rwkv_a2, *rwkv_k_k, *rwkv_k_a, *rwkv_r_k, *rwkv_g2,
        *rwkv_ln_g, *rwkv_ln_b, *w_out, *g_norm2, *w_ffn_up, *ffn_conv_w, *ffn_conv_b, *w_ffn_down, *g_final;
    float* out;
    unsigned char* ws;
    int ph_lo, ph_hi;
};

DI bf16_t f2bf(float f) { unsigned u = __float_as_uint(f); u += 0x7fffu + ((u >> 16) & 1u); return (bf16_t)(u >> 16); }
DI float bf2f(unsigned b) { return __uint_as_float(b << 16); }
DI unsigned pack2(float lo, float hi) { return (unsigned)f2bf(lo) | ((unsigned)f2bf(hi) << 16); }
DI u32x2 pack4(f32x4 v) { u32x2 r; r.x = pack2(v[0], v[1]); r.y = pack2(v[2], v[3]); return r; }
DI f32x4 unpack4(u32x2 v) { f32x4 r; r[0] = bf2f(v.x & 0xffffu); r[1] = bf2f(v.x >> 16); r[2] = bf2f(v.y & 0xffffu); r[3] = bf2f(v.y >> 16); return r; }
DI float sigmoidf_(float x) { return 1.0f / (1.0f + __expf(-x)); }
DI const float* xrow(const Params& p, int r) { return r < MC ? p.x_prompt + (size_t)r * D : p.x_sample + (size_t)(r - MC) * D; }
DI int cond_of(int r) { return r < MC ? 0 : 1 + ((r - MC) >> 11); }
DI void seq_of(int r, int& r0, int& T) { if (r < MC) { r0 = r & ~255; T = 256; } else { r0 = MC + ((r - MC) & ~2047); T = 2048; } }
DI float wave_sum(float v) {
#pragma unroll
    for (int o = 32; o >= 1; o >>= 1) v += __shfl_xor(v, o);
    return v;
}

DI void transpose_tile(const float* __restrict__ src, int K, int N, bf16_t* __restrict__ dst, int kt, int nt, float* tile, int tid) {
    const int k0 = kt * 64, n0 = nt * 64;
#pragma unroll
    for (int i = 0; i < 8; ++i) { const int k = (tid >> 6) + 8 * i, n = tid & 63; tile[k * 65 + n] = src[(size_t)(k0 + k) * N + n0 + n]; }
    __syncthreads();
#pragma unroll
    for (int i = 0; i < 8; ++i) { const int n = (tid >> 6) + 8 * i, k = tid & 63; dst[(size_t)(n0 + n) * K + k0 + k] = f2bf(tile[k * 65 + n]); }
    __syncthreads();
}

DI void phase_prep(const Params& p, char* smem) {
    const int tid = threadIdx.x, nb = gridDim.x, bid = blockIdx.x;
    unsigned char* ws = p.ws;
    {
        float* tile = (float*)smem;
        const int cnt[11] = {16 * 74, 8 * 16, 8 * 16, 16 * 16, 16 * 88, 44 * 16, 8, 8, 8, 8, 16};
        int total = 0;
#pragma unroll
        for (int i = 0; i < 11; ++i) total += cnt[i];
        for (int it = bid; it < total; it += nb) {
            int i = it, mi = 0;
#pragma unroll
            for (int q = 0; q < 10; ++q) { if (mi == q && i >= cnt[q]) { i -= cnt[q]; mi = q + 1; } }
            const float* src; bf16_t* dst; int K, N;
            switch (mi) {
                case 0: src = p.w_in; K = 1024; N = WIN; dst = (bf16_t*)(ws + OFF_WIN); break;
                case 1: src = p.w_proj_a; K = 512; N = 1024; dst = (bf16_t*)(ws + OFF_WPA); break;
                case 2: src = p.w_proj_b; K = 512; N = 1024; dst = (bf16_t*)(ws + OFF_WPB); break;
                case 3: src = p.w_out; K = 1024; N = 1024; dst = (bf16_t*)(ws + OFF_WOUT); break;
                case 4: src = p.w_ffn_up; K = 1024; N = 5632; dst = (bf16_t*)(ws + OFF_WUP); break;
                case 5: src = p.w_ffn_down; K = 2816; N = 1024; dst = (bf16_t*)(ws + OFF_WDN); break;
                case 6: src = p.rwkv_w2; K = 64; N = 512; dst = (bf16_t*)(ws + OFF_W2T); break;
                case 7: src = p.rwkv_w2 + 64 * 512; K = 64; N = 512; dst = (bf16_t*)(ws + OFF_W2T) + 512 * 64; break;
                case 8: src = p.rwkv_a2; K = 64; N = 512; dst = (bf16_t*)(ws + OFF_A2T); break;
                case 9: src = p.rwkv_a2 + 64 * 512; K = 64; N = 512; dst = (bf16_t*)(ws + OFF_A2T) + 512 * 64; break;
                default: src = p.rwkv_g2; K = 128; N = 512; dst = (bf16_t*)(ws + OFF_G2T); break;
            }
            const int ntn = N / 64;
            transpose_tile(src, K, N, dst, i / ntn, i % ntn, tile, tid);
        }
    }
    {
        bf16_t* kc = (bf16_t*)(ws + OFF_KC); bf16_t* vct = (bf16_t*)(ws + OFF_VCT);
        for (int i = bid * NTHR + tid; i < 8 * 512 * 128; i += nb * NTHR) {
            kc[i] = f2bf(p.cache_k[i]);
            const int key = i & 511, d = (i >> 9) & 63, kvh = (i >> 15) & 1, b = i >> 16;
            vct[i] = f2bf(p.cache_v[((size_t)(b * 512 + key) * 2 + kvh) * 64 + d]);
        }
    }
    {
        f32x2* tab = (f32x2*)(ws + OFF_ROPE);
        for (int i = bid * NTHR + tid; i < 1024; i += nb * NTHR) {
            const int pos = i >> 4, fi = i & 15;
            const double fr = pow(10000.0, -(double)fi / 16.0), ang = (double)pos * fr;
            f32x2 v; v.x = (float)cos(ang); v.y = (float)sin(ang); tab[i] = v;
        }
    }
    {
        float* s = (float*)smem;
        float* red = (float*)(smem + 36864);
        float* mod = (float*)(ws + OFF_MOD);
        for (int it = bid; it < 96; it += nb) {
            __syncthreads();
            for (int i = tid; i < 9 * 1024; i += NTHR) {
                const int ci = i >> 10, k = i & 1023;
                const float v = ci == 0 ? p.c_ctx[k] : p.c[(ci - 1) * 1024 + k];
                s[i] = v / (1.0f + __expf(-v));
            }
            __syncthreads();
            const int n = tid & 63, kq = tid >> 6, n0 = it * 64;
            float acc[9];
#pragma unroll
            for (int ci = 0; ci < 9; ++ci) acc[ci] = 0.f;
            for (int k = kq * 128; k < kq * 128 + 128; ++k) {
                const float w = p.w_ada[(size_t)k * 6144 + n0 + n];
#pragma unroll
                for (int ci = 0; ci < 9; ++ci) acc[ci] += s[ci * 1024 + k] * w;
            }
#pragma unroll
            for (int ci = 0; ci < 9; ++ci) red[(kq * 9 + ci) * 64 + n] = acc[ci];
            __syncthreads();
            for (int i = tid; i < 9 * 64; i += NTHR) {
                const int ci = i >> 6, nn = i & 63;
                float v = p.b_ada[n0 + nn];
#pragma unroll
                for (int q = 0; q < 8; ++q) v += red[(q * 9 + ci) * 64 + nn];
                mod[ci * 6144 + n0 + nn] = v;
            }
        }
        __syncthreads();
    }
}

template <int WHICH> DI void phase_norm(const Params& p) {
    const int tid = threadIdx.x, lane = tid & 63, wv = tid >> 6;
    const float* mod = (const float*)(p.ws + OFF_MOD);
    bf16_t* hb = (bf16_t*)(p.ws + OFF_H);
    const int ntask = M / 8;
    for (int task = blockIdx.x * 8 + wv; task < ntask; task += gridDim.x * 8) {
        const int r_first = task * 8, ci = cond_of(r_first);
        f32x4 fa[4], fb[4];
#pragma unroll
        for (int i = 0; i < 4; ++i) {
            const int col = i * 256 + lane * 4;
            if (WHICH == 3) { fa[i] = *(const f32x4*)(p.g_final + col); fb[i] = (f32x4){0.f, 0.f, 0.f, 0.f}; }
            else {
                const f32x4 g = *(const f32x4*)((WHICH == 1 ? p.g_norm1 : p.g_norm2) + col);
                const f32x4 sc = *(const f32x4*)(mod + ci * 6144 + (WHICH == 1 ? 1024 : 4096) + col);
                fb[i] = *(const f32x4*)(mod + ci * 6144 + (WHICH == 1 ? 0 : 3072) + col);
                fa[i] = g * (sc + 1.0f);
            }
        }
        for (int rr = 0; rr < 8; ++rr) {
            const int r = r_first + rr;
            const float* src = WHICH == 1 ? xrow(p, r) : p.out + OUT_Y + (size_t)r * D;
            f32x4 v[4]; float ss = 0.f;
#pragma unroll
            for (int i = 0; i < 4; ++i) { v[i] = *(const f32x4*)(src + i * 256 + lane * 4); ss += v[i][0] * v[i][0] + v[i][1] * v[i][1] + v[i][2] * v[i][2] + v[i][3] * v[i][3]; }
            ss = wave_sum(ss);
            const float rstd = 1.0f / sqrtf(ss * (1.0f / 1024.0f) + 1e-6f);
#pragma unroll
            for (int i = 0; i < 4; ++i) {
                const f32x4 o = v[i] * rstd * fa[i] + fb[i];
                if (WHICH == 3) *(f32x4*)(p.out + OUT_Y + (size_t)r * D + i * 256 + lane * 4) = o;
                else *(u32x2*)(hb + (size_t)r * D + i * 256 + lane * 4) = pack4(o);
            }
        }
    }
}

template <int NB> DI void gemm_stage(const bf16_t* A, int lda, const bf16_t* Bt, int ldb, int k0, char* sbuf, int tid) {
#pragma unroll
    for (int i = 0; i < 4; ++i) {
        const int c = tid + i * 512, row = c >> 3, pos = c & 7, kc = pos ^ ((row >> 1) & 7);
        __builtin_amdgcn_global_load_lds((const unsigned*)(A + (size_t)row * lda + k0 + kc * 8), (unsigned*)(sbuf + c * 16), 16, 0, 0);
    }
#pragma unroll
    for (int i = 0; i < NB / 2; ++i) {
        const int c = tid + i * 512, row = c >> 3, pos = c & 7, kc = pos ^ ((row >> 1) & 7);
        __builtin_amdgcn_global_load_lds((const unsigned*)(Bt + (size_t)row * ldb + k0 + kc * 8), (unsigned*)(sbuf + 32768 + c * 16), 16, 0, 0);
    }
}
template <int NB> DI void gemm_acc(f32x4 (&acc)[4][NB], const bf16_t* A, int lda, const bf16_t* Bt, int ldb, int K, char* smem, int tid) {
    const int wid = tid >> 6, lane = tid & 63, fr = lane & 15, fq = lane >> 4, wr = wid >> 1, wc = wid & 1;
    const int swz = (fr >> 1) & 7;
    const int nk = K >> 6;
    __syncthreads();
    gemm_stage<NB>(A, lda, Bt, ldb, 0, smem, tid);
#pragma unroll 1
    for (int t = 0; t < nk; ++t) {
        asm volatile("s_waitcnt vmcnt(0)" ::: "memory");
        __syncthreads();
        if (t + 1 < nk) gemm_stage<NB>(A, lda, Bt, ldb, (t + 1) * 64, smem + ((t + 1) & 1) * 49152, tid);
        const char* sA = smem + (t & 1) * 49152;
        const char* sB = sA + 32768;
#pragma unroll
        for (int ks = 0; ks < 2; ++ks) {
            bf16x8 af[4], bfr[NB];
            const int coff = ((ks * 4 + fq) ^ swz) << 4;
#pragma unroll
            for (int mb = 0; mb < 4; ++mb) af[mb] = *(const bf16x8*)(sA + (wr * 64 + mb * 16 + fr) * 128 + coff);
#pragma unroll
            for (int nb = 0; nb < NB; ++nb) bfr[nb] = *(const bf16x8*)(sB + (wc * 16 * NB + nb * 16 + fr) * 128 + coff);
#pragma unroll
            for (int mb = 0; mb < 4; ++mb)
#pragma unroll
                for (int nb = 0; nb < NB; ++nb) acc[mb][nb] = __builtin_amdgcn_mfma_f32_16x16x32_bf16(bfr[nb], af[mb], acc[mb][nb], 0, 0, 0);
        }
    }
}
template <int NB> DI void zero_acc(f32x4 (&acc)[4][NB]) {
#pragma unroll
    for (int a = 0; a < 4; ++a)
#pragma unroll
        for (int b = 0; b < NB; ++b) acc[a][b] = (f32x4){0.f, 0.f, 0.f, 0.f};
}
DI void tile_coords(int t, int MT, int NT, int& mt, int& nt) {
    const int x = t & 7, u = t >> 3, mpx = MT >> 3;
    const int bm = (mpx % 4 == 0) ? 4 : ((mpx % 2 == 0) ? 2 : 1);
    const int per_band = bm * NT, band = u / per_band, rem = u - band * per_band;
    nt = rem / bm; mt = x * mpx + band * bm + (rem % bm);
}

DI void phase_p1(const Params& p, char* smem) {
    const int tid = threadIdx.x, wid = tid >> 6, lane = tid & 63, fr = lane & 15, fq = lane >> 4, wr = wid >> 1, wc = wid & 1;
    unsigned char* ws = p.ws;
    const bf16_t* hb = (const bf16_t*)(ws + OFF_H);
    const bf16_t* wt = (const bf16_t*)(ws + OFF_WIN);
    const f32x2* tab = (const f32x2*)(ws + OFF_ROPE);
    bf16_t* qb = (bf16_t*)(ws + OFF_Q); bf16_t* kb = (bf16_t*)(ws + OFF_KB); bf16_t* vT = (bf16_t*)(ws + OFF_VT);
    bf16_t* zr = (bf16_t*)(p.out + OUT_Y);
    const int MT = M / 256, NT = 21;
    for (int t = blockIdx.x; t < MT * NT; t += gridDim.x) {
        int mt, nt; tile_coords(t, MT, NT, mt, nt);
        const int row0 = mt * 256, ncol0 = nt < 6 ? nt * 128 : 2816 + (nt - 6) * 128;
        f32x4 acc[4][4]; zero_acc<4>(acc);
        gemm_acc<4>(acc, hb + (size_t)row0 * 1024, 1024, wt + (size_t)ncol0 * 1024, 1024, 1024, smem, tid);
        const bool latent = row0 >= MC;
#pragma unroll
        for (int mb = 0; mb < 4; ++mb) {
            const int m = row0 + wr * 64 + mb * 16 + fr;
            if (nt < 5 && latent) {
                const int tt = (m - MC) & 2047, prow = tt >> 6, pcol = tt & 63;
#pragma unroll
                for (int j = 0; j < 4; ++j) {
                    const f32x2 cr = tab[prow * 16 + fq * 4 + j], cc = tab[pcol * 16 + fq * 4 + j];
                    const float a1 = acc[mb][0][j], a2 = acc[mb][1][j], b1 = acc[mb][2][j], b2 = acc[mb][3][j];
                    acc[mb][0][j] = a1 * cr.x - a2 * cr.y; acc[mb][1][j] = a2 * cr.x + a1 * cr.y;
                    acc[mb][2][j] = b1 * cc.x - b2 * cc.y; acc[mb][3][j] = b2 * cc.x + b1 * cc.y;
                }
            }
#pragma unroll
            for (int nb = 0; nb < 4; ++nb) {
                const int nl = wc * 64 + nb * 16 + fq * 4;
                const f32x4 v = acc[mb][nb];
                if (nt < 4) { *(u32x2*)(qb + (size_t)m * 512 + nt * 128 + nl) = pack4(v); }
                else if (nt == 4) {
                    if (!latent) *(f32x4*)(p.out + OUT_K + (size_t)m * 128 + nl) = v;
                    *(u32x2*)(kb + (size_t)m * 128 + nl) = pack4(v);
                } else if (nt == 5) {
                    if (!latent) *(f32x4*)(p.out + OUT_V + (size_t)m * 128 + nl) = v;
                    int r0, T; seq_of(m, r0, T);
#pragma unroll
                    for (int j = 0; j < 4; ++j) vT[(size_t)r0 * 128 + (size_t)(nl + j) * T + (m - r0)] = f2bf(v[j]);
                } else { *(u32x2*)(zr + (size_t)m * ZRC + (nt - 6) * 128 + nl) = pack4(v); }
            }
        }
    }
}

#define MFMA32(a, b, c) __builtin_amdgcn_mfma_f32_32x32x16_bf16((a), (b), (c), 0, 0, 0)
DI int crow(int i, int h) { return (i & 3) + 8 * (i >> 2) + 4 * h; }

DI void phase_attn(const Params& p, char* smem) {
    const int tid = threadIdx.x, wv = tid >> 6, lane = tid & 63, r = lane & 31, hh = lane >> 5;
    unsigned char* ws = p.ws;
    const bf16_t* qb = (const bf16_t*)(ws + OFF_Q); const bf16_t* kb = (const bf16_t*)(ws + OFF_KB); const bf16_t* vT = (const bf16_t*)(ws + OFF_VT);
    const bf16_t* kc = (const bf16_t*)(ws + OFF_KC); const bf16_t* vct = (const bf16_t*)(ws + OFF_VCT);
    bf16_t* ab = (bf16_t*)(ws + OFF_ATTN);
    bf16_t* Ks = (bf16_t*)smem;
    bf16_t* Vt = (bf16_t*)(smem + 9216);
    const float SC = 0.125f * LOG2E;
    for (int it = blockIdx.x; it < 768; it += gridDim.x) {
        int r0, T, q0, kvh, bl;
        const bool lat = it < 512;
        if (lat) { bl = it >> 6; const int rem = it & 63; q0 = (rem >> 1) * 64; kvh = rem & 1; r0 = MC + bl * 2048; T = 2048; }
        else { const int i2 = it - 512; bl = 0; const int s = i2 >> 3, rem = i2 & 7; q0 = (rem >> 1) * 64; kvh = rem & 1; r0 = s * 256; T = 256; }
        const int head = kvh * 4 + (wv & 3), sub = wv >> 2, qs = q0 + 32 * sub;
        bf16x8 qf[4];
#pragma unroll
        for (int kk = 0; kk < 4; ++kk) qf[kk] = *(const bf16x8*)(qb + (size_t)(r0 + qs + r) * 512 + head * 64 + 16 * kk + 8 * hh);
        const float sinkl = p.attn_sink[head] * LOG2E;
        float mrun = sinkl, lrun = hh == 0 ? 1.0f : 0.0f;
        f32x16 o0, o1;
#pragma unroll
        for (int i = 0; i < 16; ++i) { o0[i] = 0.f; o1[i] = 0.f; }
        const int nwin = lat ? 5 : 4, ntile = lat ? 13 : 4;
        for (int ti = 0; ti < ntile; ++ti) {
            const bf16_t* ksrc; const bf16_t* vsrc; int vstride, ks0; bool window;
            if (ti < nwin) {
                ks0 = lat ? q0 - 128 + 64 * ti : 64 * ti; window = lat;
                if (ks0 < 0 || ks0 >= T) continue;
                ksrc = kb + (size_t)(r0 + ks0) * 128 + kvh * 64; vsrc = vT + (size_t)r0 * 128 + (size_t)(kvh * 64) * T + ks0; vstride = T;
            } else {
                ks0 = 64 * (ti - nwin); window = false;
                ksrc = kc + (size_t)(bl * 512 + ks0) * 128 + kvh * 64; vsrc = vct + (size_t)((bl * 2 + kvh) * 64) * 512 + ks0; vstride = 512;
            }
            __syncthreads();
            {
                const int rw_ = tid >> 3, ch = tid & 7;
                *(u32x4*)(Ks + rw_ * 72 + ch * 8) = *(const u32x4*)(ksrc + (size_t)rw_ * 128 + ch * 8);
                *(u32x4*)(Vt + rw_ * 72 + ch * 8) = *(const u32x4*)(vsrc + (size_t)rw_ * vstride + ch * 8);
            }
            __syncthreads();
#pragma unroll
            for (int sk = 0; sk < 2; ++sk) {
                const int kb0 = ks0 + 32 * sk;
                bool need_mask = false;
                if (window) {
                    if (kb0 > qs + 31 + 128 || kb0 + 31 < qs - 128) continue;
                    need_mask = (kb0 < qs + 31 - 128) || (kb0 + 31 > qs + 128);
                }
                f32x16 x;
#pragma unroll
                for (int i = 0; i < 16; ++i) x[i] = 0.f;
#pragma unroll
                for (int kk = 0; kk < 4; ++kk) {
                    const bf16x8 kf = *(const bf16x8*)(Ks + (32 * sk + r) * 72 + 16 * kk + 8 * hh);
                    x = MFMA32(kf, qf[kk], x);
                }
                float mx = -3.0e38f;
#pragma unroll
                for (int i = 0; i < 16; ++i) {
                    float s = x[i] * SC;
                    if (need_mask) { const int dk = kb0 + crow(i, hh) - (qs + r); if (dk > 128 || dk < -128) s = -3.0e38f; }
                    x[i] = s; mx = fmaxf(mx, s);
                }
                mx = fmaxf(mx, __shfl_xor(mx, 32));
                const float mnew = fmaxf(mrun, mx), alpha = exp2f(mrun - mnew);
                mrun = mnew;
                float ps = 0.f;
#pragma unroll
                for (int i = 0; i < 16; ++i) { const float pv = exp2f(x[i] - mnew); x[i] = pv; ps += pv; }
                lrun = lrun * alpha + ps;
#pragma unroll
                for (int i = 0; i < 16; ++i) { o0[i] *= alpha; o1[i] *= alpha; }
#pragma unroll
                for (int s = 0; s < 2; ++s) {
                    u32x4 pk;
                    pk[0] = pack2(x[8 * s + 0], x[8 * s + 1]); pk[1] = pack2(x[8 * s + 2], x[8 * s + 3]);
                    pk[2] = pack2(x[8 * s + 4], x[8 * s + 5]); pk[3] = pack2(x[8 * s + 6], x[8 * s + 7]);
                    const bf16x8 pf = __builtin_bit_cast(bf16x8, pk);
                    {
                        const s16x4 lo = *(const s16x4*)(Vt + r * 72 + 32 * sk + 16 * s + 4 * hh);
                        const s16x4 hi = *(const s16x4*)(Vt + r * 72 + 32 * sk + 16 * s + 8 + 4 * hh);
                        const bf16x8 vf = __builtin_shufflevector(lo, hi, 0, 1, 2, 3, 4, 5, 6, 7);
                        o0 = MFMA32(vf, pf, o0);
                    }
                    {
                        const s16x4 lo = *(const s16x4*)(Vt + (32 + r) * 72 + 32 * sk + 16 * s + 4 * hh);
                        const s16x4 hi = *(const s16x4*)(Vt + (32 + r) * 72 + 32 * sk + 16 * s + 8 + 4 * hh);
                        const bf16x8 vf = __builtin_shufflevector(lo, hi, 0, 1, 2, 3, 4, 5, 6, 7);
                        o1 = MFMA32(vf, pf, o1);
                    }
                }
            }
        }
        const float ltot = lrun + __shfl_xor(lrun, 32), inv = 1.0f / ltot;
        bf16_t* orow = ab + (size_t)(r0 + qs + r) * 512 + head * 64;
#pragma unroll
        for (int g = 0; g < 4; ++g) {
            f32x4 a, b;
#pragma unroll
            for (int j = 0; j < 4; ++j) { a[j] = o0[4 * g + j] * inv; b[j] = o1[4 * g + j] * inv; }
            *(u32x2*)(orow + 8 * g + 4 * hh) = pack4(a);
            *(u32x2*)(orow + 32 + 8 * g + 4 * hh) = pack4(b);
        }
    }
    {
        const bf16_t* zr = (const bf16_t*)(p.out + OUT_Y);
        bf16_t* sg = (bf16_t*)(ws + OFF_SG);
        const float* mu0 = p.rwkv_mu; const float* mu1 = p.rwkv_mu + ZRC;
        for (int i = blockIdx.x * NTHR + tid; i < M * 32; i += gridDim.x * NTHR) {
            const int m = i >> 5, c = (i & 31) * 4;
            int r0, T; seq_of(m, r0, T);
            const bf16_t* zp = zr + (size_t)m * ZRC + 1792 + c;
            const f32x4 z = unpack4(*(const u32x2*)zp);
            f32x4 zprev = (f32x4){0.f, 0.f, 0.f, 0.f}, znext = zprev;
            if (m > r0) zprev = unpack4(*(const u32x2*)(zp - ZRC));
            if (m < r0 + T - 1) znext = unpack4(*(const u32x2*)(zp + ZRC));
            const f32x4 a0 = *(const f32x4*)(mu0 + 1792 + c), a1 = *(const f32x4*)(mu1 + 1792 + c);
            f32x4 o;
#pragma unroll
            for (int j = 0; j < 4; ++j) { const float zs = z[j] + a0[j] * (zprev[j] - z[j]) + a1[j] * (znext[j] - z[j]); o[j] = sigmoidf_(zs); }
            *(u32x2*)(sg + (size_t)m * 128 + c) = pack4(o);
        }
    }
}

constexpr int SC_OPW = 0, SC_OPK = 8192, SC_OPA = 16384, SC_OPB = 24576, SC_OPR = 32768, SC_OPV = 40960;
constexpr int SC_AW = 49152, SC_AA = SC_AW + 32 * 144;
constexpr int SC_LO = SC_AA + 32 * 144;
constexpr int SC_YB = SC_LO + 2 * 32 * 68 * 4;
static_assert(SC_YB + 8192 <= LDS_MAIN, "scan LDS");

DI void scan_item(const Params& p, char* smem, int r0, int T, int dsel, int h, const float* state0, float* state_out) {
    const int tid = threadIdx.x, wv = tid >> 6, lane = tid & 63;
    unsigned char* ws = p.ws;
    const bf16_t* zr = (const bf16_t*)(p.out + OUT_Y);
    float* ys = (float*)(ws + OFF_YS) + (size_t)dsel * M * 512;
    float* bn = (float*)(ws + OFF_BN);
    float* opW = (float*)(smem + SC_OPW); float* opK = (float*)(smem + SC_OPK); float* opA = (float*)(smem + SC_OPA);
    float* opB = (float*)(smem + SC_OPB); float* opR = (float*)(smem + SC_OPR); float* opV = (float*)(smem + SC_OPV);
    bf16_t* Aw = (bf16_t*)(smem + SC_AW); bf16_t* Aa = (bf16_t*)(smem + SC_AA);
    float* Lo = (float*)(smem + SC_LO); float* yb = (float*)(smem + SC_YB);

    const int rr = lane & 7, jp = lane >> 3, irow = 8 * wv + rr;
    float S[8];
    if (state0) {
        const f32x4 a = *(const f32x4*)(state0 + irow * 64 + 8 * jp), b = *(const f32x4*)(state0 + irow * 64 + 8 * jp + 4);
        S[0] = a[0]; S[1] = a[1]; S[2] = a[2]; S[3] = a[3]; S[4] = b[0]; S[5] = b[1]; S[6] = b[2]; S[7] = b[3];
    } else {
#pragma unroll
        for (int e = 0; e < 8; ++e) S[e] = 0.f;
    }
    const int tt = tid >> 4, cg4 = (tid & 15) * 4;
    const int segc[5] = {h * 64 + cg4, 512 + h * 64 + cg4, 1024 + h * 64 + cg4, 1536 + dsel * 64 + cg4, 1664 + dsel * 64 + cg4};
    f32x4 mu0[5], mu1[5];
#pragma unroll
    for (int s = 0; s < 5; ++s) { mu0[s] = *(const f32x4*)(p.rwkv_mu + segc[s]); mu1[s] = *(const f32x4*)(p.rwkv_mu + ZRC + segc[s]); }
    const f32x4 w0v = *(const f32x4*)(p.rwkv_w0 + dsel * 512 + h * 64 + cg4), a0v = *(const f32x4*)(p.rwkv_a0 + dsel * 512 + h * 64 + cg4);
    const f32x4 kkv = *(const f32x4*)(p.rwkv_k_k + h * 64 + cg4), kav = *(const f32x4*)(p.rwkv_k_a + h * 64 + cg4), rkv = *(const f32x4*)(p.rwkv_r_k + h * 64 + cg4);
    bf16x8 wfrag[4];
    {
        const int L = (wv >> 1) & 1, nbk = wv & 1, r = lane & 31, hh = lane >> 5;
        const bf16_t* wt = (const bf16_t*)(ws + (L == 0 ? OFF_W2T : OFF_A2T)) + (size_t)(dsel * 512 + h * 64 + nbk * 32 + r) * 64;
#pragma unroll
        for (int ks = 0; ks < 4; ++ks) wfrag[ks] = *(const bf16x8*)(wt + 16 * ks + 8 * hh);
    }
    u32x2 zc[5], zp[5], zn[5];
    auto load_chunk = [&](int c) {
        const int st = 32 * c + tt, tok = dsel ? T - 1 - st : st;
        const bf16_t* base = zr + (size_t)(r0 + tok) * ZRC;
#pragma unroll
        for (int s = 0; s < 5; ++s) {
            zc[s] = *(const u32x2*)(base + segc[s]);
            zp[s] = (u32x2){0u, 0u}; zn[s] = (u32x2){0u, 0u};
            if (tok > 0) zp[s] = *(const u32x2*)(base - ZRC + segc[s]);
            if (tok < T - 1) zn[s] = *(const u32x2*)(base + ZRC + segc[s]);
        }
    };
    const int nchunk = T >> 5;
    load_chunk(0);
    for (int c = 0; c < nchunk; ++c) {
        const int st = 32 * c + tt, tok = dsel ? T - 1 - st : st, m = r0 + tok;
        f32x4 zs[5];
#pragma unroll
        for (int s = 0; s < 5; ++s) {
            const f32x4 z = unpack4(zc[s]), a = unpack4(zp[s]), b = unpack4(zn[s]);
            zs[s] = z + mu0[s] * (a - z) + mu1[s] * (b - z);
        }
        f32x4 kk = zs[1] * kkv;
        float n2 = kk[0] * kk[0] + kk[1] * kk[1] + kk[2] * kk[2] + kk[3] * kk[3];
        n2 += __shfl_xor(n2, 1); n2 += __shfl_xor(n2, 2); n2 += __shfl_xor(n2, 4); n2 += __shfl_xor(n2, 8);
        kk = kk * (1.0f / fmaxf(sqrtf(n2), 1e-12f));
        {
            f32x4 tw; tw[0] = tanhf(zs[3][0]); tw[1] = tanhf(zs[3][1]); tw[2] = tanhf(zs[3][2]); tw[3] = tanhf(zs[3][3]);
            *(u32x2*)(Aw + tt * 72 + cg4) = pack4(tw);
            *(u32x2*)(Aa + tt * 72 + cg4) = pack4(zs[4]);
            *(f32x4*)(opR + tt * 64 + cg4) = zs[0];
            *(f32x4*)(opV + tt * 64 + cg4) = zs[2];
            *(f32x4*)(opA + tt * 64 + cg4) = -kk;
        }
        __syncthreads();
        if (wv < 4) {
            const int L = wv >> 1, nbk = wv & 1, r = lane & 31, hh = lane >> 5;
            const bf16_t* As = L == 0 ? Aw : Aa;
            f32x16 x;
#pragma unroll
            for (int i = 0; i < 16; ++i) x[i] = 0.f;
#pragma unroll
            for (int ks = 0; ks < 4; ++ks) {
                const bf16x8 af = *(const bf16x8*)(As + r * 72 + 16 * ks + 8 * hh);
                x = MFMA32(af, wfrag[ks], x);
            }
#pragma unroll
            for (int i = 0; i < 16; ++i) Lo[(L * 32 + crow(i, hh)) * 68 + nbk * 32 + r] = x[i];
        }
        __syncthreads();
        {
            const f32x4 lw = *(const f32x4*)(Lo + tt * 68 + cg4), la = *(const f32x4*)(Lo + (32 + tt) * 68 + cg4);
            f32x4 wd, kd, bb; float bs = 0.f;
#pragma unroll
            for (int j = 0; j < 4; ++j) {
                wd[j] = __expf(-0.6065306597126334f * sigmoidf_(w0v[j] + lw[j]));
                const float a = sigmoidf_(a0v[j] + la[j]);
                kd[j] = zs[1][j] * (1.0f + (a - 1.0f) * kav[j]);
                bb[j] = a * kk[j];
                bs += zs[0][j] * kd[j] * rkv[j];
            }
            *(f32x4*)(opW + tt * 64 + cg4) = wd;
            *(f32x4*)(opK + tt * 64 + cg4) = kd;
            *(f32x4*)(opB + tt * 64 + cg4) = bb;
            bs += __shfl_xor(bs, 1); bs += __shfl_xor(bs, 2); bs += __shfl_xor(bs, 4); bs += __shfl_xor(bs, 8);
            if ((tid & 15) == 0) bn[(size_t)m * 16 + dsel * 8 + h] = bs;
        }
        __syncthreads();
        if (c + 1 < nchunk) load_chunk(c + 1);
#pragma unroll 2
        for (int s = 0; s < 32; ++s) {
            const f32x4 wa = *(const f32x4*)(opW + s * 64 + 8 * jp), wb = *(const f32x4*)(opW + s * 64 + 8 * jp + 4);
            const f32x4 ka = *(const f32x4*)(opK + s * 64 + 8 * jp), kb_ = *(const f32x4*)(opK + s * 64 + 8 * jp + 4);
            const f32x4 aa = *(const f32x4*)(opA + s * 64 + 8 * jp), ab_ = *(const f32x4*)(opA + s * 64 + 8 * jp + 4);
            const f32x4 ba = *(const f32x4*)(opB + s * 64 + 8 * jp), bb_ = *(const f32x4*)(opB + s * 64 + 8 * jp + 4);
            const f32x4 ra = *(const f32x4*)(opR + s * 64 + 8 * jp), rb_ = *(const f32x4*)(opR + s * 64 + 8 * jp + 4);
            const float vv = opV[s * 64 + irow];
            const float wq[8] = {wa[0], wa[1], wa[2], wa[3], wb[0], wb[1], wb[2], wb[3]};
            const float kq[8] = {ka[0], ka[1], ka[2], ka[3], kb_[0], kb_[1], kb_[2], kb_[3]};
            const float aq[8] = {aa[0], aa[1], aa[2], aa[3], ab_[0], ab_[1], ab_[2], ab_[3]};
            const float bq[8] = {ba[0], ba[1], ba[2], ba[3], bb_[0], bb_[1], bb_[2], bb_[3]};
            const float rq[8] = {ra[0], ra[1], ra[2], ra[3], rb_[0], rb_[1], rb_[2], rb_[3]};
            float sa0 = 0.f, sa1 = 0.f;
#pragma unroll
            for (int e = 0; e < 8; e += 2) { sa0 += S[e] * aq[e]; sa1 += S[e + 1] * aq[e + 1]; }
            float sa = sa0 + sa1;
            sa += __shfl_xor(sa, 8); sa += __shfl_xor(sa, 16); sa += __shfl_xor(sa, 32);
            float y0 = 0.f, y1 = 0.f;
#pragma unroll
            for (int e = 0; e < 8; e += 2) {
                float t0 = sa * bq[e]; t0 += vv * kq[e]; t0 += S[e] * wq[e]; S[e] = t0; y0 += t0 * rq[e];
                float t1 = sa * bq[e + 1]; t1 += vv * kq[e + 1]; t1 += S[e + 1] * wq[e + 1]; S[e + 1] = t1; y1 += t1 * rq[e + 1];
            }
            float y = y0 + y1;
            y += __shfl_xor(y, 8); y += __shfl_xor(y, 16); y += __shfl_xor(y, 32);
            if (jp == 0) yb[s * 64 + irow] = y;
        }
        __syncthreads();
        *(f32x4*)(ys + (size_t)m * 512 + h * 64 + cg4) = *(const f32x4*)(yb + tt * 64 + cg4);
    }
    if (state_out) {
        f32x4 a, b; a[0] = S[0]; a[1] = S[1]; a[2] = S[2]; a[3] = S[3]; b[0] = S[4]; b[1] = S[5]; b[2] = S[6]; b[3] = S[7];
        *(f32x4*)(state_out + irow * 64 + 8 * jp) = a; *(f32x4*)(state_out + irow * 64 + 8 * jp + 4) = b;
    }
    __syncthreads();
}

DI void scan_dispatch(const Params& p, char* smem, int it) {
    if (it < 128) {
        const int b = it >> 4, dsel = (it >> 3) & 1, h = it & 7;
        scan_item(p, smem, MC + b * 2048, 2048, dsel, h, p.state_rwkv + (size_t)((b * 2 + dsel) * 8 + h) * 4096, nullptr);
    } else {
        const int i2 = it - 128, s = i2 >> 4, dsel = (i2 >> 3) & 1, h = i2 & 7;
        scan_item(p, smem, s * 256, 256, dsel, h, nullptr, p.out + OUT_S + (size_t)((s * 2 + dsel) * 8 + h) * 4096);
    }
}
DI void phase_scan(const Params& p, char* smem) {
    const int nb = gridDim.x, bid = blockIdx.x;
    if (nb >= 256) {
        if (bid < 128) scan_dispatch(p, smem, bid);
        else for (int it = 128 + (bid - 128); it < 640; it += nb - 128) scan_dispatch(p, smem, it);
    } else {
        for (int it = bid; it < 640; it += nb) scan_dispatch(p, smem, it);
    }
}

DI void phase_post(const Params& p, char* smem) {
    const int tid = threadIdx.x, wid = tid >> 6, lane = tid & 63, fr = lane & 15, fq = lane >> 4, wr = wid >> 1, wc = wid & 1;
    unsigned char* ws = p.ws;
    const bf16_t* sg = (const bf16_t*)(ws + OFF_SG); const bf16_t* g2t = (const bf16_t*)(ws + OFF_G2T);
    const float* ys0 = (const float*)(ws + OFF_YS); const float* ys1 = ys0 + (size_t)M * 512;
    const float* bn = (const float*)(ws + OFF_BN);
    const bf16_t* zr = (const bf16_t*)(p.out + OUT_Y);
    bf16_t* rw = (bf16_t*)(ws + OFF_RW);
    const int MT = M / 256, NT = 4;
    for (int t = blockIdx.x; t < MT * NT; t += gridDim.x) {
        int mt, nt; tile_coords(t, MT, NT, mt, nt);
        const int row0 = mt * 256;
        f32x4 acc[4][4]; zero_acc<4>(acc);
        gemm_acc<4>(acc, sg + (size_t)row0 * 128, 128, g2t + (size_t)(nt * 128) * 128, 128, 128, smem, tid);
        const int head = nt * 2 + wc;
#pragma unroll
        for (int mb = 0; mb < 4; ++mb) {
            const int m = row0 + wr * 64 + mb * 16 + fr;
            int r0, T; seq_of(m, r0, T);
            f32x4 y[4]; float s1 = 0.f;
#pragma unroll
            for (int nb = 0; nb < 4; ++nb) {
                const size_t o = (size_t)m * 512 + head * 64 + nb * 16 + fq * 4;
                y[nb] = *(const f32x4*)(ys0 + o) + *(const f32x4*)(ys1 + o);
                s1 += y[nb][0] + y[nb][1] + y[nb][2] + y[nb][3];
            }
            s1 += __shfl_xor(s1, 16); s1 += __shfl_xor(s1, 32);
            const float mean = s1 * (1.0f / 64.0f);
            float s2 = 0.f;
#pragma unroll
            for (int nb = 0; nb < 4; ++nb) { const f32x4 dlt = y[nb] - mean; s2 += dlt[0] * dlt[0] + dlt[1] * dlt[1] + dlt[2] * dlt[2] + dlt[3] * dlt[3]; }
            s2 += __shfl_xor(s2, 16); s2 += __shfl_xor(s2, 32);
            const float rstd = 1.0f / sqrtf(s2 * (1.0f / 64.0f) + 64e-5f);
            const float bonus = bn[(size_t)m * 16 + head] + bn[(size_t)m * 16 + 8 + head];
#pragma unroll
            for (int nb = 0; nb < 4; ++nb) {
                const int c = head * 64 + nb * 16 + fq * 4;
                const bf16_t* zp = zr + (size_t)m * ZRC + 1024 + c;
                const f32x4 z = unpack4(*(const u32x2*)zp);
                f32x4 zprev = (f32x4){0.f, 0.f, 0.f, 0.f}, znext = zprev;
                if (m > r0) zprev = unpack4(*(const u32x2*)(zp - ZRC));
                if (m < r0 + T - 1) znext = unpack4(*(const u32x2*)(zp + ZRC));
                const f32x4 a0 = *(const f32x4*)(p.rwkv_mu + 1024 + c), a1 = *(const f32x4*)(p.rwkv_mu + ZRC + 1024 + c);
                const f32x4 v = z + a0 * (zprev - z) + a1 * (znext - z);
                const f32x4 lg = *(const f32x4*)(p.rwkv_ln_g + c), lb = *(const f32x4*)(p.rwkv_ln_b + c);
                const f32x4 yn = (y[nb] - mean) * rstd * lg + lb;
                const f32x4 o = (yn + v * bonus) * acc[mb][nb];
                *(u32x2*)(rw + (size_t)m * 512 + c) = pack4(o);
            }
        }
    }
}

DI void phase_merge(const Params& p, char* smem) {
    const int tid = threadIdx.x, wid = tid >> 6, lane = tid & 63, fr = lane & 15, fq = lane >> 4, wr = wid >> 1, wc = wid & 1;
    unsigned char* ws = p.ws;
    const bf16_t* hb = (const bf16_t*)(ws + OFF_H); const bf16_t* wt = (const bf16_t*)(ws + OFF_WIN);
    const bf16_t* ab = (const bf16_t*)(ws + OFF_ATTN); const bf16_t* rw = (const bf16_t*)(ws + OFF_RW);
    const bf16_t* wpa = (const bf16_t*)(ws + OFF_WPA); const bf16_t* wpb = (const bf16_t*)(ws + OFF_WPB);
    bf16_t* mg = (bf16_t*)(ws + OFF_MRG);
    const int MT = M / 256, NT = 16;
    for (int t = blockIdx.x; t < MT * NT; t += gridDim.x) {
        int mt, nt; tile_coords(t, MT, NT, mt, nt);
        const int row0 = mt * 256, n0 = nt * 64;
        f32x4 acc[4][2], res[4][2], gate[4][2];
        zero_acc<2>(acc);
        gemm_acc<2>(acc, hb + (size_t)row0 * 1024, 1024, wt + (size_t)(768 + n0) * 1024, 1024, 1024, smem, tid);
#pragma unroll
        for (int a = 0; a < 4; ++a)
#pragma unroll
            for (int b = 0; b < 2; ++b)
#pragma unroll
                for (int j = 0; j < 4; ++j) gate[a][b][j] = sigmoidf_(acc[a][b][j]);
        zero_acc<2>(acc);
        gemm_acc<2>(acc, ab + (size_t)row0 * 512, 512, wpa + (size_t)n0 * 512, 512, 512, smem, tid);
#pragma unroll
        for (int a = 0; a < 4; ++a)
#pragma unroll
            for (int b = 0; b < 2; ++b) res[a][b] = gate[a][b] * acc[a][b];
        zero_acc<2>(acc);
        gemm_acc<2>(acc, hb + (size_t)row0 * 1024, 1024, wt + (size_t)(1792 + n0) * 1024, 1024, 1024, smem, tid);
#pragma unroll
        for (int a = 0; a < 4; ++a)
#pragma unroll
            for (int b = 0; b < 2; ++b)
#pragma unroll
                for (int j = 0; j < 4; ++j) gate[a][b][j] = sigmoidf_(acc[a][b][j]);
        zero_acc<2>(acc);
        gemm_acc<2>(acc, rw + (size_t)row0 * 512, 512, wpb + (size_t)n0 * 512, 512, 512, smem, tid);
#pragma unroll
        for (int mb = 0; mb < 4; ++mb) {
            const int m = row0 + wr * 64 + mb * 16 + fr;
#pragma unroll
            for (int nb = 0; nb < 2; ++nb) {
                const f32x4 o = res[mb][nb] + gate[mb][nb] * acc[mb][nb];
                *(u32x2*)(mg + (size_t)m * 1024 + n0 + wc * 32 + nb * 16 + fq * 4) = pack4(o);
            }
        }
    }
}

DI void phase_out(const Params& p, char* smem) {
    const int tid = threadIdx.x, wid = tid >> 6, lane = tid & 63, fr = lane & 15, fq = lane >> 4, wr = wid >> 1, wc = wid & 1;
    unsigned char* ws = p.ws;
    const bf16_t* mg = (const bf16_t*)(ws + OFF_MRG); const bf16_t* wo = (const bf16_t*)(ws + OFF_WOUT);
    const float* mod = (const float*)(ws + OFF_MOD);
    const int MT = M / 256, NT = 8;
    for (int t = blockIdx.x; t < MT * NT; t += gridDim.x) {
        int mt, nt; tile_coords(t, MT, NT, mt, nt);
        const int row0 = mt * 256, n0 = nt * 128;
        f32x4 acc[4][4]; zero_acc<4>(acc);
        gemm_acc<4>(acc, mg + (size_t)row0 * 1024, 1024, wo + (size_t)n0 * 1024, 1024, 1024, smem, tid);
        const int ci = cond_of(row0);
#pragma unroll
        for (int nb = 0; nb < 4; ++nb) {
            const int n = n0 + wc * 64 + nb * 16 + fq * 4;
            const f32x4 g1 = *(const f32x4*)(mod + ci * 6144 + 2048 + n);
#pragma unroll
            for (int mb = 0; mb < 4; ++mb) {
                const int m = row0 + wr * 64 + mb * 16 + fr;
                const f32x4 xv = *(const f32x4*)(xrow(p, m) + n);
                *(f32x4*)(p.out + OUT_Y + (size_t)m * D + n) = xv + g1 * acc[mb][nb];
            }
        }
    }
}

DI void phase_up(const Params& p, char* smem, int ch) {
    const int tid = threadIdx.x, wid = tid >> 6, lane = tid & 63, fr = lane & 15, fq = lane >> 4, wr = wid >> 1, wc = wid & 1;
    unsigned char* ws = p.ws;
    const bf16_t* hb = (const bf16_t*)(ws + OFF_H); const bf16_t* wu = (const bf16_t*)(ws + OFF_WUP);
    bf16_t* ub = (bf16_t*)(ws + OFF_U);
    const int MT = 16, NT = 44;
    for (int t = blockIdx.x; t < MT * NT; t += gridDim.x) {
        int mt, nt; tile_coords(t, MT, NT, mt, nt);
        const int lrow0 = mt * 256, row0 = ch * 4096 + lrow0, n0 = nt * 128;
        f32x4 acc[4][4]; zero_acc<4>(acc);
        gemm_acc<4>(acc, hb + (size_t)row0 * 1024, 1024, wu + (size_t)n0 * 1024, 1024, 1024, smem, tid);
#pragma unroll
        for (int mb = 0; mb < 4; ++mb) {
            const int ml = lrow0 + wr * 64 + mb * 16 + fr;
#pragma unroll
            for (int nb = 0; nb < 4; ++nb) *(u32x2*)(ub + (size_t)ml * 5632 + n0 + wc * 64 + nb * 16 + fq * 4) = pack4(acc[mb][nb]);
        }
    }
}
DI void phase_conv(const Params& p, int ch) {
    const int tid = threadIdx.x;
    unsigned char* ws = p.ws;
    const bf16_t* ub = (const bf16_t*)(ws + OFF_U);
    bf16_t* act = (bf16_t*)(ws + OFF_ACT);
    const float* cw = p.ffn_conv_w; const float* cb = p.ffn_conv_b;
    const int per_row = DFF / 4;
    for (int i = blockIdx.x * NTHR + tid; i < 4096 * per_row; i += gridDim.x * NTHR) {
        const int ml = i / per_row, c = (i - ml * per_row) * 4, m = ch * 4096 + ml;
        int r0, T; seq_of(m, r0, T);
        const bool hp = m > r0, hn = m < r0 + T - 1;
        f32x4 res[2];
#pragma unroll
        for (int part = 0; part < 2; ++part) {
            const int cc = c + part * DFF;
            const bf16_t* up = ub + (size_t)ml * 5632 + cc;
            const f32x4 u0 = unpack4(*(const u32x2*)up);
            f32x4 um = (f32x4){0.f, 0.f, 0.f, 0.f}, upn = um;
            if (hp) um = unpack4(*(const u32x2*)(up - 5632));
            if (hn) upn = unpack4(*(const u32x2*)(up + 5632));
            const f32x4 w0 = *(const f32x4*)(cw + cc), w1 = *(const f32x4*)(cw + 5632 + cc), w2 = *(const f32x4*)(cw + 2 * 5632 + cc), bb = *(const f32x4*)(cb + cc);
            res[part] = um * w0 + u0 * w1 + upn * w2 + bb;
        }
        f32x4 o;
#pragma unroll
        for (int j = 0; j < 4; ++j) { const float g = res[1][j]; o[j] = g / (1.0f + __expf(-g)) * res[0][j]; }
        *(u32x2*)(act + (size_t)m * DFF + c) = pack4(o);
    }
}
DI void phase_down(const Params& p, char* smem) {
    const int tid = threadIdx.x, wid = tid >> 6, lane = tid & 63, fr = lane & 15, fq = lane >> 4, wr = wid >> 1, wc = wid & 1;
    unsigned char* ws = p.ws;
    const bf16_t* act = (const bf16_t*)(ws + OFF_ACT); const bf16_t* wd = (const bf16_t*)(ws + OFF_WDN);
    const float* mod = (const float*)(ws + OFF_MOD);
    const int MT = M / 256, NT = 8;
    for (int t = blockIdx.x; t < MT * NT; t += gridDim.x) {
        int mt, nt; tile_coords(t, MT, NT, mt, nt);
        const int row0 = mt * 256, n0 = nt * 128;
        f32x4 acc[4][4]; zero_acc<4>(acc);
        gemm_acc<4>(acc, act + (size_t)row0 * DFF, DFF, wd + (size_t)n0 * DFF, DFF, DFF, smem, tid);
        const int ci = cond_of(row0);
#pragma unroll
        for (int nb = 0; nb < 4; ++nb) {
            const int n = n0 + wc * 64 + nb * 16 + fq * 4;
            const f32x4 g2 = *(const f32x4*)(mod + ci * 6144 + 5120 + n);
#pragma unroll
            for (int mb = 0; mb < 4; ++mb) {
                const int m = row0 + wr * 64 + mb * 16 + fr;
                float* px = p.out + OUT_Y + (size_t)m * D + n;
                *(f32x4*)px = *(const f32x4*)px + g2 * acc[mb][nb];
            }
        }
    }
}

#define XB_TMO      128
#define XB_XCNT(j)  (256  + 64 * (j))
#define XB_XSUB(j)  (1280 + 64 * (j))
#define XB_XGEN(j)  (2304 + 64 * (j))
#define XB_TOP      3328
#define XB_TOPGEN   3392
#define XCD_BAR_WORDS 3456
#define XB_SPIN_CAP (1u << 20)
#define LAS __attribute__((address_space(3)))
DI unsigned xb_ld(unsigned* p)              { return __hip_atomic_load(p, __ATOMIC_RELAXED, __HIP_MEMORY_SCOPE_AGENT); }
DI unsigned xb_add(unsigned* p, unsigned v) { return __hip_atomic_fetch_add(p, v, __ATOMIC_RELAXED, __HIP_MEMORY_SCOPE_AGENT); }
DI unsigned xb_xcc_id() { return (unsigned)__builtin_amdgcn_s_getreg((3 << 11) | 20) & 0xFu; }
#define XB_SPIN(cond, bar) do { unsigned _sp = 0; while (cond) { __builtin_amdgcn_s_sleep(1); \
    if ((++_sp & 255u) == 0u) { if (xb_ld(&(bar)[XB_TMO])) break; if (_sp > XB_SPIN_CAP) { atomicAdd(&(bar)[XB_TMO], 1u); break; } } } } while (0)
struct XcdBarrier { unsigned* bar; unsigned x; volatile LAS unsigned* st; };
DI XcdBarrier xcd_barrier_post(unsigned* bar, volatile LAS unsigned* st) {
    XcdBarrier b; b.bar = bar; b.x = xb_xcc_id(); b.st = st;
    if (threadIdx.x == 0) (void)xb_add(&bar[XB_XCNT(b.x)], 1u);
    return b;
}
DI void xcd_barrier_complete(unsigned* bar, unsigned x, unsigned& nloc, unsigned& nx) {
    const unsigned G = gridDim.x * gridDim.y * gridDim.z;
    unsigned sum, cnt, mine, sp = 0u;
    for (;;) {
        sum = 0u; cnt = 0u; mine = 0u;
#pragma unroll
        for (unsigned j = 0; j < 16; ++j) { const unsigned c = xb_ld(&bar[XB_XCNT(j)]); sum += c; cnt += (c > 0u) ? 1u : 0u; mine = (j == x) ? c : mine; }
        if (sum == G) break;
        __builtin_amdgcn_s_sleep(1);
        if ((++sp & 255u) == 0u) { if (xb_ld(&bar[XB_TMO])) break; if (sp > XB_SPIN_CAP) { atomicAdd(&bar[XB_TMO], 1u); break; } }
    }
    nloc = mine > 0u ? mine : 1u; nx = cnt > 0u ? cnt : 1u;
}
DI void xcd_barrier(const XcdBarrier& b) {
    asm volatile("s_waitcnt vmcnt(0)" ::: "memory");
    __syncthreads();
    if (threadIdx.x == 0) {
        unsigned* bar = b.bar;
        __builtin_amdgcn_s_waitcnt(0);
        unsigned nloc = b.st[0], nx = b.st[1];
        if (nloc == 0u) { xcd_barrier_complete(bar, b.x, nloc, nx); b.st[0] = nloc; b.st[1] = nx; }
        const unsigned old = xb_add(&bar[XB_XSUB(b.x)], 1u);
        const unsigned gen = old / nloc;
        if (old + 1u == (gen + 1u) * nloc) {
            __builtin_amdgcn_fence(__ATOMIC_RELEASE, "agent");
            asm volatile("s_waitcnt vmcnt(0)" ::: "memory");
            const unsigned og = xb_add(&bar[XB_TOP], 1u);
            const unsigned tg = og / nx;
            if (og + 1u == (tg + 1u) * nx) xb_add(&bar[XB_TOPGEN], 1u);
            else XB_SPIN(xb_ld(&bar[XB_TOPGEN]) == tg, bar);
            __builtin_amdgcn_fence(__ATOMIC_ACQUIRE, "agent");
            xb_add(&bar[XB_XGEN(b.x)], 1u);
            asm volatile("s_waitcnt vmcnt(0)" ::: "memory");
        } else {
            XB_SPIN(xb_ld(&bar[XB_XGEN(b.x)]) == gen, bar);
            __builtin_amdgcn_fence(__ATOMIC_ACQUIRE, "agent");
            asm volatile("s_waitcnt vmcnt(0)" ::: "memory");
        }
    }
    __syncthreads();
}

constexpr int N_PHASES = 23;
__global__ void __launch_bounds__(NTHR) fwd_kernel(Params p) {
    extern __shared__ __attribute__((aligned(16))) char smem[];
    volatile LAS unsigned* xst = (volatile LAS unsigned*)(smem + LDS_MAIN);
    if (threadIdx.x == 0) { xst[0] = 0u; xst[1] = 0u; }
    __syncthreads();
    const XcdBarrier xb = xcd_barrier_post((unsigned*)(p.ws + OFF_BAR), xst);
#ifndef PH_MASK
#define PH_MASK 0xffff
#endif
#ifndef REP_MASK
#define REP_MASK 0
#endif
#define RUN_PHASE(ph, bit, call) if (p.ph_lo <= (ph) && (ph) < p.ph_hi) { if ((ph) > p.ph_lo) xcd_barrier(xb); if (PH_MASK & (bit)) { call; if (REP_MASK & (bit)) { call; } } }
    RUN_PHASE(0, 1, phase_prep(p, smem))
    RUN_PHASE(1, 2, phase_norm<1>(p))
    RUN_PHASE(2, 4, phase_p1(p, smem))
    RUN_PHASE(3, 8, phase_attn(p, smem))
    RUN_PHASE(4, 16, phase_scan(p, smem))
    RUN_PHASE(5, 32, phase_post(p, smem))
    RUN_PHASE(6, 64, phase_merge(p, smem))
    RUN_PHASE(7, 128, phase_out(p, smem))
    RUN_PHASE(8, 256, phase_norm<2>(p))
#pragma unroll 1
    for (int ch = 0; ch < 6; ++ch) {
        RUN_PHASE(9 + 2 * ch, 512, phase_up(p, smem, ch))
        RUN_PHASE(10 + 2 * ch, 1024, phase_conv(p, ch))
    }
    RUN_PHASE(21, 2048, phase_down(p, smem))
    RUN_PHASE(22, 4096, phase_norm<3>(p))
}

extern "C" void kernel_launch(void* const* d_in, const int* in_sizes, int n_in, void* d_out, int out_size, void* d_ws, size_t ws_size, hipStream_t stream) {
    static int grid = 0;
    if (grid == 0) {
        if (n_in != 32 || ws_size < WS_NEED) { fprintf(stderr, "kernel_launch: unexpected inputs (n_in %d, ws %zu, need %zu)\n", n_in, ws_size, (size_t)WS_NEED); grid = -1; return; }
        int dev = 0, cus = 0, per_cu = 0;
        hipGetDevice(&dev);
        hipDeviceGetAttribute(&cus, hipDeviceAttributeMultiprocessorCount, dev);
        hipFuncSetAttribute((const void*)fwd_kernel, hipFuncAttributeMaxDynamicSharedMemorySize, LDS_BYTES);
        hipOccupancyMaxActiveBlocksPerMultiprocessor(&per_cu, (const void*)fwd_kernel, NTHR, LDS_BYTES);
        if (per_cu < 1) { fprintf(stderr, "kernel_launch: occupancy query says %d blocks per CU\n", per_cu); grid = -1; return; }
        grid = cus;
        grid &= ~7;
    }
    if (grid < 0) return;
    if (hipMemsetAsync((char*)d_ws + OFF_BAR, 0, XCD_BAR_WORDS * 4, stream) != hipSuccess) { fprintf(stderr, "kernel_launch: memset failed\n"); return; }
    Params p{};
    const float** pp = (const float**)&p;
    for (int i = 0; i < 32; ++i) pp[i] = (const float*)d_in[i];
    p.out = (float*)d_out; p.ws = (unsigned char*)d_ws;
#if N_LAUNCH_SPLIT
    for (int ph = 0; ph < N_PHASES; ++ph) {
        p.ph_lo = ph; p.ph_hi = ph + 1;
        hipLaunchKernelGGL(fwd_kernel, dim3(grid), dim3(NTHR), LDS_BYTES, stream, p);
    }
#else
    p.ph_lo = 0; p.ph_hi = N_PHASES;
    void* args[] = {&p};
    hipError_t e = hipLaunchCooperativeKernel((const void*)fwd_kernel, dim3(grid), dim3(NTHR), args, LDS_BYTES, stream);
    if (e != hipSuccess) fprintf(stderr, "cooperative launch failed: %s (grid %d)\n", hipGetErrorString(e), grid);
#endif
}
```

```cpp
#include <hip/hip_runtime.h>
#include <hip/hip_cooperative_groups.h>
#include <cstdio>
namespace cg = cooperative_groups;

#define DI __device__ __forceinline__
typedef unsigned short bf16_t;
typedef short bf16x8 __attribute__((ext_vector_type(8)));
typedef short s16x4 __attribute__((ext_vector_type(4)));
typedef float f32x4 __attribute__((ext_vector_type(4)));
typedef float f32x2 __attribute__((ext_vector_type(2)));
typedef float f32x16 __attribute__((ext_vector_type(16)));
typedef unsigned u32x4 __attribute__((ext_vector_type(4)));
typedef unsigned u32x2 __attribute__((ext_vector_type(2)));

#ifndef N_LAUNCH_SPLIT
#define N_LAUNCH_SPLIT 0
#endif

constexpr int NTHR = 512;
constexpr int D = 1024;
constexpr int MC = 8192;
constexpr int ML = 16384;
constexpr int M = MC + ML;
constexpr int WIN = 4736;
constexpr int ZRC = 1920;
constexpr int DFF = 2816;
constexpr int LDS_MAIN = 98304;
constexpr int LDS_BYTES = LDS_MAIN + 16;
constexpr float LOG2E = 1.4426950408889634f;

constexpr size_t al256(size_t x) { return (x + 255) & ~(size_t)255; }
constexpr size_t OFF_WUP   = 0;
constexpr size_t OFF_WDN   = OFF_WUP + al256((size_t)5632 * 1024 * 2);
constexpr size_t OFF_MOD   = OFF_WDN + al256((size_t)1024 * 2816 * 2);
constexpr size_t OFF_ROPE  = OFF_MOD + al256((size_t)9 * 6144 * 4);
constexpr size_t OFF_W2T   = OFF_ROPE + al256((size_t)64 * 16 * 8);
constexpr size_t OFF_A2T   = OFF_W2T + al256((size_t)2 * 512 * 64 * 2);
constexpr size_t OFF_G2T   = OFF_A2T + al256((size_t)2 * 512 * 64 * 2);
constexpr size_t OFF_KC    = OFF_G2T + al256((size_t)512 * 128 * 2);
constexpr size_t OFF_VCT   = OFF_KC + al256((size_t)8 * 512 * 128 * 2);
constexpr size_t OFF_BAR   = OFF_VCT + al256((size_t)8 * 512 * 128 * 2);
constexpr size_t OFF_H     = OFF_BAR + al256((size_t)(3456 + 64) * 4);
constexpr size_t OFF_X     = OFF_H + al256((size_t)M * 1024 * 2);
constexpr size_t OFF_WIN   = OFF_X;
constexpr size_t OFF_WPA   = OFF_WIN + al256((size_t)WIN * 1024 * 2);
constexpr size_t OFF_WPB   = OFF_WPA + al256((size_t)1024 * 512 * 2);
constexpr size_t OFF_WOUT  = OFF_WPB + al256((size_t)1024 * 512 * 2);
constexpr size_t OFF_Q     = OFF_WOUT + al256((size_t)1024 * 1024 * 2);
constexpr size_t OFF_RW    = OFF_Q;
constexpr size_t OFF_KB    = OFF_Q + al256((size_t)M * 512 * 2);
constexpr size_t OFF_VT    = OFF_KB + al256((size_t)M * 128 * 2);
constexpr size_t OFF_ATTN  = OFF_VT + al256((size_t)M * 128 * 2);
constexpr size_t OFF_SG    = OFF_ATTN + al256((size_t)M * 512 * 2);
constexpr size_t OFF_BN    = OFF_SG + al256((size_t)M * 128 * 2);
constexpr size_t OFF_YS    = OFF_BN + al256((size_t)M * 16 * 4);
constexpr size_t OFF_MRG   = OFF_YS;
constexpr size_t END_EARLY = OFF_YS + al256((size_t)2 * M * 512 * 4);
constexpr size_t OFF_ACT   = OFF_X;
constexpr size_t OFF_U     = OFF_ACT + al256((size_t)M * DFF * 2);
constexpr size_t END_FFN   = OFF_U + al256((size_t)4096 * 5632 * 2);
constexpr size_t WS_NEED   = END_EARLY > END_FFN ? END_EARLY : END_FFN;
static_assert(WS_NEED <= (size_t)256 * 1024 * 1024, "workspace over 256 MiB");

constexpr size_t OUT_Y  = 0;
constexpr size_t OUT_K  = (size_t)M * 1024;
constexpr size_t OUT_V  = OUT_K + (size_t)MC * 128;
constexpr size_t OUT_S  = OUT_V + (size_t)MC * 128;

struct Params {
    const float *x_prompt, *x_sample, *c, *cache_k, *cache_v, *state_rwkv, *c_ctx, *w_ada, *b_ada, *g_norm1, *w_in, *attn_sink,
        *w_proj_a, *w_proj_b, *rwkv_mu, *rwkv_w0, *rwkv_w2, *rwkv_a0, *rwkv_a2, *rwkv_k_k, *rwkv_k_a, *rwkv_r_k, *rwkv_g2,
        *rwkv_ln_g, *rwkv_ln_b, *w_out, *g_norm2, *w_ffn_up, *ffn_conv_w, *ffn_conv_b, *w_ffn_down, *g_final;
    float* out;
    unsigned char* ws;
    int ph_lo, ph_hi;
};

#define XCD_BAR_WORDS 3456
#define LAS __attribute__((address_space(3)))
DI bf16_t f2bf(float f) { unsigned u = __float_as_uint(f); u += 0x7fffu + ((u >> 16) & 1u); return (bf16_t)(u >> 16); }
DI float bf2f(unsigned b) { return __uint_as_float(b << 16); }
DI unsigned pack2(float lo, float hi) { return (unsigned)f2bf(lo) | ((unsigned)f2bf(hi) << 16); }
DI u32x2 pack4(f32x4 v) { u32x2 r; r.x = pack2(v[0], v[1]); r.y = pack2(v[2], v[3]); return r; }
DI f32x4 unpack4(u32x2 v) { f32x4 r; r[0] = bf2f(v.x & 0xffffu); r[1] = bf2f(v.x >> 16); r[2] = bf2f(v.y & 0xffffu); r[3] = bf2f(v.y >> 16); return r; }
DI float sigmoidf_(float x) { return 1.0f / (1.0f + __expf(-x)); }
DI const float* xrow(const Params& p, int r) { return r < MC ? p.x_prompt + (size_t)r * D : p.x_sample + (size_t)(r - MC) * D; }
DI int cond_of(int r) { return r < MC ? 0 : 1 + ((r - MC) >> 11); }
DI void seq_of(int r, int& r0, int& T) { if (r < MC) { r0 = r & ~255; T = 256; } else { r0 = MC + ((r - MC) & ~2047); T = 2048; } }
DI float wave_sum(float v) {
#pragma unroll
    for (int o = 32; o >= 1; o >>= 1) v += __shfl_xor(v, o);
    return v;
}

DI void transpose_tile(const float* __restrict__ src, int K, int N, bf16_t* __restrict__ dst, int kt, int nt, float* tile, int tid) {
    const int k0 = kt * 64, n0 = nt * 64;
#pragma unroll
    for (int i = 0; i < 8; ++i) { const int k = (tid >> 6) + 8 * i, n = tid & 63; tile[k * 65 + n] = src[(size_t)(k0 + k) * N + n0 + n]; }
    __syncthreads();
#pragma unroll
    for (int i = 0; i < 8; ++i) { const int n = (tid >> 6) + 8 * i, k = tid & 63; dst[(size_t)(n0 + n) * K + k0 + k] = f2bf(tile[k * 65 + n]); }
    __syncthreads();
}

DI void phase_prep(const Params& p, char* smem) {
    const int tid = threadIdx.x, nb = gridDim.x, bid = blockIdx.x;
    unsigned char* ws = p.ws;
    {
        float* tile = (float*)smem;
        const int cnt[11] = {16 * 74, 8 * 16, 8 * 16, 16 * 16, 16 * 88, 44 * 16, 8, 8, 8, 8, 16};
        int total = 0;
#pragma unroll
        for (int i = 0; i < 11; ++i) total += cnt[i];
        for (int it = bid; it < total; it += nb) {
            int i = it, mi = 0;
#pragma unroll
            for (int q = 0; q < 10; ++q) { if (mi == q && i >= cnt[q]) { i -= cnt[q]; mi = q + 1; } }
            const float* src; bf16_t* dst; int K, N;
            switch (mi) {
                case 0: src = p.w_in; K = 1024; N = WIN; dst = (bf16_t*)(ws + OFF_WIN); break;
                case 1: src = p.w_proj_a; K = 512; N = 1024; dst = (bf16_t*)(ws + OFF_WPA); break;
                case 2: src = p.w_proj_b; K = 512; N = 1024; dst = (bf16_t*)(ws + OFF_WPB); break;
                case 3: src = p.w_out; K = 1024; N = 1024; dst = (bf16_t*)(ws + OFF_WOUT); break;
                case 4: src = p.w_ffn_up; K = 1024; N = 5632; dst = (bf16_t*)(ws + OFF_WUP); break;
                case 5: src = p.w_ffn_down; K = 2816; N = 1024; dst = (bf16_t*)(ws + OFF_WDN); break;
                case 6: src = p.rwkv_w2; K = 64; N = 512; dst = (bf16_t*)(ws + OFF_W2T); break;
                case 7: src = p.rwkv_w2 + 64 * 512; K = 64; N = 512; dst = (bf16_t*)(ws + OFF_W2T) + 512 * 64; break;
                case 8: src = p.rwkv_a2; K = 64; N = 512; dst = (bf16_t*)(ws + OFF_A2T); break;
                case 9: src = p.rwkv_a2 + 64 * 512; K = 64; N = 512; dst = (bf16_t*)(ws + OFF_A2T) + 512 * 64; break;
                default: src = p.rwkv_g2; K = 128; N = 512; dst = (bf16_t*)(ws + OFF_G2T); break;
            }
            const int ntn = N / 64;
            transpose_tile(src, K, N, dst, i / ntn, i % ntn, tile, tid);
        }
    }
    {
        bf16_t* kc = (bf16_t*)(ws + OFF_KC); bf16_t* vct = (bf16_t*)(ws + OFF_VCT);
        for (int i = bid * NTHR + tid; i < 8 * 512 * 128; i += nb * NTHR) {
            kc[i] = f2bf(p.cache_k[i]);
            const int key = i & 511, d = (i >> 9) & 63, kvh = (i >> 15) & 1, b = i >> 16;
            vct[i] = f2bf(p.cache_v[((size_t)(b * 512 + key) * 2 + kvh) * 64 + d]);
        }
    }
    {
        f32x2* tab = (f32x2*)(ws + OFF_ROPE);
        for (int i = bid * NTHR + tid; i < 1024; i += nb * NTHR) {
            const int pos = i >> 4, fi = i & 15;
            const double fr = pow(10000.0, -(double)fi / 16.0), ang = (double)pos * fr;
            f32x2 v; v.x = (float)cos(ang); v.y = (float)sin(ang); tab[i] = v;
        }
    }
    {
        float* s = (float*)smem;
        float* red = (float*)(smem + 36864);
        float* mod = (float*)(ws + OFF_MOD);
        for (int it = bid; it < 96; it += nb) {
            __syncthreads();
            for (int i = tid; i < 9 * 1024; i += NTHR) {
                const int ci = i >> 10, k = i & 1023;
                const float v = ci == 0 ? p.c_ctx[k] : p.c[(ci - 1) * 1024 + k];
                s[i] = v / (1.0f + __expf(-v));
            }
            __syncthreads();
            const int n = tid & 63, kq = tid >> 6, n0 = it * 64;
            float acc[9];
#pragma unroll
            for (int ci = 0; ci < 9; ++ci) acc[ci] = 0.f;
            for (int k = kq * 128; k < kq * 128 + 128; ++k) {
                const float w = p.w_ada[(size_t)k * 6144 + n0 + n];
#pragma unroll
                for (int ci = 0; ci < 9; ++ci) acc[ci] += s[ci * 1024 + k] * w;
            }
#pragma unroll
            for (int ci = 0; ci < 9; ++ci) red[(kq * 9 + ci) * 64 + n] = acc[ci];
            __syncthreads();
            for (int i = tid; i < 9 * 64; i += NTHR) {
                const int ci = i >> 6, nn = i & 63;
                float v = p.b_ada[n0 + nn];
#pragma unroll
                for (int q = 0; q < 8; ++q) v += red[(q * 9 + ci) * 64 + nn];
                mod[ci * 6144 + n0 + nn] = v;
            }
        }
        __syncthreads();
    }
}

template <int WHICH> DI void phase_norm(const Params& p) {
    const int tid = threadIdx.x, lane = tid & 63, wv = tid >> 6;
    const float* mod = (const float*)(p.ws + OFF_MOD);
    bf16_t* hb = (bf16_t*)(p.ws + OFF_H);
    const int ntask = M / 8;
    for (int task = blockIdx.x * 8 + wv; task < ntask; task += gridDim.x * 8) {
        const int r_first = task * 8, ci = cond_of(r_first);
        f32x4 fa[4], fb[4];
#pragma unroll
        for (int i = 0; i < 4; ++i) {
            const int col = i * 256 + lane * 4;
            if (WHICH == 3) { fa[i] = *(const f32x4*)(p.g_final + col); fb[i] = (f32x4){0.f, 0.f, 0.f, 0.f}; }
            else {
                const f32x4 g = *(const f32x4*)((WHICH == 1 ? p.g_norm1 : p.g_norm2) + col);
                const f32x4 sc = *(const f32x4*)(mod + ci * 6144 + (WHICH == 1 ? 1024 : 4096) + col);
                fb[i] = *(const f32x4*)(mod + ci * 6144 + (WHICH == 1 ? 0 : 3072) + col);
                fa[i] = g * (sc + 1.0f);
            }
        }
        for (int rr = 0; rr < 8; ++rr) {
            const int r = r_first + rr;
            const float* src = WHICH == 1 ? xrow(p, r) : p.out + OUT_Y + (size_t)r * D;
            f32x4 v[4]; float ss = 0.f;
#pragma unroll
            for (int i = 0; i < 4; ++i) { v[i] = *(const f32x4*)(src + i * 256 + lane * 4); ss += v[i][0] * v[i][0] + v[i][1] * v[i][1] + v[i][2] * v[i][2] + v[i][3] * v[i][3]; }
            ss = wave_sum(ss);
            const float rstd = 1.0f / sqrtf(ss * (1.0f / 1024.0f) + 1e-6f);
#pragma unroll
            for (int i = 0; i < 4; ++i) {
                const f32x4 o = v[i] * rstd * fa[i] + fb[i];
                if (WHICH == 3) *(f32x4*)(p.out + OUT_Y + (size_t)r * D + i * 256 + lane * 4) = o;
                else *(u32x2*)(hb + (size_t)r * D + i * 256 + lane * 4) = pack4(o);
            }
        }
    }
}

template <int NB> DI void gemm_stage(const bf16_t* A, int lda, const bf16_t* Bt, int ldb, int k0, char* sbuf, int tid) {
#pragma unroll
    for (int i = 0; i < 4; ++i) {
        const int c = tid + i * 512, row = c >> 3, pos = c & 7, kc = pos ^ ((row >> 1) & 7);
        __builtin_amdgcn_global_load_lds((const unsigned*)(A + (size_t)row * lda + k0 + kc * 8), (unsigned*)(sbuf + c * 16), 16, 0, 0);
    }
#pragma unroll
    for (int i = 0; i < NB / 2; ++i) {
        const int c = tid + i * 512, row = c >> 3, pos = c & 7, kc = pos ^ ((row >> 1) & 7);
        __builtin_amdgcn_global_load_lds((const unsigned*)(Bt + (size_t)row * ldb + k0 + kc * 8), (unsigned*)(sbuf + 32768 + c * 16), 16, 0, 0);
    }
}
template <int NB> DI void gemm_acc(f32x4 (&acc)[4][NB], const bf16_t* A, int lda, const bf16_t* Bt, int ldb, int K, char* smem, int tid) {
    const int wid = tid >> 6, lane = tid & 63, fr = lane & 15, fq = lane >> 4, wr = wid >> 1, wc = wid & 1;
    const int swz = (fr >> 1) & 7;
    const int nk = K >> 6;
    __syncthreads();
    gemm_stage<NB>(A, lda, Bt, ldb, 0, smem, tid);
#pragma unroll 1
    for (int t = 0; t < nk; ++t) {
        asm volatile("s_waitcnt vmcnt(0)" ::: "memory");
        __syncthreads();
        if (t + 1 < nk) gemm_stage<NB>(A, lda, Bt, ldb, (t + 1) * 64, smem + ((t + 1) & 1) * 49152, tid);
        const char* sA = smem + (t & 1) * 49152;
        const char* sB = sA + 32768;
#pragma unroll
        for (int ks = 0; ks < 2; ++ks) {
            bf16x8 af[4], bfr[NB];
            const int coff = ((ks * 4 + fq) ^ swz) << 4;
#pragma unroll
            for (int mb = 0; mb < 4; ++mb) af[mb] = *(const bf16x8*)(sA + (wr * 64 + mb * 16 + fr) * 128 + coff);
#pragma unroll
            for (int nb = 0; nb < NB; ++nb) bfr[nb] = *(const bf16x8*)(sB + (wc * 16 * NB + nb * 16 + fr) * 128 + coff);
#pragma unroll
            for (int mb = 0; mb < 4; ++mb)
#pragma unroll
                for (int nb = 0; nb < NB; ++nb) acc[mb][nb] = __builtin_amdgcn_mfma_f32_16x16x32_bf16(bfr[nb], af[mb], acc[mb][nb], 0, 0, 0);
        }
    }
}
template <int NB> DI void zero_acc(f32x4 (&acc)[4][NB]) {
#pragma unroll
    for (int a = 0; a < 4; ++a)
#pragma unroll
        for (int b = 0; b < NB; ++b) acc[a][b] = (f32x4){0.f, 0.f, 0.f, 0.f};
}
DI void tile_coords(int t, int MT, int NT, int& mt, int& nt) {
    const int x = t & 7, u = t >> 3, mpx = MT >> 3;
    const int bm = (mpx % 4 == 0) ? 4 : ((mpx % 2 == 0) ? 2 : 1);
    const int per_band = bm * NT, band = u / per_band, rem = u - band * per_band;
    nt = rem / bm; mt = x * mpx + band * bm + (rem % bm);
}

DI void phase_p1(const Params& p, char* smem) {
    const int tid = threadIdx.x, wid = tid >> 6, lane = tid & 63, fr = lane & 15, fq = lane >> 4, wr = wid >> 1, wc = wid & 1;
    unsigned char* ws = p.ws;
    const bf16_t* hb = (const bf16_t*)(ws + OFF_H);
    const bf16_t* wt = (const bf16_t*)(ws + OFF_WIN);
    const f32x2* tab = (const f32x2*)(ws + OFF_ROPE);
    bf16_t* qb = (bf16_t*)(ws + OFF_Q); bf16_t* kb = (bf16_t*)(ws + OFF_KB); bf16_t* vT = (bf16_t*)(ws + OFF_VT);
    bf16_t* zr = (bf16_t*)(p.out + OUT_Y);
    const int MT = M / 256, NT = 21;
    for (int t = blockIdx.x; t < MT * NT; t += gridDim.x) {
        int mt, nt; tile_coords(t, MT, NT, mt, nt);
        const int row0 = mt * 256, ncol0 = nt < 6 ? nt * 128 : 2816 + (nt - 6) * 128;
        f32x4 acc[4][4]; zero_acc<4>(acc);
        gemm_acc<4>(acc, hb + (size_t)row0 * 1024, 1024, wt + (size_t)ncol0 * 1024, 1024, 1024, smem, tid);
        const bool latent = row0 >= MC;
#pragma unroll
        for (int mb = 0; mb < 4; ++mb) {
            const int m = row0 + wr * 64 + mb * 16 + fr;
            if (nt < 5 && latent) {
                const int tt = (m - MC) & 2047, prow = tt >> 6, pcol = tt & 63;
#pragma unroll
                for (int j = 0; j < 4; ++j) {
                    const f32x2 cr = tab[prow * 16 + fq * 4 + j], cc = tab[pcol * 16 + fq * 4 + j];
                    const float a1 = acc[mb][0][j], a2 = acc[mb][1][j], b1 = acc[mb][2][j], b2 = acc[mb][3][j];
                    acc[mb][0][j] = a1 * cr.x - a2 * cr.y; acc[mb][1][j] = a2 * cr.x + a1 * cr.y;
                    acc[mb][2][j] = b1 * cc.x - b2 * cc.y; acc[mb][3][j] = b2 * cc.x + b1 * cc.y;
                }
            }
#pragma unroll
            for (int nb = 0; nb < 4; ++nb) {
                const int nl = wc * 64 + nb * 16 + fq * 4;
                const f32x4 v = acc[mb][nb];
                if (nt < 4) { *(u32x2*)(qb + (size_t)m * 512 + nt * 128 + nl) = pack4(v); }
                else if (nt == 4) {
                    if (!latent) *(f32x4*)(p.out + OUT_K + (size_t)m * 128 + nl) = v;
                    *(u32x2*)(kb + (size_t)m * 128 + nl) = pack4(v);
                } else if (nt == 5) {
                    if (!latent) *(f32x4*)(p.out + OUT_V + (size_t)m * 128 + nl) = v;
                    int r0, T; seq_of(m, r0, T);
#pragma unroll
                    for (int j = 0; j < 4; ++j) vT[(size_t)r0 * 128 + (size_t)(nl + j) * T + (m - r0)] = f2bf(v[j]);
                } else { *(u32x2*)(zr + (size_t)m * ZRC + (nt - 6) * 128 + nl) = pack4(v); }
            }
        }
    }
}

#define MFMA32(a, b, c) __builtin_amdgcn_mfma_f32_32x32x16_bf16((a), (b), (c), 0, 0, 0)
DI int crow(int i, int h) { return (i & 3) + 8 * (i >> 2) + 4 * h; }

DI void attn_item(const Params& p, char* smem, int it) {
    const int tid = threadIdx.x, wv = tid >> 6, lane = tid & 63, r = lane & 31, hh = lane >> 5;
    unsigned char* ws = p.ws;
    const bf16_t* qb = (const bf16_t*)(ws + OFF_Q); const bf16_t* kb = (const bf16_t*)(ws + OFF_KB); const bf16_t* vT = (const bf16_t*)(ws + OFF_VT);
    const bf16_t* kc = (const bf16_t*)(ws + OFF_KC); const bf16_t* vct = (const bf16_t*)(ws + OFF_VCT);
    bf16_t* ab = (bf16_t*)(ws + OFF_ATTN);
    bf16_t* Ks = (bf16_t*)smem;
    bf16_t* Vt = (bf16_t*)(smem + 9216);
    const float SC = 0.125f * LOG2E;
    {
        int r0, T, q0, kvh, bl;
        const bool lat = it < 512;
        if (lat) { bl = it >> 6; const int rem = it & 63; q0 = (rem >> 1) * 64; kvh = rem & 1; r0 = MC + bl * 2048; T = 2048; }
        else { const int i2 = it - 512; bl = 0; const int s = i2 >> 3, rem = i2 & 7; q0 = (rem >> 1) * 64; kvh = rem & 1; r0 = s * 256; T = 256; }
        const int head = kvh * 4 + (wv & 3), sub = wv >> 2, qs = q0 + 32 * sub;
        bf16x8 qf[4];
#pragma unroll
        for (int kk = 0; kk < 4; ++kk) qf[kk] = *(const bf16x8*)(qb + (size_t)(r0 + qs + r) * 512 + head * 64 + 16 * kk + 8 * hh);
        const float sinkl = p.attn_sink[head] * LOG2E;
        float mrun = sinkl, lrun = hh == 0 ? 1.0f : 0.0f;
        f32x16 o0, o1;
#pragma unroll
        for (int i = 0; i < 16; ++i) { o0[i] = 0.f; o1[i] = 0.f; }
        const int nwin = lat ? 5 : 4, ntile = lat ? 13 : 4;
        for (int ti = 0; ti < ntile; ++ti) {
            const bf16_t* ksrc; const bf16_t* vsrc; int vstride, ks0; bool window;
            if (ti < nwin) {
                ks0 = lat ? q0 - 128 + 64 * ti : 64 * ti; window = lat;
                if (ks0 < 0 || ks0 >= T) continue;
                ksrc = kb + (size_t)(r0 + ks0) * 128 + kvh * 64; vsrc = vT + (size_t)r0 * 128 + (size_t)(kvh * 64) * T + ks0; vstride = T;
            } else {
                ks0 = 64 * (ti - nwin); window = false;
                ksrc = kc + (size_t)(bl * 512 + ks0) * 128 + kvh * 64; vsrc = vct + (size_t)((bl * 2 + kvh) * 64) * 512 + ks0; vstride = 512;
            }
            __syncthreads();
            {
                const int rw_ = tid >> 3, ch = tid & 7;
                *(u32x4*)(Ks + rw_ * 72 + ch * 8) = *(const u32x4*)(ksrc + (size_t)rw_ * 128 + ch * 8);
                *(u32x4*)(Vt + rw_ * 72 + ch * 8) = *(const u32x4*)(vsrc + (size_t)rw_ * vstride + ch * 8);
            }
            __syncthreads();
#pragma unroll
            for (int sk = 0; sk < 2; ++sk) {
                const int kb0 = ks0 + 32 * sk;
                bool need_mask = false;
                if (window) {
                    if (kb0 > qs + 31 + 128 || kb0 + 31 < qs - 128) continue;
                    need_mask = (kb0 < qs + 31 - 128) || (kb0 + 31 > qs + 128);
                }
                f32x16 x;
#pragma unroll
                for (int i = 0; i < 16; ++i) x[i] = 0.f;
#pragma unroll
                for (int kk = 0; kk < 4; ++kk) {
                    const bf16x8 kf = *(const bf16x8*)(Ks + (32 * sk + r) * 72 + 16 * kk + 8 * hh);
                    x = MFMA32(kf, qf[kk], x);
                }
                float mx = -3.0e38f;
#pragma unroll
                for (int i = 0; i < 16; ++i) {
                    float s = x[i] * SC;
                    if (need_mask) { const int dk = kb0 + crow(i, hh) - (qs + r); if (dk > 128 || dk < -128) s = -3.0e38f; }
                    x[i] = s; mx = fmaxf(mx, s);
                }
                mx = fmaxf(mx, __shfl_xor(mx, 32));
                const float mnew = fmaxf(mrun, mx), alpha = exp2f(mrun - mnew);
                mrun = mnew;
                float ps = 0.f;
#pragma unroll
                for (int i = 0; i < 16; ++i) { const float pv = exp2f(x[i] - mnew); x[i] = pv; ps += pv; }
                lrun = lrun * alpha + ps;
#pragma unroll
                for (int i = 0; i < 16; ++i) { o0[i] *= alpha; o1[i] *= alpha; }
#pragma unroll
                for (int s = 0; s < 2; ++s) {
                    u32x4 pk;
                    pk[0] = pack2(x[8 * s + 0], x[8 * s + 1]); pk[1] = pack2(x[8 * s + 2], x[8 * s + 3]);
                    pk[2] = pack2(x[8 * s + 4], x[8 * s + 5]); pk[3] = pack2(x[8 * s + 6], x[8 * s + 7]);
                    const bf16x8 pf = __builtin_bit_cast(bf16x8, pk);
                    {
                        const s16x4 lo = *(const s16x4*)(Vt + r * 72 + 32 * sk + 16 * s + 4 * hh);
                        const s16x4 hi = *(const s16x4*)(Vt + r * 72 + 32 * sk + 16 * s + 8 + 4 * hh);
                        const bf16x8 vf = __builtin_shufflevector(lo, hi, 0, 1, 2, 3, 4, 5, 6, 7);
                        o0 = MFMA32(vf, pf, o0);
                    }
                    {
                        const s16x4 lo = *(const s16x4*)(Vt + (32 + r) * 72 + 32 * sk + 16 * s + 4 * hh);
                        const s16x4 hi = *(const s16x4*)(Vt + (32 + r) * 72 + 32 * sk + 16 * s + 8 + 4 * hh);
                        const bf16x8 vf = __builtin_shufflevector(lo, hi, 0, 1, 2, 3, 4, 5, 6, 7);
                        o1 = MFMA32(vf, pf, o1);
                    }
                }
            }
        }
        const float ltot = lrun + __shfl_xor(lrun, 32), inv = 1.0f / ltot;
        bf16_t* orow = ab + (size_t)(r0 + qs + r) * 512 + head * 64;
#pragma unroll
        for (int g = 0; g < 4; ++g) {
            f32x4 a, b;
#pragma unroll
            for (int j = 0; j < 4; ++j) { a[j] = o0[4 * g + j] * inv; b[j] = o1[4 * g + j] * inv; }
            *(u32x2*)(orow + 8 * g + 4 * hh) = pack4(a);
            *(u32x2*)(orow + 32 + 8 * g + 4 * hh) = pack4(b);
        }
    }
    __syncthreads();
}

DI void sg_pass(const Params& p) {
    const int tid = threadIdx.x;
    unsigned char* ws = p.ws;
    {
        const bf16_t* zr = (const bf16_t*)(p.out + OUT_Y);
        bf16_t* sg = (bf16_t*)(ws + OFF_SG);
        const float* mu0 = p.rwkv_mu; const float* mu1 = p.rwkv_mu + ZRC;
        for (int i = blockIdx.x * NTHR + tid; i < M * 32; i += gridDim.x * NTHR) {
            const int m = i >> 5, c = (i & 31) * 4;
            int r0, T; seq_of(m, r0, T);
            const bf16_t* zp = zr + (size_t)m * ZRC + 1792 + c;
            const f32x4 z = unpack4(*(const u32x2*)zp);
            f32x4 zprev = (f32x4){0.f, 0.f, 0.f, 0.f}, znext = zprev;
            if (m > r0) zprev = unpack4(*(const u32x2*)(zp - ZRC));
            if (m < r0 + T - 1) znext = unpack4(*(const u32x2*)(zp + ZRC));
            const f32x4 a0 = *(const f32x4*)(mu0 + 1792 + c), a1 = *(const f32x4*)(mu1 + 1792 + c);
            f32x4 o;
#pragma unroll
            for (int j = 0; j < 4; ++j) { const float zs = z[j] + a0[j] * (zprev[j] - z[j]) + a1[j] * (znext[j] - z[j]); o[j] = sigmoidf_(zs); }
            *(u32x2*)(sg + (size_t)m * 128 + c) = pack4(o);
        }
    }
}


template <int CTRL> DI float dpp_f(float x) { return __builtin_bit_cast(float, __builtin_amdgcn_mov_dpp(__builtin_bit_cast(int, x), CTRL, 0xf, 0xf, true)); }
DI float swap32_sum(float x) {
    float a = x, b = x;
    asm volatile("s_nop 1\n\tv_permlane32_swap_b32 %0, %1\n\ts_nop 1" : "+v"(a), "+v"(b));
    return a + b;
}
DI float row16_allsum(float x) { x += dpp_f<0x128>(x); x += dpp_f<0x124>(x); x += dpp_f<0x122>(x); x += dpp_f<0x121>(x); return x; }
template <int E> DI float qbc(f32x2 v) { return dpp_f<(E >> 1) * 0x55>((E & 1) ? v.y : v.x); }

#define QP0 " quad_perm:[0,0,0,0] row_mask:0xf bank_mask:0xf bound_ctrl:1\n\t"
#define QP1 " quad_perm:[1,1,1,1] row_mask:0xf bank_mask:0xf bound_ctrl:1\n\t"
#define QP2 " quad_perm:[2,2,2,2] row_mask:0xf bank_mask:0xf bound_ctrl:1\n\t"
#define QP3 " quad_perm:[3,3,3,3] row_mask:0xf bank_mask:0xf bound_ctrl:1\n\t"
#define ROR4 " row_ror:4 row_mask:0xf bank_mask:0xf bound_ctrl:1\n\t"
#define ROR8 " row_ror:8 row_mask:0xf bank_mask:0xf bound_ctrl:1\n\t"
DI float scan_sa(const float (&S)[8], f32x2 A) {
    float sa, t1, t2, t3;
    asm volatile(
        "s_nop 1\n\t"
        "v_mul_f32_dpp %0, %12, %4" QP0
        "v_mul_f32_dpp %1, %13, %5" QP0
        "v_mul_f32_dpp %2, %12, %6" QP1
        "v_mul_f32_dpp %3, %13, %7" QP1
        "v_fmac_f32_dpp %0, %12, %8" QP2
        "v_fmac_f32_dpp %1, %13, %9" QP2
        "v_fmac_f32_dpp %2, %12, %10" QP3
        "v_fmac_f32_dpp %3, %13, %11" QP3
        "v_add_f32 %0, %0, %1\n\t"
        "v_add_f32 %2, %2, %3\n\t"
        "v_add_f32 %0, %0, %2\n\t"
        "s_nop 1\n\t"
        "v_add_f32_dpp %0, %0, %0" ROR4
        "s_nop 1\n\t"
        "v_add_f32_dpp %0, %0, %0" ROR8
        "v_mov_b32 %1, %0\n\t"
        "s_nop 1\n\t"
        "v_permlane32_swap_b32 %0, %1\n\t"
        "s_nop 1\n\t"
        "v_add_f32 %0, %0, %1"
        : "=&v"(sa), "=&v"(t1), "=&v"(t2), "=&v"(t3)
        : "v"(S[0]), "v"(S[1]), "v"(S[2]), "v"(S[3]), "v"(S[4]), "v"(S[5]), "v"(S[6]), "v"(S[7]), "v"(A.x), "v"(A.y));
    return sa;
}
DI float scan_upd(float (&S)[8], float sa, float vv, f32x2 B, f32x2 K, f32x2 W, f32x2 R) {
    float n0, n1, n2, n3, n4, n5, n6, n7, y0, y1, y2, y3;
    asm volatile(
        "s_nop 1\n\t"
        "v_mul_f32_dpp %0, %22, %20" QP0  "v_mul_f32_dpp %1, %23, %20" QP0  "v_mul_f32_dpp %2, %22, %20" QP1  "v_mul_f32_dpp %3, %23, %20" QP1
        "v_mul_f32_dpp %4, %22, %20" QP2  "v_mul_f32_dpp %5, %23, %20" QP2  "v_mul_f32_dpp %6, %22, %20" QP3  "v_mul_f32_dpp %7, %23, %20" QP3
        "v_fmac_f32_dpp %0, %24, %21" QP0  "v_fmac_f32_dpp %1, %25, %21" QP0  "v_fmac_f32_dpp %2, %24, %21" QP1  "v_fmac_f32_dpp %3, %25, %21" QP1
        "v_fmac_f32_dpp %4, %24, %21" QP2  "v_fmac_f32_dpp %5, %25, %21" QP2  "v_fmac_f32_dpp %6, %24, %21" QP3  "v_fmac_f32_dpp %7, %25, %21" QP3
        "v_fmac_f32_dpp %0, %26, %12" QP0  "v_fmac_f32_dpp %1, %27, %13" QP0  "v_fmac_f32_dpp %2, %26, %14" QP1  "v_fmac_f32_dpp %3, %27, %15" QP1
        "v_fmac_f32_dpp %4, %26, %16" QP2  "v_fmac_f32_dpp %5, %27, %17" QP2  "v_fmac_f32_dpp %6, %26, %18" QP3  "v_fmac_f32_dpp %7, %27, %19" QP3
        "v_mul_f32_dpp %8, %28, %0" QP0   "v_mul_f32_dpp %9, %29, %1" QP0   "v_mul_f32_dpp %10, %28, %2" QP1  "v_mul_f32_dpp %11, %29, %3" QP1
        "v_fmac_f32_dpp %8, %28, %4" QP2  "v_fmac_f32_dpp %9, %29, %5" QP2  "v_fmac_f32_dpp %10, %28, %6" QP3 "v_fmac_f32_dpp %11, %29, %7" QP3
        "v_add_f32 %8, %8, %9\n\t"
        "v_add_f32 %10, %10, %11\n\t"
        "v_add_f32 %8, %8, %10\n\t"
        "s_nop 1\n\t"
        "v_add_f32_dpp %8, %8, %8" ROR4
        "s_nop 1\n\t"
        "v_add_f32_dpp %8, %8, %8" ROR8
        "v_mov_b32 %9, %8\n\t"
        "s_nop 1\n\t"
        "v_permlane32_swap_b32 %8, %9\n\t"
        "s_nop 1\n\t"
        "v_add_f32 %8, %8, %9"
        : "=&v"(n0), "=&v"(n1), "=&v"(n2), "=&v"(n3), "=&v"(n4), "=&v"(n5), "=&v"(n6), "=&v"(n7), "=&v"(y0), "=&v"(y1), "=&v"(y2), "=&v"(y3)
        : "v"(S[0]), "v"(S[1]), "v"(S[2]), "v"(S[3]), "v"(S[4]), "v"(S[5]), "v"(S[6]), "v"(S[7]), "v"(sa), "v"(vv),
          "v"(B.x), "v"(B.y), "v"(K.x), "v"(K.y), "v"(W.x), "v"(W.y), "v"(R.x), "v"(R.y));
    S[0] = n0; S[1] = n1; S[2] = n2; S[3] = n3; S[4] = n4; S[5] = n5; S[6] = n6; S[7] = n7;
    return y0;
}

constexpr int SC_OPW = 0, SC_OPK = 8192, SC_OPA = 16384, SC_OPB = 24576, SC_OPR = 32768, SC_OPV = 40960;
constexpr int SC_AW = 49152, SC_AA = SC_AW + 32 * 144;
constexpr int SC_LO = SC_AA + 32 * 144;
constexpr int SC_YB = SC_LO + 2 * 32 * 68 * 4;
static_assert(SC_YB + 8192 <= LDS_MAIN, "scan LDS");

DI void lds_barrier() { asm volatile("s_waitcnt lgkmcnt(0)\n\ts_barrier" ::: "memory"); }

DI void scan_item(const Params& p, char* smem, int r0, int T, int dsel, int h, const float* state0, float* state_out) {
    const int tid = threadIdx.x, wv = tid >> 6, lane = tid & 63;
    unsigned char* ws = p.ws;
    const bf16_t* zr = (const bf16_t*)(p.out + OUT_Y);
    float* ys = (float*)(ws + OFF_YS) + (size_t)dsel * M * 512;
    float* bn = (float*)(ws + OFF_BN);
    float* opW = (float*)(smem + SC_OPW); float* opK = (float*)(smem + SC_OPK); float* opA = (float*)(smem + SC_OPA);
    float* opB = (float*)(smem + SC_OPB); float* opR = (float*)(smem + SC_OPR); float* opV = (float*)(smem + SC_OPV);
    bf16_t* Aw = (bf16_t*)(smem + SC_AW); bf16_t* Aa = (bf16_t*)(smem + SC_AA);
    float* Lo = (float*)(smem + SC_LO); float* yb = (float*)(smem + SC_YB);

    const int qd = lane & 3, rr = qd | (((lane >> 4) & 1) << 2), jp = ((lane >> 2) & 3) | (((lane >> 5) & 1) << 2), irow = 8 * wv + rr, jo = 8 * jp + 2 * qd;
    float S[8];
    if (state0) {
        const f32x4 a = *(const f32x4*)(state0 + irow * 64 + 8 * jp), b = *(const f32x4*)(state0 + irow * 64 + 8 * jp + 4);
        S[0] = a[0]; S[1] = a[1]; S[2] = a[2]; S[3] = a[3]; S[4] = b[0]; S[5] = b[1]; S[6] = b[2]; S[7] = b[3];
    } else {
#pragma unroll
        for (int e = 0; e < 8; ++e) S[e] = 0.f;
    }
    const int tt = tid >> 4, cg4 = (tid & 15) * 4;
    const int segc[5] = {h * 64 + cg4, 512 + h * 64 + cg4, 1024 + h * 64 + cg4, 1536 + dsel * 64 + cg4, 1664 + dsel * 64 + cg4};
    bf16x8 wfrag[4];
    {
        const int L = (wv >> 1) & 1, nbk = wv & 1, r = lane & 31, hh = lane >> 5;
        const bf16_t* wt = (const bf16_t*)(ws + (L == 0 ? OFF_W2T : OFF_A2T)) + (size_t)(dsel * 512 + h * 64 + nbk * 32 + r) * 64;
#pragma unroll
        for (int ks = 0; ks < 4; ++ks) wfrag[ks] = *(const bf16x8*)(wt + 16 * ks + 8 * hh);
    }
    u32x2 zc[5], zp[5], zn[5];
    auto load_chunk = [&](int c) {
        const int st = 32 * c + tt, tok = dsel ? T - 1 - st : st;
        const bf16_t* base = zr + (size_t)(r0 + tok) * ZRC;
#pragma unroll
        for (int s = 0; s < 5; ++s) {
            zc[s] = *(const u32x2*)(base + segc[s]);
            zp[s] = (u32x2){0u, 0u}; zn[s] = (u32x2){0u, 0u};
            if (tok > 0) zp[s] = *(const u32x2*)(base - ZRC + segc[s]);
            if (tok < T - 1) zn[s] = *(const u32x2*)(base + ZRC + segc[s]);
        }
    };
    const int nchunk = T >> 5;
    load_chunk(0);
    for (int c = 0; c < nchunk; ++c) {
        const int st = 32 * c + tt, tok = dsel ? T - 1 - st : st, m = r0 + tok;
        f32x4 mu0[5], mu1[5];
#pragma unroll
        for (int s = 0; s < 5; ++s) { mu0[s] = *(const f32x4*)(p.rwkv_mu + segc[s]); mu1[s] = *(const f32x4*)(p.rwkv_mu + ZRC + segc[s]); }
        const f32x4 w0v = *(const f32x4*)(p.rwkv_w0 + dsel * 512 + h * 64 + cg4), a0v = *(const f32x4*)(p.rwkv_a0 + dsel * 512 + h * 64 + cg4);
        const f32x4 kkv = *(const f32x4*)(p.rwkv_k_k + h * 64 + cg4), kav = *(const f32x4*)(p.rwkv_k_a + h * 64 + cg4), rkv = *(const f32x4*)(p.rwkv_r_k + h * 64 + cg4);
        f32x4 zs[5];
#pragma unroll
        for (int s = 0; s < 5; ++s) {
            const f32x4 z = unpack4(zc[s]), a = unpack4(zp[s]), b = unpack4(zn[s]);
            zs[s] = z + mu0[s] * (a - z) + mu1[s] * (b - z);
        }
        f32x4 kk = zs[1] * kkv;
        float n2 = kk[0] * kk[0] + kk[1] * kk[1] + kk[2] * kk[2] + kk[3] * kk[3];
        n2 = row16_allsum(n2);
        kk = kk * (1.0f / fmaxf(sqrtf(n2), 1e-12f));
        {
            f32x4 tw; for (int j = 0; j < 4; ++j) tw[j] = 1.0f - 2.0f / (1.0f + __expf(2.0f * zs[3][j]));
            *(u32x2*)(Aw + tt * 72 + cg4) = pack4(tw);
            *(u32x2*)(Aa + tt * 72 + cg4) = pack4(zs[4]);
            *(f32x4*)(opR + tt * 64 + cg4) = zs[0];
            *(f32x4*)(opV + tt * 64 + cg4) = zs[2];
            *(f32x4*)(opA + tt * 64 + cg4) = -kk;
        }
        lds_barrier();
        if (wv < 4) {
            const int L = wv >> 1, nbk = wv & 1, r = lane & 31, hh = lane >> 5;
            const bf16_t* As = L == 0 ? Aw : Aa;
            f32x16 x;
#pragma unroll
            for (int i = 0; i < 16; ++i) x[i] = 0.f;
#pragma unroll
            for (int ks = 0; ks < 4; ++ks) {
                const bf16x8 af = *(const bf16x8*)(As + r * 72 + 16 * ks + 8 * hh);
                x = MFMA32(af, wfrag[ks], x);
            }
#pragma unroll
            for (int i = 0; i < 16; ++i) Lo[(L * 32 + crow(i, hh)) * 68 + nbk * 32 + r] = x[i];
        }
        lds_barrier();
        {
            const f32x4 lw = *(const f32x4*)(Lo + tt * 68 + cg4), la = *(const f32x4*)(Lo + (32 + tt) * 68 + cg4);
            f32x4 wd, kd, bb; float bs = 0.f;
#pragma unroll
            for (int j = 0; j < 4; ++j) {
                wd[j] = __expf(-0.6065306597126334f * sigmoidf_(w0v[j] + lw[j]));
                const float a = sigmoidf_(a0v[j] + la[j]);
                kd[j] = zs[1][j] * (1.0f + (a - 1.0f) * kav[j]);
                bb[j] = a * kk[j];
                bs += zs[0][j] * kd[j] * rkv[j];
            }
            *(f32x4*)(opW + tt * 64 + cg4) = wd;
            *(f32x4*)(opK + tt * 64 + cg4) = kd;
            *(f32x4*)(opB + tt * 64 + cg4) = bb;
            bs = row16_allsum(bs);
            if ((tid & 15) == 0) bn[(size_t)m * 16 + dsel * 8 + h] = bs;
        }
        lds_barrier();
        if (c + 1 < nchunk) load_chunk(c + 1);
        {
            const int jb = 8 * jp;
            f32x4 Wa = *(const f32x4*)(opW + jb), Wb = *(const f32x4*)(opW + jb + 4), Ka = *(const f32x4*)(opK + jb), Kb = *(const f32x4*)(opK + jb + 4);
            f32x4 Aa = *(const f32x4*)(opA + jb), Ab = *(const f32x4*)(opA + jb + 4), Ba = *(const f32x4*)(opB + jb), Bb = *(const f32x4*)(opB + jb + 4);
            f32x4 Ra = *(const f32x4*)(opR + jb), Rb = *(const f32x4*)(opR + jb + 4);
            float vv = opV[irow];
            f32x4 Sa = (f32x4){S[0], S[1], S[2], S[3]}, Sb = (f32x4){S[4], S[5], S[6], S[7]};
#pragma unroll 2
            for (int s = 0; s < 32; ++s) {
                const int sn = ((s + 1) & 31) * 64 + jb;
                const f32x4 Wan = *(const f32x4*)(opW + sn), Wbn = *(const f32x4*)(opW + sn + 4), Kan = *(const f32x4*)(opK + sn), Kbn = *(const f32x4*)(opK + sn + 4);
                const f32x4 Aan = *(const f32x4*)(opA + sn), Abn = *(const f32x4*)(opA + sn + 4), Ban = *(const f32x4*)(opB + sn), Bbn = *(const f32x4*)(opB + sn + 4);
                const f32x4 Ran = *(const f32x4*)(opR + sn), Rbn = *(const f32x4*)(opR + sn + 4);
                const float vn = opV[((s + 1) & 31) * 64 + irow];
                const f32x4 pa = Sa * Aa + Sb * Ab;
                float sa = (pa[0] + pa[1]) + (pa[2] + pa[3]);
                sa += dpp_f<0x124>(sa); sa += dpp_f<0x128>(sa); sa = swap32_sum(sa);
                Sa = Sa * Wa + (Ba * sa + Ka * vv);
                Sb = Sb * Wb + (Bb * sa + Kb * vv);
                const f32x4 py = Sa * Ra + Sb * Rb;
                float y = (py[0] + py[1]) + (py[2] + py[3]);
                y += dpp_f<0x124>(y); y += dpp_f<0x128>(y); y = swap32_sum(y);
                if (jp == 0) yb[s * 64 + irow] = y;
                Wa = Wan; Wb = Wbn; Ka = Kan; Kb = Kbn; Aa = Aan; Ab = Abn; Ba = Ban; Bb = Bbn; Ra = Ran; Rb = Rbn; vv = vn;
            }
            S[0] = Sa[0]; S[1] = Sa[1]; S[2] = Sa[2]; S[3] = Sa[3]; S[4] = Sb[0]; S[5] = Sb[1]; S[6] = Sb[2]; S[7] = Sb[3];
        }
        lds_barrier();
        *(f32x4*)(ys + (size_t)m * 512 + h * 64 + cg4) = *(const f32x4*)(yb + tt * 64 + cg4);
    }
    if (state_out) {
        f32x4 a, b; a[0] = S[0]; a[1] = S[1]; a[2] = S[2]; a[3] = S[3]; b[0] = S[4]; b[1] = S[5]; b[2] = S[6]; b[3] = S[7];
        *(f32x4*)(state_out + irow * 64 + 8 * jp) = a; *(f32x4*)(state_out + irow * 64 + 8 * jp + 4) = b;
    }
    lds_barrier();
}

DI void scan_dispatch(const Params& p, char* smem, int it) {
    if (it < 128) {
        const int b = it >> 4, dsel = (it >> 3) & 1, h = it & 7;
        scan_item(p, smem, MC + b * 2048, 2048, dsel, h, p.state_rwkv + (size_t)((b * 2 + dsel) * 8 + h) * 4096, nullptr);
    } else {
        const int i2 = it - 128, s = i2 >> 4, dsel = (i2 >> 3) & 1, h = i2 & 7;
        scan_item(p, smem, s * 256, 256, dsel, h, nullptr, p.out + OUT_S + (size_t)((s * 2 + dsel) * 8 + h) * 4096);
    }
}
DI void phase_mix(const Params& p, char* smem) {
    unsigned* ctr = (unsigned*)(p.ws + OFF_BAR) + XCD_BAR_WORDS;
    volatile LAS unsigned* slot = (volatile LAS unsigned*)(smem + LDS_MAIN + 8);
    for (;;) {
        if (threadIdx.x == 0) *slot = __hip_atomic_fetch_add(ctr, 1u, __ATOMIC_RELAXED, __HIP_MEMORY_SCOPE_AGENT);
        __syncthreads();
        const int it = (int)*slot;
        __syncthreads();
        if (it >= 640 + 768) break;
        if (it < 640) scan_dispatch(p, smem, it);
        else attn_item(p, smem, it - 640);
    }
    sg_pass(p);
}

DI void phase_post(const Params& p, char* smem) {
    const int tid = threadIdx.x, wid = tid >> 6, lane = tid & 63, fr = lane & 15, fq = lane >> 4, wr = wid >> 1, wc = wid & 1;
    unsigned char* ws = p.ws;
    const bf16_t* sg = (const bf16_t*)(ws + OFF_SG); const bf16_t* g2t = (const bf16_t*)(ws + OFF_G2T);
    const float* ys0 = (const float*)(ws + OFF_YS); const float* ys1 = ys0 + (size_t)M * 512;
    const float* bn = (const float*)(ws + OFF_BN);
    const bf16_t* zr = (const bf16_t*)(p.out + OUT_Y);
    bf16_t* rw = (bf16_t*)(ws + OFF_RW);
    const int MT = M / 256, NT = 4;
    for (int t = blockIdx.x; t < MT * NT; t += gridDim.x) {
        int mt, nt; tile_coords(t, MT, NT, mt, nt);
        const int row0 = mt * 256;
        f32x4 acc[4][4]; zero_acc<4>(acc);
        gemm_acc<4>(acc, sg + (size_t)row0 * 128, 128, g2t + (size_t)(nt * 128) * 128, 128, 128, smem, tid);
        const int head = nt * 2 + wc;
#pragma unroll
        for (int mb = 0; mb < 4; ++mb) {
            const int m = row0 + wr * 64 + mb * 16 + fr;
            int r0, T; seq_of(m, r0, T);
            f32x4 y[4]; float s1 = 0.f;
#pragma unroll
            for (int nb = 0; nb < 4; ++nb) {
                const size_t o = (size_t)m * 512 + head * 64 + nb * 16 + fq * 4;
                y[nb] = *(const f32x4*)(ys0 + o) + *(const f32x4*)(ys1 + o);
                s1 += y[nb][0] + y[nb][1] + y[nb][2] + y[nb][3];
            }
            s1 += __shfl_xor(s1, 16); s1 += __shfl_xor(s1, 32);
            const float mean = s1 * (1.0f / 64.0f);
            float s2 = 0.f;
#pragma unroll
            for (int nb = 0; nb < 4; ++nb) { const f32x4 dlt = y[nb] - mean; s2 += dlt[0] * dlt[0] + dlt[1] * dlt[1] + dlt[2] * dlt[2] + dlt[3] * dlt[3]; }
            s2 += __shfl_xor(s2, 16); s2 += __shfl_xor(s2, 32);
            const float rstd = 1.0f / sqrtf(s2 * (1.0f / 64.0f) + 64e-5f);
            const float bonus = bn[(size_t)m * 16 + head] + bn[(size_t)m * 16 + 8 + head];
#pragma unroll
            for (int nb = 0; nb < 4; ++nb) {
                const int c = head * 64 + nb * 16 + fq * 4;
                const bf16_t* zp = zr + (size_t)m * ZRC + 1024 + c;
                const f32x4 z = unpack4(*(const u32x2*)zp);
                f32x4 zprev = (f32x4){0.f, 0.f, 0.f, 0.f}, znext = zprev;
                if (m > r0) zprev = unpack4(*(const u32x2*)(zp - ZRC));
                if (m < r0 + T - 1) znext = unpack4(*(const u32x2*)(zp + ZRC));
                const f32x4 a0 = *(const f32x4*)(p.rwkv_mu + 1024 + c), a1 = *(const f32x4*)(p.rwkv_mu + ZRC + 1024 + c);
                const f32x4 v = z + a0 * (zprev - z) + a1 * (znext - z);
                const f32x4 lg = *(const f32x4*)(p.rwkv_ln_g + c), lb = *(const f32x4*)(p.rwkv_ln_b + c);
                const f32x4 yn = (y[nb] - mean) * rstd * lg + lb;
                const f32x4 o = (yn + v * bonus) * acc[mb][nb];
                *(u32x2*)(rw + (size_t)m * 512 + c) = pack4(o);
            }
        }
    }
}

DI void phase_merge(const Params& p, char* smem) {
    const int tid = threadIdx.x, wid = tid >> 6, lane = tid & 63, fr = lane & 15, fq = lane >> 4, wr = wid >> 1, wc = wid & 1;
    unsigned char* ws = p.ws;
    const bf16_t* hb = (const bf16_t*)(ws + OFF_H); const bf16_t* wt = (const bf16_t*)(ws + OFF_WIN);
    const bf16_t* ab = (const bf16_t*)(ws + OFF_ATTN); const bf16_t* rw = (const bf16_t*)(ws + OFF_RW);
    const bf16_t* wpa = (const bf16_t*)(ws + OFF_WPA); const bf16_t* wpb = (const bf16_t*)(ws + OFF_WPB);
    bf16_t* mg = (bf16_t*)(ws + OFF_MRG);
    const int MT = M / 256, NT = 16;
    for (int t = blockIdx.x; t < MT * NT; t += gridDim.x) {
        int mt, nt; tile_coords(t, MT, NT, mt, nt);
        const int row0 = mt * 256, n0 = nt * 64;
        f32x4 acc[4][2], res[4][2], gate[4][2];
        zero_acc<2>(acc);
        gemm_acc<2>(acc, hb + (size_t)row0 * 1024, 1024, wt + (size_t)(768 + n0) * 1024, 1024, 1024, smem, tid);
#pragma unroll
        for (int a = 0; a < 4; ++a)
#pragma unroll
            for (int b = 0; b < 2; ++b)
#pragma unroll
                for (int j = 0; j < 4; ++j) gate[a][b][j] = sigmoidf_(acc[a][b][j]);
        zero_acc<2>(acc);
        gemm_acc<2>(acc, ab + (size_t)row0 * 512, 512, wpa + (size_t)n0 * 512, 512, 512, smem, tid);
#pragma unroll
        for (int a = 0; a < 4; ++a)
#pragma unroll
            for (int b = 0; b < 2; ++b) res[a][b] = gate[a][b] * acc[a][b];
        zero_acc<2>(acc);
        gemm_acc<2>(acc, hb + (size_t)row0 * 1024, 1024, wt + (size_t)(1792 + n0) * 1024, 1024, 1024, smem, tid);
#pragma unroll
        for (int a = 0; a < 4; ++a)
#pragma unroll
            for (int b = 0; b < 2; ++b)
#pragma unroll
                for (int j = 0; j < 4; ++j) gate[a][b][j] = sigmoidf_(acc[a][b][j]);
        zero_acc<2>(acc);
        gemm_acc<2>(acc, rw + (size_t)row0 * 512, 512, wpb + (size_t)n0 * 512, 512, 512, smem, tid);
#pragma unroll
        for (int mb = 0; mb < 4; ++mb) {
            const int m = row0 + wr * 64 + mb * 16 + fr;
#pragma unroll
            for (int nb = 0; nb < 2; ++nb) {
                const f32x4 o = res[mb][nb] + gate[mb][nb] * acc[mb][nb];
                *(u32x2*)(mg + (size_t)m * 1024 + n0 + wc * 32 + nb * 16 + fq * 4) = pack4(o);
            }
        }
    }
}

DI void phase_out(const Params& p, char* smem) {
    const int tid = threadIdx.x, wid = tid >> 6, lane = tid & 63, fr = lane & 15, fq = lane >> 4, wr = wid >> 1, wc = wid & 1;
    unsigned char* ws = p.ws;
    const bf16_t* mg = (const bf16_t*)(ws + OFF_MRG); const bf16_t* wo = (const bf16_t*)(ws + OFF_WOUT);
    const float* mod = (const float*)(ws + OFF_MOD);
    const int MT = M / 256, NT = 8;
    for (int t = blockIdx.x; t < MT * NT; t += gridDim.x) {
        int mt, nt; tile_coords(t, MT, NT, mt, nt);
        const int row0 = mt * 256, n0 = nt * 128;
        f32x4 acc[4][4]; zero_acc<4>(acc);
        gemm_acc<4>(acc, mg + (size_t)row0 * 1024, 1024, wo + (size_t)n0 * 1024, 1024, 1024, smem, tid);
        const int ci = cond_of(row0);
#pragma unroll
        for (int nb = 0; nb < 4; ++nb) {
            const int n = n0 + wc * 64 + nb * 16 + fq * 4;
            const f32x4 g1 = *(const f32x4*)(mod + ci * 6144 + 2048 + n);
#pragma unroll
            for (int mb = 0; mb < 4; ++mb) {
                const int m = row0 + wr * 64 + mb * 16 + fr;
                const f32x4 xv = *(const f32x4*)(xrow(p, m) + n);
                *(f32x4*)(p.out + OUT_Y + (size_t)m * D + n) = xv + g1 * acc[mb][nb];
            }
        }
    }
}

DI void phase_up(const Params& p, char* smem, int ch) {
    const int tid = threadIdx.x, wid = tid >> 6, lane = tid & 63, fr = lane & 15, fq = lane >> 4, wr = wid >> 1, wc = wid & 1;
    unsigned char* ws = p.ws;
    const bf16_t* hb = (const bf16_t*)(ws + OFF_H); const bf16_t* wu = (const bf16_t*)(ws + OFF_WUP);
    bf16_t* ub = (bf16_t*)(ws + OFF_U);
    const int MT = 16, NT = 44;
    for (int t = blockIdx.x; t < MT * NT; t += gridDim.x) {
        int mt, nt; tile_coords(t, MT, NT, mt, nt);
        const int lrow0 = mt * 256, row0 = ch * 4096 + lrow0, n0 = nt * 128;
        f32x4 acc[4][4]; zero_acc<4>(acc);
        gemm_acc<4>(acc, hb + (size_t)row0 * 1024, 1024, wu + (size_t)n0 * 1024, 1024, 1024, smem, tid);
#pragma unroll
        for (int mb = 0; mb < 4; ++mb) {
            const int ml = lrow0 + wr * 64 + mb * 16 + fr;
#pragma unroll
            for (int nb = 0; nb < 4; ++nb) *(u32x2*)(ub + (size_t)ml * 5632 + n0 + wc * 64 + nb * 16 + fq * 4) = pack4(acc[mb][nb]);
        }
    }
}
DI void phase_conv(const Params& p, int ch) {
    const int tid = threadIdx.x;
    unsigned char* ws = p.ws;
    const bf16_t* ub = (const bf16_t*)(ws + OFF_U);
    bf16_t* act = (bf16_t*)(ws + OFF_ACT);
    const float* cw = p.ffn_conv_w; const float* cb = p.ffn_conv_b;
    const int per_row = DFF / 4;
    for (int i = blockIdx.x * NTHR + tid; i < 4096 * per_row; i += gridDim.x * NTHR) {
        const int ml = i / per_row, c = (i - ml * per_row) * 4, m = ch * 4096 + ml;
        int r0, T; seq_of(m, r0, T);
        const bool hp = m > r0, hn = m < r0 + T - 1;
        f32x4 res[2];
#pragma unroll
        for (int part = 0; part < 2; ++part) {
            const int cc = c + part * DFF;
            const bf16_t* up = ub + (size_t)ml * 5632 + cc;
            const f32x4 u0 = unpack4(*(const u32x2*)up);
            f32x4 um = (f32x4){0.f, 0.f, 0.f, 0.f}, upn = um;
            if (hp) um = unpack4(*(const u32x2*)(up - 5632));
            if (hn) upn = unpack4(*(const u32x2*)(up + 5632));
            const f32x4 w0 = *(const f32x4*)(cw + cc), w1 = *(const f32x4*)(cw + 5632 + cc), w2 = *(const f32x4*)(cw + 2 * 5632 + cc), bb = *(const f32x4*)(cb + cc);
            res[part] = um * w0 + u0 * w1 + upn * w2 + bb;
        }
        f32x4 o;
#pragma unroll
        for (int j = 0; j < 4; ++j) { const float g = res[1][j]; o[j] = g / (1.0f + __expf(-g)) * res[0][j]; }
        *(u32x2*)(act + (size_t)m * DFF + c) = pack4(o);
    }
}
DI void phase_down(const Params& p, char* smem) {
    const int tid = threadIdx.x, wid = tid >> 6, lane = tid & 63, fr = lane & 15, fq = lane >> 4, wr = wid >> 1, wc = wid & 1;
    unsigned char* ws = p.ws;
    const bf16_t* act = (const bf16_t*)(ws + OFF_ACT); const bf16_t* wd = (const bf16_t*)(ws + OFF_WDN);
    const float* mod = (const float*)(ws + OFF_MOD);
    const int MT = M / 256, NT = 8;
    for (int t = blockIdx.x; t < MT * NT; t += gridDim.x) {
        int mt, nt; tile_coords(t, MT, NT, mt, nt);
        const int row0 = mt * 256, n0 = nt * 128;
        f32x4 acc[4][4]; zero_acc<4>(acc);
        gemm_acc<4>(acc, act + (size_t)row0 * DFF, DFF, wd + (size_t)n0 * DFF, DFF, DFF, smem, tid);
        const int ci = cond_of(row0);
#pragma unroll
        for (int nb = 0; nb < 4; ++nb) {
            const int n = n0 + wc * 64 + nb * 16 + fq * 4;
            const f32x4 g2 = *(const f32x4*)(mod + ci * 6144 + 5120 + n);
#pragma unroll
            for (int mb = 0; mb < 4; ++mb) {
                const int m = row0 + wr * 64 + mb * 16 + fr;
                float* px = p.out + OUT_Y + (size_t)m * D + n;
                *(f32x4*)px = *(const f32x4*)px + g2 * acc[mb][nb];
            }
        }
    }
}

#define XB_TMO      128
#define XB_XCNT(j)  (256  + 64 * (j))
#define XB_XSUB(j)  (1280 + 64 * (j))
#define XB_XGEN(j)  (2304 + 64 * (j))
#define XB_TOP      3328
#define XB_TOPGEN   3392
#define XB_SPIN_CAP (1u << 20)
DI unsigned xb_ld(unsigned* p)              { return __hip_atomic_load(p, __ATOMIC_RELAXED, __HIP_MEMORY_SCOPE_AGENT); }
DI unsigned xb_add(unsigned* p, unsigned v) { return __hip_atomic_fetch_add(p, v, __ATOMIC_RELAXED, __HIP_MEMORY_SCOPE_AGENT); }
DI unsigned xb_xcc_id() { return (unsigned)__builtin_amdgcn_s_getreg((3 << 11) | 20) & 0xFu; }
#define XB_SPIN(cond, bar) do { unsigned _sp = 0; while (cond) { __builtin_amdgcn_s_sleep(1); \
    if ((++_sp & 255u) == 0u) { if (xb_ld(&(bar)[XB_TMO])) break; if (_sp > XB_SPIN_CAP) { atomicAdd(&(bar)[XB_TMO], 1u); break; } } } } while (0)
struct XcdBarrier { unsigned* bar; unsigned x; volatile LAS unsigned* st; };
DI XcdBarrier xcd_barrier_post(unsigned* bar, volatile LAS unsigned* st) {
    XcdBarrier b; b.bar = bar; b.x = xb_xcc_id(); b.st = st;
    if (threadIdx.x == 0) (void)xb_add(&bar[XB_XCNT(b.x)], 1u);
    return b;
}
DI void xcd_barrier_complete(unsigned* bar, unsigned x, unsigned& nloc, unsigned& nx) {
    const unsigned G = gridDim.x * gridDim.y * gridDim.z;
    unsigned sum, cnt, mine, sp = 0u;
    for (;;) {
        sum = 0u; cnt = 0u; mine = 0u;
#pragma unroll
        for (unsigned j = 0; j < 16; ++j) { const unsigned c = xb_ld(&bar[XB_XCNT(j)]); sum += c; cnt += (c > 0u) ? 1u : 0u; mine = (j == x) ? c : mine; }
        if (sum == G) break;
        __builtin_amdgcn_s_sleep(1);
        if ((++sp & 255u) == 0u) { if (xb_ld(&bar[XB_TMO])) break; if (sp > XB_SPIN_CAP) { atomicAdd(&bar[XB_TMO], 1u); break; } }
    }
    nloc = mine > 0u ? mine : 1u; nx = cnt > 0u ? cnt : 1u;
}
DI void xcd_barrier(const XcdBarrier& b) {
    asm volatile("s_waitcnt vmcnt(0)" ::: "memory");
    __syncthreads();
    if (threadIdx.x == 0) {
        unsigned* bar = b.bar;
        __builtin_amdgcn_s_waitcnt(0);
        unsigned nloc = b.st[0], nx = b.st[1];
        if (nloc == 0u) { xcd_barrier_complete(bar, b.x, nloc, nx); b.st[0] = nloc; b.st[1] = nx; }
        const unsigned old = xb_add(&bar[XB_XSUB(b.x)], 1u);
        const unsigned gen = old / nloc;
        if (old + 1u == (gen + 1u) * nloc) {
            __builtin_amdgcn_fence(__ATOMIC_RELEASE, "agent");
            asm volatile("s_waitcnt vmcnt(0)" ::: "memory");
            const unsigned og = xb_add(&bar[XB_TOP], 1u);
            const unsigned tg = og / nx;
            if (og + 1u == (tg + 1u) * nx) xb_add(&bar[XB_TOPGEN], 1u);
            else XB_SPIN(xb_ld(&bar[XB_TOPGEN]) == tg, bar);
            __builtin_amdgcn_fence(__ATOMIC_ACQUIRE, "agent");
            xb_add(&bar[XB_XGEN(b.x)], 1u);
            asm volatile("s_waitcnt vmcnt(0)" ::: "memory");
        } else {
            XB_SPIN(xb_ld(&bar[XB_XGEN(b.x)]) == gen, bar);
            __builtin_amdgcn_fence(__ATOMIC_ACQUIRE, "agent");
            asm volatile("s_waitcnt vmcnt(0)" ::: "memory");
        }
    }
    __syncthreads();
}

constexpr int N_PHASES = 23;
__global__ void __launch_bounds__(NTHR) fwd_kernel(Params p) {
    extern __shared__ __attribute__((aligned(16))) char smem[];
    volatile LAS unsigned* xst = (volatile LAS unsigned*)(smem + LDS_MAIN);
    if (threadIdx.x == 0) { xst[0] = 0u; xst[1] = 0u; }
    __syncthreads();
    const XcdBarrier xb = xcd_barrier_post((unsigned*)(p.ws + OFF_BAR), xst);
#ifndef PH_MASK
#define PH_MASK 0xffff
#endif
#ifndef REP_MASK
#define REP_MASK 0
#endif
#define RUN_PHASE(ph, bit, call) if (p.ph_lo <= (ph) && (ph) < p.ph_hi) { if ((ph) > p.ph_lo) xcd_barrier(xb); if (PH_MASK & (bit)) { call; if (REP_MASK & (bit)) { call; } } }
    RUN_PHASE(0, 1, phase_prep(p, smem))
    RUN_PHASE(1, 2, phase_norm<1>(p))
    RUN_PHASE(2, 4, phase_p1(p, smem))
    RUN_PHASE(4, 16, phase_mix(p, smem))
    RUN_PHASE(5, 32, phase_post(p, smem))
    RUN_PHASE(6, 64, phase_merge(p, smem))
    RUN_PHASE(7, 128, phase_out(p, smem))
    RUN_PHASE(8, 256, phase_norm<2>(p))
#pragma unroll 1
    for (int ch = 0; ch < 6; ++ch) {
        RUN_PHASE(9 + 2 * ch, 512, phase_up(p, smem, ch))
        RUN_PHASE(10 + 2 * ch, 1024, phase_conv(p, ch))
    }
    RUN_PHASE(21, 2048, phase_down(p, smem))
    RUN_PHASE(22, 4096, phase_norm<3>(p))
}

extern "C" void kernel_launch(void* const* d_in, const int* in_sizes, int n_in, void* d_out, int out_size, void* d_ws, size_t ws_size, hipStream_t stream) {
    static int grid = 0;
    if (grid == 0) {
        if (n_in != 32 || ws_size < WS_NEED) { fprintf(stderr, "kernel_launch: unexpected inputs (n_in %d, ws %zu, need %zu)\n", n_in, ws_size, (size_t)WS_NEED); grid = -1; return; }
        int dev = 0, cus = 0, per_cu = 0;
        hipGetDevice(&dev);
        hipDeviceGetAttribute(&cus, hipDeviceAttributeMultiprocessorCount, dev);
        hipFuncSetAttribute((const void*)fwd_kernel, hipFuncAttributeMaxDynamicSharedMemorySize, LDS_BYTES);
        hipOccupancyMaxActiveBlocksPerMultiprocessor(&per_cu, (const void*)fwd_kernel, NTHR, LDS_BYTES);
        if (per_cu < 1) { fprintf(stderr, "kernel_launch: occupancy query says %d blocks per CU\n", per_cu); grid = -1; return; }
        grid = cus;
        grid &= ~7;
    }
    if (grid < 0) return;
    if (hipMemsetAsync((char*)d_ws + OFF_BAR, 0, (XCD_BAR_WORDS + 64) * 4, stream) != hipSuccess) { fprintf(stderr, "kernel_launch: memset failed\n"); return; }
    Params p{};
    const float** pp = (const float**)&p;
    for (int i = 0; i < 32; ++i) pp[i] = (const float*)d_in[i];
    p.out = (float*)d_out; p.ws = (unsigned char*)d_ws;
#if N_LAUNCH_SPLIT
    for (int ph = 0; ph < N_PHASES; ++ph) {
        p.ph_lo = ph; p.ph_hi = ph + 1;
        hipLaunchKernelGGL(fwd_kernel, dim3(grid), dim3(NTHR), LDS_BYTES, stream, p);
    }
#else
    p.ph_lo = 0; p.ph_hi = N_PHASES;
    void* args[] = {&p};
    hipError_t e = hipLaunchCooperativeKernel((const void*)fwd_kernel, dim3(grid), dim3(NTHR), args, LDS_BYTES, stream);
    if (e != hipSuccess) fprintf(stderr, "cooperative launch failed: %s (grid %d)\n", hipGetErrorString(e), grid);
#endif
}
```

```cpp
#include <hip/hip_runtime.h>
#include <hip/hip_cooperative_groups.h>
#include <cstdio>
namespace cg = cooperative_groups;

#define DI __device__ __forceinline__
typedef unsigned short bf16_t;
typedef short bf16x8 __attribute__((ext_vector_type(8)));
typedef short s16x4 __attribute__((ext_vector_type(4)));
typedef float f32x4 __attribute__((ext_vector_type(4)));
typedef float f32x2 __attribute__((ext_vector_type(2)));
typedef float f32x16 __attribute__((ext_vector_type(16)));
typedef unsigned u32x4 __attribute__((ext_vector_type(4)));
typedef unsigned u32x2 __attribute__((ext_vector_type(2)));

#ifndef N_LAUNCH_SPLIT
#define N_LAUNCH_SPLIT 0
#endif

constexpr int NTHR = 512;
constexpr int D = 1024;
constexpr int MC = 8192;
constexpr int ML = 16384;
constexpr int M = MC + ML;
constexpr int WIN = 4736;
constexpr int ZRC = 1920;
constexpr int DFF = 2816;
constexpr int LDS_MAIN = 98304;
constexpr int LDS_BYTES = LDS_MAIN + 16;
constexpr float LOG2E = 1.4426950408889634f;

constexpr size_t al256(size_t x) { return (x + 255) & ~(size_t)255; }
constexpr size_t OFF_WUP   = 0;
constexpr size_t OFF_WDN   = OFF_WUP + al256((size_t)5632 * 1024 * 2);
constexpr size_t OFF_MOD   = OFF_WDN + al256((size_t)1024 * 2816 * 2);
constexpr size_t OFF_ROPE  = OFF_MOD + al256((size_t)9 * 6144 * 4);
constexpr size_t OFF_W2T   = OFF_ROPE + al256((size_t)64 * 16 * 8);
constexpr size_t OFF_A2T   = OFF_W2T + al256((size_t)2 * 512 * 64 * 2);
constexpr size_t OFF_G2T   = OFF_A2T + al256((size_t)2 * 512 * 64 * 2);
constexpr size_t OFF_KC    = OFF_G2T + al256((size_t)512 * 128 * 2);
constexpr size_t OFF_VCT   = OFF_KC + al256((size_t)8 * 512 * 128 * 2);
constexpr size_t OFF_BAR   = OFF_VCT + al256((size_t)8 * 512 * 128 * 2);
constexpr size_t OFF_H     = OFF_BAR + al256((size_t)(3456 + 64) * 4);
constexpr size_t OFF_X     = OFF_H + al256((size_t)M * 1024 * 2);
constexpr size_t OFF_WIN   = OFF_X;
constexpr size_t OFF_WPA   = OFF_WIN + al256((size_t)WIN * 1024 * 2);
constexpr size_t OFF_WPB   = OFF_WPA + al256((size_t)1024 * 512 * 2);
constexpr size_t OFF_WOUT  = OFF_WPB + al256((size_t)1024 * 512 * 2);
constexpr size_t OFF_Q     = OFF_WOUT + al256((size_t)1024 * 1024 * 2);
constexpr size_t OFF_RW    = OFF_Q;
constexpr size_t OFF_KB    = OFF_Q + al256((size_t)M * 512 * 2);
constexpr size_t OFF_VT    = OFF_KB + al256((size_t)M * 128 * 2);
constexpr size_t OFF_ATTN  = OFF_VT + al256((size_t)M * 128 * 2);
constexpr size_t OFF_SG    = OFF_ATTN + al256((size_t)M * 512 * 2);
constexpr size_t OFF_BN    = OFF_SG + al256((size_t)M * 128 * 2);
constexpr size_t OFF_YS    = OFF_BN + al256((size_t)M * 16 * 4);
constexpr size_t OFF_MRG   = OFF_YS;
constexpr size_t END_EARLY = OFF_YS + al256((size_t)2 * M * 512 * 4);
constexpr size_t OFF_ACT   = OFF_X;
constexpr size_t OFF_U     = OFF_ACT + al256((size_t)M * DFF * 2);
constexpr size_t END_FFN   = OFF_U + al256((size_t)96 * 44 * 4 * 128 * 2);
constexpr size_t WS_NEED   = END_EARLY > END_FFN ? END_EARLY : END_FFN;
static_assert(WS_NEED <= (size_t)256 * 1024 * 1024, "workspace over 256 MiB");

constexpr size_t OUT_Y  = 0;
constexpr size_t OUT_K  = (size_t)M * 1024;
constexpr size_t OUT_V  = OUT_K + (size_t)MC * 128;
constexpr size_t OUT_S  = OUT_V + (size_t)MC * 128;

struct Params {
    const float *x_prompt, *x_sample, *c, *cache_k, *cache_v, *state_rwkv, *c_ctx, *w_ada, *b_ada, *g_norm1, *w_in, *attn_sink,
        *w_proj_a, *w_proj_b, *rwkv_mu, *rwkv_w0, *rwkv_w2, *rwkv_a0, *rwkv_a2, *rwkv_k_k, *rwkv_k_a, *rwkv_r_k, *rwkv_g2,
        *rwkv_ln_g, *rwkv_ln_b, *w_out, *g_norm2, *w_ffn_up, *ffn_conv_w, *ffn_conv_b, *w_ffn_down, *g_final;
    float* out;
    unsigned char* ws;
    int ph_lo, ph_hi;
};

#define XCD_BAR_WORDS 3456
#define LAS __attribute__((address_space(3)))
DI bf16_t f2bf(float f) { unsigned u = __float_as_uint(f); u += 0x7fffu + ((u >> 16) & 1u); return (bf16_t)(u >> 16); }
DI float bf2f(unsigned b) { return __uint_as_float(b << 16); }
DI unsigned pack2(float lo, float hi) { return (unsigned)f2bf(lo) | ((unsigned)f2bf(hi) << 16); }
DI u32x2 pack4(f32x4 v) { u32x2 r; r.x = pack2(v[0], v[1]); r.y = pack2(v[2], v[3]); return r; }
DI f32x4 unpack4(u32x2 v) { f32x4 r; r[0] = bf2f(v.x & 0xffffu); r[1] = bf2f(v.x >> 16); r[2] = bf2f(v.y & 0xffffu); r[3] = bf2f(v.y >> 16); return r; }
DI float sigmoidf_(float x) { return 1.0f / (1.0f + __expf(-x)); }
DI const float* xrow(const Params& p, int r) { return r < MC ? p.x_prompt + (size_t)r * D : p.x_sample + (size_t)(r - MC) * D; }
DI int cond_of(int r) { return r < MC ? 0 : 1 + ((r - MC) >> 11); }
DI void seq_of(int r, int& r0, int& T) { if (r < MC) { r0 = r & ~255; T = 256; } else { r0 = MC + ((r - MC) & ~2047); T = 2048; } }
DI float wave_sum(float v) {
#pragma unroll
    for (int o = 32; o >= 1; o >>= 1) v += __shfl_xor(v, o);
    return v;
}

DI void transpose_tile(const float* __restrict__ src, int K, int N, bf16_t* __restrict__ dst, int kt, int nt, float* tile, int tid) {
    const int k0 = kt * 64, n0 = nt * 64;
#pragma unroll
    for (int i = 0; i < 8; ++i) { const int k = (tid >> 6) + 8 * i, n = tid & 63; tile[k * 65 + n] = src[(size_t)(k0 + k) * N + n0 + n]; }
    __syncthreads();
#pragma unroll
    for (int i = 0; i < 8; ++i) { const int n = (tid >> 6) + 8 * i, k = tid & 63; dst[(size_t)(n0 + n) * K + k0 + k] = f2bf(tile[k * 65 + n]); }
    __syncthreads();
}

DI void phase_prep(const Params& p, char* smem) {
    const int tid = threadIdx.x, nb = gridDim.x, bid = blockIdx.x;
    unsigned char* ws = p.ws;
    {
        float* tile = (float*)smem;
        const int cnt[11] = {16 * 74, 8 * 16, 8 * 16, 16 * 16, 16 * 88, 44 * 16, 8, 8, 8, 8, 16};
        int total = 0;
#pragma unroll
        for (int i = 0; i < 11; ++i) total += cnt[i];
        for (int it = bid; it < total; it += nb) {
            int i = it, mi = 0;
#pragma unroll
            for (int q = 0; q < 10; ++q) { if (mi == q && i >= cnt[q]) { i -= cnt[q]; mi = q + 1; } }
            const float* src; bf16_t* dst; int K, N;
            switch (mi) {
                case 0: src = p.w_in; K = 1024; N = WIN; dst = (bf16_t*)(ws + OFF_WIN); break;
                case 1: src = p.w_proj_a; K = 512; N = 1024; dst = (bf16_t*)(ws + OFF_WPA); break;
                case 2: src = p.w_proj_b; K = 512; N = 1024; dst = (bf16_t*)(ws + OFF_WPB); break;
                case 3: src = p.w_out; K = 1024; N = 1024; dst = (bf16_t*)(ws + OFF_WOUT); break;
                case 4: src = p.w_ffn_up; K = 1024; N = 5632; dst = (bf16_t*)(ws + OFF_WUP); break;
                case 5: src = p.w_ffn_down; K = 2816; N = 1024; dst = (bf16_t*)(ws + OFF_WDN); break;
                case 6: src = p.rwkv_w2; K = 64; N = 512; dst = (bf16_t*)(ws + OFF_W2T); break;
                case 7: src = p.rwkv_w2 + 64 * 512; K = 64; N = 512; dst = (bf16_t*)(ws + OFF_W2T) + 512 * 64; break;
                case 8: src = p.rwkv_a2; K = 64; N = 512; dst = (bf16_t*)(ws + OFF_A2T); break;
                case 9: src = p.rwkv_a2 + 64 * 512; K = 64; N = 512; dst = (bf16_t*)(ws + OFF_A2T) + 512 * 64; break;
                default: src = p.rwkv_g2; K = 128; N = 512; dst = (bf16_t*)(ws + OFF_G2T); break;
            }
            const int ntn = N / 64;
            transpose_tile(src, K, N, dst, i / ntn, i % ntn, tile, tid);
        }
    }
    {
        bf16_t* kc = (bf16_t*)(ws + OFF_KC); bf16_t* vct = (bf16_t*)(ws + OFF_VCT);
        for (int i = bid * NTHR + tid; i < 8 * 512 * 128; i += nb * NTHR) {
            kc[i] = f2bf(p.cache_k[i]);
            const int key = i & 511, d = (i >> 9) & 63, kvh = (i >> 15) & 1, b = i >> 16;
            vct[i] = f2bf(p.cache_v[((size_t)(b * 512 + key) * 2 + kvh) * 64 + d]);
        }
    }
    {
        f32x2* tab = (f32x2*)(ws + OFF_ROPE);
        for (int i = bid * NTHR + tid; i < 1024; i += nb * NTHR) {
            const int pos = i >> 4, fi = i & 15;
            const double fr = pow(10000.0, -(double)fi / 16.0), ang = (double)pos * fr;
            f32x2 v; v.x = (float)cos(ang); v.y = (float)sin(ang); tab[i] = v;
        }
    }
    {
        float* s = (float*)smem;
        float* red = (float*)(smem + 36864);
        float* mod = (float*)(ws + OFF_MOD);
        for (int it = bid; it < 96; it += nb) {
            __syncthreads();
            for (int i = tid; i < 9 * 1024; i += NTHR) {
                const int ci = i >> 10, k = i & 1023;
                const float v = ci == 0 ? p.c_ctx[k] : p.c[(ci - 1) * 1024 + k];
                s[i] = v / (1.0f + __expf(-v));
            }
            __syncthreads();
            const int n = tid & 63, kq = tid >> 6, n0 = it * 64;
            float acc[9];
#pragma unroll
            for (int ci = 0; ci < 9; ++ci) acc[ci] = 0.f;
            for (int k = kq * 128; k < kq * 128 + 128; ++k) {
                const float w = p.w_ada[(size_t)k * 6144 + n0 + n];
#pragma unroll
                for (int ci = 0; ci < 9; ++ci) acc[ci] += s[ci * 1024 + k] * w;
            }
#pragma unroll
            for (int ci = 0; ci < 9; ++ci) red[(kq * 9 + ci) * 64 + n] = acc[ci];
            __syncthreads();
            for (int i = tid; i < 9 * 64; i += NTHR) {
                const int ci = i >> 6, nn = i & 63;
                float v = p.b_ada[n0 + nn];
#pragma unroll
                for (int q = 0; q < 8; ++q) v += red[(q * 9 + ci) * 64 + nn];
                mod[ci * 6144 + n0 + nn] = v;
            }
        }
        __syncthreads();
    }
}

template <int WHICH> DI void phase_norm(const Params& p) {
    const int tid = threadIdx.x, lane = tid & 63, wv = tid >> 6;
    const float* mod = (const float*)(p.ws + OFF_MOD);
    bf16_t* hb = (bf16_t*)(p.ws + OFF_H);
    const int ntask = M / 8;
    for (int task = blockIdx.x * 8 + wv; task < ntask; task += gridDim.x * 8) {
        const int r_first = task * 8, ci = cond_of(r_first);
        f32x4 fa[4], fb[4];
#pragma unroll
        for (int i = 0; i < 4; ++i) {
            const int col = i * 256 + lane * 4;
            if (WHICH == 3) { fa[i] = *(const f32x4*)(p.g_final + col); fb[i] = (f32x4){0.f, 0.f, 0.f, 0.f}; }
            else {
                const f32x4 g = *(const f32x4*)((WHICH == 1 ? p.g_norm1 : p.g_norm2) + col);
                const f32x4 sc = *(const f32x4*)(mod + ci * 6144 + (WHICH == 1 ? 1024 : 4096) + col);
                fb[i] = *(const f32x4*)(mod + ci * 6144 + (WHICH == 1 ? 0 : 3072) + col);
                fa[i] = g * (sc + 1.0f);
            }
        }
        for (int rr = 0; rr < 8; ++rr) {
            const int r = r_first + rr;
            const float* src = WHICH == 1 ? xrow(p, r) : p.out + OUT_Y + (size_t)r * D;
            f32x4 v[4]; float ss = 0.f;
#pragma unroll
            for (int i = 0; i < 4; ++i) { v[i] = *(const f32x4*)(src + i * 256 + lane * 4); ss += v[i][0] * v[i][0] + v[i][1] * v[i][1] + v[i][2] * v[i][2] + v[i][3] * v[i][3]; }
            ss = wave_sum(ss);
            const float rstd = 1.0f / sqrtf(ss * (1.0f / 1024.0f) + 1e-6f);
#pragma unroll
            for (int i = 0; i < 4; ++i) {
                const f32x4 o = v[i] * rstd * fa[i] + fb[i];
                if (WHICH == 3) *(f32x4*)(p.out + OUT_Y + (size_t)r * D + i * 256 + lane * 4) = o;
                else *(u32x2*)(hb + (size_t)r * D + i * 256 + lane * 4) = pack4(o);
            }
        }
    }
}

template <int NB, int BMAP> DI void gemm_stage(const bf16_t* A, int lda, const bf16_t* Bt, int ldb, int k0, char* sbuf, int tid) {
#pragma unroll
    for (int i = 0; i < 4; ++i) {
        const int c = tid + i * 512, row = c >> 3, pos = c & 7, kc = pos ^ ((row >> 1) & 7);
        __builtin_amdgcn_global_load_lds((const unsigned*)(A + (size_t)row * lda + k0 + kc * 8), (unsigned*)(sbuf + c * 16), 16, 0, 0);
    }
#pragma unroll
    for (int i = 0; i < NB / 2; ++i) {
        const int c = tid + i * 512, row = c >> 3, pos = c & 7, kc = pos ^ ((row >> 1) & 7);
        const int brow = BMAP ? (((row >> 5) & 1) * DFF + (row >> 6) * 32 + (row & 31)) : row;
        __builtin_amdgcn_global_load_lds((const unsigned*)(Bt + (size_t)brow * ldb + k0 + kc * 8), (unsigned*)(sbuf + 32768 + c * 16), 16, 0, 0);
    }
}
template <int NB, int BMAP = 0> DI void gemm_acc(f32x4 (&acc)[4][NB], const bf16_t* A, int lda, const bf16_t* Bt, int ldb, int K, char* smem, int tid) {
    const int wid = tid >> 6, lane = tid & 63, fr = lane & 15, fq = lane >> 4, wr = wid >> 1, wc = wid & 1;
    const int swz = (fr >> 1) & 7;
    const int nk = K >> 6;
    __syncthreads();
    gemm_stage<NB, BMAP>(A, lda, Bt, ldb, 0, smem, tid);
#pragma unroll 1
    for (int t = 0; t < nk; ++t) {
        asm volatile("s_waitcnt vmcnt(0)" ::: "memory");
        __syncthreads();
        if (t + 1 < nk) gemm_stage<NB, BMAP>(A, lda, Bt, ldb, (t + 1) * 64, smem + ((t + 1) & 1) * 49152, tid);
        const char* sA = smem + (t & 1) * 49152;
        const char* sB = sA + 32768;
#pragma unroll
        for (int ks = 0; ks < 2; ++ks) {
            bf16x8 af[4], bfr[NB];
            const int coff = ((ks * 4 + fq) ^ swz) << 4;
#pragma unroll
            for (int mb = 0; mb < 4; ++mb) af[mb] = *(const bf16x8*)(sA + (wr * 64 + mb * 16 + fr) * 128 + coff);
#pragma unroll
            for (int nb = 0; nb < NB; ++nb) bfr[nb] = *(const bf16x8*)(sB + (wc * 16 * NB + nb * 16 + fr) * 128 + coff);
#pragma unroll
            for (int mb = 0; mb < 4; ++mb)
#pragma unroll
                for (int nb = 0; nb < NB; ++nb) acc[mb][nb] = __builtin_amdgcn_mfma_f32_16x16x32_bf16(bfr[nb], af[mb], acc[mb][nb], 0, 0, 0);
        }
    }
}
template <int NB> DI void zero_acc(f32x4 (&acc)[4][NB]) {
#pragma unroll
    for (int a = 0; a < 4; ++a)
#pragma unroll
        for (int b = 0; b < NB; ++b) acc[a][b] = (f32x4){0.f, 0.f, 0.f, 0.f};
}
DI void tile_coords(int t, int MT, int NT, int& mt, int& nt) {
    const int x = t & 7, u = t >> 3, mpx = MT >> 3;
    const int bm = (mpx % 4 == 0) ? 4 : ((mpx % 2 == 0) ? 2 : 1);
    const int per_band = bm * NT, band = u / per_band, rem = u - band * per_band;
    nt = rem / bm; mt = x * mpx + band * bm + (rem % bm);
}

DI void phase_p1(const Params& p, char* smem) {
    const int tid = threadIdx.x, wid = tid >> 6, lane = tid & 63, fr = lane & 15, fq = lane >> 4, wr = wid >> 1, wc = wid & 1;
    unsigned char* ws = p.ws;
    const bf16_t* hb = (const bf16_t*)(ws + OFF_H);
    const bf16_t* wt = (const bf16_t*)(ws + OFF_WIN);
    const f32x2* tab = (const f32x2*)(ws + OFF_ROPE);
    bf16_t* qb = (bf16_t*)(ws + OFF_Q); bf16_t* kb = (bf16_t*)(ws + OFF_KB); bf16_t* vT = (bf16_t*)(ws + OFF_VT);
    bf16_t* zr = (bf16_t*)(p.out + OUT_Y);
    const int MT = M / 256, NT = 21;
    for (int t = blockIdx.x; t < MT * NT; t += gridDim.x) {
        int mt, nt; tile_coords(t, MT, NT, mt, nt);
        const int row0 = mt * 256, ncol0 = nt < 6 ? nt * 128 : 2816 + (nt - 6) * 128;
        f32x4 acc[4][4]; zero_acc<4>(acc);
        gemm_acc<4>(acc, hb + (size_t)row0 * 1024, 1024, wt + (size_t)ncol0 * 1024, 1024, 1024, smem, tid);
        const bool latent = row0 >= MC;
#pragma unroll
        for (int mb = 0; mb < 4; ++mb) {
            const int m = row0 + wr * 64 + mb * 16 + fr;
            if (nt < 5 && latent) {
                const int tt = (m - MC) & 2047, prow = tt >> 6, pcol = tt & 63;
#pragma unroll
                for (int j = 0; j < 4; ++j) {
                    const f32x2 cr = tab[prow * 16 + fq * 4 + j], cc = tab[pcol * 16 + fq * 4 + j];
                    const float a1 = acc[mb][0][j], a2 = acc[mb][1][j], b1 = acc[mb][2][j], b2 = acc[mb][3][j];
                    acc[mb][0][j] = a1 * cr.x - a2 * cr.y; acc[mb][1][j] = a2 * cr.x + a1 * cr.y;
                    acc[mb][2][j] = b1 * cc.x - b2 * cc.y; acc[mb][3][j] = b2 * cc.x + b1 * cc.y;
                }
            }
#pragma unroll
            for (int nb = 0; nb < 4; ++nb) {
                const int nl = wc * 64 + nb * 16 + fq * 4;
                const f32x4 v = acc[mb][nb];
                if (nt < 4) { *(u32x2*)(qb + (size_t)m * 512 + nt * 128 + nl) = pack4(v); }
                else if (nt == 4) {
                    if (!latent) *(f32x4*)(p.out + OUT_K + (size_t)m * 128 + nl) = v;
                    *(u32x2*)(kb + (size_t)m * 128 + nl) = pack4(v);
                } else if (nt == 5) {
                    if (!latent) *(f32x4*)(p.out + OUT_V + (size_t)m * 128 + nl) = v;
                    int r0, T; seq_of(m, r0, T);
#pragma unroll
                    for (int j = 0; j < 4; ++j) vT[(size_t)r0 * 128 + (size_t)(nl + j) * T + (m - r0)] = f2bf(v[j]);
                } else { *(u32x2*)(zr + (size_t)m * ZRC + (nt - 6) * 128 + nl) = pack4(v); }
            }
        }
    }
}

#define MFMA32(a, b, c) __builtin_amdgcn_mfma_f32_32x32x16_bf16((a), (b), (c), 0, 0, 0)
DI int crow(int i, int h) { return (i & 3) + 8 * (i >> 2) + 4 * h; }

DI void attn_item(const Params& p, char* smem, int it) {
    const int tid = threadIdx.x, wv = tid >> 6, lane = tid & 63, r = lane & 31, hh = lane >> 5;
    unsigned char* ws = p.ws;
    const bf16_t* qb = (const bf16_t*)(ws + OFF_Q); const bf16_t* kb = (const bf16_t*)(ws + OFF_KB); const bf16_t* vT = (const bf16_t*)(ws + OFF_VT);
    const bf16_t* kc = (const bf16_t*)(ws + OFF_KC); const bf16_t* vct = (const bf16_t*)(ws + OFF_VCT);
    bf16_t* ab = (bf16_t*)(ws + OFF_ATTN);
    bf16_t* Ks = (bf16_t*)smem;
    bf16_t* Vt = (bf16_t*)(smem + 9216);
    const float SC = 0.125f * LOG2E;
    {
        int r0, T, q0, kvh, bl;
        const bool lat = it < 512;
        if (lat) { bl = it >> 6; const int rem = it & 63; q0 = (rem >> 1) * 64; kvh = rem & 1; r0 = MC + bl * 2048; T = 2048; }
        else { const int i2 = it - 512; bl = 0; const int s = i2 >> 3, rem = i2 & 7; q0 = (rem >> 1) * 64; kvh = rem & 1; r0 = s * 256; T = 256; }
        const int head = kvh * 4 + (wv & 3), sub = wv >> 2, qs = q0 + 32 * sub;
        bf16x8 qf[4];
#pragma unroll
        for (int kk = 0; kk < 4; ++kk) qf[kk] = *(const bf16x8*)(qb + (size_t)(r0 + qs + r) * 512 + head * 64 + 16 * kk + 8 * hh);
        const float sinkl = p.attn_sink[head] * LOG2E;
        float mrun = sinkl, lrun = hh == 0 ? 1.0f : 0.0f;
        f32x16 o0, o1;
#pragma unroll
        for (int i = 0; i < 16; ++i) { o0[i] = 0.f; o1[i] = 0.f; }
        const int nwin = lat ? 5 : 4, ntile = lat ? 13 : 4;
        for (int ti = 0; ti < ntile; ++ti) {
            const bf16_t* ksrc; const bf16_t* vsrc; int vstride, ks0; bool window;
            if (ti < nwin) {
                ks0 = lat ? q0 - 128 + 64 * ti : 64 * ti; window = lat;
                if (ks0 < 0 || ks0 >= T) continue;
                ksrc = kb + (size_t)(r0 + ks0) * 128 + kvh * 64; vsrc = vT + (size_t)r0 * 128 + (size_t)(kvh * 64) * T + ks0; vstride = T;
            } else {
                ks0 = 64 * (ti - nwin); window = false;
                ksrc = kc + (size_t)(bl * 512 + ks0) * 128 + kvh * 64; vsrc = vct + (size_t)((bl * 2 + kvh) * 64) * 512 + ks0; vstride = 512;
            }
            __syncthreads();
            {
                const int rw_ = tid >> 3, ch = tid & 7;
                *(u32x4*)(Ks + rw_ * 72 + ch * 8) = *(const u32x4*)(ksrc + (size_t)rw_ * 128 + ch * 8);
                *(u32x4*)(Vt + rw_ * 72 + ch * 8) = *(const u32x4*)(vsrc + (size_t)rw_ * vstride + ch * 8);
            }
            __syncthreads();
#pragma unroll
            for (int sk = 0; sk < 2; ++sk) {
                const int kb0 = ks0 + 32 * sk;
                bool need_mask = false;
                if (window) {
                    if (kb0 > qs + 31 + 128 || kb0 + 31 < qs - 128) continue;
                    need_mask = (kb0 < qs + 31 - 128) || (kb0 + 31 > qs + 128);
                }
                f32x16 x;
#pragma unroll
                for (int i = 0; i < 16; ++i) x[i] = 0.f;
#pragma unroll
                for (int kk = 0; kk < 4; ++kk) {
                    const bf16x8 kf = *(const bf16x8*)(Ks + (32 * sk + r) * 72 + 16 * kk + 8 * hh);
                    x = MFMA32(kf, qf[kk], x);
                }
                float mx = -3.0e38f;
#pragma unroll
                for (int i = 0; i < 16; ++i) {
                    float s = x[i] * SC;
                    if (need_mask) { const int dk = kb0 + crow(i, hh) - (qs + r); if (dk > 128 || dk < -128) s = -3.0e38f; }
                    x[i] = s; mx = fmaxf(mx, s);
                }
                mx = fmaxf(mx, __shfl_xor(mx, 32));
                const float mnew = fmaxf(mrun, mx), alpha = exp2f(mrun - mnew);
                mrun = mnew;
                float ps = 0.f;
#pragma unroll
                for (int i = 0; i < 16; ++i) { const float pv = exp2f(x[i] - mnew); x[i] = pv; ps += pv; }
                lrun = lrun * alpha + ps;
#pragma unroll
                for (int i = 0; i < 16; ++i) { o0[i] *= alpha; o1[i] *= alpha; }
#pragma unroll
                for (int s = 0; s < 2; ++s) {
                    u32x4 pk;
                    pk[0] = pack2(x[8 * s + 0], x[8 * s + 1]); pk[1] = pack2(x[8 * s + 2], x[8 * s + 3]);
                    pk[2] = pack2(x[8 * s + 4], x[8 * s + 5]); pk[3] = pack2(x[8 * s + 6], x[8 * s + 7]);
                    const bf16x8 pf = __builtin_bit_cast(bf16x8, pk);
                    {
                        const s16x4 lo = *(const s16x4*)(Vt + r * 72 + 32 * sk + 16 * s + 4 * hh);
                        const s16x4 hi = *(const s16x4*)(Vt + r * 72 + 32 * sk + 16 * s + 8 + 4 * hh);
                        const bf16x8 vf = __builtin_shufflevector(lo, hi, 0, 1, 2, 3, 4, 5, 6, 7);
                        o0 = MFMA32(vf, pf, o0);
                    }
                    {
                        const s16x4 lo = *(const s16x4*)(Vt + (32 + r) * 72 + 32 * sk + 16 * s + 4 * hh);
                        const s16x4 hi = *(const s16x4*)(Vt + (32 + r) * 72 + 32 * sk + 16 * s + 8 + 4 * hh);
                        const bf16x8 vf = __builtin_shufflevector(lo, hi, 0, 1, 2, 3, 4, 5, 6, 7);
                        o1 = MFMA32(vf, pf, o1);
                    }
                }
            }
        }
        const float ltot = lrun + __shfl_xor(lrun, 32), inv = 1.0f / ltot;
        bf16_t* orow = ab + (size_t)(r0 + qs + r) * 512 + head * 64;
#pragma unroll
        for (int g = 0; g < 4; ++g) {
            f32x4 a, b;
#pragma unroll
            for (int j = 0; j < 4; ++j) { a[j] = o0[4 * g + j] * inv; b[j] = o1[4 * g + j] * inv; }
            *(u32x2*)(orow + 8 * g + 4 * hh) = pack4(a);
            *(u32x2*)(orow + 32 + 8 * g + 4 * hh) = pack4(b);
        }
    }
    __syncthreads();
}

DI void sg_pass(const Params& p) {
    const int tid = threadIdx.x;
    unsigned char* ws = p.ws;
    {
        const bf16_t* zr = (const bf16_t*)(p.out + OUT_Y);
        bf16_t* sg = (bf16_t*)(ws + OFF_SG);
        const float* mu0 = p.rwkv_mu; const float* mu1 = p.rwkv_mu + ZRC;
        for (int i = blockIdx.x * NTHR + tid; i < M * 32; i += gridDim.x * NTHR) {
            const int m = i >> 5, c = (i & 31) * 4;
            int r0, T; seq_of(m, r0, T);
            const bf16_t* zp = zr + (size_t)m * ZRC + 1792 + c;
            const f32x4 z = unpack4(*(const u32x2*)zp);
            f32x4 zprev = (f32x4){0.f, 0.f, 0.f, 0.f}, znext = zprev;
            if (m > r0) zprev = unpack4(*(const u32x2*)(zp - ZRC));
            if (m < r0 + T - 1) znext = unpack4(*(const u32x2*)(zp + ZRC));
            const f32x4 a0 = *(const f32x4*)(mu0 + 1792 + c), a1 = *(const f32x4*)(mu1 + 1792 + c);
            f32x4 o;
#pragma unroll
            for (int j = 0; j < 4; ++j) { const float zs = z[j] + a0[j] * (zprev[j] - z[j]) + a1[j] * (znext[j] - z[j]); o[j] = sigmoidf_(zs); }
            *(u32x2*)(sg + (size_t)m * 128 + c) = pack4(o);
        }
    }
}


template <int CTRL> DI float dpp_f(float x) { return __builtin_bit_cast(float, __builtin_amdgcn_mov_dpp(__builtin_bit_cast(int, x), CTRL, 0xf, 0xf, true)); }
DI float swap32_sum(float x) {
    float a = x, b = x;
    asm volatile("s_nop 1\n\tv_permlane32_swap_b32 %0, %1\n\ts_nop 1" : "+v"(a), "+v"(b));
    return a + b;
}
DI float row16_allsum(float x) { x += dpp_f<0x128>(x); x += dpp_f<0x124>(x); x += dpp_f<0x122>(x); x += dpp_f<0x121>(x); return x; }
template <int E> DI float qbc(f32x2 v) { return dpp_f<(E >> 1) * 0x55>((E & 1) ? v.y : v.x); }

#define QP0 " quad_perm:[0,0,0,0] row_mask:0xf bank_mask:0xf bound_ctrl:1\n\t"
#define QP1 " quad_perm:[1,1,1,1] row_mask:0xf bank_mask:0xf bound_ctrl:1\n\t"
#define QP2 " quad_perm:[2,2,2,2] row_mask:0xf bank_mask:0xf bound_ctrl:1\n\t"
#define QP3 " quad_perm:[3,3,3,3] row_mask:0xf bank_mask:0xf bound_ctrl:1\n\t"
#define ROR4 " row_ror:4 row_mask:0xf bank_mask:0xf bound_ctrl:1\n\t"
#define ROR8 " row_ror:8 row_mask:0xf bank_mask:0xf bound_ctrl:1\n\t"
DI float scan_sa(const float (&S)[8], f32x2 A) {
    float sa, t1, t2, t3;
    asm volatile(
        "s_nop 1\n\t"
        "v_mul_f32_dpp %0, %12, %4" QP0
        "v_mul_f32_dpp %1, %13, %5" QP0
        "v_mul_f32_dpp %2, %12, %6" QP1
        "v_mul_f32_dpp %3, %13, %7" QP1
        "v_fmac_f32_dpp %0, %12, %8" QP2
        "v_fmac_f32_dpp %1, %13, %9" QP2
        "v_fmac_f32_dpp %2, %12, %10" QP3
        "v_fmac_f32_dpp %3, %13, %11" QP3
        "v_add_f32 %0, %0, %1\n\t"
        "v_add_f32 %2, %2, %3\n\t"
        "v_add_f32 %0, %0, %2\n\t"
        "s_nop 1\n\t"
        "v_add_f32_dpp %0, %0, %0" ROR4
        "s_nop 1\n\t"
        "v_add_f32_dpp %0, %0, %0" ROR8
        "v_mov_b32 %1, %0\n\t"
        "s_nop 1\n\t"
        "v_permlane32_swap_b32 %0, %1\n\t"
        "s_nop 1\n\t"
        "v_add_f32 %0, %0, %1"
        : "=&v"(sa), "=&v"(t1), "=&v"(t2), "=&v"(t3)
        : "v"(S[0]), "v"(S[1]), "v"(S[2]), "v"(S[3]), "v"(S[4]), "v"(S[5]), "v"(S[6]), "v"(S[7]), "v"(A.x), "v"(A.y));
    return sa;
}
DI float scan_upd(float (&S)[8], float sa, float vv, f32x2 B, f32x2 K, f32x2 W, f32x2 R) {
    float n0, n1, n2, n3, n4, n5, n6, n7, y0, y1, y2, y3;
    asm volatile(
        "s_nop 1\n\t"
        "v_mul_f32_dpp %0, %22, %20" QP0  "v_mul_f32_dpp %1, %23, %20" QP0  "v_mul_f32_dpp %2, %22, %20" QP1  "v_mul_f32_dpp %3, %23, %20" QP1
        "v_mul_f32_dpp %4, %22, %20" QP2  "v_mul_f32_dpp %5, %23, %20" QP2  "v_mul_f32_dpp %6, %22, %20" QP3  "v_mul_f32_dpp %7, %23, %20" QP3
        "v_fmac_f32_dpp %0, %24, %21" QP0  "v_fmac_f32_dpp %1, %25, %21" QP0  "v_fmac_f32_dpp %2, %24, %21" QP1  "v_fmac_f32_dpp %3, %25, %21" QP1
        "v_fmac_f32_dpp %4, %24, %21" QP2  "v_fmac_f32_dpp %5, %25, %21" QP2  "v_fmac_f32_dpp %6, %24, %21" QP3  "v_fmac_f32_dpp %7, %25, %21" QP3
        "v_fmac_f32_dpp %0, %26, %12" QP0  "v_fmac_f32_dpp %1, %27, %13" QP0  "v_fmac_f32_dpp %2, %26, %14" QP1  "v_fmac_f32_dpp %3, %27, %15" QP1
        "v_fmac_f32_dpp %4, %26, %16" QP2  "v_fmac_f32_dpp %5, %27, %17" QP2  "v_fmac_f32_dpp %6, %26, %18" QP3  "v_fmac_f32_dpp %7, %27, %19" QP3
        "v_mul_f32_dpp %8, %28, %0" QP0   "v_mul_f32_dpp %9, %29, %1" QP0   "v_mul_f32_dpp %10, %28, %2" QP1  "v_mul_f32_dpp %11, %29, %3" QP1
        "v_fmac_f32_dpp %8, %28, %4" QP2  "v_fmac_f32_dpp %9, %29, %5" QP2  "v_fmac_f32_dpp %10, %28, %6" QP3 "v_fmac_f32_dpp %11, %29, %7" QP3
        "v_add_f32 %8, %8, %9\n\t"
        "v_add_f32 %10, %10, %11\n\t"
        "v_add_f32 %8, %8, %10\n\t"
        "s_nop 1\n\t"
        "v_add_f32_dpp %8, %8, %8" ROR4
        "s_nop 1\n\t"
        "v_add_f32_dpp %8, %8, %8" ROR8
        "v_mov_b32 %9, %8\n\t"
        "s_nop 1\n\t"
        "v_permlane32_swap_b32 %8, %9\n\t"
        "s_nop 1\n\t"
        "v_add_f32 %8, %8, %9"
        : "=&v"(n0), "=&v"(n1), "=&v"(n2), "=&v"(n3), "=&v"(n4), "=&v"(n5), "=&v"(n6), "=&v"(n7), "=&v"(y0), "=&v"(y1), "=&v"(y2), "=&v"(y3)
        : "v"(S[0]), "v"(S[1]), "v"(S[2]), "v"(S[3]), "v"(S[4]), "v"(S[5]), "v"(S[6]), "v"(S[7]), "v"(sa), "v"(vv),
          "v"(B.x), "v"(B.y), "v"(K.x), "v"(K.y), "v"(W.x), "v"(W.y), "v"(R.x), "v"(R.y));
    S[0] = n0; S[1] = n1; S[2] = n2; S[3] = n3; S[4] = n4; S[5] = n5; S[6] = n6; S[7] = n7;
    return y0;
}

constexpr int SC_OPW = 0, SC_OPK = 8192, SC_OPA = 16384, SC_OPB = 24576, SC_OPR = 32768, SC_OPV = 40960;
constexpr int SC_AW = 49152, SC_AA = SC_AW + 32 * 144;
constexpr int SC_LO = SC_AA + 32 * 144;
constexpr int SC_YB = SC_LO + 2 * 32 * 68 * 4;
static_assert(SC_YB + 8192 <= LDS_MAIN, "scan LDS");

DI void lds_barrier() { asm volatile("s_waitcnt lgkmcnt(0)\n\ts_barrier" ::: "memory"); }

DI void scan_item(const Params& p, char* smem, int r0, int T, int dsel, int h, const float* state0, float* state_out) {
    const int tid = threadIdx.x, wv = tid >> 6, lane = tid & 63;
    unsigned char* ws = p.ws;
    const bf16_t* zr = (const bf16_t*)(p.out + OUT_Y);
    float* ys = (float*)(ws + OFF_YS) + (size_t)dsel * M * 512;
    float* bn = (float*)(ws + OFF_BN);
    float* opW = (float*)(smem + SC_OPW); float* opK = (float*)(smem + SC_OPK); float* opA = (float*)(smem + SC_OPA);
    float* opB = (float*)(smem + SC_OPB); float* opR = (float*)(smem + SC_OPR); float* opV = (float*)(smem + SC_OPV);
    bf16_t* Aw = (bf16_t*)(smem + SC_AW); bf16_t* Aa = (bf16_t*)(smem + SC_AA);
    float* Lo = (float*)(smem + SC_LO); float* yb = (float*)(smem + SC_YB);

    const int qd = lane & 3, rr = qd | (((lane >> 4) & 1) << 2), jp = ((lane >> 2) & 3) | (((lane >> 5) & 1) << 2), irow = 8 * wv + rr, jo = 8 * jp + 2 * qd;
    float S[8];
    if (state0) {
        const f32x4 a = *(const f32x4*)(state0 + irow * 64 + 8 * jp), b = *(const f32x4*)(state0 + irow * 64 + 8 * jp + 4);
        S[0] = a[0]; S[1] = a[1]; S[2] = a[2]; S[3] = a[3]; S[4] = b[0]; S[5] = b[1]; S[6] = b[2]; S[7] = b[3];
    } else {
#pragma unroll
        for (int e = 0; e < 8; ++e) S[e] = 0.f;
    }
    const int tt = tid >> 4, cg4 = (tid & 15) * 4;
    const int segc[5] = {h * 64 + cg4, 512 + h * 64 + cg4, 1024 + h * 64 + cg4, 1536 + dsel * 64 + cg4, 1664 + dsel * 64 + cg4};
    bf16x8 wfrag[4];
    {
        const int L = (wv >> 1) & 1, nbk = wv & 1, r = lane & 31, hh = lane >> 5;
        const bf16_t* wt = (const bf16_t*)(ws + (L == 0 ? OFF_W2T : OFF_A2T)) + (size_t)(dsel * 512 + h * 64 + nbk * 32 + r) * 64;
#pragma unroll
        for (int ks = 0; ks < 4; ++ks) wfrag[ks] = *(const bf16x8*)(wt + 16 * ks + 8 * hh);
    }
    u32x2 zc[5], zp[5], zn[5];
    auto load_chunk = [&](int c) {
        const int st = 32 * c + tt, tok = dsel ? T - 1 - st : st;
        const bf16_t* base = zr + (size_t)(r0 + tok) * ZRC;
#pragma unroll
        for (int s = 0; s < 5; ++s) {
            zc[s] = *(const u32x2*)(base + segc[s]);
            zp[s] = (u32x2){0u, 0u}; zn[s] = (u32x2){0u, 0u};
            if (tok > 0) zp[s] = *(const u32x2*)(base - ZRC + segc[s]);
            if (tok < T - 1) zn[s] = *(const u32x2*)(base + ZRC + segc[s]);
        }
    };
    const int nchunk = T >> 5;
    load_chunk(0);
    for (int c = 0; c < nchunk; ++c) {
        const int st = 32 * c + tt, tok = dsel ? T - 1 - st : st, m = r0 + tok;
        f32x4 mu0[5], mu1[5];
#pragma unroll
        for (int s = 0; s < 5; ++s) { mu0[s] = *(const f32x4*)(p.rwkv_mu + segc[s]); mu1[s] = *(const f32x4*)(p.rwkv_mu + ZRC + segc[s]); }
        const f32x4 w0v = *(const f32x4*)(p.rwkv_w0 + dsel * 512 + h * 64 + cg4), a0v = *(const f32x4*)(p.rwkv_a0 + dsel * 512 + h * 64 + cg4);
        const f32x4 kkv = *(const f32x4*)(p.rwkv_k_k + h * 64 + cg4), kav = *(const f32x4*)(p.rwkv_k_a + h * 64 + cg4), rkv = *(const f32x4*)(p.rwkv_r_k + h * 64 + cg4);
        f32x4 zs[5];
#pragma unroll
        for (int s = 0; s < 5; ++s) {
            const f32x4 z = unpack4(zc[s]), a = unpack4(zp[s]), b = unpack4(zn[s]);
            zs[s] = z + mu0[s] * (a - z) + mu1[s] * (b - z);
        }
        f32x4 kk = zs[1] * kkv;
        float n2 = kk[0] * kk[0] + kk[1] * kk[1] + kk[2] * kk[2] + kk[3] * kk[3];
        n2 = row16_allsum(n2);
        kk = kk * (1.0f / fmaxf(sqrtf(n2), 1e-12f));
        {
            f32x4 tw; for (int j = 0; j < 4; ++j) tw[j] = 1.0f - 2.0f / (1.0f + __expf(2.0f * zs[3][j]));
            *(u32x2*)(Aw + tt * 72 + cg4) = pack4(tw);
            *(u32x2*)(Aa + tt * 72 + cg4) = pack4(zs[4]);
            *(f32x4*)(opR + tt * 64 + cg4) = zs[0];
            *(f32x4*)(opV + tt * 64 + cg4) = zs[2];
            *(f32x4*)(opA + tt * 64 + cg4) = -kk;
        }
        lds_barrier();
        if (wv < 4) {
            const int L = wv >> 1, nbk = wv & 1, r = lane & 31, hh = lane >> 5;
            const bf16_t* As = L == 0 ? Aw : Aa;
            f32x16 x;
#pragma unroll
            for (int i = 0; i < 16; ++i) x[i] = 0.f;
#pragma unroll
            for (int ks = 0; ks < 4; ++ks) {
                const bf16x8 af = *(const bf16x8*)(As + r * 72 + 16 * ks + 8 * hh);
                x = MFMA32(af, wfrag[ks], x);
            }
#pragma unroll
            for (int i = 0; i < 16; ++i) Lo[(L * 32 + crow(i, hh)) * 68 + nbk * 32 + r] = x[i];
        }
        lds_barrier();
        {
            const f32x4 lw = *(const f32x4*)(Lo + tt * 68 + cg4), la = *(const f32x4*)(Lo + (32 + tt) * 68 + cg4);
            f32x4 wd, kd, bb; float bs = 0.f;
#pragma unroll
            for (int j = 0; j < 4; ++j) {
                wd[j] = __expf(-0.6065306597126334f * sigmoidf_(w0v[j] + lw[j]));
                const float a = sigmoidf_(a0v[j] + la[j]);
                kd[j] = zs[1][j] * (1.0f + (a - 1.0f) * kav[j]);
                bb[j] = a * kk[j];
                bs += zs[0][j] * kd[j] * rkv[j];
            }
            *(f32x4*)(opW + tt * 64 + cg4) = wd;
            *(f32x4*)(opK + tt * 64 + cg4) = kd;
            *(f32x4*)(opB + tt * 64 + cg4) = bb;
            bs = row16_allsum(bs);
            if ((tid & 15) == 0) bn[(size_t)m * 16 + dsel * 8 + h] = bs;
        }
        lds_barrier();
        if (c + 1 < nchunk) load_chunk(c + 1);
        {
            const int jb = 8 * jp;
            f32x4 Wa = *(const f32x4*)(opW + jb), Wb = *(const f32x4*)(opW + jb + 4), Ka = *(const f32x4*)(opK + jb), Kb = *(const f32x4*)(opK + jb + 4);
            f32x4 Aa = *(const f32x4*)(opA + jb), Ab = *(const f32x4*)(opA + jb + 4), Ba = *(const f32x4*)(opB + jb), Bb = *(const f32x4*)(opB + jb + 4);
            f32x4 Ra = *(const f32x4*)(opR + jb), Rb = *(const f32x4*)(opR + jb + 4);
            float vv = opV[irow];
            f32x4 Sa = (f32x4){S[0], S[1], S[2], S[3]}, Sb = (f32x4){S[4], S[5], S[6], S[7]};
#pragma unroll 2
            for (int s = 0; s < 32; ++s) {
                const int sn = ((s + 1) & 31) * 64 + jb;
                const f32x4 Wan = *(const f32x4*)(opW + sn), Wbn = *(const f32x4*)(opW + sn + 4), Kan = *(const f32x4*)(opK + sn), Kbn = *(const f32x4*)(opK + sn + 4);
                const f32x4 Aan = *(const f32x4*)(opA + sn), Abn = *(const f32x4*)(opA + sn + 4), Ban = *(const f32x4*)(opB + sn), Bbn = *(const f32x4*)(opB + sn + 4);
                const f32x4 Ran = *(const f32x4*)(opR + sn), Rbn = *(const f32x4*)(opR + sn + 4);
                const float vn = opV[((s + 1) & 31) * 64 + irow];
                const f32x4 pa = Sa * Aa + Sb * Ab;
                float sa = (pa[0] + pa[1]) + (pa[2] + pa[3]);
                sa += dpp_f<0x124>(sa); sa += dpp_f<0x128>(sa); sa = swap32_sum(sa);
                Sa = Sa * Wa + (Ba * sa + Ka * vv);
                Sb = Sb * Wb + (Bb * sa + Kb * vv);
                const f32x4 py = Sa * Ra + Sb * Rb;
                float y = (py[0] + py[1]) + (py[2] + py[3]);
                y += dpp_f<0x124>(y); y += dpp_f<0x128>(y); y = swap32_sum(y);
                if (jp == 0) yb[s * 64 + irow] = y;
                Wa = Wan; Wb = Wbn; Ka = Kan; Kb = Kbn; Aa = Aan; Ab = Abn; Ba = Ban; Bb = Bbn; Ra = Ran; Rb = Rbn; vv = vn;
            }
            S[0] = Sa[0]; S[1] = Sa[1]; S[2] = Sa[2]; S[3] = Sa[3]; S[4] = Sb[0]; S[5] = Sb[1]; S[6] = Sb[2]; S[7] = Sb[3];
        }
        lds_barrier();
        *(f32x4*)(ys + (size_t)m * 512 + h * 64 + cg4) = *(const f32x4*)(yb + tt * 64 + cg4);
    }
    if (state_out) {
        f32x4 a, b; a[0] = S[0]; a[1] = S[1]; a[2] = S[2]; a[3] = S[3]; b[0] = S[4]; b[1] = S[5]; b[2] = S[6]; b[3] = S[7];
        *(f32x4*)(state_out + irow * 64 + 8 * jp) = a; *(f32x4*)(state_out + irow * 64 + 8 * jp + 4) = b;
    }
    lds_barrier();
}

DI void scan_dispatch(const Params& p, char* smem, int it) {
    if (it < 128) {
        const int b = it >> 4, dsel = (it >> 3) & 1, h = it & 7;
        scan_item(p, smem, MC + b * 2048, 2048, dsel, h, p.state_rwkv + (size_t)((b * 2 + dsel) * 8 + h) * 4096, nullptr);
    } else {
        const int i2 = it - 128, s = i2 >> 4, dsel = (i2 >> 3) & 1, h = i2 & 7;
        scan_item(p, smem, s * 256, 256, dsel, h, nullptr, p.out + OUT_S + (size_t)((s * 2 + dsel) * 8 + h) * 4096);
    }
}
DI void phase_mix(const Params& p, char* smem) {
    unsigned* ctr = (unsigned*)(p.ws + OFF_BAR) + XCD_BAR_WORDS;
    volatile LAS unsigned* slot = (volatile LAS unsigned*)(smem + LDS_MAIN + 8);
    for (;;) {
        if (threadIdx.x == 0) *slot = __hip_atomic_fetch_add(ctr, 1u, __ATOMIC_RELAXED, __HIP_MEMORY_SCOPE_AGENT);
        __syncthreads();
        const int it = (int)*slot;
        __syncthreads();
        if (it >= 640 + 768) break;
        if (it < 640) scan_dispatch(p, smem, it);
        else attn_item(p, smem, it - 640);
    }
    sg_pass(p);
}

DI void phase_post(const Params& p, char* smem) {
    const int tid = threadIdx.x, wid = tid >> 6, lane = tid & 63, fr = lane & 15, fq = lane >> 4, wr = wid >> 1, wc = wid & 1;
    unsigned char* ws = p.ws;
    const bf16_t* sg = (const bf16_t*)(ws + OFF_SG); const bf16_t* g2t = (const bf16_t*)(ws + OFF_G2T);
    const float* ys0 = (const float*)(ws + OFF_YS); const float* ys1 = ys0 + (size_t)M * 512;
    const float* bn = (const float*)(ws + OFF_BN);
    const bf16_t* zr = (const bf16_t*)(p.out + OUT_Y);
    bf16_t* rw = (bf16_t*)(ws + OFF_RW);
    const int MT = M / 256, NT = 4;
    for (int t = blockIdx.x; t < MT * NT; t += gridDim.x) {
        int mt, nt; tile_coords(t, MT, NT, mt, nt);
        const int row0 = mt * 256;
        f32x4 acc[4][4]; zero_acc<4>(acc);
        gemm_acc<4>(acc, sg + (size_t)row0 * 128, 128, g2t + (size_t)(nt * 128) * 128, 128, 128, smem, tid);
        const int head = nt * 2 + wc;
#pragma unroll
        for (int mb = 0; mb < 4; ++mb) {
            const int m = row0 + wr * 64 + mb * 16 + fr;
            int r0, T; seq_of(m, r0, T);
            f32x4 y[4]; float s1 = 0.f;
#pragma unroll
            for (int nb = 0; nb < 4; ++nb) {
                const size_t o = (size_t)m * 512 + head * 64 + nb * 16 + fq * 4;
                y[nb] = *(const f32x4*)(ys0 + o) + *(const f32x4*)(ys1 + o);
                s1 += y[nb][0] + y[nb][1] + y[nb][2] + y[nb][3];
            }
            s1 += __shfl_xor(s1, 16); s1 += __shfl_xor(s1, 32);
            const float mean = s1 * (1.0f / 64.0f);
            float s2 = 0.f;
#pragma unroll
            for (int nb = 0; nb < 4; ++nb) { const f32x4 dlt = y[nb] - mean; s2 += dlt[0] * dlt[0] + dlt[1] * dlt[1] + dlt[2] * dlt[2] + dlt[3] * dlt[3]; }
            s2 += __shfl_xor(s2, 16); s2 += __shfl_xor(s2, 32);
            const float rstd = 1.0f / sqrtf(s2 * (1.0f / 64.0f) + 64e-5f);
            const float bonus = bn[(size_t)m * 16 + head] + bn[(size_t)m * 16 + 8 + head];
#pragma unroll
            for (int nb = 0; nb < 4; ++nb) {
                const int c = head * 64 + nb * 16 + fq * 4;
                const bf16_t* zp = zr + (size_t)m * ZRC + 1024 + c;
                const f32x4 z = unpack4(*(const u32x2*)zp);
                f32x4 zprev = (f32x4){0.f, 0.f, 0.f, 0.f}, znext = zprev;
                if (m > r0) zprev = unpack4(*(const u32x2*)(zp - ZRC));
                if (m < r0 + T - 1) znext = unpack4(*(const u32x2*)(zp + ZRC));
                const f32x4 a0 = *(const f32x4*)(p.rwkv_mu + 1024 + c), a1 = *(const f32x4*)(p.rwkv_mu + ZRC + 1024 + c);
                const f32x4 v = z + a0 * (zprev - z) + a1 * (znext - z);
                const f32x4 lg = *(const f32x4*)(p.rwkv_ln_g + c), lb = *(const f32x4*)(p.rwkv_ln_b + c);
                const f32x4 yn = (y[nb] - mean) * rstd * lg + lb;
                const f32x4 o = (yn + v * bonus) * acc[mb][nb];
                *(u32x2*)(rw + (size_t)m * 512 + c) = pack4(o);
            }
        }
    }
}

DI void phase_merge(const Params& p, char* smem) {
    const int tid = threadIdx.x, wid = tid >> 6, lane = tid & 63, fr = lane & 15, fq = lane >> 4, wr = wid >> 1, wc = wid & 1;
    unsigned char* ws = p.ws;
    const bf16_t* hb = (const bf16_t*)(ws + OFF_H); const bf16_t* wt = (const bf16_t*)(ws + OFF_WIN);
    const bf16_t* ab = (const bf16_t*)(ws + OFF_ATTN); const bf16_t* rw = (const bf16_t*)(ws + OFF_RW);
    const bf16_t* wpa = (const bf16_t*)(ws + OFF_WPA); const bf16_t* wpb = (const bf16_t*)(ws + OFF_WPB);
    bf16_t* mg = (bf16_t*)(ws + OFF_MRG);
    const int MT = M / 256, NT = 16;
    for (int t = blockIdx.x; t < MT * NT; t += gridDim.x) {
        int mt, nt; tile_coords(t, MT, NT, mt, nt);
        const int row0 = mt * 256, n0 = nt * 64;
        f32x4 acc[4][2], res[4][2], gate[4][2];
        zero_acc<2>(acc);
        gemm_acc<2>(acc, hb + (size_t)row0 * 1024, 1024, wt + (size_t)(768 + n0) * 1024, 1024, 1024, smem, tid);
#pragma unroll
        for (int a = 0; a < 4; ++a)
#pragma unroll
            for (int b = 0; b < 2; ++b)
#pragma unroll
                for (int j = 0; j < 4; ++j) gate[a][b][j] = sigmoidf_(acc[a][b][j]);
        zero_acc<2>(acc);
        gemm_acc<2>(acc, ab + (size_t)row0 * 512, 512, wpa + (size_t)n0 * 512, 512, 512, smem, tid);
#pragma unroll
        for (int a = 0; a < 4; ++a)
#pragma unroll
            for (int b = 0; b < 2; ++b) res[a][b] = gate[a][b] * acc[a][b];
        zero_acc<2>(acc);
        gemm_acc<2>(acc, hb + (size_t)row0 * 1024, 1024, wt + (size_t)(1792 + n0) * 1024, 1024, 1024, smem, tid);
#pragma unroll
        for (int a = 0; a < 4; ++a)
#pragma unroll
            for (int b = 0; b < 2; ++b)
#pragma unroll
                for (int j = 0; j < 4; ++j) gate[a][b][j] = sigmoidf_(acc[a][b][j]);
        zero_acc<2>(acc);
        gemm_acc<2>(acc, rw + (size_t)row0 * 512, 512, wpb + (size_t)n0 * 512, 512, 512, smem, tid);
#pragma unroll
        for (int mb = 0; mb < 4; ++mb) {
            const int m = row0 + wr * 64 + mb * 16 + fr;
#pragma unroll
            for (int nb = 0; nb < 2; ++nb) {
                const f32x4 o = res[mb][nb] + gate[mb][nb] * acc[mb][nb];
                *(u32x2*)(mg + (size_t)m * 1024 + n0 + wc * 32 + nb * 16 + fq * 4) = pack4(o);
            }
        }
    }
}

DI void phase_out(const Params& p, char* smem) {
    const int tid = threadIdx.x, wid = tid >> 6, lane = tid & 63, fr = lane & 15, fq = lane >> 4, wr = wid >> 1, wc = wid & 1;
    unsigned char* ws = p.ws;
    const bf16_t* mg = (const bf16_t*)(ws + OFF_MRG); const bf16_t* wo = (const bf16_t*)(ws + OFF_WOUT);
    const float* mod = (const float*)(ws + OFF_MOD);
    const int MT = M / 256, NT = 8;
    for (int t = blockIdx.x; t < MT * NT; t += gridDim.x) {
        int mt, nt; tile_coords(t, MT, NT, mt, nt);
        const int row0 = mt * 256, n0 = nt * 128;
        f32x4 acc[4][4]; zero_acc<4>(acc);
        gemm_acc<4>(acc, mg + (size_t)row0 * 1024, 1024, wo + (size_t)n0 * 1024, 1024, 1024, smem, tid);
        const int ci = cond_of(row0);
#pragma unroll
        for (int nb = 0; nb < 4; ++nb) {
            const int n = n0 + wc * 64 + nb * 16 + fq * 4;
            const f32x4 g1 = *(const f32x4*)(mod + ci * 6144 + 2048 + n);
#pragma unroll
            for (int mb = 0; mb < 4; ++mb) {
                const int m = row0 + wr * 64 + mb * 16 + fr;
                const f32x4 xv = *(const f32x4*)(xrow(p, m) + n);
                *(f32x4*)(p.out + OUT_Y + (size_t)m * D + n) = xv + g1 * acc[mb][nb];
            }
        }
    }
}

DI u32x2 conv_act(const f32x4 (&um)[2], const f32x4 (&u0)[2], const f32x4 (&up)[2], const float* cw, const float* cb, int gcol) {
    f32x4 res[2];
#pragma unroll
    for (int part = 0; part < 2; ++part) {
        const int cc = gcol + part * DFF;
        const f32x4 w0 = *(const f32x4*)(cw + cc), w1 = *(const f32x4*)(cw + 5632 + cc), w2 = *(const f32x4*)(cw + 2 * 5632 + cc), bb = *(const f32x4*)(cb + cc);
        res[part] = um[part] * w0 + u0[part] * w1 + up[part] * w2 + bb;
    }
    f32x4 o;
#pragma unroll
    for (int j = 0; j < 4; ++j) { const float g = res[1][j]; o[j] = g / (1.0f + __expf(-g)) * res[0][j]; }
    return pack4(o);
}
DI void phase_up(const Params& p, char* smem) {
    const int tid = threadIdx.x, wid = tid >> 6, lane = tid & 63, fr = lane & 15, fq = lane >> 4, wr = wid >> 1, wc = wid & 1;
    unsigned char* ws = p.ws;
    const bf16_t* hb = (const bf16_t*)(ws + OFF_H); const bf16_t* wu = (const bf16_t*)(ws + OFF_WUP);
    bf16_t* act = (bf16_t*)(ws + OFF_ACT); bf16_t* ub = (bf16_t*)(ws + OFF_U);
    bf16_t* ut = (bf16_t*)smem;
    const int MT = M / 256, NT = 44;
    for (int t = blockIdx.x; t < MT * NT; t += gridDim.x) {
        int mt, nt; tile_coords(t, MT, NT, mt, nt);
        const int row0 = mt * 256, n0 = nt * 64;
        f32x4 acc[4][4]; zero_acc<4>(acc);
        gemm_acc<4, 1>(acc, hb + (size_t)row0 * 1024, 1024, wu + (size_t)n0 * 1024, 1024, 1024, smem, tid);
        __syncthreads();
#pragma unroll
        for (int mb = 0; mb < 4; ++mb)
#pragma unroll
            for (int nb = 0; nb < 4; ++nb) *(u32x2*)(ut + (wr * 64 + mb * 16 + fr) * 136 + wc * 64 + nb * 16 + fq * 4) = pack4(acc[mb][nb]);
        __syncthreads();
        const int c4 = (tid & 15) * 4, lv = (c4 >> 5) * 64 + (c4 & 31), lg = lv + 32;
#pragma unroll 2
        for (int it = 0; it < 8; ++it) {
            const int row = it * 32 + (tid >> 4);
            f32x4 um[2], u0[2], up[2];
            const f32x4 z4 = (f32x4){0.f, 0.f, 0.f, 0.f};
            u0[0] = unpack4(*(const u32x2*)(ut + row * 136 + lv)); u0[1] = unpack4(*(const u32x2*)(ut + row * 136 + lg));
            um[0] = row > 0 ? unpack4(*(const u32x2*)(ut + (row - 1) * 136 + lv)) : z4; um[1] = row > 0 ? unpack4(*(const u32x2*)(ut + (row - 1) * 136 + lg)) : z4;
            up[0] = row < 255 ? unpack4(*(const u32x2*)(ut + (row + 1) * 136 + lv)) : z4; up[1] = row < 255 ? unpack4(*(const u32x2*)(ut + (row + 1) * 136 + lg)) : z4;
            *(u32x2*)(act + (size_t)(row0 + row) * DFF + n0 + c4) = conv_act(um, u0, up, p.ffn_conv_w, p.ffn_conv_b, n0 + c4);
        }
        if (row0 >= MC && tid < 256) {
            const int k = tid >> 6, rsel = k < 2 ? k : 252 + k, cp = (tid & 63) * 2;
            *(unsigned*)(ub + ((size_t)(mt * NT + nt) * 4 + k) * 128 + cp) = *(const unsigned*)(ut + rsel * 136 + cp);
        }
    }
}
DI void phase_fix(const Params& p) {
    unsigned char* ws = p.ws;
    bf16_t* act = (bf16_t*)(ws + OFF_ACT); const bf16_t* ub = (const bf16_t*)(ws + OFF_U);
    const int NT = 44;
    for (int i = blockIdx.x * NTHR + threadIdx.x; i < 64 * NT * 2 * 16; i += gridDim.x * NTHR) {
        const int cg = i & 15, which = (i >> 4) & 1, rest = i >> 5, nt = rest % NT, mt = 32 + rest / NT;
        const int row0 = mt * 256, tpos = (row0 - MC) & 2047;
        if (which == 0 ? tpos == 0 : tpos == 2048 - 256) continue;
        const bf16_t* own = ub + (size_t)(mt * NT + nt) * 4 * 128;
        const bf16_t *pv, *cu, *nx; int m;
        if (which == 0) { m = row0; pv = ub + ((size_t)((mt - 1) * NT + nt) * 4 + 3) * 128; cu = own; nx = own + 128; }
        else { m = row0 + 255; pv = own + 2 * 128; cu = own + 3 * 128; nx = ub + (size_t)((mt + 1) * NT + nt) * 4 * 128; }
        const int c4 = cg * 4, lv = (c4 >> 5) * 64 + (c4 & 31), lg = lv + 32;
        f32x4 um[2], u0[2], up[2];
        um[0] = unpack4(*(const u32x2*)(pv + lv)); um[1] = unpack4(*(const u32x2*)(pv + lg));
        u0[0] = unpack4(*(const u32x2*)(cu + lv)); u0[1] = unpack4(*(const u32x2*)(cu + lg));
        up[0] = unpack4(*(const u32x2*)(nx + lv)); up[1] = unpack4(*(const u32x2*)(nx + lg));
        *(u32x2*)(act + (size_t)m * DFF + nt * 64 + c4) = conv_act(um, u0, up, p.ffn_conv_w, p.ffn_conv_b, nt * 64 + c4);
    }
}
DI void phase_down(const Params& p, char* smem) {
    const int tid = threadIdx.x, wid = tid >> 6, lane = tid & 63, fr = lane & 15, fq = lane >> 4, wr = wid >> 1, wc = wid & 1;
    unsigned char* ws = p.ws;
    const bf16_t* act = (const bf16_t*)(ws + OFF_ACT); const bf16_t* wd = (const bf16_t*)(ws + OFF_WDN);
    const float* mod = (const float*)(ws + OFF_MOD);
    const int MT = M / 256, NT = 8;
    for (int t = blockIdx.x; t < MT * NT; t += gridDim.x) {
        int mt, nt; tile_coords(t, MT, NT, mt, nt);
        const int row0 = mt * 256, n0 = nt * 128;
        f32x4 acc[4][4]; zero_acc<4>(acc);
        gemm_acc<4>(acc, act + (size_t)row0 * DFF, DFF, wd + (size_t)n0 * DFF, DFF, DFF, smem, tid);
        const int ci = cond_of(row0);
#pragma unroll
        for (int nb = 0; nb < 4; ++nb) {
            const int n = n0 + wc * 64 + nb * 16 + fq * 4;
            const f32x4 g2 = *(const f32x4*)(mod + ci * 6144 + 5120 + n);
#pragma unroll
            for (int mb = 0; mb < 4; ++mb) {
                const int m = row0 + wr * 64 + mb * 16 + fr;
                float* px = p.out + OUT_Y + (size_t)m * D + n;
                *(f32x4*)px = *(const f32x4*)px + g2 * acc[mb][nb];
            }
        }
    }
}

#define XB_TMO      128
#define XB_XCNT(j)  (256  + 64 * (j))
#define XB_XSUB(j)  (1280 + 64 * (j))
#define XB_XGEN(j)  (2304 + 64 * (j))
#define XB_TOP      3328
#define XB_TOPGEN   3392
#define XB_SPIN_CAP (1u << 20)
DI unsigned xb_ld(unsigned* p)              { return __hip_atomic_load(p, __ATOMIC_RELAXED, __HIP_MEMORY_SCOPE_AGENT); }
DI unsigned xb_add(unsigned* p, unsigned v) { return __hip_atomic_fetch_add(p, v, __ATOMIC_RELAXED, __HIP_MEMORY_SCOPE_AGENT); }
DI unsigned xb_xcc_id() { return (unsigned)__builtin_amdgcn_s_getreg((3 << 11) | 20) & 0xFu; }
#define XB_SPIN(cond, bar) do { unsigned _sp = 0; while (cond) { __builtin_amdgcn_s_sleep(1); \
    if ((++_sp & 255u) == 0u) { if (xb_ld(&(bar)[XB_TMO])) break; if (_sp > XB_SPIN_CAP) { atomicAdd(&(bar)[XB_TMO], 1u); break; } } } } while (0)
struct XcdBarrier { unsigned* bar; unsigned x; volatile LAS unsigned* st; };
DI XcdBarrier xcd_barrier_post(unsigned* bar, volatile LAS unsigned* st) {
    XcdBarrier b; b.bar = bar; b.x = xb_xcc_id(); b.st = st;
    if (threadIdx.x == 0) (void)xb_add(&bar[XB_XCNT(b.x)], 1u);
    return b;
}
DI void xcd_barrier_complete(unsigned* bar, unsigned x, unsigned& nloc, unsigned& nx) {
    const unsigned G = gridDim.x * gridDim.y * gridDim.z;
    unsigned sum, cnt, mine, sp = 0u;
    for (;;) {
        sum = 0u; cnt = 0u; mine = 0u;
#pragma unroll
        for (unsigned j = 0; j < 16; ++j) { const unsigned c = xb_ld(&bar[XB_XCNT(j)]); sum += c; cnt += (c > 0u) ? 1u : 0u; mine = (j == x) ? c : mine; }
        if (sum == G) break;
        __builtin_amdgcn_s_sleep(1);
        if ((++sp & 255u) == 0u) { if (xb_ld(&bar[XB_TMO])) break; if (sp > XB_SPIN_CAP) { atomicAdd(&bar[XB_TMO], 1u); break; } }
    }
    nloc = mine > 0u ? mine : 1u; nx = cnt > 0u ? cnt : 1u;
}
DI void xcd_barrier(const XcdBarrier& b) {
    asm volatile("s_waitcnt vmcnt(0)" ::: "memory");
    __syncthreads();
    if (threadIdx.x == 0) {
        unsigned* bar = b.bar;
        __builtin_amdgcn_s_waitcnt(0);
        unsigned nloc = b.st[0], nx = b.st[1];
        if (nloc == 0u) { xcd_barrier_complete(bar, b.x, nloc, nx); b.st[0] = nloc; b.st[1] = nx; }
        const unsigned old = xb_add(&bar[XB_XSUB(b.x)], 1u);
        const unsigned gen = old / nloc;
        if (old + 1u == (gen + 1u) * nloc) {
            __builtin_amdgcn_fence(__ATOMIC_RELEASE, "agent");
            asm volatile("s_waitcnt vmcnt(0)" ::: "memory");
            const unsigned og = xb_add(&bar[XB_TOP], 1u);
            const unsigned tg = og / nx;
            if (og + 1u == (tg + 1u) * nx) xb_add(&bar[XB_TOPGEN], 1u);
            else XB_SPIN(xb_ld(&bar[XB_TOPGEN]) == tg, bar);
            __builtin_amdgcn_fence(__ATOMIC_ACQUIRE, "agent");
            xb_add(&bar[XB_XGEN(b.x)], 1u);
            asm volatile("s_waitcnt vmcnt(0)" ::: "memory");
        } else {
            XB_SPIN(xb_ld(&bar[XB_XGEN(b.x)]) == gen, bar);
            __builtin_amdgcn_fence(__ATOMIC_ACQUIRE, "agent");
            asm volatile("s_waitcnt vmcnt(0)" ::: "memory");
        }
    }
    __syncthreads();
}

constexpr int N_PHASES = 23;
__global__ void __launch_bounds__(NTHR) fwd_kernel(Params p) {
    extern __shared__ __attribute__((aligned(16))) char smem[];
    volatile LAS unsigned* xst = (volatile LAS unsigned*)(smem + LDS_MAIN);
    if (threadIdx.x == 0) { xst[0] = 0u; xst[1] = 0u; }
    __syncthreads();
    const XcdBarrier xb = xcd_barrier_post((unsigned*)(p.ws + OFF_BAR), xst);
#ifndef PH_MASK
#define PH_MASK 0xffff
#endif
#ifndef REP_MASK
#define REP_MASK 0
#endif
#define RUN_PHASE(ph, bit, call) if (p.ph_lo <= (ph) && (ph) < p.ph_hi) { if ((ph) > p.ph_lo) xcd_barrier(xb); if (PH_MASK & (bit)) { call; if (REP_MASK & (bit)) { call; } } }
    RUN_PHASE(0, 1, phase_prep(p, smem))
    RUN_PHASE(1, 2, phase_norm<1>(p))
    RUN_PHASE(2, 4, phase_p1(p, smem))
    RUN_PHASE(4, 16, phase_mix(p, smem))
    RUN_PHASE(5, 32, phase_post(p, smem))
    RUN_PHASE(6, 64, phase_merge(p, smem))
    RUN_PHASE(7, 128, phase_out(p, smem))
    RUN_PHASE(8, 256, phase_norm<2>(p))
    RUN_PHASE(9, 512, phase_up(p, smem))
    RUN_PHASE(10, 1024, phase_fix(p))
    RUN_PHASE(21, 2048, phase_down(p, smem))
    RUN_PHASE(22, 4096, phase_norm<3>(p))
}

extern "C" void kernel_launch(void* const* d_in, const int* in_sizes, int n_in, void* d_out, int out_size, void* d_ws, size_t ws_size, hipStream_t stream) {
    static int grid = 0;
    if (grid == 0) {
        if (n_in != 32 || ws_size < WS_NEED) { fprintf(stderr, "kernel_launch: unexpected inputs (n_in %d, ws %zu, need %zu)\n", n_in, ws_size, (size_t)WS_NEED); grid = -1; return; }
        int dev = 0, cus = 0, per_cu = 0;
        hipGetDevice(&dev);
        hipDeviceGetAttribute(&cus, hipDeviceAttributeMultiprocessorCount, dev);
        hipFuncSetAttribute((const void*)fwd_kernel, hipFuncAttributeMaxDynamicSharedMemorySize, LDS_BYTES);
        hipOccupancyMaxActiveBlocksPerMultiprocessor(&per_cu, (const void*)fwd_kernel, NTHR, LDS_BYTES);
        if (per_cu < 1) { fprintf(stderr, "kernel_launch: occupancy query says %d blocks per CU\n", per_cu); grid = -1; return; }
        grid = cus;
        grid &= ~7;
    }
    if (grid < 0) return;
    if (hipMemsetAsync((char*)d_ws + OFF_BAR, 0, (XCD_BAR_WORDS + 64) * 4, stream) != hipSuccess) { fprintf(stderr, "kernel_launch: memset failed\n"); return; }
    Params p{};
    const float** pp = (const float**)&p;
    for (int i = 0; i < 32; ++i) pp[i] = (const float*)d_in[i];
    p.out = (float*)d_out; p.ws = (unsigned char*)d_ws;
#if N_LAUNCH_SPLIT
    for (int ph = 0; ph < N_PHASES; ++ph) {
        p.ph_lo = ph; p.ph_hi = ph + 1;
        hipLaunchKernelGGL(fwd_kernel, dim3(grid), dim3(NTHR), LDS_BYTES, stream, p);
    }
#else
    p.ph_lo = 0; p.ph_hi = N_PHASES;
    void* args[] = {&p};
    hipError_t e = hipLaunchCooperativeKernel((const void*)fwd_kernel, dim3(grid), dim3(NTHR), args, LDS_BYTES, stream);
    if (e != hipSuccess) fprintf(stderr, "cooperative launch failed: %s (grid %d)\n", hipGetErrorString(e), grid);
#endif
}
```

```cpp
#include <hip/hip_runtime.h>
#include <hip/hip_cooperative_groups.h>
#include <cstdio>
namespace cg = cooperative_groups;

#define DI __device__ __forceinline__
typedef unsigned short bf16_t;
typedef short bf16x8 __attribute__((ext_vector_type(8)));
typedef short s16x4 __attribute__((ext_vector_type(4)));
typedef float f32x4 __attribute__((ext_vector_type(4)));
typedef float f32x2 __attribute__((ext_vector_type(2)));
typedef float f32x16 __attribute__((ext_vector_type(16)));
typedef unsigned u32x4 __attribute__((ext_vector_type(4)));
typedef unsigned u32x2 __attribute__((ext_vector_type(2)));

#ifndef N_LAUNCH_SPLIT
#define N_LAUNCH_SPLIT 0
#endif

constexpr int NTHR = 512;
constexpr int D = 1024;
constexpr int MC = 8192;
constexpr int ML = 16384;
constexpr int M = MC + ML;
constexpr int WIN = 4736;
constexpr int ZRC = 1920;
constexpr int DFF = 2816;
constexpr int LDS_MAIN = 147456;
constexpr int LDS_BYTES = LDS_MAIN + 16;
constexpr float LOG2E = 1.4426950408889634f;

constexpr size_t al256(size_t x) { return (x + 255) & ~(size_t)255; }
constexpr size_t OFF_WUP   = 0;
constexpr size_t OFF_WDN   = OFF_WUP + al256((size_t)5632 * 1024 * 2);
constexpr size_t OFF_MOD   = OFF_WDN + al256((size_t)1024 * 2816 * 2);
constexpr size_t OFF_ROPE  = OFF_MOD + al256((size_t)9 * 6144 * 4);
constexpr size_t OFF_W2T   = OFF_ROPE + al256((size_t)64 * 16 * 8);
constexpr size_t OFF_A2T   = OFF_W2T + al256((size_t)2 * 512 * 64 * 2);
constexpr size_t OFF_G2T   = OFF_A2T + al256((size_t)2 * 512 * 64 * 2);
constexpr size_t OFF_KC    = OFF_G2T + al256((size_t)512 * 128 * 2);
constexpr size_t OFF_VCT   = OFF_KC + al256((size_t)8 * 512 * 128 * 2);
constexpr size_t OFF_BAR   = OFF_VCT + al256((size_t)8 * 512 * 128 * 2);
constexpr size_t OFF_H     = OFF_BAR + al256((size_t)(3456 + 64) * 4);
constexpr size_t OFF_X     = OFF_H + al256((size_t)M * 1024 * 2);
constexpr size_t OFF_WIN   = OFF_X;
constexpr size_t OFF_WPA   = OFF_WIN + al256((size_t)WIN * 1024 * 2);
constexpr size_t OFF_WPB   = OFF_WPA + al256((size_t)1024 * 512 * 2);
constexpr size_t OFF_WOUT  = OFF_WPB + al256((size_t)1024 * 512 * 2);
constexpr size_t OFF_Q     = OFF_WOUT + al256((size_t)1024 * 1024 * 2);
constexpr size_t OFF_RW    = OFF_Q;
constexpr size_t OFF_KB    = OFF_Q + al256((size_t)M * 512 * 2);
constexpr size_t OFF_VT    = OFF_KB + al256((size_t)M * 128 * 2);
constexpr size_t OFF_ATTN  = OFF_VT + al256((size_t)M * 128 * 2);
constexpr size_t OFF_SG    = OFF_ATTN + al256((size_t)M * 512 * 2);
constexpr size_t OFF_BN    = OFF_SG + al256((size_t)M * 128 * 2);
constexpr size_t OFF_YS    = OFF_BN + al256((size_t)M * 16 * 4);
constexpr size_t OFF_MRG   = OFF_YS;
constexpr size_t END_EARLY = OFF_YS + al256((size_t)2 * M * 512 * 4);
constexpr size_t OFF_ACT   = OFF_X;
constexpr size_t OFF_U     = OFF_ACT + al256((size_t)M * DFF * 2);
constexpr size_t END_FFN   = OFF_U + al256((size_t)96 * 44 * 4 * 128 * 2);
constexpr size_t WS_NEED   = END_EARLY > END_FFN ? END_EARLY : END_FFN;
static_assert(WS_NEED <= (size_t)256 * 1024 * 1024, "workspace over 256 MiB");

constexpr size_t OUT_Y  = 0;
constexpr size_t OUT_K  = (size_t)M * 1024;
constexpr size_t OUT_V  = OUT_K + (size_t)MC * 128;
constexpr size_t OUT_S  = OUT_V + (size_t)MC * 128;

struct Params {
    const float *x_prompt, *x_sample, *c, *cache_k, *cache_v, *state_rwkv, *c_ctx, *w_ada, *b_ada, *g_norm1, *w_in, *attn_sink,
        *w_proj_a, *w_proj_b, *rwkv_mu, *rwkv_w0, *rwkv_w2, *rwkv_a0, *rwkv_a2, *rwkv_k_k, *rwkv_k_a, *rwkv_r_k, *rwkv_g2,
        *rwkv_ln_g, *rwkv_ln_b, *w_out, *g_norm2, *w_ffn_up, *ffn_conv_w, *ffn_conv_b, *w_ffn_down, *g_final;
    float* out;
    unsigned char* ws;
    int ph_lo, ph_hi;
};

#define XCD_BAR_WORDS 3456
#define LAS __attribute__((address_space(3)))
DI bf16_t f2bf(float f) { unsigned u = __float_as_uint(f); u += 0x7fffu + ((u >> 16) & 1u); return (bf16_t)(u >> 16); }
DI float bf2f(unsigned b) { return __uint_as_float(b << 16); }
typedef __bf16 bf16v2_t __attribute__((ext_vector_type(2)));
DI unsigned pack2(float lo, float hi) { f32x2 v; v.x = lo; v.y = hi; return __builtin_bit_cast(unsigned, __builtin_convertvector(v, bf16v2_t)); }
DI u32x2 pack4(f32x4 v) { u32x2 r; r.x = pack2(v[0], v[1]); r.y = pack2(v[2], v[3]); return r; }
DI f32x4 unpack4(u32x2 v) { f32x4 r; r[0] = bf2f(v.x & 0xffffu); r[1] = bf2f(v.x >> 16); r[2] = bf2f(v.y & 0xffffu); r[3] = bf2f(v.y >> 16); return r; }
DI float rcpf_(float x) { return __builtin_amdgcn_rcpf(x); }
DI float sigmoidf_(float x) { return rcpf_(1.0f + __expf(-x)); }
DI const float* xrow(const Params& p, int r) { return r < MC ? p.x_prompt + (size_t)r * D : p.x_sample + (size_t)(r - MC) * D; }
DI int cond_of(int r) { return r < MC ? 0 : 1 + ((r - MC) >> 11); }
DI void seq_of(int r, int& r0, int& T) { if (r < MC) { r0 = r & ~255; T = 256; } else { r0 = MC + ((r - MC) & ~2047); T = 2048; } }
DI float wave_sum(float v) {
#pragma unroll
    for (int o = 32; o >= 1; o >>= 1) v += __shfl_xor(v, o);
    return v;
}

DI void transpose_tile(const float* __restrict__ src, int K, int N, bf16_t* __restrict__ dst, int kt, int nt, float* tile, int tid) {
    const int k0 = kt * 64, n0 = nt * 64;
#pragma unroll
    for (int i = 0; i < 8; ++i) { const int k = (tid >> 6) + 8 * i, n = tid & 63; tile[k * 65 + n] = src[(size_t)(k0 + k) * N + n0 + n]; }
    __syncthreads();
#pragma unroll
    for (int i = 0; i < 8; ++i) { const int n = (tid >> 6) + 8 * i, k = tid & 63; dst[(size_t)(n0 + n) * K + k0 + k] = f2bf(tile[k * 65 + n]); }
    __syncthreads();
}

DI void phase_prep(const Params& p, char* smem) {
    const int tid = threadIdx.x, nb = gridDim.x, bid = blockIdx.x;
    unsigned char* ws = p.ws;
    {
        float* tile = (float*)smem;
        const int cnt[11] = {16 * 74, 8 * 16, 8 * 16, 16 * 16, 16 * 88, 44 * 16, 8, 8, 8, 8, 16};
        int total = 0;
#pragma unroll
        for (int i = 0; i < 11; ++i) total += cnt[i];
        for (int it = bid; it < total; it += nb) {
            int i = it, mi = 0;
#pragma unroll
            for (int q = 0; q < 10; ++q) { if (mi == q && i >= cnt[q]) { i -= cnt[q]; mi = q + 1; } }
            const float* src; bf16_t* dst; int K, N;
            switch (mi) {
                case 0: src = p.w_in; K = 1024; N = WIN; dst = (bf16_t*)(ws + OFF_WIN); break;
                case 1: src = p.w_proj_a; K = 512; N = 1024; dst = (bf16_t*)(ws + OFF_WPA); break;
                case 2: src = p.w_proj_b; K = 512; N = 1024; dst = (bf16_t*)(ws + OFF_WPB); break;
                case 3: src = p.w_out; K = 1024; N = 1024; dst = (bf16_t*)(ws + OFF_WOUT); break;
                case 4: src = p.w_ffn_up; K = 1024; N = 5632; dst = (bf16_t*)(ws + OFF_WUP); break;
                case 5: src = p.w_ffn_down; K = 2816; N = 1024; dst = (bf16_t*)(ws + OFF_WDN); break;
                case 6: src = p.rwkv_w2; K = 64; N = 512; dst = (bf16_t*)(ws + OFF_W2T); break;
                case 7: src = p.rwkv_w2 + 64 * 512; K = 64; N = 512; dst = (bf16_t*)(ws + OFF_W2T) + 512 * 64; break;
                case 8: src = p.rwkv_a2; K = 64; N = 512; dst = (bf16_t*)(ws + OFF_A2T); break;
                case 9: src = p.rwkv_a2 + 64 * 512; K = 64; N = 512; dst = (bf16_t*)(ws + OFF_A2T) + 512 * 64; break;
                default: src = p.rwkv_g2; K = 128; N = 512; dst = (bf16_t*)(ws + OFF_G2T); break;
            }
            const int ntn = N / 64;
            transpose_tile(src, K, N, dst, i / ntn, i % ntn, tile, tid);
        }
    }
    {
        bf16_t* kc = (bf16_t*)(ws + OFF_KC); bf16_t* vct = (bf16_t*)(ws + OFF_VCT);
        for (int i = bid * NTHR + tid; i < 8 * 512 * 128; i += nb * NTHR) {
            kc[i] = f2bf(p.cache_k[i]);
            const int key = i & 511, d = (i >> 9) & 63, kvh = (i >> 15) & 1, b = i >> 16;
            vct[i] = f2bf(p.cache_v[((size_t)(b * 512 + key) * 2 + kvh) * 64 + d]);
        }
    }
    {
        f32x2* tab = (f32x2*)(ws + OFF_ROPE);
        for (int i = bid * NTHR + tid; i < 1024; i += nb * NTHR) {
            const int pos = i >> 4, fi = i & 15;
            const double fr = pow(10000.0, -(double)fi / 16.0), ang = (double)pos * fr;
            f32x2 v; v.x = (float)cos(ang); v.y = (float)sin(ang); tab[i] = v;
        }
    }
    {
        float* s = (float*)smem;
        float* red = (float*)(smem + 36864);
        float* mod = (float*)(ws + OFF_MOD);
        for (int it = bid; it < 96; it += nb) {
            __syncthreads();
            for (int i = tid; i < 9 * 1024; i += NTHR) {
                const int ci = i >> 10, k = i & 1023;
                const float v = ci == 0 ? p.c_ctx[k] : p.c[(ci - 1) * 1024 + k];
                s[i] = v / (1.0f + __expf(-v));
            }
            __syncthreads();
            const int n = tid & 63, kq = tid >> 6, n0 = it * 64;
            float acc[9];
#pragma unroll
            for (int ci = 0; ci < 9; ++ci) acc[ci] = 0.f;
            for (int k = kq * 128; k < kq * 128 + 128; ++k) {
                const float w = p.w_ada[(size_t)k * 6144 + n0 + n];
#pragma unroll
                for (int ci = 0; ci < 9; ++ci) acc[ci] += s[ci * 1024 + k] * w;
            }
#pragma unroll
            for (int ci = 0; ci < 9; ++ci) red[(kq * 9 + ci) * 64 + n] = acc[ci];
            __syncthreads();
            for (int i = tid; i < 9 * 64; i += NTHR) {
                const int ci = i >> 6, nn = i & 63;
                float v = p.b_ada[n0 + nn];
#pragma unroll
                for (int q = 0; q < 8; ++q) v += red[(q * 9 + ci) * 64 + nn];
                mod[ci * 6144 + n0 + nn] = v;
            }
        }
        __syncthreads();
    }
}

template <int WHICH> DI void phase_norm(const Params& p) {
    const int tid = threadIdx.x, lane = tid & 63, wv = tid >> 6;
    const float* mod = (const float*)(p.ws + OFF_MOD);
    bf16_t* hb = (bf16_t*)(p.ws + OFF_H);
    const int ntask = M / 8;
    for (int task = blockIdx.x * 8 + wv; task < ntask; task += gridDim.x * 8) {
        const int r_first = task * 8, ci = cond_of(r_first);
        f32x4 fa[4], fb[4];
#pragma unroll
        for (int i = 0; i < 4; ++i) {
            const int col = i * 256 + lane * 4;
            if (WHICH == 3) { fa[i] = *(const f32x4*)(p.g_final + col); fb[i] = (f32x4){0.f, 0.f, 0.f, 0.f}; }
            else {
                const f32x4 g = *(const f32x4*)((WHICH == 1 ? p.g_norm1 : p.g_norm2) + col);
                const f32x4 sc = *(const f32x4*)(mod + ci * 6144 + (WHICH == 1 ? 1024 : 4096) + col);
                fb[i] = *(const f32x4*)(mod + ci * 6144 + (WHICH == 1 ? 0 : 3072) + col);
                fa[i] = g * (sc + 1.0f);
            }
        }
        for (int rr = 0; rr < 8; ++rr) {
            const int r = r_first + rr;
            const float* src = WHICH == 1 ? xrow(p, r) : p.out + OUT_Y + (size_t)r * D;
            f32x4 v[4]; float ss = 0.f;
#pragma unroll
            for (int i = 0; i < 4; ++i) { v[i] = *(const f32x4*)(src + i * 256 + lane * 4); ss += v[i][0] * v[i][0] + v[i][1] * v[i][1] + v[i][2] * v[i][2] + v[i][3] * v[i][3]; }
            ss = wave_sum(ss);
            const float rstd = __builtin_amdgcn_rsqf(ss * (1.0f / 1024.0f) + 1e-6f);
#pragma unroll
            for (int i = 0; i < 4; ++i) {
                const f32x4 o = v[i] * rstd * fa[i] + fb[i];
                if (WHICH == 3) *(f32x4*)(p.out + OUT_Y + (size_t)r * D + i * 256 + lane * 4) = o;
                else *(u32x2*)(hb + (size_t)r * D + i * 256 + lane * 4) = pack4(o);
            }
        }
    }
}

template <int NB, int BMAP> DI void gemm_stage(const bf16_t* A, int lda, const bf16_t* Bt, int ldb, int k0, char* sbuf, int tid) {
#pragma unroll
    for (int i = 0; i < 4; ++i) {
        const int c = tid + i * 512, row = c >> 3, pos = c & 7, kc = pos ^ ((row >> 1) & 7);
        __builtin_amdgcn_global_load_lds((const unsigned*)(A + (size_t)row * lda + k0 + kc * 8), (unsigned*)(sbuf + c * 16), 16, 0, 0);
    }
#pragma unroll
    for (int i = 0; i < NB / 2; ++i) {
        const int c = tid + i * 512, row = c >> 3, pos = c & 7, kc = pos ^ ((row >> 1) & 7);
        const int brow = BMAP ? (((row >> 5) & 1) * DFF + (row >> 6) * 32 + (row & 31)) : row;
        __builtin_amdgcn_global_load_lds((const unsigned*)(Bt + (size_t)brow * ldb + k0 + kc * 8), (unsigned*)(sbuf + 32768 + c * 16), 16, 0, 0);
    }
}
template <int NB, int BMAP = 0> DI void gemm_acc(f32x4 (&acc)[4][NB], const bf16_t* A, int lda, const bf16_t* Bt, int ldb, int K, char* smem, int tid) {
    const int wid = tid >> 6, lane = tid & 63, fr = lane & 15, fq = lane >> 4, wr = wid >> 1, wc = wid & 1;
    const int swz = (fr >> 1) & 7;
    const int nk = K >> 6;
    __syncthreads();
    gemm_stage<NB, BMAP>(A, lda, Bt, ldb, 0, smem, tid);
    if (nk > 1) gemm_stage<NB, BMAP>(A, lda, Bt, ldb, 64, smem + 49152, tid);
    int cur = 0;
#pragma unroll 1
    for (int t = 0; t < nk; ++t) {
        if (t + 1 < nk) { if (NB == 4) asm volatile("s_waitcnt vmcnt(6)" ::: "memory"); else asm volatile("s_waitcnt vmcnt(5)" ::: "memory"); }
        else asm volatile("s_waitcnt vmcnt(0)" ::: "memory");
        __builtin_amdgcn_s_barrier();
        asm volatile("" ::: "memory");
        const int nxt2 = cur >= 1 ? cur - 1 : 2;
        const bool late = __builtin_amdgcn_readfirstlane(wid) >= 4;
        if (t + 2 < nk && !late) gemm_stage<NB, BMAP>(A, lda, Bt, ldb, (t + 2) * 64, smem + nxt2 * 49152, tid);
        const char* sA = smem + cur * 49152;
        const char* sB = sA + 32768;
#pragma unroll
        for (int ks = 0; ks < 2; ++ks) {
            if (ks == 1 && t + 2 < nk && late) gemm_stage<NB, BMAP>(A, lda, Bt, ldb, (t + 2) * 64, smem + nxt2 * 49152, tid);
            bf16x8 af[4], bfr[NB];
            const int coff = ((ks * 4 + fq) ^ swz) << 4;
#pragma unroll
            for (int mb = 0; mb < 4; ++mb) af[mb] = *(const bf16x8*)(sA + (wr * 64 + mb * 16 + fr) * 128 + coff);
#pragma unroll
            for (int nb = 0; nb < NB; ++nb) bfr[nb] = *(const bf16x8*)(sB + (wc * 16 * NB + nb * 16 + fr) * 128 + coff);
            __builtin_amdgcn_s_setprio(1);
#pragma unroll
            for (int mb = 0; mb < 4; ++mb)
#pragma unroll
                for (int nb = 0; nb < NB; ++nb) acc[mb][nb] = __builtin_amdgcn_mfma_f32_16x16x32_bf16(bfr[nb], af[mb], acc[mb][nb], 0, 0, 0);
            __builtin_amdgcn_s_setprio(0);
        }
        cur = cur == 2 ? 0 : cur + 1;
    }
}
template <int NB> DI void zero_acc(f32x4 (&acc)[4][NB]) {
#pragma unroll
    for (int a = 0; a < 4; ++a)
#pragma unroll
        for (int b = 0; b < NB; ++b) acc[a][b] = (f32x4){0.f, 0.f, 0.f, 0.f};
}
DI void tile_coords(int t, int MT, int NT, int& mt, int& nt) {
    const int x = t & 7, u = t >> 3, mpx = MT >> 3;
    const int bm = (mpx % 4 == 0) ? 4 : ((mpx % 2 == 0) ? 2 : 1);
    const int per_band = bm * NT, band = u / per_band, rem = u - band * per_band;
    nt = rem / bm; mt = x * mpx + band * bm + (rem % bm);
}

DI void phase_p1(const Params& p, char* smem) {
    const int tid = threadIdx.x, wid = tid >> 6, lane = tid & 63, fr = lane & 15, fq = lane >> 4, wr = wid >> 1, wc = wid & 1;
    unsigned char* ws = p.ws;
    const bf16_t* hb = (const bf16_t*)(ws + OFF_H);
    const bf16_t* wt = (const bf16_t*)(ws + OFF_WIN);
    const f32x2* tab = (const f32x2*)(ws + OFF_ROPE);
    bf16_t* qb = (bf16_t*)(ws + OFF_Q); bf16_t* kb = (bf16_t*)(ws + OFF_KB); bf16_t* vT = (bf16_t*)(ws + OFF_VT);
    bf16_t* zr = (bf16_t*)(p.out + OUT_Y);
    const int MT = M / 256, NT = 21;
    for (int t = blockIdx.x; t < MT * NT; t += gridDim.x) {
        int mt, nt; tile_coords(t, MT, NT, mt, nt);
        const int row0 = mt * 256, ncol0 = nt < 6 ? nt * 128 : 2816 + (nt - 6) * 128;
        f32x4 acc[4][4]; zero_acc<4>(acc);
        gemm_acc<4>(acc, hb + (size_t)row0 * 1024, 1024, wt + (size_t)ncol0 * 1024, 1024, 1024, smem, tid);
        const bool latent = row0 >= MC;
#pragma unroll
        for (int mb = 0; mb < 4; ++mb) {
            const int m = row0 + wr * 64 + mb * 16 + fr;
            if (nt < 5 && latent) {
                const int tt = (m - MC) & 2047, prow = tt >> 6, pcol = tt & 63;
#pragma unroll
                for (int j = 0; j < 4; ++j) {
                    const f32x2 cr = tab[prow * 16 + fq * 4 + j], cc = tab[pcol * 16 + fq * 4 + j];
                    const float a1 = acc[mb][0][j], a2 = acc[mb][1][j], b1 = acc[mb][2][j], b2 = acc[mb][3][j];
                    acc[mb][0][j] = a1 * cr.x - a2 * cr.y; acc[mb][1][j] = a2 * cr.x + a1 * cr.y;
                    acc[mb][2][j] = b1 * cc.x - b2 * cc.y; acc[mb][3][j] = b2 * cc.x + b1 * cc.y;
                }
            }
#pragma unroll
            for (int nb = 0; nb < 4; ++nb) {
                const int nl = wc * 64 + nb * 16 + fq * 4;
                const f32x4 v = acc[mb][nb];
                if (nt < 4) { *(u32x2*)(qb + (size_t)m * 512 + nt * 128 + nl) = pack4(v); }
                else if (nt == 4) {
                    if (!latent) *(f32x4*)(p.out + OUT_K + (size_t)m * 128 + nl) = v;
                    *(u32x2*)(kb + (size_t)m * 128 + nl) = pack4(v);
                } else if (nt == 5) {
                    if (!latent) *(f32x4*)(p.out + OUT_V + (size_t)m * 128 + nl) = v;
                    int r0, T; seq_of(m, r0, T);
#pragma unroll
                    for (int j = 0; j < 4; ++j) vT[(size_t)r0 * 128 + (size_t)(nl + j) * T + (m - r0)] = f2bf(v[j]);
                } else { *(u32x2*)(zr + (size_t)m * ZRC + (nt - 6) * 128 + nl) = pack4(v); }
            }
        }
    }
}

#define MFMA32(a, b, c) __builtin_amdgcn_mfma_f32_32x32x16_bf16((a), (b), (c), 0, 0, 0)
DI int crow(int i, int h) { return (i & 3) + 8 * (i >> 2) + 4 * h; }

DI void attn_item(const Params& p, char* smem, int it) {
    const int tid = threadIdx.x, wv = tid >> 6, lane = tid & 63, r = lane & 31, hh = lane >> 5;
    unsigned char* ws = p.ws;
    const bf16_t* qb = (const bf16_t*)(ws + OFF_Q); const bf16_t* kb = (const bf16_t*)(ws + OFF_KB); const bf16_t* vT = (const bf16_t*)(ws + OFF_VT);
    const bf16_t* kc = (const bf16_t*)(ws + OFF_KC); const bf16_t* vct = (const bf16_t*)(ws + OFF_VCT);
    bf16_t* ab = (bf16_t*)(ws + OFF_ATTN);
    bf16_t* Ks = (bf16_t*)smem;
    bf16_t* Vt = (bf16_t*)(smem + 9216);
    const float SC = 0.125f * LOG2E;
    {
        int r0, T, q0, kvh, bl;
        const bool lat = it < 512;
        if (lat) { bl = it >> 6; const int rem = it & 63; q0 = (rem >> 1) * 64; kvh = rem & 1; r0 = MC + bl * 2048; T = 2048; }
        else { const int i2 = it - 512; bl = 0; const int s = i2 >> 3, rem = i2 & 7; q0 = (rem >> 1) * 64; kvh = rem & 1; r0 = s * 256; T = 256; }
        const int head = kvh * 4 + (wv & 3), sub = wv >> 2, qs = q0 + 32 * sub;
        bf16x8 qf[4];
#pragma unroll
        for (int kk = 0; kk < 4; ++kk) qf[kk] = *(const bf16x8*)(qb + (size_t)(r0 + qs + r) * 512 + head * 64 + 16 * kk + 8 * hh);
        const float sinkl = p.attn_sink[head] * LOG2E;
        float mrun = sinkl, lrun = hh == 0 ? 1.0f : 0.0f;
        f32x16 o0, o1;
#pragma unroll
        for (int i = 0; i < 16; ++i) { o0[i] = 0.f; o1[i] = 0.f; }
        const int nwin = lat ? 5 : 4, ntile = lat ? 13 : 4;
        for (int ti = 0; ti < ntile; ++ti) {
            const bf16_t* ksrc; const bf16_t* vsrc; int vstride, ks0; bool window;
            if (ti < nwin) {
                ks0 = lat ? q0 - 128 + 64 * ti : 64 * ti; window = lat;
                if (ks0 < 0 || ks0 >= T) continue;
                ksrc = kb + (size_t)(r0 + ks0) * 128 + kvh * 64; vsrc = vT + (size_t)r0 * 128 + (size_t)(kvh * 64) * T + ks0; vstride = T;
            } else {
                ks0 = 64 * (ti - nwin); window = false;
                ksrc = kc + (size_t)(bl * 512 + ks0) * 128 + kvh * 64; vsrc = vct + (size_t)((bl * 2 + kvh) * 64) * 512 + ks0; vstride = 512;
            }
            __syncthreads();
            {
                const int rw_ = tid >> 3, ch = tid & 7;
                *(u32x4*)(Ks + rw_ * 72 + ch * 8) = *(const u32x4*)(ksrc + (size_t)rw_ * 128 + ch * 8);
                *(u32x4*)(Vt + rw_ * 72 + ch * 8) = *(const u32x4*)(vsrc + (size_t)rw_ * vstride + ch * 8);
            }
            __syncthreads();
#pragma unroll
            for (int sk = 0; sk < 2; ++sk) {
                const int kb0 = ks0 + 32 * sk;
                bool need_mask = false;
                if (window) {
                    if (kb0 > qs + 31 + 128 || kb0 + 31 < qs - 128) continue;
                    need_mask = (kb0 < qs + 31 - 128) || (kb0 + 31 > qs + 128);
                }
                f32x16 x;
#pragma unroll
                for (int i = 0; i < 16; ++i) x[i] = 0.f;
#pragma unroll
                for (int kk = 0; kk < 4; ++kk) {
                    const bf16x8 kf = *(const bf16x8*)(Ks + (32 * sk + r) * 72 + 16 * kk + 8 * hh);
                    x = MFMA32(kf, qf[kk], x);
                }
                float mx = -3.0e38f;
#pragma unroll
                for (int i = 0; i < 16; ++i) {
                    float s = x[i] * SC;
                    if (need_mask) { const int dk = kb0 + crow(i, hh) - (qs + r); if (dk > 128 || dk < -128) s = -3.0e38f; }
                    x[i] = s; mx = fmaxf(mx, s);
                }
                mx = fmaxf(mx, __shfl_xor(mx, 32));
                const float mnew = fmaxf(mrun, mx), alpha = exp2f(mrun - mnew);
                mrun = mnew;
                float ps = 0.f;
#pragma unroll
                for (int i = 0; i < 16; ++i) { const float pv = exp2f(x[i] - mnew); x[i] = pv; ps += pv; }
                lrun = lrun * alpha + ps;
#pragma unroll
                for (int i = 0; i < 16; ++i) { o0[i] *= alpha; o1[i] *= alpha; }
#pragma unroll
                for (int s = 0; s < 2; ++s) {
                    u32x4 pk;
                    pk[0] = pack2(x[8 * s + 0], x[8 * s + 1]); pk[1] = pack2(x[8 * s + 2], x[8 * s + 3]);
                    pk[2] = pack2(x[8 * s + 4], x[8 * s + 5]); pk[3] = pack2(x[8 * s + 6], x[8 * s + 7]);
                    const bf16x8 pf = __builtin_bit_cast(bf16x8, pk);
                    {
                        const s16x4 lo = *(const s16x4*)(Vt + r * 72 + 32 * sk + 16 * s + 4 * hh);
                        const s16x4 hi = *(const s16x4*)(Vt + r * 72 + 32 * sk + 16 * s + 8 + 4 * hh);
                        const bf16x8 vf = __builtin_shufflevector(lo, hi, 0, 1, 2, 3, 4, 5, 6, 7);
                        o0 = MFMA32(vf, pf, o0);
                    }
                    {
                        const s16x4 lo = *(const s16x4*)(Vt + (32 + r) * 72 + 32 * sk + 16 * s + 4 * hh);
                        const s16x4 hi = *(const s16x4*)(Vt + (32 + r) * 72 + 32 * sk + 16 * s + 8 + 4 * hh);
                        const bf16x8 vf = __builtin_shufflevector(lo, hi, 0, 1, 2, 3, 4, 5, 6, 7);
                        o1 = MFMA32(vf, pf, o1);
                    }
                }
            }
        }
        const float ltot = lrun + __shfl_xor(lrun, 32), inv = rcpf_(ltot);
        bf16_t* orow = ab + (size_t)(r0 + qs + r) * 512 + head * 64;
#pragma unroll
        for (int g = 0; g < 4; ++g) {
            f32x4 a, b;
#pragma unroll
            for (int j = 0; j < 4; ++j) { a[j] = o0[4 * g + j] * inv; b[j] = o1[4 * g + j] * inv; }
            *(u32x2*)(orow + 8 * g + 4 * hh) = pack4(a);
            *(u32x2*)(orow + 32 + 8 * g + 4 * hh) = pack4(b);
        }
    }
    __syncthreads();
}

DI void sg_pass(const Params& p) {
    const int tid = threadIdx.x;
    unsigned char* ws = p.ws;
    {
        const bf16_t* zr = (const bf16_t*)(p.out + OUT_Y);
        bf16_t* sg = (bf16_t*)(ws + OFF_SG);
        const float* mu0 = p.rwkv_mu; const float* mu1 = p.rwkv_mu + ZRC;
        for (int i = blockIdx.x * NTHR + tid; i < M * 32; i += gridDim.x * NTHR) {
            const int m = i >> 5, c = (i & 31) * 4;
            int r0, T; seq_of(m, r0, T);
            const bf16_t* zp = zr + (size_t)m * ZRC + 1792 + c;
            const f32x4 z = unpack4(*(const u32x2*)zp);
            f32x4 zprev = (f32x4){0.f, 0.f, 0.f, 0.f}, znext = zprev;
            if (m > r0) zprev = unpack4(*(const u32x2*)(zp - ZRC));
            if (m < r0 + T - 1) znext = unpack4(*(const u32x2*)(zp + ZRC));
            const f32x4 a0 = *(const f32x4*)(mu0 + 1792 + c), a1 = *(const f32x4*)(mu1 + 1792 + c);
            f32x4 o;
#pragma unroll
            for (int j = 0; j < 4; ++j) { const float zs = z[j] + a0[j] * (zprev[j] - z[j]) + a1[j] * (znext[j] - z[j]); o[j] = sigmoidf_(zs); }
            *(u32x2*)(sg + (size_t)m * 128 + c) = pack4(o);
        }
    }
}


template <int CTRL> DI float dpp_f(float x) { return __builtin_bit_cast(float, __builtin_amdgcn_mov_dpp(__builtin_bit_cast(int, x), CTRL, 0xf, 0xf, true)); }
DI float swap32_sum(float x) {
    float a = x, b = x;
    asm volatile("s_nop 1\n\tv_permlane32_swap_b32 %0, %1\n\ts_nop 1" : "+v"(a), "+v"(b));
    return a + b;
}
DI float row16_allsum(float x) { x += dpp_f<0x128>(x); x += dpp_f<0x124>(x); x += dpp_f<0x122>(x); x += dpp_f<0x121>(x); return x; }
template <int E> DI float qbc(f32x2 v) { return dpp_f<(E >> 1) * 0x55>((E & 1) ? v.y : v.x); }

#define QP0 " quad_perm:[0,0,0,0] row_mask:0xf bank_mask:0xf bound_ctrl:1\n\t"
#define QP1 " quad_perm:[1,1,1,1] row_mask:0xf bank_mask:0xf bound_ctrl:1\n\t"
#define QP2 " quad_perm:[2,2,2,2] row_mask:0xf bank_mask:0xf bound_ctrl:1\n\t"
#define QP3 " quad_perm:[3,3,3,3] row_mask:0xf bank_mask:0xf bound_ctrl:1\n\t"
#define ROR4 " row_ror:4 row_mask:0xf bank_mask:0xf bound_ctrl:1\n\t"
#define ROR8 " row_ror:8 row_mask:0xf bank_mask:0xf bound_ctrl:1\n\t"
DI float scan_sa(const float (&S)[8], f32x2 A) {
    float sa, t1, t2, t3;
    asm volatile(
        "s_nop 1\n\t"
        "v_mul_f32_dpp %0, %12, %4" QP0
        "v_mul_f32_dpp %1, %13, %5" QP0
        "v_mul_f32_dpp %2, %12, %6" QP1
        "v_mul_f32_dpp %3, %13, %7" QP1
        "v_fmac_f32_dpp %0, %12, %8" QP2
        "v_fmac_f32_dpp %1, %13, %9" QP2
        "v_fmac_f32_dpp %2, %12, %10" QP3
        "v_fmac_f32_dpp %3, %13, %11" QP3
        "v_add_f32 %0, %0, %1\n\t"
        "v_add_f32 %2, %2, %3\n\t"
        "v_add_f32 %0, %0, %2\n\t"
        "s_nop 1\n\t"
        "v_add_f32_dpp %0, %0, %0" ROR4
        "s_nop 1\n\t"
        "v_add_f32_dpp %0, %0, %0" ROR8
        "v_mov_b32 %1, %0\n\t"
        "s_nop 1\n\t"
        "v_permlane32_swap_b32 %0, %1\n\t"
        "s_nop 1\n\t"
        "v_add_f32 %0, %0, %1"
        : "=&v"(sa), "=&v"(t1), "=&v"(t2), "=&v"(t3)
        : "v"(S[0]), "v"(S[1]), "v"(S[2]), "v"(S[3]), "v"(S[4]), "v"(S[5]), "v"(S[6]), "v"(S[7]), "v"(A.x), "v"(A.y));
    return sa;
}
DI float scan_upd(float (&S)[8], float sa, float vv, f32x2 B, f32x2 K, f32x2 W, f32x2 R) {
    float n0, n1, n2, n3, n4, n5, n6, n7, y0, y1, y2, y3;
    asm volatile(
        "s_nop 1\n\t"
        "v_mul_f32_dpp %0, %22, %20" QP0  "v_mul_f32_dpp %1, %23, %20" QP0  "v_mul_f32_dpp %2, %22, %20" QP1  "v_mul_f32_dpp %3, %23, %20" QP1
        "v_mul_f32_dpp %4, %22, %20" QP2  "v_mul_f32_dpp %5, %23, %20" QP2  "v_mul_f32_dpp %6, %22, %20" QP3  "v_mul_f32_dpp %7, %23, %20" QP3
        "v_fmac_f32_dpp %0, %24, %21" QP0  "v_fmac_f32_dpp %1, %25, %21" QP0  "v_fmac_f32_dpp %2, %24, %21" QP1  "v_fmac_f32_dpp %3, %25, %21" QP1
        "v_fmac_f32_dpp %4, %24, %21" QP2  "v_fmac_f32_dpp %5, %25, %21" QP2  "v_fmac_f32_dpp %6, %24, %21" QP3  "v_fmac_f32_dpp %7, %25, %21" QP3
        "v_fmac_f32_dpp %0, %26, %12" QP0  "v_fmac_f32_dpp %1, %27, %13" QP0  "v_fmac_f32_dpp %2, %26, %14" QP1  "v_fmac_f32_dpp %3, %27, %15" QP1
        "v_fmac_f32_dpp %4, %26, %16" QP2  "v_fmac_f32_dpp %5, %27, %17" QP2  "v_fmac_f32_dpp %6, %26, %18" QP3  "v_fmac_f32_dpp %7, %27, %19" QP3
        "v_mul_f32_dpp %8, %28, %0" QP0   "v_mul_f32_dpp %9, %29, %1" QP0   "v_mul_f32_dpp %10, %28, %2" QP1  "v_mul_f32_dpp %11, %29, %3" QP1
        "v_fmac_f32_dpp %8, %28, %4" QP2  "v_fmac_f32_dpp %9, %29, %5" QP2  "v_fmac_f32_dpp %10, %28, %6" QP3 "v_fmac_f32_dpp %11, %29, %7" QP3
        "v_add_f32 %8, %8, %9\n\t"
        "v_add_f32 %10, %10, %11\n\t"
        "v_add_f32 %8, %8, %10\n\t"
        "s_nop 1\n\t"
        "v_add_f32_dpp %8, %8, %8" ROR4
        "s_nop 1\n\t"
        "v_add_f32_dpp %8, %8, %8" ROR8
        "v_mov_b32 %9, %8\n\t"
        "s_nop 1\n\t"
        "v_permlane32_swap_b32 %8, %9\n\t"
        "s_nop 1\n\t"
        "v_add_f32 %8, %8, %9"
        : "=&v"(n0), "=&v"(n1), "=&v"(n2), "=&v"(n3), "=&v"(n4), "=&v"(n5), "=&v"(n6), "=&v"(n7), "=&v"(y0), "=&v"(y1), "=&v"(y2), "=&v"(y3)
        : "v"(S[0]), "v"(S[1]), "v"(S[2]), "v"(S[3]), "v"(S[4]), "v"(S[5]), "v"(S[6]), "v"(S[7]), "v"(sa), "v"(vv),
          "v"(B.x), "v"(B.y), "v"(K.x), "v"(K.y), "v"(W.x), "v"(W.y), "v"(R.x), "v"(R.y));
    S[0] = n0; S[1] = n1; S[2] = n2; S[3] = n3; S[4] = n4; S[5] = n5; S[6] = n6; S[7] = n7;
    return y0;
}

constexpr int SC_OPW = 0, SC_OPK = 8192, SC_OPA = 16384, SC_OPB = 24576, SC_OPR = 32768, SC_OPV = 40960;
constexpr int SC_AW = 49152, SC_AA = SC_AW + 32 * 144;
constexpr int SC_LO = SC_AA + 32 * 144;
constexpr int SC_YB = SC_LO + 2 * 32 * 68 * 4;
static_assert(SC_YB + 8192 <= LDS_MAIN, "scan LDS");

DI void lds_barrier() { asm volatile("s_waitcnt lgkmcnt(0)\n\ts_barrier" ::: "memory"); }

constexpr int S2_OP = 0;
constexpr int S2_AW = 49152, S2_AA = S2_AW + 2304;
constexpr int S2_LO = S2_AA + 2304;
constexpr int S2_YB = S2_LO + 8704;
static_assert(S2_YB + 8192 <= LDS_MAIN, "scan LDS");

DI void scan_item(const Params& p, char* smem, int r0, int T, int dsel, int h, const float* state0, float* state_out) {
    const int tid = threadIdx.x, wv = tid >> 6, lane = tid & 63;
    const bool is_scan = wv < 4;
    unsigned char* ws = p.ws;
    const bf16_t* zr = (const bf16_t*)(p.out + OUT_Y);
    float* ys = (float*)(ws + OFF_YS) + (size_t)dsel * M * 512;
    float* bn = (float*)(ws + OFF_BN);
    float* op = (float*)(smem + S2_OP);
    bf16_t* Aw = (bf16_t*)(smem + S2_AW); bf16_t* Aa = (bf16_t*)(smem + S2_AA);
    float* Lo = (float*)(smem + S2_LO); float* yb = (float*)(smem + S2_YB);
    const int nchunk = T >> 4;

    const int rr = (lane & 3) | ((lane >> 4) << 2), jq = (lane >> 2) & 3, irow = 16 * (wv & 3) + rr, jb = 16 * jq;
    f32x4 S0, S1, S2, S3;
    if (state0 && is_scan) {
        const float* sp = state0 + irow * 64 + jb;
        S0 = *(const f32x4*)sp; S1 = *(const f32x4*)(sp + 4); S2 = *(const f32x4*)(sp + 8); S3 = *(const f32x4*)(sp + 12);
    } else { S0 = (f32x4){0.f, 0.f, 0.f, 0.f}; S1 = S0; S2 = S0; S3 = S0; }

    const int ptid = tid & 255, tt = ptid >> 4, cg4 = (ptid & 15) * 4;
    const int segc[5] = {h * 64 + cg4, 512 + h * 64 + cg4, 1024 + h * 64 + cg4, 1536 + dsel * 64 + cg4, 1664 + dsel * 64 + cg4};
    const int pL = (wv >> 1) & 1, pnh = wv & 1, fr = lane & 15, fq = lane >> 4;
    const bf16_t* wt = (const bf16_t*)(ws + (pL == 0 ? OFF_W2T : OFF_A2T)) + (size_t)(dsel * 512 + h * 64) * 64;
    u32x2 zc[5], zp[5], zn[5];
    f32x4 kreg, kkreg, rreg;
    auto load_chunk = [&](int c) {
        const int st = 16 * c + tt, tok = dsel ? T - 1 - st : st;
        const bf16_t* base = zr + (size_t)(r0 + tok) * ZRC;
#pragma unroll
        for (int s = 0; s < 5; ++s) {
            zc[s] = *(const u32x2*)(base + segc[s]);
            zp[s] = (u32x2){0u, 0u}; zn[s] = (u32x2){0u, 0u};
            if (tok > 0) zp[s] = *(const u32x2*)(base - ZRC + segc[s]);
            if (tok < T - 1) zn[s] = *(const u32x2*)(base + ZRC + segc[s]);
        }
    };
    auto prodA = [&](int buf) {
        f32x4 zs[5];
#pragma unroll
        for (int s = 0; s < 5; ++s) {
            const f32x4 mu0 = *(const f32x4*)(p.rwkv_mu + segc[s]), mu1 = *(const f32x4*)(p.rwkv_mu + ZRC + segc[s]);
            const f32x4 z = unpack4(zc[s]), a = unpack4(zp[s]), b = unpack4(zn[s]);
            zs[s] = z + mu0 * (a - z) + mu1 * (b - z);
        }
        const f32x4 kkv = *(const f32x4*)(p.rwkv_k_k + h * 64 + cg4);
        f32x4 kk = zs[1] * kkv;
        float n2 = kk[0] * kk[0] + kk[1] * kk[1] + kk[2] * kk[2] + kk[3] * kk[3];
        n2 = row16_allsum(n2);
        kk = kk * __builtin_amdgcn_rsqf(fmaxf(n2, 1e-24f));
        f32x4 tw;
#pragma unroll
        for (int j = 0; j < 4; ++j) tw[j] = 1.0f - 2.0f * rcpf_(1.0f + __expf(2.0f * zs[3][j]));
        *(u32x2*)(Aw + tt * 72 + cg4) = pack4(tw);
        *(u32x2*)(Aa + tt * 72 + cg4) = pack4(zs[4]);
        float* ob = op + buf * 6144 + tt * 64 + cg4;
        *(f32x4*)(ob + 4 * 1024) = zs[0];
        *(f32x4*)(ob + 5 * 1024) = zs[2];
        *(f32x4*)(ob + 2 * 1024) = -kk;
        kreg = zs[1]; kkreg = kk; rreg = zs[0];
    };
    auto prodB = [&]() {
        const bf16_t* As = pL == 0 ? Aw : Aa;
        const bf16x8 a0 = *(const bf16x8*)(As + fr * 72 + fq * 8), a1 = *(const bf16x8*)(As + fr * 72 + 32 + fq * 8);
#pragma unroll
        for (int n2 = 0; n2 < 2; ++n2) {
            f32x4 x = (f32x4){0.f, 0.f, 0.f, 0.f};
            const bf16_t* wr_ = wt + (size_t)((pnh * 2 + n2) * 16 + fr) * 64 + fq * 8;
            x = __builtin_amdgcn_mfma_f32_16x16x32_bf16(a0, *(const bf16x8*)wr_, x, 0, 0, 0);
            x = __builtin_amdgcn_mfma_f32_16x16x32_bf16(a1, *(const bf16x8*)(wr_ + 32), x, 0, 0, 0);
#pragma unroll
            for (int j = 0; j < 4; ++j) Lo[(pL * 16 + fq * 4 + j) * 68 + (pnh * 2 + n2) * 16 + fr] = x[j];
        }
    };
    auto prodC = [&](int c, int buf) {
        const int st = 16 * c + tt, tok = dsel ? T - 1 - st : st, m = r0 + tok;
        const f32x4 w0v = *(const f32x4*)(p.rwkv_w0 + dsel * 512 + h * 64 + cg4), a0v = *(const f32x4*)(p.rwkv_a0 + dsel * 512 + h * 64 + cg4);
        const f32x4 kav = *(const f32x4*)(p.rwkv_k_a + h * 64 + cg4), rkv = *(const f32x4*)(p.rwkv_r_k + h * 64 + cg4);
        const f32x4 lw = *(const f32x4*)(Lo + tt * 68 + cg4), la = *(const f32x4*)(Lo + (16 + tt) * 68 + cg4);
        f32x4 wd, kd, bb; float bs = 0.f;
#pragma unroll
        for (int j = 0; j < 4; ++j) {
            wd[j] = __expf(-0.6065306597126334f * sigmoidf_(w0v[j] + lw[j]));
            const float a = sigmoidf_(a0v[j] + la[j]);
            kd[j] = kreg[j] * (1.0f + (a - 1.0f) * kav[j]);
            bb[j] = a * kkreg[j];
            bs += rreg[j] * kd[j] * rkv[j];
        }
        float* ob = op + buf * 6144 + tt * 64 + cg4;
        *(f32x4*)(ob) = wd;
        *(f32x4*)(ob + 1024) = kd;
        *(f32x4*)(ob + 3 * 1024) = bb;
        bs = row16_allsum(bs);
        if ((ptid & 15) == 0) bn[(size_t)m * 16 + dsel * 8 + h] = bs;
    };
    auto flush_ys = [&](int c) {
        const int st = 16 * c + tt, tok = dsel ? T - 1 - st : st, m = r0 + tok;
        *(f32x4*)(ys + (size_t)m * 512 + h * 64 + cg4) = *(const f32x4*)(yb + (c & 1) * 1024 + tt * 64 + cg4);
    };
    auto chunk_steps = [&](int buf) {
        const float* ob = op + buf * 6144 + jb;
        const float* ov = op + buf * 6144 + 5 * 1024 + irow;
        float* yo = yb + buf * 1024 + irow;
        f32x4 W0 = *(const f32x4*)(ob), W1 = *(const f32x4*)(ob + 4), W2 = *(const f32x4*)(ob + 8), W3 = *(const f32x4*)(ob + 12);
        f32x4 K0 = *(const f32x4*)(ob + 1024), K1 = *(const f32x4*)(ob + 1028), K2 = *(const f32x4*)(ob + 1032), K3 = *(const f32x4*)(ob + 1036);
        f32x4 A0 = *(const f32x4*)(ob + 2048), A1 = *(const f32x4*)(ob + 2052), A2 = *(const f32x4*)(ob + 2056), A3 = *(const f32x4*)(ob + 2060);
        f32x4 B0 = *(const f32x4*)(ob + 3072), B1 = *(const f32x4*)(ob + 3076), B2 = *(const f32x4*)(ob + 3080), B3 = *(const f32x4*)(ob + 3084);
        f32x4 R0 = *(const f32x4*)(ob + 4096), R1 = *(const f32x4*)(ob + 4100), R2 = *(const f32x4*)(ob + 4104), R3 = *(const f32x4*)(ob + 4108);
        float vv = ov[0];
#pragma unroll 2
        for (int s = 0; s < 16; ++s) {
            const float* o = ob + ((s + 1) & 15) * 64;
            const f32x4 W0n = *(const f32x4*)(o), W1n = *(const f32x4*)(o + 4), W2n = *(const f32x4*)(o + 8), W3n = *(const f32x4*)(o + 12);
            const f32x4 K0n = *(const f32x4*)(o + 1024), K1n = *(const f32x4*)(o + 1028), K2n = *(const f32x4*)(o + 1032), K3n = *(const f32x4*)(o + 1036);
            const f32x4 A0n = *(const f32x4*)(o + 2048), A1n = *(const f32x4*)(o + 2052), A2n = *(const f32x4*)(o + 2056), A3n = *(const f32x4*)(o + 2060);
            const f32x4 B0n = *(const f32x4*)(o + 3072), B1n = *(const f32x4*)(o + 3076), B2n = *(const f32x4*)(o + 3080), B3n = *(const f32x4*)(o + 3084);
            const f32x4 R0n = *(const f32x4*)(o + 4096), R1n = *(const f32x4*)(o + 4100), R2n = *(const f32x4*)(o + 4104), R3n = *(const f32x4*)(o + 4108);
            const float vn = ov[((s + 1) & 15) * 64];
            const f32x4 pa = (S0 * A0 + S1 * A1) + (S2 * A2 + S3 * A3);
            float sa = (pa[0] + pa[1]) + (pa[2] + pa[3]);
            sa += dpp_f<0x124>(sa); sa += dpp_f<0x128>(sa);
            S0 = S0 * W0 + (B0 * sa + K0 * vv);
            S1 = S1 * W1 + (B1 * sa + K1 * vv);
            S2 = S2 * W2 + (B2 * sa + K2 * vv);
            S3 = S3 * W3 + (B3 * sa + K3 * vv);
            const f32x4 py = (S0 * R0 + S1 * R1) + (S2 * R2 + S3 * R3);
            float y = (py[0] + py[1]) + (py[2] + py[3]);
            y += dpp_f<0x124>(y); y += dpp_f<0x128>(y);
            if (jq == 0) yo[s * 64] = y;
            W0 = W0n; W1 = W1n; W2 = W2n; W3 = W3n; K0 = K0n; K1 = K1n; K2 = K2n; K3 = K3n; A0 = A0n; A1 = A1n; A2 = A2n; A3 = A3n;
            B0 = B0n; B1 = B1n; B2 = B2n; B3 = B3n; R0 = R0n; R1 = R1n; R2 = R2n; R3 = R3n; vv = vn;
            if (s == 4 || s == 9) lds_barrier();
        }
    };

    lds_barrier();
    if (is_scan) {
        lds_barrier(); lds_barrier(); lds_barrier();
#pragma unroll 1
        for (int c = 0; c < nchunk; ++c) {
            chunk_steps(c & 1);
            lds_barrier();
        }
        if (state_out) {
            float* sp = state_out + irow * 64 + jb;
            *(f32x4*)sp = S0; *(f32x4*)(sp + 4) = S1; *(f32x4*)(sp + 8) = S2; *(f32x4*)(sp + 12) = S3;
        }
    } else {
        load_chunk(0); prodA(0);
        lds_barrier();
        prodB();
        lds_barrier();
        prodC(0, 0); if (nchunk > 1) load_chunk(1);
        lds_barrier();
#pragma unroll 1
        for (int c = 0; c < nchunk; ++c) {
            const int b = c & 1;
            const bool more = c + 1 < nchunk;
            if (c > 0) flush_ys(c - 1);
            if (more) prodA(b ^ 1);
            lds_barrier();
            if (more) prodB();
            lds_barrier();
            if (more) { prodC(c + 1, b ^ 1); if (c + 2 < nchunk) load_chunk(c + 2); }
            lds_barrier();
        }
        flush_ys(nchunk - 1);
    }
    lds_barrier();
}

DI void scan_dispatch(const Params& p, char* smem, int it) {
    if (it < 128) {
        const int b = it >> 4, dsel = (it >> 3) & 1, h = it & 7;
        scan_item(p, smem, MC + b * 2048, 2048, dsel, h, p.state_rwkv + (size_t)((b * 2 + dsel) * 8 + h) * 4096, nullptr);
    } else {
        const int i2 = it - 128, s = i2 >> 4, dsel = (i2 >> 3) & 1, h = i2 & 7;
        scan_item(p, smem, s * 256, 256, dsel, h, nullptr, p.out + OUT_S + (size_t)((s * 2 + dsel) * 8 + h) * 4096);
    }
}
DI void phase_mix(const Params& p, char* smem) {
    unsigned* ctr = (unsigned*)(p.ws + OFF_BAR) + XCD_BAR_WORDS;
    volatile LAS unsigned* slot = (volatile LAS unsigned*)(smem + LDS_MAIN + 8);
    for (;;) {
        if (threadIdx.x == 0) *slot = __hip_atomic_fetch_add(ctr, 1u, __ATOMIC_RELAXED, __HIP_MEMORY_SCOPE_AGENT);
        __syncthreads();
        const int it = (int)*slot;
        __syncthreads();
        if (it >= 640 + 768) break;
        if (it < 640) scan_dispatch(p, smem, it);
        else attn_item(p, smem, it - 640);
    }
    sg_pass(p);
}

DI void phase_post(const Params& p, char* smem) {
    const int tid = threadIdx.x, wid = tid >> 6, lane = tid & 63, fr = lane & 15, fq = lane >> 4, wr = wid >> 1, wc = wid & 1;
    unsigned char* ws = p.ws;
    const bf16_t* sg = (const bf16_t*)(ws + OFF_SG); const bf16_t* g2t = (const bf16_t*)(ws + OFF_G2T);
    const float* ys0 = (const float*)(ws + OFF_YS); const float* ys1 = ys0 + (size_t)M * 512;
    const float* bn = (const float*)(ws + OFF_BN);
    const bf16_t* zr = (const bf16_t*)(p.out + OUT_Y);
    bf16_t* rw = (bf16_t*)(ws + OFF_RW);
    const int MT = M / 256, NT = 4;
    for (int t = blockIdx.x; t < MT * NT; t += gridDim.x) {
        int mt, nt; tile_coords(t, MT, NT, mt, nt);
        const int row0 = mt * 256;
        f32x4 acc[4][4]; zero_acc<4>(acc);
        gemm_acc<4>(acc, sg + (size_t)row0 * 128, 128, g2t + (size_t)(nt * 128) * 128, 128, 128, smem, tid);
        const int head = nt * 2 + wc;
#pragma unroll
        for (int mb = 0; mb < 4; ++mb) {
            const int m = row0 + wr * 64 + mb * 16 + fr;
            int r0, T; seq_of(m, r0, T);
            f32x4 y[4]; float s1 = 0.f;
#pragma unroll
            for (int nb = 0; nb < 4; ++nb) {
                const size_t o = (size_t)m * 512 + head * 64 + nb * 16 + fq * 4;
                y[nb] = *(const f32x4*)(ys0 + o) + *(const f32x4*)(ys1 + o);
                s1 += y[nb][0] + y[nb][1] + y[nb][2] + y[nb][3];
            }
            s1 += __shfl_xor(s1, 16); s1 += __shfl_xor(s1, 32);
            const float mean = s1 * (1.0f / 64.0f);
            float s2 = 0.f;
#pragma unroll
            for (int nb = 0; nb < 4; ++nb) { const f32x4 dlt = y[nb] - mean; s2 += dlt[0] * dlt[0] + dlt[1] * dlt[1] + dlt[2] * dlt[2] + dlt[3] * dlt[3]; }
            s2 += __shfl_xor(s2, 16); s2 += __shfl_xor(s2, 32);
            const float rstd = __builtin_amdgcn_rsqf(s2 * (1.0f / 64.0f) + 64e-5f);
            const float bonus = bn[(size_t)m * 16 + head] + bn[(size_t)m * 16 + 8 + head];
#pragma unroll
            for (int nb = 0; nb < 4; ++nb) {
                const int c = head * 64 + nb * 16 + fq * 4;
                const bf16_t* zp = zr + (size_t)m * ZRC + 1024 + c;
                const f32x4 z = unpack4(*(const u32x2*)zp);
                f32x4 zprev = (f32x4){0.f, 0.f, 0.f, 0.f}, znext = zprev;
                if (m > r0) zprev = unpack4(*(const u32x2*)(zp - ZRC));
                if (m < r0 + T - 1) znext = unpack4(*(const u32x2*)(zp + ZRC));
                const f32x4 a0 = *(const f32x4*)(p.rwkv_mu + 1024 + c), a1 = *(const f32x4*)(p.rwkv_mu + ZRC + 1024 + c);
                const f32x4 v = z + a0 * (zprev - z) + a1 * (znext - z);
                const f32x4 lg = *(const f32x4*)(p.rwkv_ln_g + c), lb = *(const f32x4*)(p.rwkv_ln_b + c);
                const f32x4 yn = (y[nb] - mean) * rstd * lg + lb;
                const f32x4 o = (yn + v * bonus) * acc[mb][nb];
                *(u32x2*)(rw + (size_t)m * 512 + c) = pack4(o);
            }
        }
    }
}

DI void phase_merge(const Params& p, char* smem) {
    const int tid = threadIdx.x, wid = tid >> 6, lane = tid & 63, fr = lane & 15, fq = lane >> 4, wr = wid >> 1, wc = wid & 1;
    unsigned char* ws = p.ws;
    const bf16_t* hb = (const bf16_t*)(ws + OFF_H); const bf16_t* wt = (const bf16_t*)(ws + OFF_WIN);
    const bf16_t* ab = (const bf16_t*)(ws + OFF_ATTN); const bf16_t* rw = (const bf16_t*)(ws + OFF_RW);
    const bf16_t* wpa = (const bf16_t*)(ws + OFF_WPA); const bf16_t* wpb = (const bf16_t*)(ws + OFF_WPB);
    bf16_t* mg = (bf16_t*)(ws + OFF_MRG);
    const int MT = M / 256, NT = 16;
    for (int t = blockIdx.x; t < MT * NT; t += gridDim.x) {
        int mt, nt; tile_coords(t, MT, NT, mt, nt);
        const int row0 = mt * 256, n0 = nt * 64;
        f32x4 acc[4][2], res[4][2], gate[4][2];
        zero_acc<2>(acc);
        gemm_acc<2>(acc, hb + (size_t)row0 * 1024, 1024, wt + (size_t)(768 + n0) * 1024, 1024, 1024, smem, tid);
#pragma unroll
        for (int a = 0; a < 4; ++a)
#pragma unroll
            for (int b = 0; b < 2; ++b)
#pragma unroll
                for (int j = 0; j < 4; ++j) gate[a][b][j] = sigmoidf_(acc[a][b][j]);
        zero_acc<2>(acc);
        gemm_acc<2>(acc, ab + (size_t)row0 * 512, 512, wpa + (size_t)n0 * 512, 512, 512, smem, tid);
#pragma unroll
        for (int a = 0; a < 4; ++a)
#pragma unroll
            for (int b = 0; b < 2; ++b) res[a][b] = gate[a][b] * acc[a][b];
        zero_acc<2>(acc);
        gemm_acc<2>(acc, hb + (size_t)row0 * 1024, 1024, wt + (size_t)(1792 + n0) * 1024, 1024, 1024, smem, tid);
#pragma unroll
        for (int a = 0; a < 4; ++a)
#pragma unroll
            for (int b = 0; b < 2; ++b)
#pragma unroll
                for (int j = 0; j < 4; ++j) gate[a][b][j] = sigmoidf_(acc[a][b][j]);
        zero_acc<2>(acc);
        gemm_acc<2>(acc, rw + (size_t)row0 * 512, 512, wpb + (size_t)n0 * 512, 512, 512, smem, tid);
#pragma unroll
        for (int mb = 0; mb < 4; ++mb) {
            const int m = row0 + wr * 64 + mb * 16 + fr;
#pragma unroll
            for (int nb = 0; nb < 2; ++nb) {
                const f32x4 o = res[mb][nb] + gate[mb][nb] * acc[mb][nb];
                *(u32x2*)(mg + (size_t)m * 1024 + n0 + wc * 32 + nb * 16 + fq * 4) = pack4(o);
            }
        }
    }
}

DI void phase_out(const Params& p, char* smem) {
    const int tid = threadIdx.x, wid = tid >> 6, lane = tid & 63, fr = lane & 15, fq = lane >> 4, wr = wid >> 1, wc = wid & 1;
    unsigned char* ws = p.ws;
    const bf16_t* mg = (const bf16_t*)(ws + OFF_MRG); const bf16_t* wo = (const bf16_t*)(ws + OFF_WOUT);
    const float* mod = (const float*)(ws + OFF_MOD);
    const int MT = M / 256, NT = 8;
    for (int t = blockIdx.x; t < MT * NT; t += gridDim.x) {
        int mt, nt; tile_coords(t, MT, NT, mt, nt);
        const int row0 = mt * 256, n0 = nt * 128;
        f32x4 acc[4][4]; zero_acc<4>(acc);
        gemm_acc<4>(acc, mg + (size_t)row0 * 1024, 1024, wo + (size_t)n0 * 1024, 1024, 1024, smem, tid);
        const int ci = cond_of(row0);
#pragma unroll
        for (int nb = 0; nb < 4; ++nb) {
            const int n = n0 + wc * 64 + nb * 16 + fq * 4;
            const f32x4 g1 = *(const f32x4*)(mod + ci * 6144 + 2048 + n);
#pragma unroll
            for (int mb = 0; mb < 4; ++mb) {
                const int m = row0 + wr * 64 + mb * 16 + fr;
                const f32x4 xv = *(const f32x4*)(xrow(p, m) + n);
                *(f32x4*)(p.out + OUT_Y + (size_t)m * D + n) = xv + g1 * acc[mb][nb];
            }
        }
    }
}

DI u32x2 conv_act(const f32x4 (&um)[2], const f32x4 (&u0)[2], const f32x4 (&up)[2], const float* cw, const float* cb, int gcol) {
    f32x4 res[2];
#pragma unroll
    for (int part = 0; part < 2; ++part) {
        const int cc = gcol + part * DFF;
        const f32x4 w0 = *(const f32x4*)(cw + cc), w1 = *(const f32x4*)(cw + 5632 + cc), w2 = *(const f32x4*)(cw + 2 * 5632 + cc), bb = *(const f32x4*)(cb + cc);
        res[part] = um[part] * w0 + u0[part] * w1 + up[part] * w2 + bb;
    }
    f32x4 o;
#pragma unroll
    for (int j = 0; j < 4; ++j) { const float g = res[1][j]; o[j] = g * rcpf_(1.0f + __expf(-g)) * res[0][j]; }
    return pack4(o);
}
DI void phase_up(const Params& p, char* smem) {
    const int tid = threadIdx.x, wid = tid >> 6, lane = tid & 63, fr = lane & 15, fq = lane >> 4, wr = wid >> 1, wc = wid & 1;
    unsigned char* ws = p.ws;
    const bf16_t* hb = (const bf16_t*)(ws + OFF_H); const bf16_t* wu = (const bf16_t*)(ws + OFF_WUP);
    bf16_t* act = (bf16_t*)(ws + OFF_ACT); bf16_t* ub = (bf16_t*)(ws + OFF_U);
    bf16_t* ut = (bf16_t*)smem;
    const int MT = M / 256, NT = 44;
    for (int t = blockIdx.x; t < MT * NT; t += gridDim.x) {
        int mt, nt; tile_coords(t, MT, NT, mt, nt);
        const int row0 = mt * 256, n0 = nt * 64;
        f32x4 acc[4][4]; zero_acc<4>(acc);
        gemm_acc<4, 1>(acc, hb + (size_t)row0 * 1024, 1024, wu + (size_t)n0 * 1024, 1024, 1024, smem, tid);
        __syncthreads();
#pragma unroll
        for (int mb = 0; mb < 4; ++mb)
#pragma unroll
            for (int nb = 0; nb < 4; ++nb) *(u32x2*)(ut + (wr * 64 + mb * 16 + fr) * 136 + wc * 64 + nb * 16 + fq * 4) = pack4(acc[mb][nb]);
        __syncthreads();
        const int c4 = (tid & 15) * 4, lv = (c4 >> 5) * 64 + (c4 & 31), lg = lv + 32;
#pragma unroll 2
        for (int it = 0; it < 8; ++it) {
            const int row = it * 32 + (tid >> 4);
            f32x4 um[2], u0[2], up[2];
            const f32x4 z4 = (f32x4){0.f, 0.f, 0.f, 0.f};
            u0[0] = unpack4(*(const u32x2*)(ut + row * 136 + lv)); u0[1] = unpack4(*(const u32x2*)(ut + row * 136 + lg));
            um[0] = row > 0 ? unpack4(*(const u32x2*)(ut + (row - 1) * 136 + lv)) : z4; um[1] = row > 0 ? unpack4(*(const u32x2*)(ut + (row - 1) * 136 + lg)) : z4;
            up[0] = row < 255 ? unpack4(*(const u32x2*)(ut + (row + 1) * 136 + lv)) : z4; up[1] = row < 255 ? unpack4(*(const u32x2*)(ut + (row + 1) * 136 + lg)) : z4;
            *(u32x2*)(act + (size_t)(row0 + row) * DFF + n0 + c4) = conv_act(um, u0, up, p.ffn_conv_w, p.ffn_conv_b, n0 + c4);
        }
        if (row0 >= MC && tid < 256) {
            const int k = tid >> 6, rsel = k < 2 ? k : 252 + k, cp = (tid & 63) * 2;
            *(unsigned*)(ub + ((size_t)(mt * NT + nt) * 4 + k) * 128 + cp) = *(const unsigned*)(ut + rsel * 136 + cp);
        }
    }
}
DI void phase_fix(const Params& p) {
    unsigned char* ws = p.ws;
    bf16_t* act = (bf16_t*)(ws + OFF_ACT); const bf16_t* ub = (const bf16_t*)(ws + OFF_U);
    const int NT = 44;
    for (int i = blockIdx.x * NTHR + threadIdx.x; i < 64 * NT * 2 * 16; i += gridDim.x * NTHR) {
        const int cg = i & 15, which = (i >> 4) & 1, rest = i >> 5, nt = rest % NT, mt = 32 + rest / NT;
        const int row0 = mt * 256, tpos = (row0 - MC) & 2047;
        if (which == 0 ? tpos == 0 : tpos == 2048 - 256) continue;
        const bf16_t* own = ub + (size_t)(mt * NT + nt) * 4 * 128;
        const bf16_t *pv, *cu, *nx; int m;
        if (which == 0) { m = row0; pv = ub + ((size_t)((mt - 1) * NT + nt) * 4 + 3) * 128; cu = own; nx = own + 128; }
        else { m = row0 + 255; pv = own + 2 * 128; cu = own + 3 * 128; nx = ub + (size_t)((mt + 1) * NT + nt) * 4 * 128; }
        const int c4 = cg * 4, lv = (c4 >> 5) * 64 + (c4 & 31), lg = lv + 32;
        f32x4 um[2], u0[2], up[2];
        um[0] = unpack4(*(const u32x2*)(pv + lv)); um[1] = unpack4(*(const u32x2*)(pv + lg));
        u0[0] = unpack4(*(const u32x2*)(cu + lv)); u0[1] = unpack4(*(const u32x2*)(cu + lg));
        up[0] = unpack4(*(const u32x2*)(nx + lv)); up[1] = unpack4(*(const u32x2*)(nx + lg));
        *(u32x2*)(act + (size_t)m * DFF + nt * 64 + c4) = conv_act(um, u0, up, p.ffn_conv_w, p.ffn_conv_b, nt * 64 + c4);
    }
}
DI void phase_down(const Params& p, char* smem) {
    const int tid = threadIdx.x, wid = tid >> 6, lane = tid & 63, fr = lane & 15, fq = lane >> 4, wr = wid >> 1, wc = wid & 1;
    unsigned char* ws = p.ws;
    const bf16_t* act = (const bf16_t*)(ws + OFF_ACT); const bf16_t* wd = (const bf16_t*)(ws + OFF_WDN);
    const float* mod = (const float*)(ws + OFF_MOD);
    const int MT = M / 256, NT = 8;
    for (int t = blockIdx.x; t < MT * NT; t += gridDim.x) {
        int mt, nt; tile_coords(t, MT, NT, mt, nt);
        const int row0 = mt * 256, n0 = nt * 128;
        f32x4 acc[4][4]; zero_acc<4>(acc);
        gemm_acc<4>(acc, act + (size_t)row0 * DFF, DFF, wd + (size_t)n0 * DFF, DFF, DFF, smem, tid);
        const int ci = cond_of(row0);
#pragma unroll
        for (int nb = 0; nb < 4; ++nb) {
            const int n = n0 + wc * 64 + nb * 16 + fq * 4;
            const f32x4 g2 = *(const f32x4*)(mod + ci * 6144 + 5120 + n);
#pragma unroll
            for (int mb = 0; mb < 4; ++mb) {
                const int m = row0 + wr * 64 + mb * 16 + fr;
                float* px = p.out + OUT_Y + (size_t)m * D + n;
                *(f32x4*)px = *(const f32x4*)px + g2 * acc[mb][nb];
            }
        }
    }
}

#define XB_TMO      128
#define XB_XCNT(j)  (256  + 64 * (j))
#define XB_XSUB(j)  (1280 + 64 * (j))
#define XB_XGEN(j)  (2304 + 64 * (j))
#define XB_TOP      3328
#define XB_TOPGEN   3392
#define XB_SPIN_CAP (1u << 20)
DI unsigned xb_ld(unsigned* p)              { return __hip_atomic_load(p, __ATOMIC_RELAXED, __HIP_MEMORY_SCOPE_AGENT); }
DI unsigned xb_add(unsigned* p, unsigned v) { return __hip_atomic_fetch_add(p, v, __ATOMIC_RELAXED, __HIP_MEMORY_SCOPE_AGENT); }
DI unsigned xb_xcc_id() { return (unsigned)__builtin_amdgcn_s_getreg((3 << 11) | 20) & 0xFu; }
#define XB_SPIN(cond, bar) do { unsigned _sp = 0; while (cond) { __builtin_amdgcn_s_sleep(1); \
    if ((++_sp & 255u) == 0u) { if (xb_ld(&(bar)[XB_TMO])) break; if (_sp > XB_SPIN_CAP) { atomicAdd(&(bar)[XB_TMO], 1u); break; } } } } while (0)
struct XcdBarrier { unsigned* bar; unsigned x; volatile LAS unsigned* st; };
DI XcdBarrier xcd_barrier_post(unsigned* bar, volatile LAS unsigned* st) {
    XcdBarrier b; b.bar = bar; b.x = xb_xcc_id(); b.st = st;
    if (threadIdx.x == 0) (void)xb_add(&bar[XB_XCNT(b.x)], 1u);
    return b;
}
DI void xcd_barrier_complete(unsigned* bar, unsigned x, unsigned& nloc, unsigned& nx) {
    const unsigned G = gridDim.x * gridDim.y * gridDim.z;
    unsigned sum, cnt, mine, sp = 0u;
    for (;;) {
        sum = 0u; cnt = 0u; mine = 0u;
#pragma unroll
        for (unsigned j = 0; j < 16; ++j) { const unsigned c = xb_ld(&bar[XB_XCNT(j)]); sum += c; cnt += (c > 0u) ? 1u : 0u; mine = (j == x) ? c : mine; }
        if (sum == G) break;
        __builtin_amdgcn_s_sleep(1);
        if ((++sp & 255u) == 0u) { if (xb_ld(&bar[XB_TMO])) break; if (sp > XB_SPIN_CAP) { atomicAdd(&bar[XB_TMO], 1u); break; } }
    }
    nloc = mine > 0u ? mine : 1u; nx = cnt > 0u ? cnt : 1u;
}
DI void xcd_barrier(const XcdBarrier& b) {
    asm volatile("s_waitcnt vmcnt(0)" ::: "memory");
    __syncthreads();
    if (threadIdx.x == 0) {
        unsigned* bar = b.bar;
        __builtin_amdgcn_s_waitcnt(0);
        unsigned nloc = b.st[0], nx = b.st[1];
        if (nloc == 0u) { xcd_barrier_complete(bar, b.x, nloc, nx); b.st[0] = nloc; b.st[1] = nx; }
        const unsigned old = xb_add(&bar[XB_XSUB(b.x)], 1u);
        const unsigned gen = old / nloc;
        if (old + 1u == (gen + 1u) * nloc) {
            __builtin_amdgcn_fence(__ATOMIC_RELEASE, "agent");
            asm volatile("s_waitcnt vmcnt(0)" ::: "memory");
            const unsigned og = xb_add(&bar[XB_TOP], 1u);
            const unsigned tg = og / nx;
            if (og + 1u == (tg + 1u) * nx) xb_add(&bar[XB_TOPGEN], 1u);
            else XB_SPIN(xb_ld(&bar[XB_TOPGEN]) == tg, bar);
            __builtin_amdgcn_fence(__ATOMIC_ACQUIRE, "agent");
            xb_add(&bar[XB_XGEN(b.x)], 1u);
            asm volatile("s_waitcnt vmcnt(0)" ::: "memory");
        } else {
            XB_SPIN(xb_ld(&bar[XB_XGEN(b.x)]) == gen, bar);
            __builtin_amdgcn_fence(__ATOMIC_ACQUIRE, "agent");
            asm volatile("s_waitcnt vmcnt(0)" ::: "memory");
        }
    }
    __syncthreads();
}

constexpr int N_PHASES = 23;
__global__ void __launch_bounds__(NTHR) fwd_kernel(Params p) {
    extern __shared__ __attribute__((aligned(16))) char smem[];
    volatile LAS unsigned* xst = (volatile LAS unsigned*)(smem + LDS_MAIN);
    if (threadIdx.x == 0) { xst[0] = 0u; xst[1] = 0u; }
    __syncthreads();
    const XcdBarrier xb = xcd_barrier_post((unsigned*)(p.ws + OFF_BAR), xst);
#ifndef PH_MASK
#define PH_MASK 0xffff
#endif
#ifndef REP_MASK
#define REP_MASK 0
#endif
#define RUN_PHASE(ph, bit, call) if (p.ph_lo <= (ph) && (ph) < p.ph_hi) { if ((ph) > p.ph_lo) xcd_barrier(xb); if (PH_MASK & (bit)) { call; if (REP_MASK & (bit)) { call; } } }
    RUN_PHASE(0, 1, phase_prep(p, smem))
    RUN_PHASE(1, 2, phase_norm<1>(p))
    RUN_PHASE(2, 4, phase_p1(p, smem))
    RUN_PHASE(4, 16, phase_mix(p, smem))
    RUN_PHASE(5, 32, phase_post(p, smem))
    RUN_PHASE(6, 64, phase_merge(p, smem))
    RUN_PHASE(7, 128, phase_out(p, smem))
    RUN_PHASE(8, 256, phase_norm<2>(p))
    RUN_PHASE(9, 512, phase_up(p, smem))
    RUN_PHASE(10, 1024, phase_fix(p))
    RUN_PHASE(21, 2048, phase_down(p, smem))
    RUN_PHASE(22, 4096, phase_norm<3>(p))
}

extern "C" void kernel_launch(void* const* d_in, const int* in_sizes, int n_in, void* d_out, int out_size, void* d_ws, size_t ws_size, hipStream_t stream) {
    static int grid = 0;
    if (grid == 0) {
        if (n_in != 32 || ws_size < WS_NEED) { fprintf(stderr, "kernel_launch: unexpected inputs (n_in %d, ws %zu, need %zu)\n", n_in, ws_size, (size_t)WS_NEED); grid = -1; return; }
        int dev = 0, cus = 0, per_cu = 0;
        hipGetDevice(&dev);
        hipDeviceGetAttribute(&cus, hipDeviceAttributeMultiprocessorCount, dev);
        hipFuncSetAttribute((const void*)fwd_kernel, hipFuncAttributeMaxDynamicSharedMemorySize, LDS_BYTES);
        hipOccupancyMaxActiveBlocksPerMultiprocessor(&per_cu, (const void*)fwd_kernel, NTHR, LDS_BYTES);
        if (per_cu < 1) { fprintf(stderr, "kernel_launch: occupancy query says %d blocks per CU\n", per_cu); grid = -1; return; }
        grid = cus;
        grid &= ~7;
    }
    if (grid < 0) return;
    if (hipMemsetAsync((char*)d_ws + OFF_BAR, 0, (XCD_BAR_WORDS + 64) * 4, stream) != hipSuccess) { fprintf(stderr, "kernel_launch: memset failed\n"); return; }
    Params p{};
    const float** pp = (const float**)&p;
    for (int i = 0; i < 32; ++i) pp[i] = (const float*)d_in[i];
    p.out = (float*)d_out; p.ws = (unsigned char*)d_ws;
#if N_LAUNCH_SPLIT
    for (int ph = 0; ph < N_PHASES; ++ph) {
        p.ph_lo = ph; p.ph_hi = ph + 1;
        hipLaunchKernelGGL(fwd_kernel, dim3(grid), dim3(NTHR), LDS_BYTES, stream, p);
    }
#else
    p.ph_lo = 0; p.ph_hi = N_PHASES;
    void* args[] = {&p};
    hipError_t e = hipLaunchCooperativeKernel((const void*)fwd_kernel, dim3(grid), dim3(NTHR), args, LDS_BYTES, stream);
    if (e != hipSuccess) fprintf(stderr, "cooperative launch failed: %s (grid %d)\n", hipGetErrorString(e), grid);
#endif
}
```

```cpp
#include <hip/hip_runtime.h>
#include <hip/hip_cooperative_groups.h>
#include <cstdio>
namespace cg = cooperative_groups;

#define DI __device__ __forceinline__
typedef unsigned short bf16_t;
typedef short bf16x8 __attribute__((ext_vector_type(8)));
typedef short s16x4 __attribute__((ext_vector_type(4)));
typedef float f32x4 __attribute__((ext_vector_type(4)));
typedef float f32x2 __attribute__((ext_vector_type(2)));
typedef float f32x16 __attribute__((ext_vector_type(16)));
typedef unsigned u32x4 __attribute__((ext_vector_type(4)));
typedef unsigned u32x2 __attribute__((ext_vector_type(2)));

#ifndef N_LAUNCH_SPLIT
#define N_LAUNCH_SPLIT 0
#endif

constexpr int NTHR = 512;
constexpr int D = 1024;
constexpr int MC = 8192;
constexpr int ML = 16384;
constexpr int M = MC + ML;
constexpr int WIN = 4736;
constexpr int ZRC = 1920;
constexpr int DFF = 2816;
constexpr int LDS_MAIN = 147456;
constexpr int LDS_BYTES = LDS_MAIN + 16;
constexpr float LOG2E = 1.4426950408889634f;

constexpr size_t al256(size_t x) { return (x + 255) & ~(size_t)255; }
constexpr size_t OFF_WUP   = 0;
constexpr size_t OFF_WDN   = OFF_WUP + al256((size_t)5632 * 1024 * 2);
constexpr size_t OFF_MOD   = OFF_WDN + al256((size_t)1024 * 2816 * 2);
constexpr size_t OFF_ROPE  = OFF_MOD + al256((size_t)9 * 6144 * 4);
constexpr size_t OFF_W2T   = OFF_ROPE + al256((size_t)64 * 16 * 8);
constexpr size_t OFF_A2T   = OFF_W2T + al256((size_t)2 * 512 * 64 * 2);
constexpr size_t OFF_G2T   = OFF_A2T + al256((size_t)2 * 512 * 64 * 2);
constexpr size_t OFF_KC    = OFF_G2T + al256((size_t)512 * 128 * 2);
constexpr size_t OFF_VCT   = OFF_KC + al256((size_t)8 * 512 * 128 * 2);
constexpr size_t OFF_BAR   = OFF_VCT + al256((size_t)8 * 512 * 128 * 2);
constexpr size_t OFF_H     = OFF_BAR + al256((size_t)(3456 + 64) * 4);
constexpr size_t OFF_X     = OFF_H + al256((size_t)M * 1024 * 2);
constexpr size_t OFF_WIN   = OFF_X;
constexpr size_t OFF_WPA   = OFF_WIN + al256((size_t)WIN * 1024 * 2);
constexpr size_t OFF_WPB   = OFF_WPA + al256((size_t)1024 * 512 * 2);
constexpr size_t OFF_WOUT  = OFF_WPB + al256((size_t)1024 * 512 * 2);
constexpr size_t OFF_Q     = OFF_WOUT + al256((size_t)1024 * 1024 * 2);
constexpr size_t OFF_RW    = OFF_Q;
constexpr size_t OFF_KB    = OFF_Q + al256((size_t)M * 512 * 2);
constexpr size_t OFF_VT    = OFF_KB + al256((size_t)M * 128 * 2);
constexpr size_t OFF_ATTN  = OFF_VT + al256((size_t)M * 128 * 2);
constexpr size_t OFF_SG    = OFF_ATTN + al256((size_t)M * 512 * 2);
constexpr size_t OFF_BN    = OFF_SG + al256((size_t)M * 128 * 2);
constexpr size_t OFF_YS    = OFF_BN + al256((size_t)M * 16 * 4);
constexpr size_t OFF_MRG   = OFF_YS;
constexpr size_t END_EARLY = OFF_YS + al256((size_t)2 * M * 512 * 4);
constexpr size_t OFF_ACT   = OFF_X;
constexpr size_t OFF_U     = OFF_ACT + al256((size_t)M * DFF * 2);
constexpr size_t END_FFN   = OFF_U + al256((size_t)96 * 44 * 4 * 128 * 2);
constexpr size_t WS_NEED   = END_EARLY > END_FFN ? END_EARLY : END_FFN;
static_assert(WS_NEED <= (size_t)256 * 1024 * 1024, "workspace over 256 MiB");

constexpr size_t OUT_Y  = 0;
constexpr size_t OUT_K  = (size_t)M * 1024;
constexpr size_t OUT_V  = OUT_K + (size_t)MC * 128;
constexpr size_t OUT_S  = OUT_V + (size_t)MC * 128;

struct Params {
    const float *x_prompt, *x_sample, *c, *cache_k, *cache_v, *state_rwkv, *c_ctx, *w_ada, *b_ada, *g_norm1, *w_in, *attn_sink,
        *w_proj_a, *w_proj_b, *rwkv_mu, *rwkv_w0, *rwkv_w2, *rwkv_a0, *rwkv_a2, *rwkv_k_k, *rwkv_k_a, *rwkv_r_k, *rwkv_g2,
        *rwkv_ln_g, *rwkv_ln_b, *w_out, *g_norm2, *w_ffn_up, *ffn_conv_w, *ffn_conv_b, *w_ffn_down, *g_final;
    float* out;
    unsigned char* ws;
    int ph_lo, ph_hi;
};

#define XCD_BAR_WORDS 3456
#define LAS __attribute__((address_space(3)))
DI bf16_t f2bf(float f) { unsigned u = __float_as_uint(f); u += 0x7fffu + ((u >> 16) & 1u); return (bf16_t)(u >> 16); }
DI float bf2f(unsigned b) { return __uint_as_float(b << 16); }
typedef __bf16 bf16v2_t __attribute__((ext_vector_type(2)));
DI unsigned pack2(float lo, float hi) { f32x2 v; v.x = lo; v.y = hi; return __builtin_bit_cast(unsigned, __builtin_convertvector(v, bf16v2_t)); }
DI u32x2 pack4(f32x4 v) { u32x2 r; r.x = pack2(v[0], v[1]); r.y = pack2(v[2], v[3]); return r; }
DI f32x4 unpack4(u32x2 v) { f32x4 r; r[0] = bf2f(v.x & 0xffffu); r[1] = bf2f(v.x >> 16); r[2] = bf2f(v.y & 0xffffu); r[3] = bf2f(v.y >> 16); return r; }
DI float rcpf_(float x) { return __builtin_amdgcn_rcpf(x); }
DI float sigmoidf_(float x) { return rcpf_(1.0f + __expf(-x)); }
DI const float* xrow(const Params& p, int r) { return r < MC ? p.x_prompt + (size_t)r * D : p.x_sample + (size_t)(r - MC) * D; }
DI int cond_of(int r) { return r < MC ? 0 : 1 + ((r - MC) >> 11); }
DI void seq_of(int r, int& r0, int& T) { if (r < MC) { r0 = r & ~255; T = 256; } else { r0 = MC + ((r - MC) & ~2047); T = 2048; } }
DI float wave_sum(float v) {
#pragma unroll
    for (int o = 32; o >= 1; o >>= 1) v += __shfl_xor(v, o);
    return v;
}

DI void transpose_tile(const float* __restrict__ src, int K, int N, bf16_t* __restrict__ dst, int kt, int nt, float* tile, int tid) {
    const int k0 = kt * 64, n0 = nt * 64;
#pragma unroll
    for (int i = 0; i < 8; ++i) { const int k = (tid >> 6) + 8 * i, n = tid & 63; tile[k * 65 + n] = src[(size_t)(k0 + k) * N + n0 + n]; }
    __syncthreads();
#pragma unroll
    for (int i = 0; i < 8; ++i) { const int n = (tid >> 6) + 8 * i, k = tid & 63; dst[(size_t)(n0 + n) * K + k0 + k] = f2bf(tile[k * 65 + n]); }
    __syncthreads();
}

DI void phase_prep(const Params& p, char* smem) {
    const int tid = threadIdx.x, nb = gridDim.x, bid = blockIdx.x;
    unsigned char* ws = p.ws;
    {
        float* tile = (float*)smem;
        const int cnt[11] = {16 * 74, 8 * 16, 8 * 16, 16 * 16, 16 * 88, 44 * 16, 8, 8, 8, 8, 16};
        int total = 0;
#pragma unroll
        for (int i = 0; i < 11; ++i) total += cnt[i];
        for (int it = bid; it < total; it += nb) {
            int i = it, mi = 0;
#pragma unroll
            for (int q = 0; q < 10; ++q) { if (mi == q && i >= cnt[q]) { i -= cnt[q]; mi = q + 1; } }
            const float* src; bf16_t* dst; int K, N;
            switch (mi) {
                case 0: src = p.w_in; K = 1024; N = WIN; dst = (bf16_t*)(ws + OFF_WIN); break;
                case 1: src = p.w_proj_a; K = 512; N = 1024; dst = (bf16_t*)(ws + OFF_WPA); break;
                case 2: src = p.w_proj_b; K = 512; N = 1024; dst = (bf16_t*)(ws + OFF_WPB); break;
                case 3: src = p.w_out; K = 1024; N = 1024; dst = (bf16_t*)(ws + OFF_WOUT); break;
                case 4: src = p.w_ffn_up; K = 1024; N = 5632; dst = (bf16_t*)(ws + OFF_WUP); break;
                case 5: src = p.w_ffn_down; K = 2816; N = 1024; dst = (bf16_t*)(ws + OFF_WDN); break;
                case 6: src = p.rwkv_w2; K = 64; N = 512; dst = (bf16_t*)(ws + OFF_W2T); break;
                case 7: src = p.rwkv_w2 + 64 * 512; K = 64; N = 512; dst = (bf16_t*)(ws + OFF_W2T) + 512 * 64; break;
                case 8: src = p.rwkv_a2; K = 64; N = 512; dst = (bf16_t*)(ws + OFF_A2T); break;
                case 9: src = p.rwkv_a2 + 64 * 512; K = 64; N = 512; dst = (bf16_t*)(ws + OFF_A2T) + 512 * 64; break;
                default: src = p.rwkv_g2; K = 128; N = 512; dst = (bf16_t*)(ws + OFF_G2T); break;
            }
            const int ntn = N / 64;
            transpose_tile(src, K, N, dst, i / ntn, i % ntn, tile, tid);
        }
    }
    {
        bf16_t* kc = (bf16_t*)(ws + OFF_KC); bf16_t* vct = (bf16_t*)(ws + OFF_VCT);
        for (int i = bid * NTHR + tid; i < 8 * 512 * 128; i += nb * NTHR) {
            kc[i] = f2bf(p.cache_k[i]);
            const int key = i & 511, d = (i >> 9) & 63, kvh = (i >> 15) & 1, b = i >> 16;
            vct[i] = f2bf(p.cache_v[((size_t)(b * 512 + key) * 2 + kvh) * 64 + d]);
        }
    }
    {
        f32x2* tab = (f32x2*)(ws + OFF_ROPE);
        for (int i = bid * NTHR + tid; i < 1024; i += nb * NTHR) {
            const int pos = i >> 4, fi = i & 15;
            const double fr = pow(10000.0, -(double)fi / 16.0), ang = (double)pos * fr;
            f32x2 v; v.x = (float)cos(ang); v.y = (float)sin(ang); tab[i] = v;
        }
    }
    {
        float* s = (float*)smem;
        float* red = (float*)(smem + 36864);
        float* mod = (float*)(ws + OFF_MOD);
        for (int it = bid; it < 96; it += nb) {
            __syncthreads();
            for (int i = tid; i < 9 * 1024; i += NTHR) {
                const int ci = i >> 10, k = i & 1023;
                const float v = ci == 0 ? p.c_ctx[k] : p.c[(ci - 1) * 1024 + k];
                s[i] = v / (1.0f + __expf(-v));
            }
            __syncthreads();
            const int n = tid & 63, kq = tid >> 6, n0 = it * 64;
            float acc[9];
#pragma unroll
            for (int ci = 0; ci < 9; ++ci) acc[ci] = 0.f;
            for (int k = kq * 128; k < kq * 128 + 128; ++k) {
                const float w = p.w_ada[(size_t)k * 6144 + n0 + n];
#pragma unroll
                for (int ci = 0; ci < 9; ++ci) acc[ci] += s[ci * 1024 + k] * w;
            }
#pragma unroll
            for (int ci = 0; ci < 9; ++ci) red[(kq * 9 + ci) * 64 + n] = acc[ci];
            __syncthreads();
            for (int i = tid; i < 9 * 64; i += NTHR) {
                const int ci = i >> 6, nn = i & 63;
                float v = p.b_ada[n0 + nn];
#pragma unroll
                for (int q = 0; q < 8; ++q) v += red[(q * 9 + ci) * 64 + nn];
                mod[ci * 6144 + n0 + nn] = v;
            }
        }
        __syncthreads();
    }
}

template <int WHICH> DI void phase_norm(const Params& p) {
    const int tid = threadIdx.x, lane = tid & 63, wv = tid >> 6;
    const float* mod = (const float*)(p.ws + OFF_MOD);
    bf16_t* hb = (bf16_t*)(p.ws + OFF_H);
    const int ntask = M / 8;
    for (int task = blockIdx.x * 8 + wv; task < ntask; task += gridDim.x * 8) {
        const int r_first = task * 8, ci = cond_of(r_first);
        f32x4 fa[4], fb[4];
#pragma unroll
        for (int i = 0; i < 4; ++i) {
            const int col = i * 256 + lane * 4;
            if (WHICH == 3) { fa[i] = *(const f32x4*)(p.g_final + col); fb[i] = (f32x4){0.f, 0.f, 0.f, 0.f}; }
            else {
                const f32x4 g = *(const f32x4*)((WHICH == 1 ? p.g_norm1 : p.g_norm2) + col);
                const f32x4 sc = *(const f32x4*)(mod + ci * 6144 + (WHICH == 1 ? 1024 : 4096) + col);
                fb[i] = *(const f32x4*)(mod + ci * 6144 + (WHICH == 1 ? 0 : 3072) + col);
                fa[i] = g * (sc + 1.0f);
            }
        }
        for (int rr = 0; rr < 8; ++rr) {
            const int r = r_first + rr;
            const float* src = WHICH == 1 ? xrow(p, r) : p.out + OUT_Y + (size_t)r * D;
            f32x4 v[4]; float ss = 0.f;
#pragma unroll
            for (int i = 0; i < 4; ++i) { v[i] = *(const f32x4*)(src + i * 256 + lane * 4); ss += v[i][0] * v[i][0] + v[i][1] * v[i][1] + v[i][2] * v[i][2] + v[i][3] * v[i][3]; }
            ss = wave_sum(ss);
            const float rstd = __builtin_amdgcn_rsqf(ss * (1.0f / 1024.0f) + 1e-6f);
#pragma unroll
            for (int i = 0; i < 4; ++i) {
                const f32x4 o = v[i] * rstd * fa[i] + fb[i];
                if (WHICH == 3) *(f32x4*)(p.out + OUT_Y + (size_t)r * D + i * 256 + lane * 4) = o;
                else *(u32x2*)(hb + (size_t)r * D + i * 256 + lane * 4) = pack4(o);
            }
        }
    }
}

template <int NB, int BMAP> DI void gemm_stage(const bf16_t* A, int lda, const bf16_t* Bt, int ldb, int k0, char* sbuf, int tid) {
#pragma unroll
    for (int i = 0; i < 4; ++i) {
        const int c = tid + i * 512, row = c >> 3, pos = c & 7, kc = pos ^ ((row >> 1) & 7);
        __builtin_amdgcn_global_load_lds((const unsigned*)(A + (size_t)row * lda + k0 + kc * 8), (unsigned*)(sbuf + c * 16), 16, 0, 0);
    }
#pragma unroll
    for (int i = 0; i < NB / 2; ++i) {
        const int c = tid + i * 512, row = c >> 3, pos = c & 7, kc = pos ^ ((row >> 1) & 7);
        const int brow = BMAP ? (((row >> 5) & 1) * DFF + (row >> 6) * 32 + (row & 31)) : row;
        __builtin_amdgcn_global_load_lds((const unsigned*)(Bt + (size_t)brow * ldb + k0 + kc * 8), (unsigned*)(sbuf + 32768 + c * 16), 16, 0, 0);
    }
}
template <int NB, int BMAP = 0> DI void gemm_acc(f32x4 (&acc)[4][NB], const bf16_t* A, int lda, const bf16_t* Bt, int ldb, int K, char* smem, int tid) {
    const int wid = tid >> 6, lane = tid & 63, fr = lane & 15, fq = lane >> 4, wr = wid >> 1, wc = wid & 1;
    const int swz = (fr >> 1) & 7;
    const int nk = K >> 6;
    __syncthreads();
    gemm_stage<NB, BMAP>(A, lda, Bt, ldb, 0, smem, tid);
    if (nk > 1) gemm_stage<NB, BMAP>(A, lda, Bt, ldb, 64, smem + 49152, tid);
    int cur = 0;
#pragma unroll 1
    for (int t = 0; t < nk; ++t) {
        if (t + 1 < nk) { if (NB == 4) asm volatile("s_waitcnt vmcnt(6)" ::: "memory"); else asm volatile("s_waitcnt vmcnt(5)" ::: "memory"); }
        else asm volatile("s_waitcnt vmcnt(0)" ::: "memory");
        __builtin_amdgcn_s_barrier();
        asm volatile("" ::: "memory");
        const int nxt2 = cur >= 1 ? cur - 1 : 2;
        const bool late = __builtin_amdgcn_readfirstlane(wid) >= 4;
        if (t + 2 < nk && !late) gemm_stage<NB, BMAP>(A, lda, Bt, ldb, (t + 2) * 64, smem + nxt2 * 49152, tid);
        const char* sA = smem + cur * 49152;
        const char* sB = sA + 32768;
#pragma unroll
        for (int ks = 0; ks < 2; ++ks) {
            if (ks == 1 && t + 2 < nk && late) gemm_stage<NB, BMAP>(A, lda, Bt, ldb, (t + 2) * 64, smem + nxt2 * 49152, tid);
            bf16x8 af[4], bfr[NB];
            const int coff = ((ks * 4 + fq) ^ swz) << 4;
#pragma unroll
            for (int mb = 0; mb < 4; ++mb) af[mb] = *(const bf16x8*)(sA + (wr * 64 + mb * 16 + fr) * 128 + coff);
#pragma unroll
            for (int nb = 0; nb < NB; ++nb) bfr[nb] = *(const bf16x8*)(sB + (wc * 16 * NB + nb * 16 + fr) * 128 + coff);
            __builtin_amdgcn_s_setprio(1);
#pragma unroll
            for (int mb = 0; mb < 4; ++mb)
#pragma unroll
                for (int nb = 0; nb < NB; ++nb) acc[mb][nb] = __builtin_amdgcn_mfma_f32_16x16x32_bf16(bfr[nb], af[mb], acc[mb][nb], 0, 0, 0);
            __builtin_amdgcn_s_setprio(0);
        }
        cur = cur == 2 ? 0 : cur + 1;
    }
}
template <int NB> DI void zero_acc(f32x4 (&acc)[4][NB]) {
#pragma unroll
    for (int a = 0; a < 4; ++a)
#pragma unroll
        for (int b = 0; b < NB; ++b) acc[a][b] = (f32x4){0.f, 0.f, 0.f, 0.f};
}
DI void tile_coords(int t, int MT, int NT, int& mt, int& nt) {
    const int x = t & 7, u = t >> 3, mpx = MT >> 3;
    const int bm = (mpx % 4 == 0) ? 4 : ((mpx % 2 == 0) ? 2 : 1);
    const int per_band = bm * NT, band = u / per_band, rem = u - band * per_band;
    nt = rem / bm; mt = x * mpx + band * bm + (rem % bm);
}


namespace pg8 {
#define PG8_LAS __attribute__((address_space(3)))
constexpr int BM = 256, BK = 64, HALF = 128, HTB = HALF * BK * 2  , STAGE_BYTES = 8 * HTB, NXCD = 8, WGM = 8;
__host__ __device__ __forceinline__ int lds_byte(int r, int c) { const int st = (r >> 4) * 2 + (c >> 5), rr = r & 15, cc = c & 31, ob = rr * 64 + cc * 2; return st * 1024 + (ob ^ (((ob >> 9) & 1) << 5)); }
__host__ __device__ __forceinline__ void stage_rc(int b, int& R, int& C) { const int st = b / 1024, sb = b % 1024, swz = sb ^ (((sb >> 9) & 1) << 5); R = (st >> 1) * 16 + swz / 64; C = (st & 1) * 32 + (swz % 64) / 2; }
__host__ __device__ __forceinline__ int perm32(int rho) { const int n = rho >> 4, i = rho & 15; return 8 * (i >> 2) + 4 * n + (i & 3); }


struct Unit { int pm, pn, brow; };
struct Gemm8 { const bf16_t* A; const bf16_t* Bt; int K; int bhalf; };
__device__ __forceinline__ void unit_of(int L, int nM, int nN, int& pm, int& pn) {
    const int nwg = nM * nN;
    int wgid = L; { const int q = nwg / NXCD, r = nwg % NXCD, xcd = wgid % NXCD, off = wgid / NXCD; wgid = (xcd < r ? xcd * (q + 1) : r * (q + 1) + (xcd - r) * q) + off; }
    const int nig = WGM * nN, gid = wgid / nig, fm = gid * WGM, gsz = (nM - fm) < WGM ? (nM - fm) : WGM;
    pm = fm + ((wgid % nig) % gsz); pn = (wgid % nig) / gsz;
}
struct Order8 {
    int nM, nN, nlim, G, c;
    __device__ __forceinline__ bool next(int i, Unit& u) const {
        const long L = (long)i * G + c; if (L >= nlim) return false;
        unit_of((int)L, nM, nN, u.pm, u.pn); u.brow = u.pn * 256; return true;
    }
    __device__ __forceinline__ void a_ready(const Unit&) const {}
    __device__ __forceinline__ void done(const Unit&) const {}
};
template <class Epi, class Sched>
__device__ __forceinline__ void gemm8(PG8_LAS unsigned char* lds, const Gemm8 g, const Sched& S, const Epi& E) {
    const int tid = threadIdx.x, wid = __builtin_amdgcn_readfirstlane(tid >> 6), lane = tid & 63, wr = wid >> 2, wc = wid & 3, fr = lane & 15, fq = lane >> 4;
    const int K = g.K, nt = K / BK;
    unsigned voffA[2], voffB[2];
#pragma unroll
    for (int i = 0; i < 2; ++i) { int R, C; stage_rc(tid * 16 + i * 8192, R, C); const int Rb = Epi::PERM ? ((R & ~31) + perm32(R & 31)) : R;
        voffA[i] = (unsigned)(R * K + C) * 2u; voffB[i] = (unsigned)(Rb * K + C) * 2u; }
    const size_t kstep = (size_t)(BK * 2);
    const size_t hstep = (size_t)HALF * K * 2;
    const size_t tstep = 2 * hstep;
    const size_t hstepB = (size_t)g.bhalf * K * 2;
    const size_t rowB = (size_t)K * 2;
    const unsigned ldsw = (unsigned)wid * 1024u;
    const int aoff = lds_byte(wr * 64 + fr, fq * 8), boff = lds_byte(wc * 32 + fr, fq * 8);
#define PG8_SA(b, h) (((b) * 2 + (h)) * HTB)
#define PG8_SB(b, h) ((4 + (b) * 2 + (h)) * HTB)
#define PG8_STAGE(bufoff, gbase, voff) do { _Pragma("unroll") for (int _i = 0; _i < 2; ++_i) \
        __builtin_amdgcn_global_load_lds((const unsigned*)((const char*)(gbase) + (voff)[_i]), (PG8_LAS unsigned*)(lds + (bufoff) + ldsw + _i * 8192), 16, 0, 0); } while (0)
#define PG8_LDA(dst, b, h) do { _Pragma("unroll") for (int m = 0; m < 4; ++m) _Pragma("unroll") for (int k = 0; k < 2; ++k) dst[m][k] = *(const PG8_LAS bf16x8*)(lds + PG8_SA(b, h) + aoff + m * 2048 + k * 1024); } while (0)
#define PG8_LDB(dst, b, h) do { _Pragma("unroll") for (int n = 0; n < 2; ++n) _Pragma("unroll") for (int k = 0; k < 2; ++k) dst[n][k] = *(const PG8_LAS bf16x8*)(lds + PG8_SB(b, h) + boff + n * 2048 + k * 1024); } while (0)
#define PG8_MMA(ai, bj, At, Bt) do { __builtin_amdgcn_s_setprio(1); _Pragma("unroll") for (int m = 0; m < 4; ++m) _Pragma("unroll") for (int n = 0; n < 2; ++n) _Pragma("unroll") for (int k = 0; k < 2; ++k) \
        acc[ai][bj][m][n] = __builtin_amdgcn_mfma_f32_16x16x32_bf16(Bt[n][k], At[m][k], acc[ai][bj][m][n], 0, 0, 0); __builtin_amdgcn_s_setprio(0); } while (0)
#define PG8_WAIT_V(n) asm volatile("s_waitcnt vmcnt(" #n ")" ::: "memory")
#define PG8_WAIT_L(n) asm volatile("s_waitcnt lgkmcnt(" #n ")" ::: "memory")
#define PG8_BAR __builtin_amdgcn_s_barrier()
#define PG8_SCHED __builtin_amdgcn_sched_barrier(0)
    Unit cur, nxt; int ui = 0;
    if (!S.next(0, cur)) return;
    f32x4 acc[2][2][4][2];
#pragma unroll
    for (int a = 0; a < 2; ++a)
#pragma unroll
        for (int b = 0; b < 2; ++b)
#pragma unroll
            for (int m = 0; m < 4; ++m)
#pragma unroll
                for (int n = 0; n < 2; ++n) acc[a][b][m][n] = (f32x4){0.f, 0.f, 0.f, 0.f};
    bf16x8 At[4][2], B0[2][2], B1[2][2];
    const char* cA = (const char*)g.A + (size_t)cur.pm * tstep; const char* cB = (const char*)g.Bt + (size_t)cur.brow * rowB;
    S.a_ready(cur);
    PG8_STAGE(PG8_SB(0, 0), cB, voffB); PG8_STAGE(PG8_SA(0, 0), cA, voffA); PG8_STAGE(PG8_SB(0, 1), cB + hstepB, voffB); PG8_STAGE(PG8_SA(0, 1), cA + hstep, voffA);
    if (wr == 1) PG8_BAR;
    PG8_WAIT_V(4); PG8_BAR;
    PG8_STAGE(PG8_SB(1, 0), cB + kstep, voffB); PG8_STAGE(PG8_SA(1, 0), cA + kstep, voffA); PG8_STAGE(PG8_SB(1, 1), cB + hstepB + kstep, voffB);
    PG8_WAIT_V(6); PG8_BAR;
    for (;;) {
        const bool has_next = S.next(ui + 1, nxt);
        const char* nA = has_next ? (const char*)g.A + (size_t)nxt.pm * tstep : cA; const char* nB = has_next ? (const char*)g.Bt + (size_t)nxt.brow * rowB : cB;
        for (int t = 0; t < nt; t += 2) {
            const bool last = (t == nt - 2);
            const char* a1 = cA + (size_t)(t + 1) * kstep;
            const char* a2 = last ? nA : cA + (size_t)(t + 2) * kstep; const char* b2 = last ? nB : cB + (size_t)(t + 2) * kstep;
            const char* a3 = a2 + kstep; const char* b3 = b2 + kstep;
            if (last && has_next) S.a_ready(nxt);
            PG8_LDB(B0, 0, 0); PG8_SCHED; PG8_LDA(At, 0, 0); PG8_STAGE(PG8_SA(1, 1), a1 + hstep, voffA);
            PG8_WAIT_L(8); PG8_BAR; PG8_WAIT_L(0); PG8_MMA(0, 0, At, B0); PG8_BAR; PG8_SCHED;
            PG8_LDB(B1, 0, 1); PG8_STAGE(PG8_SB(0, 0), b2, voffB);
            PG8_BAR; PG8_WAIT_L(0); PG8_MMA(0, 1, At, B1); PG8_BAR;
            PG8_LDA(At, 0, 1); PG8_STAGE(PG8_SA(0, 0), a2, voffA);
            PG8_BAR; PG8_WAIT_L(0); PG8_MMA(1, 0, At, B0); PG8_BAR; PG8_SCHED;
            PG8_STAGE(PG8_SB(0, 1), b2 + hstepB, voffB);
            PG8_WAIT_V(6); PG8_BAR; PG8_MMA(1, 1, At, B1); PG8_BAR;
            PG8_LDB(B0, 1, 0); PG8_SCHED; PG8_LDA(At, 1, 0); PG8_STAGE(PG8_SA(0, 1), a2 + hstep, voffA);
            PG8_WAIT_L(8); PG8_BAR; PG8_WAIT_L(0); PG8_MMA(0, 0, At, B0); PG8_BAR; PG8_SCHED;
            PG8_LDB(B1, 1, 1); PG8_STAGE(PG8_SB(1, 0), b3, voffB);
            PG8_BAR; PG8_WAIT_L(0); PG8_MMA(0, 1, At, B1); PG8_BAR;
            PG8_LDA(At, 1, 1); PG8_STAGE(PG8_SA(1, 0), a3, voffA);
            PG8_BAR; PG8_WAIT_L(0); PG8_MMA(1, 0, At, B0); PG8_BAR; PG8_SCHED;
            PG8_STAGE(PG8_SB(1, 1), b3 + hstepB, voffB);
            PG8_WAIT_V(6); PG8_BAR; PG8_MMA(1, 1, At, B1); PG8_BAR;
        }
        if constexpr (!Epi::AFTER_DRAIN) { E(acc, cur, wr, wc, fr, fq); S.done(cur); }
        if (!has_next) break;
#pragma unroll
        for (int a = 0; a < 2; ++a)
#pragma unroll
            for (int b = 0; b < 2; ++b)
#pragma unroll
                for (int m = 0; m < 4; ++m)
#pragma unroll
                    for (int n = 0; n < 2; ++n) acc[a][b][m][n] = (f32x4){0.f, 0.f, 0.f, 0.f};
        cur = nxt; cA = nA; cB = nB; ++ui;
    }
    PG8_WAIT_V(0);
    if (wr == 0) PG8_BAR;
    PG8_BAR;
    if constexpr (Epi::AFTER_DRAIN) { E.fused(acc, cur, wr, wc, fr, fq, lds, wid, lane); S.done(cur); }
#undef PG8_SA
#undef PG8_SB
#undef PG8_STAGE
#undef PG8_LDA
#undef PG8_LDB
#undef PG8_MMA
#undef PG8_WAIT_V
#undef PG8_WAIT_L
#undef PG8_BAR
#undef PG8_SCHED
}

}

DI void phase_p1(const Params& p, char* smem) {
    const int tid = threadIdx.x, wid = tid >> 6, lane = tid & 63, fr = lane & 15, fq = lane >> 4, wr = wid >> 1, wc = wid & 1;
    unsigned char* ws = p.ws;
    const bf16_t* hb = (const bf16_t*)(ws + OFF_H);
    const bf16_t* wt = (const bf16_t*)(ws + OFF_WIN);
    const f32x2* tab = (const f32x2*)(ws + OFF_ROPE);
    bf16_t* qb = (bf16_t*)(ws + OFF_Q); bf16_t* kb = (bf16_t*)(ws + OFF_KB); bf16_t* vT = (bf16_t*)(ws + OFF_VT);
    bf16_t* zr = (bf16_t*)(p.out + OUT_Y);
    const int MT = M / 256, NT = 21;
    for (int t = blockIdx.x; t < MT * NT; t += gridDim.x) {
        int mt, nt; tile_coords(t, MT, NT, mt, nt);
        const int row0 = mt * 256, ncol0 = nt < 6 ? nt * 128 : 2816 + (nt - 6) * 128;
        f32x4 acc[4][4]; zero_acc<4>(acc);
        gemm_acc<4>(acc, hb + (size_t)row0 * 1024, 1024, wt + (size_t)ncol0 * 1024, 1024, 1024, smem, tid);
        const bool latent = row0 >= MC;
#pragma unroll
        for (int mb = 0; mb < 4; ++mb) {
            const int m = row0 + wr * 64 + mb * 16 + fr;
            if (nt < 5 && latent) {
                const int tt = (m - MC) & 2047, prow = tt >> 6, pcol = tt & 63;
#pragma unroll
                for (int j = 0; j < 4; ++j) {
                    const f32x2 cr = tab[prow * 16 + fq * 4 + j], cc = tab[pcol * 16 + fq * 4 + j];
                    const float a1 = acc[mb][0][j], a2 = acc[mb][1][j], b1 = acc[mb][2][j], b2 = acc[mb][3][j];
                    acc[mb][0][j] = a1 * cr.x - a2 * cr.y; acc[mb][1][j] = a2 * cr.x + a1 * cr.y;
                    acc[mb][2][j] = b1 * cc.x - b2 * cc.y; acc[mb][3][j] = b2 * cc.x + b1 * cc.y;
                }
            }
#pragma unroll
            for (int nb = 0; nb < 4; ++nb) {
                const int nl = wc * 64 + nb * 16 + fq * 4;
                const f32x4 v = acc[mb][nb];
                if (nt < 4) { *(u32x2*)(qb + (size_t)m * 512 + nt * 128 + nl) = pack4(v); }
                else if (nt == 4) {
                    if (!latent) *(f32x4*)(p.out + OUT_K + (size_t)m * 128 + nl) = v;
                    *(u32x2*)(kb + (size_t)m * 128 + nl) = pack4(v);
                } else if (nt == 5) {
                    if (!latent) *(f32x4*)(p.out + OUT_V + (size_t)m * 128 + nl) = v;
                    int r0, T; seq_of(m, r0, T);
#pragma unroll
                    for (int j = 0; j < 4; ++j) vT[(size_t)r0 * 128 + (size_t)(nl + j) * T + (m - r0)] = f2bf(v[j]);
                } else { *(u32x2*)(zr + (size_t)m * ZRC + (nt - 6) * 128 + nl) = pack4(v); }
            }
        }
    }
}

#define MFMA32(a, b, c) __builtin_amdgcn_mfma_f32_32x32x16_bf16((a), (b), (c), 0, 0, 0)
DI int crow(int i, int h) { return (i & 3) + 8 * (i >> 2) + 4 * h; }

DI void attn_item(const Params& p, char* smem, int it) {
    const int tid = threadIdx.x, wv = tid >> 6, lane = tid & 63, r = lane & 31, hh = lane >> 5;
    unsigned char* ws = p.ws;
    const bf16_t* qb = (const bf16_t*)(ws + OFF_Q); const bf16_t* kb = (const bf16_t*)(ws + OFF_KB); const bf16_t* vT = (const bf16_t*)(ws + OFF_VT);
    const bf16_t* kc = (const bf16_t*)(ws + OFF_KC); const bf16_t* vct = (const bf16_t*)(ws + OFF_VCT);
    bf16_t* ab = (bf16_t*)(ws + OFF_ATTN);
    bf16_t* Ks = (bf16_t*)smem;
    bf16_t* Vt = (bf16_t*)(smem + 9216);
    const float SC = 0.125f * LOG2E;
    {
        int r0, T, q0, kvh, bl;
        const bool lat = it < 512;
        if (lat) { bl = it >> 6; const int rem = it & 63; q0 = (rem >> 1) * 64; kvh = rem & 1; r0 = MC + bl * 2048; T = 2048; }
        else { const int i2 = it - 512; bl = 0; const int s = i2 >> 3, rem = i2 & 7; q0 = (rem >> 1) * 64; kvh = rem & 1; r0 = s * 256; T = 256; }
        const int head = kvh * 4 + (wv & 3), sub = wv >> 2, qs = q0 + 32 * sub;
        bf16x8 qf[4];
#pragma unroll
        for (int kk = 0; kk < 4; ++kk) qf[kk] = *(const bf16x8*)(qb + (size_t)(r0 + qs + r) * 512 + head * 64 + 16 * kk + 8 * hh);
        const float sinkl = p.attn_sink[head] * LOG2E;
        float mrun = sinkl, lrun = hh == 0 ? 1.0f : 0.0f;
        f32x16 o0, o1;
#pragma unroll
        for (int i = 0; i < 16; ++i) { o0[i] = 0.f; o1[i] = 0.f; }
        const int nwin = lat ? 5 : 4, ntile = lat ? 13 : 4;
        for (int ti = 0; ti < ntile; ++ti) {
            const bf16_t* ksrc; const bf16_t* vsrc; int vstride, ks0; bool window;
            if (ti < nwin) {
                ks0 = lat ? q0 - 128 + 64 * ti : 64 * ti; window = lat;
                if (ks0 < 0 || ks0 >= T) continue;
                ksrc = kb + (size_t)(r0 + ks0) * 128 + kvh * 64; vsrc = vT + (size_t)r0 * 128 + (size_t)(kvh * 64) * T + ks0; vstride = T;
            } else {
                ks0 = 64 * (ti - nwin); window = false;
                ksrc = kc + (size_t)(bl * 512 + ks0) * 128 + kvh * 64; vsrc = vct + (size_t)((bl * 2 + kvh) * 64) * 512 + ks0; vstride = 512;
            }
            __syncthreads();
            {
                const int rw_ = tid >> 3, ch = tid & 7;
                *(u32x4*)(Ks + rw_ * 72 + ch * 8) = *(const u32x4*)(ksrc + (size_t)rw_ * 128 + ch * 8);
                *(u32x4*)(Vt + rw_ * 72 + ch * 8) = *(const u32x4*)(vsrc + (size_t)rw_ * vstride + ch * 8);
            }
            __syncthreads();
#pragma unroll
            for (int sk = 0; sk < 2; ++sk) {
                const int kb0 = ks0 + 32 * sk;
                bool need_mask = false;
                if (window) {
                    if (kb0 > qs + 31 + 128 || kb0 + 31 < qs - 128) continue;
                    need_mask = (kb0 < qs + 31 - 128) || (kb0 + 31 > qs + 128);
                }
                f32x16 x;
#pragma unroll
                for (int i = 0; i < 16; ++i) x[i] = 0.f;
#pragma unroll
                for (int kk = 0; kk < 4; ++kk) {
                    const bf16x8 kf = *(const bf16x8*)(Ks + (32 * sk + r) * 72 + 16 * kk + 8 * hh);
                    x = MFMA32(kf, qf[kk], x);
                }
                float mx = -3.0e38f;
#pragma unroll
                for (int i = 0; i < 16; ++i) {
                    float s = x[i] * SC;
                    if (need_mask) { const int dk = kb0 + crow(i, hh) - (qs + r); if (dk > 128 || dk < -128) s = -3.0e38f; }
                    x[i] = s; mx = fmaxf(mx, s);
                }
                mx = fmaxf(mx, __shfl_xor(mx, 32));
                const float mnew = fmaxf(mrun, mx), alpha = exp2f(mrun - mnew);
                mrun = mnew;
                float ps = 0.f;
#pragma unroll
                for (int i = 0; i < 16; ++i) { const float pv = exp2f(x[i] - mnew); x[i] = pv; ps += pv; }
                lrun = lrun * alpha + ps;
#pragma unroll
                for (int i = 0; i < 16; ++i) { o0[i] *= alpha; o1[i] *= alpha; }
#pragma unroll
                for (int s = 0; s < 2; ++s) {
                    u32x4 pk;
                    pk[0] = pack2(x[8 * s + 0], x[8 * s + 1]); pk[1] = pack2(x[8 * s + 2], x[8 * s + 3]);
                    pk[2] = pack2(x[8 * s + 4], x[8 * s + 5]); pk[3] = pack2(x[8 * s + 6], x[8 * s + 7]);
                    const bf16x8 pf = __builtin_bit_cast(bf16x8, pk);
                    {
                        const s16x4 lo = *(const s16x4*)(Vt + r * 72 + 32 * sk + 16 * s + 4 * hh);
                        const s16x4 hi = *(const s16x4*)(Vt + r * 72 + 32 * sk + 16 * s + 8 + 4 * hh);
                        const bf16x8 vf = __builtin_shufflevector(lo, hi, 0, 1, 2, 3, 4, 5, 6, 7);
                        o0 = MFMA32(vf, pf, o0);
                    }
                    {
                        const s16x4 lo = *(const s16x4*)(Vt + (32 + r) * 72 + 32 * sk + 16 * s + 4 * hh);
                        const s16x4 hi = *(const s16x4*)(Vt + (32 + r) * 72 + 32 * sk + 16 * s + 8 + 4 * hh);
                        const bf16x8 vf = __builtin_shufflevector(lo, hi, 0, 1, 2, 3, 4, 5, 6, 7);
                        o1 = MFMA32(vf, pf, o1);
                    }
                }
            }
        }
        const float ltot = lrun + __shfl_xor(lrun, 32), inv = rcpf_(ltot);
        bf16_t* orow = ab + (size_t)(r0 + qs + r) * 512 + head * 64;
#pragma unroll
        for (int g = 0; g < 4; ++g) {
            f32x4 a, b;
#pragma unroll
            for (int j = 0; j < 4; ++j) { a[j] = o0[4 * g + j] * inv; b[j] = o1[4 * g + j] * inv; }
            *(u32x2*)(orow + 8 * g + 4 * hh) = pack4(a);
            *(u32x2*)(orow + 32 + 8 * g + 4 * hh) = pack4(b);
        }
    }
    __syncthreads();
}

DI void sg_pass(const Params& p) {
    const int tid = threadIdx.x;
    unsigned char* ws = p.ws;
    {
        const bf16_t* zr = (const bf16_t*)(p.out + OUT_Y);
        bf16_t* sg = (bf16_t*)(ws + OFF_SG);
        const float* mu0 = p.rwkv_mu; const float* mu1 = p.rwkv_mu + ZRC;
        for (int i = blockIdx.x * NTHR + tid; i < M * 32; i += gridDim.x * NTHR) {
            const int m = i >> 5, c = (i & 31) * 4;
            int r0, T; seq_of(m, r0, T);
            const bf16_t* zp = zr + (size_t)m * ZRC + 1792 + c;
            const f32x4 z = unpack4(*(const u32x2*)zp);
            f32x4 zprev = (f32x4){0.f, 0.f, 0.f, 0.f}, znext = zprev;
            if (m > r0) zprev = unpack4(*(const u32x2*)(zp - ZRC));
            if (m < r0 + T - 1) znext = unpack4(*(const u32x2*)(zp + ZRC));
            const f32x4 a0 = *(const f32x4*)(mu0 + 1792 + c), a1 = *(const f32x4*)(mu1 + 1792 + c);
            f32x4 o;
#pragma unroll
            for (int j = 0; j < 4; ++j) { const float zs = z[j] + a0[j] * (zprev[j] - z[j]) + a1[j] * (znext[j] - z[j]); o[j] = sigmoidf_(zs); }
            *(u32x2*)(sg + (size_t)m * 128 + c) = pack4(o);
        }
    }
}


template <int CTRL> DI float dpp_f(float x) { return __builtin_bit_cast(float, __builtin_amdgcn_mov_dpp(__builtin_bit_cast(int, x), CTRL, 0xf, 0xf, true)); }
DI float swap32_sum(float x) {
    float a = x, b = x;
    asm volatile("s_nop 1\n\tv_permlane32_swap_b32 %0, %1\n\ts_nop 1" : "+v"(a), "+v"(b));
    return a + b;
}
DI float row16_allsum(float x) { x += dpp_f<0x128>(x); x += dpp_f<0x124>(x); x += dpp_f<0x122>(x); x += dpp_f<0x121>(x); return x; }
template <int E> DI float qbc(f32x2 v) { return dpp_f<(E >> 1) * 0x55>((E & 1) ? v.y : v.x); }

#define QP0 " quad_perm:[0,0,0,0] row_mask:0xf bank_mask:0xf bound_ctrl:1\n\t"
#define QP1 " quad_perm:[1,1,1,1] row_mask:0xf bank_mask:0xf bound_ctrl:1\n\t"
#define QP2 " quad_perm:[2,2,2,2] row_mask:0xf bank_mask:0xf bound_ctrl:1\n\t"
#define QP3 " quad_perm:[3,3,3,3] row_mask:0xf bank_mask:0xf bound_ctrl:1\n\t"
#define ROR4 " row_ror:4 row_mask:0xf bank_mask:0xf bound_ctrl:1\n\t"
#define ROR8 " row_ror:8 row_mask:0xf bank_mask:0xf bound_ctrl:1\n\t"
DI float scan_sa(const float (&S)[8], f32x2 A) {
    float sa, t1, t2, t3;
    asm volatile(
        "s_nop 1\n\t"
        "v_mul_f32_dpp %0, %12, %4" QP0
        "v_mul_f32_dpp %1, %13, %5" QP0
        "v_mul_f32_dpp %2, %12, %6" QP1
        "v_mul_f32_dpp %3, %13, %7" QP1
        "v_fmac_f32_dpp %0, %12, %8" QP2
        "v_fmac_f32_dpp %1, %13, %9" QP2
        "v_fmac_f32_dpp %2, %12, %10" QP3
        "v_fmac_f32_dpp %3, %13, %11" QP3
        "v_add_f32 %0, %0, %1\n\t"
        "v_add_f32 %2, %2, %3\n\t"
        "v_add_f32 %0, %0, %2\n\t"
        "s_nop 1\n\t"
        "v_add_f32_dpp %0, %0, %0" ROR4
        "s_nop 1\n\t"
        "v_add_f32_dpp %0, %0, %0" ROR8
        "v_mov_b32 %1, %0\n\t"
        "s_nop 1\n\t"
        "v_permlane32_swap_b32 %0, %1\n\t"
        "s_nop 1\n\t"
        "v_add_f32 %0, %0, %1"
        : "=&v"(sa), "=&v"(t1), "=&v"(t2), "=&v"(t3)
        : "v"(S[0]), "v"(S[1]), "v"(S[2]), "v"(S[3]), "v"(S[4]), "v"(S[5]), "v"(S[6]), "v"(S[7]), "v"(A.x), "v"(A.y));
    return sa;
}
DI float scan_upd(float (&S)[8], float sa, float vv, f32x2 B, f32x2 K, f32x2 W, f32x2 R) {
    float n0, n1, n2, n3, n4, n5, n6, n7, y0, y1, y2, y3;
    asm volatile(
        "s_nop 1\n\t"
        "v_mul_f32_dpp %0, %22, %20" QP0  "v_mul_f32_dpp %1, %23, %20" QP0  "v_mul_f32_dpp %2, %22, %20" QP1  "v_mul_f32_dpp %3, %23, %20" QP1
        "v_mul_f32_dpp %4, %22, %20" QP2  "v_mul_f32_dpp %5, %23, %20" QP2  "v_mul_f32_dpp %6, %22, %20" QP3  "v_mul_f32_dpp %7, %23, %20" QP3
        "v_fmac_f32_dpp %0, %24, %21" QP0  "v_fmac_f32_dpp %1, %25, %21" QP0  "v_fmac_f32_dpp %2, %24, %21" QP1  "v_fmac_f32_dpp %3, %25, %21" QP1
        "v_fmac_f32_dpp %4, %24, %21" QP2  "v_fmac_f32_dpp %5, %25, %21" QP2  "v_fmac_f32_dpp %6, %24, %21" QP3  "v_fmac_f32_dpp %7, %25, %21" QP3
        "v_fmac_f32_dpp %0, %26, %12" QP0  "v_fmac_f32_dpp %1, %27, %13" QP0  "v_fmac_f32_dpp %2, %26, %14" QP1  "v_fmac_f32_dpp %3, %27, %15" QP1
        "v_fmac_f32_dpp %4, %26, %16" QP2  "v_fmac_f32_dpp %5, %27, %17" QP2  "v_fmac_f32_dpp %6, %26, %18" QP3  "v_fmac_f32_dpp %7, %27, %19" QP3
        "v_mul_f32_dpp %8, %28, %0" QP0   "v_mul_f32_dpp %9, %29, %1" QP0   "v_mul_f32_dpp %10, %28, %2" QP1  "v_mul_f32_dpp %11, %29, %3" QP1
        "v_fmac_f32_dpp %8, %28, %4" QP2  "v_fmac_f32_dpp %9, %29, %5" QP2  "v_fmac_f32_dpp %10, %28, %6" QP3 "v_fmac_f32_dpp %11, %29, %7" QP3
        "v_add_f32 %8, %8, %9\n\t"
        "v_add_f32 %10, %10, %11\n\t"
        "v_add_f32 %8, %8, %10\n\t"
        "s_nop 1\n\t"
        "v_add_f32_dpp %8, %8, %8" ROR4
        "s_nop 1\n\t"
        "v_add_f32_dpp %8, %8, %8" ROR8
        "v_mov_b32 %9, %8\n\t"
        "s_nop 1\n\t"
        "v_permlane32_swap_b32 %8, %9\n\t"
        "s_nop 1\n\t"
        "v_add_f32 %8, %8, %9"
        : "=&v"(n0), "=&v"(n1), "=&v"(n2), "=&v"(n3), "=&v"(n4), "=&v"(n5), "=&v"(n6), "=&v"(n7), "=&v"(y0), "=&v"(y1), "=&v"(y2), "=&v"(y3)
        : "v"(S[0]), "v"(S[1]), "v"(S[2]), "v"(S[3]), "v"(S[4]), "v"(S[5]), "v"(S[6]), "v"(S[7]), "v"(sa), "v"(vv),
          "v"(B.x), "v"(B.y), "v"(K.x), "v"(K.y), "v"(W.x), "v"(W.y), "v"(R.x), "v"(R.y));
    S[0] = n0; S[1] = n1; S[2] = n2; S[3] = n3; S[4] = n4; S[5] = n5; S[6] = n6; S[7] = n7;
    return y0;
}

constexpr int SC_OPW = 0, SC_OPK = 8192, SC_OPA = 16384, SC_OPB = 24576, SC_OPR = 32768, SC_OPV = 40960;
constexpr int SC_AW = 49152, SC_AA = SC_AW + 32 * 144;
constexpr int SC_LO = SC_AA + 32 * 144;
constexpr int SC_YB = SC_LO + 2 * 32 * 68 * 4;
static_assert(SC_YB + 8192 <= LDS_MAIN, "scan LDS");

DI void lds_barrier() { asm volatile("s_waitcnt lgkmcnt(0)\n\ts_barrier" ::: "memory"); }

constexpr int S2_OP = 0;
constexpr int S2_AW = 49152, S2_AA = S2_AW + 2304;
constexpr int S2_LO = S2_AA + 2304;
constexpr int S2_YB = S2_LO + 8704;
static_assert(S2_YB + 8192 <= LDS_MAIN, "scan LDS");

DI void scan_item(const Params& p, char* smem, int r0, int T, int dsel, int h, const float* state0, float* state_out) {
    const int tid = threadIdx.x, wv = tid >> 6, lane = tid & 63;
    const bool is_scan = wv < 4;
    unsigned char* ws = p.ws;
    const bf16_t* zr = (const bf16_t*)(p.out + OUT_Y);
    float* ys = (float*)(ws + OFF_YS) + (size_t)dsel * M * 512;
    float* bn = (float*)(ws + OFF_BN);
    float* op = (float*)(smem + S2_OP);
    bf16_t* Aw = (bf16_t*)(smem + S2_AW); bf16_t* Aa = (bf16_t*)(smem + S2_AA);
    float* Lo = (float*)(smem + S2_LO); float* yb = (float*)(smem + S2_YB);
    const int nchunk = T >> 4;

    const int rr = (lane & 3) | ((lane >> 4) << 2), jq = (lane >> 2) & 3, irow = 16 * (wv & 3) + rr, jb = 16 * jq;
    f32x4 S0, S1, S2, S3;
    if (state0 && is_scan) {
        const float* sp = state0 + irow * 64 + jb;
        S0 = *(const f32x4*)sp; S1 = *(const f32x4*)(sp + 4); S2 = *(const f32x4*)(sp + 8); S3 = *(const f32x4*)(sp + 12);
    } else { S0 = (f32x4){0.f, 0.f, 0.f, 0.f}; S1 = S0; S2 = S0; S3 = S0; }

    const int ptid = tid & 255, tt = ptid >> 4, cg4 = (ptid & 15) * 4;
    const int segc[5] = {h * 64 + cg4, 512 + h * 64 + cg4, 1024 + h * 64 + cg4, 1536 + dsel * 64 + cg4, 1664 + dsel * 64 + cg4};
    const int pL = (wv >> 1) & 1, pnh = wv & 1, fr = lane & 15, fq = lane >> 4;
    const bf16_t* wt = (const bf16_t*)(ws + (pL == 0 ? OFF_W2T : OFF_A2T)) + (size_t)(dsel * 512 + h * 64) * 64;
    u32x2 zc[5], zp[5], zn[5];
    f32x4 kreg, kkreg, rreg;
    auto load_chunk = [&](int c) {
        const int st = 16 * c + tt, tok = dsel ? T - 1 - st : st;
        const bf16_t* base = zr + (size_t)(r0 + tok) * ZRC;
#pragma unroll
        for (int s = 0; s < 5; ++s) {
            zc[s] = *(const u32x2*)(base + segc[s]);
            zp[s] = (u32x2){0u, 0u}; zn[s] = (u32x2){0u, 0u};
            if (tok > 0) zp[s] = *(const u32x2*)(base - ZRC + segc[s]);
            if (tok < T - 1) zn[s] = *(const u32x2*)(base + ZRC + segc[s]);
        }
    };
    auto prodA = [&](int buf) {
        f32x4 zs[5];
#pragma unroll
        for (int s = 0; s < 5; ++s) {
            const f32x4 mu0 = *(const f32x4*)(p.rwkv_mu + segc[s]), mu1 = *(const f32x4*)(p.rwkv_mu + ZRC + segc[s]);
            const f32x4 z = unpack4(zc[s]), a = unpack4(zp[s]), b = unpack4(zn[s]);
            zs[s] = z + mu0 * (a - z) + mu1 * (b - z);
        }
        const f32x4 kkv = *(const f32x4*)(p.rwkv_k_k + h * 64 + cg4);
        f32x4 kk = zs[1] * kkv;
        float n2 = kk[0] * kk[0] + kk[1] * kk[1] + kk[2] * kk[2] + kk[3] * kk[3];
        n2 = row16_allsum(n2);
        kk = kk * __builtin_amdgcn_rsqf(fmaxf(n2, 1e-24f));
        f32x4 tw;
#pragma unroll
        for (int j = 0; j < 4; ++j) tw[j] = 1.0f - 2.0f * rcpf_(1.0f + __expf(2.0f * zs[3][j]));
        *(u32x2*)(Aw + tt * 72 + cg4) = pack4(tw);
        *(u32x2*)(Aa + tt * 72 + cg4) = pack4(zs[4]);
        float* ob = op + buf * 6144 + tt * 64 + cg4;
        *(f32x4*)(ob + 4 * 1024) = zs[0];
        *(f32x4*)(ob + 5 * 1024) = zs[2];
        *(f32x4*)(ob + 2 * 1024) = -kk;
        kreg = zs[1]; kkreg = kk; rreg = zs[0];
    };
    auto prodB = [&]() {
        const bf16_t* As = pL == 0 ? Aw : Aa;
        const bf16x8 a0 = *(const bf16x8*)(As + fr * 72 + fq * 8), a1 = *(const bf16x8*)(As + fr * 72 + 32 + fq * 8);
#pragma unroll
        for (int n2 = 0; n2 < 2; ++n2) {
            f32x4 x = (f32x4){0.f, 0.f, 0.f, 0.f};
            const bf16_t* wr_ = wt + (size_t)((pnh * 2 + n2) * 16 + fr) * 64 + fq * 8;
            x = __builtin_amdgcn_mfma_f32_16x16x32_bf16(a0, *(const bf16x8*)wr_, x, 0, 0, 0);
            x = __builtin_amdgcn_mfma_f32_16x16x32_bf16(a1, *(const bf16x8*)(wr_ + 32), x, 0, 0, 0);
#pragma unroll
            for (int j = 0; j < 4; ++j) Lo[(pL * 16 + fq * 4 + j) * 68 + (pnh * 2 + n2) * 16 + fr] = x[j];
        }
    };
    auto prodC = [&](int c, int buf) {
        const int st = 16 * c + tt, tok = dsel ? T - 1 - st : st, m = r0 + tok;
        const f32x4 w0v = *(const f32x4*)(p.rwkv_w0 + dsel * 512 + h * 64 + cg4), a0v = *(const f32x4*)(p.rwkv_a0 + dsel * 512 + h * 64 + cg4);
        const f32x4 kav = *(const f32x4*)(p.rwkv_k_a + h * 64 + cg4), rkv = *(const f32x4*)(p.rwkv_r_k + h * 64 + cg4);
        const f32x4 lw = *(const f32x4*)(Lo + tt * 68 + cg4), la = *(const f32x4*)(Lo + (16 + tt) * 68 + cg4);
        f32x4 wd, kd, bb; float bs = 0.f;
#pragma unroll
        for (int j = 0; j < 4; ++j) {
            wd[j] = __expf(-0.6065306597126334f * sigmoidf_(w0v[j] + lw[j]));
            const float a = sigmoidf_(a0v[j] + la[j]);
            kd[j] = kreg[j] * (1.0f + (a - 1.0f) * kav[j]);
            bb[j] = a * kkreg[j];
            bs += rreg[j] * kd[j] * rkv[j];
        }
        float* ob = op + buf * 6144 + tt * 64 + cg4;
        *(f32x4*)(ob) = wd;
        *(f32x4*)(ob + 1024) = kd;
        *(f32x4*)(ob + 3 * 1024) = bb;
        bs = row16_allsum(bs);
        if ((ptid & 15) == 0) bn[(size_t)m * 16 + dsel * 8 + h] = bs;
    };
    auto flush_ys = [&](int c) {
        const int st = 16 * c + tt, tok = dsel ? T - 1 - st : st, m = r0 + tok;
        *(f32x4*)(ys + (size_t)m * 512 + h * 64 + cg4) = *(const f32x4*)(yb + (c & 1) * 1024 + tt * 64 + cg4);
    };
    auto chunk_steps = [&](int buf) {
        const float* ob = op + buf * 6144 + jb;
        const float* ov = op + buf * 6144 + 5 * 1024 + irow;
        float* yo = yb + buf * 1024 + irow;
        f32x4 W0 = *(const f32x4*)(ob), W1 = *(const f32x4*)(ob + 4), W2 = *(const f32x4*)(ob + 8), W3 = *(const f32x4*)(ob + 12);
        f32x4 K0 = *(const f32x4*)(ob + 1024), K1 = *(const f32x4*)(ob + 1028), K2 = *(const f32x4*)(ob + 1032), K3 = *(const f32x4*)(ob + 1036);
        f32x4 A0 = *(const f32x4*)(ob + 2048), A1 = *(const f32x4*)(ob + 2052), A2 = *(const f32x4*)(ob + 2056), A3 = *(const f32x4*)(ob + 2060);
        f32x4 B0 = *(const f32x4*)(ob + 3072), B1 = *(const f32x4*)(ob + 3076), B2 = *(const f32x4*)(ob + 3080), B3 = *(const f32x4*)(ob + 3084);
        f32x4 R0 = *(const f32x4*)(ob + 4096), R1 = *(const f32x4*)(ob + 4100), R2 = *(const f32x4*)(ob + 4104), R3 = *(const f32x4*)(ob + 4108);
        float vv = ov[0];
#pragma unroll 2
        for (int s = 0; s < 16; ++s) {
            const float* o = ob + ((s + 1) & 15) * 64;
            const f32x4 W0n = *(const f32x4*)(o), W1n = *(const f32x4*)(o + 4), W2n = *(const f32x4*)(o + 8), W3n = *(const f32x4*)(o + 12);
            const f32x4 K0n = *(const f32x4*)(o + 1024), K1n = *(const f32x4*)(o + 1028), K2n = *(const f32x4*)(o + 1032), K3n = *(const f32x4*)(o + 1036);
            const f32x4 A0n = *(const f32x4*)(o + 2048), A1n = *(const f32x4*)(o + 2052), A2n = *(const f32x4*)(o + 2056), A3n = *(const f32x4*)(o + 2060);
            const f32x4 B0n = *(const f32x4*)(o + 3072), B1n = *(const f32x4*)(o + 3076), B2n = *(const f32x4*)(o + 3080), B3n = *(const f32x4*)(o + 3084);
            const f32x4 R0n = *(const f32x4*)(o + 4096), R1n = *(const f32x4*)(o + 4100), R2n = *(const f32x4*)(o + 4104), R3n = *(const f32x4*)(o + 4108);
            const float vn = ov[((s + 1) & 15) * 64];
            const f32x4 pa = (S0 * A0 + S1 * A1) + (S2 * A2 + S3 * A3);
            float sa = (pa[0] + pa[1]) + (pa[2] + pa[3]);
            sa += dpp_f<0x124>(sa); sa += dpp_f<0x128>(sa);
            S0 = S0 * W0 + (B0 * sa + K0 * vv);
            S1 = S1 * W1 + (B1 * sa + K1 * vv);
            S2 = S2 * W2 + (B2 * sa + K2 * vv);
            S3 = S3 * W3 + (B3 * sa + K3 * vv);
            const f32x4 py = (S0 * R0 + S1 * R1) + (S2 * R2 + S3 * R3);
            float y = (py[0] + py[1]) + (py[2] + py[3]);
            y += dpp_f<0x124>(y); y += dpp_f<0x128>(y);
            if (jq == 0) yo[s * 64] = y;
            W0 = W0n; W1 = W1n; W2 = W2n; W3 = W3n; K0 = K0n; K1 = K1n; K2 = K2n; K3 = K3n; A0 = A0n; A1 = A1n; A2 = A2n; A3 = A3n;
            B0 = B0n; B1 = B1n; B2 = B2n; B3 = B3n; R0 = R0n; R1 = R1n; R2 = R2n; R3 = R3n; vv = vn;
            if (s == 4 || s == 9) lds_barrier();
        }
    };

    lds_barrier();
    if (is_scan) {
        lds_barrier(); lds_barrier(); lds_barrier();
#pragma unroll 1
        for (int c = 0; c < nchunk; ++c) {
            chunk_steps(c & 1);
            lds_barrier();
        }
        if (state_out) {
            float* sp = state_out + irow * 64 + jb;
            *(f32x4*)sp = S0; *(f32x4*)(sp + 4) = S1; *(f32x4*)(sp + 8) = S2; *(f32x4*)(sp + 12) = S3;
        }
    } else {
        load_chunk(0); prodA(0);
        lds_barrier();
        prodB();
        lds_barrier();
        prodC(0, 0); if (nchunk > 1) load_chunk(1);
        lds_barrier();
#pragma unroll 1
        for (int c = 0; c < nchunk; ++c) {
            const int b = c & 1;
            const bool more = c + 1 < nchunk;
            if (c > 0) flush_ys(c - 1);
            if (more) prodA(b ^ 1);
            lds_barrier();
            if (more) prodB();
            lds_barrier();
            if (more) { prodC(c + 1, b ^ 1); if (c + 2 < nchunk) load_chunk(c + 2); }
            lds_barrier();
        }
        flush_ys(nchunk - 1);
    }
    lds_barrier();
}

DI void scan_dispatch(const Params& p, char* smem, int it) {
    if (it < 128) {
        const int b = it >> 4, dsel = (it >> 3) & 1, h = it & 7;
        scan_item(p, smem, MC + b * 2048, 2048, dsel, h, p.state_rwkv + (size_t)((b * 2 + dsel) * 8 + h) * 4096, nullptr);
    } else {
        const int i2 = it - 128, s = i2 >> 4, dsel = (i2 >> 3) & 1, h = i2 & 7;
        scan_item(p, smem, s * 256, 256, dsel, h, nullptr, p.out + OUT_S + (size_t)((s * 2 + dsel) * 8 + h) * 4096);
    }
}
DI void phase_mix(const Params& p, char* smem) {
    unsigned* ctr = (unsigned*)(p.ws + OFF_BAR) + XCD_BAR_WORDS;
    volatile LAS unsigned* slot = (volatile LAS unsigned*)(smem + LDS_MAIN + 8);
    for (;;) {
        if (threadIdx.x == 0) *slot = __hip_atomic_fetch_add(ctr, 1u, __ATOMIC_RELAXED, __HIP_MEMORY_SCOPE_AGENT);
        __syncthreads();
        const int it = (int)*slot;
        __syncthreads();
        if (it >= 640 + 768) break;
        if (it < 640) scan_dispatch(p, smem, it);
        else attn_item(p, smem, it - 640);
    }
    sg_pass(p);
}

DI void phase_post(const Params& p, char* smem) {
    const int tid = threadIdx.x, wid = tid >> 6, lane = tid & 63, fr = lane & 15, fq = lane >> 4, wr = wid >> 1, wc = wid & 1;
    unsigned char* ws = p.ws;
    const bf16_t* sg = (const bf16_t*)(ws + OFF_SG); const bf16_t* g2t = (const bf16_t*)(ws + OFF_G2T);
    const float* ys0 = (const float*)(ws + OFF_YS); const float* ys1 = ys0 + (size_t)M * 512;
    const float* bn = (const float*)(ws + OFF_BN);
    const bf16_t* zr = (const bf16_t*)(p.out + OUT_Y);
    bf16_t* rw = (bf16_t*)(ws + OFF_RW);
    const int MT = M / 256, NT = 4;
    for (int t = blockIdx.x; t < MT * NT; t += gridDim.x) {
        int mt, nt; tile_coords(t, MT, NT, mt, nt);
        const int row0 = mt * 256;
        f32x4 acc[4][4]; zero_acc<4>(acc);
        gemm_acc<4>(acc, sg + (size_t)row0 * 128, 128, g2t + (size_t)(nt * 128) * 128, 128, 128, smem, tid);
        const int head = nt * 2 + wc;
#pragma unroll
        for (int mb = 0; mb < 4; ++mb) {
            const int m = row0 + wr * 64 + mb * 16 + fr;
            int r0, T; seq_of(m, r0, T);
            f32x4 y[4]; float s1 = 0.f;
#pragma unroll
            for (int nb = 0; nb < 4; ++nb) {
                const size_t o = (size_t)m * 512 + head * 64 + nb * 16 + fq * 4;
                y[nb] = *(const f32x4*)(ys0 + o) + *(const f32x4*)(ys1 + o);
                s1 += y[nb][0] + y[nb][1] + y[nb][2] + y[nb][3];
            }
            s1 += __shfl_xor(s1, 16); s1 += __shfl_xor(s1, 32);
            const float mean = s1 * (1.0f / 64.0f);
            float s2 = 0.f;
#pragma unroll
            for (int nb = 0; nb < 4; ++nb) { const f32x4 dlt = y[nb] - mean; s2 += dlt[0] * dlt[0] + dlt[1] * dlt[1] + dlt[2] * dlt[2] + dlt[3] * dlt[3]; }
            s2 += __shfl_xor(s2, 16); s2 += __shfl_xor(s2, 32);
            const float rstd = __builtin_amdgcn_rsqf(s2 * (1.0f / 64.0f) + 64e-5f);
            const float bonus = bn[(size_t)m * 16 + head] + bn[(size_t)m * 16 + 8 + head];
#pragma unroll
            for (int nb = 0; nb < 4; ++nb) {
                const int c = head * 64 + nb * 16 + fq * 4;
                const bf16_t* zp = zr + (size_t)m * ZRC + 1024 + c;
                const f32x4 z = unpack4(*(const u32x2*)zp);
                f32x4 zprev = (f32x4){0.f, 0.f, 0.f, 0.f}, znext = zprev;
                if (m > r0) zprev = unpack4(*(const u32x2*)(zp - ZRC));
                if (m < r0 + T - 1) znext = unpack4(*(const u32x2*)(zp + ZRC));
                const f32x4 a0 = *(const f32x4*)(p.rwkv_mu + 1024 + c), a1 = *(const f32x4*)(p.rwkv_mu + ZRC + 1024 + c);
                const f32x4 v = z + a0 * (zprev - z) + a1 * (znext - z);
                const f32x4 lg = *(const f32x4*)(p.rwkv_ln_g + c), lb = *(const f32x4*)(p.rwkv_ln_b + c);
                const f32x4 yn = (y[nb] - mean) * rstd * lg + lb;
                const f32x4 o = (yn + v * bonus) * acc[mb][nb];
                *(u32x2*)(rw + (size_t)m * 512 + c) = pack4(o);
            }
        }
    }
}

DI void phase_merge(const Params& p, char* smem) {
    const int tid = threadIdx.x, wid = tid >> 6, lane = tid & 63, fr = lane & 15, fq = lane >> 4, wr = wid >> 1, wc = wid & 1;
    unsigned char* ws = p.ws;
    const bf16_t* hb = (const bf16_t*)(ws + OFF_H); const bf16_t* wt = (const bf16_t*)(ws + OFF_WIN);
    const bf16_t* ab = (const bf16_t*)(ws + OFF_ATTN); const bf16_t* rw = (const bf16_t*)(ws + OFF_RW);
    const bf16_t* wpa = (const bf16_t*)(ws + OFF_WPA); const bf16_t* wpb = (const bf16_t*)(ws + OFF_WPB);
    bf16_t* mg = (bf16_t*)(ws + OFF_MRG);
    const int MT = M / 256, NT = 16;
    for (int t = blockIdx.x; t < MT * NT; t += gridDim.x) {
        int mt, nt; tile_coords(t, MT, NT, mt, nt);
        const int row0 = mt * 256, n0 = nt * 64;
        f32x4 acc[4][2], res[4][2], gate[4][2];
        zero_acc<2>(acc);
        gemm_acc<2>(acc, hb + (size_t)row0 * 1024, 1024, wt + (size_t)(768 + n0) * 1024, 1024, 1024, smem, tid);
#pragma unroll
        for (int a = 0; a < 4; ++a)
#pragma unroll
            for (int b = 0; b < 2; ++b)
#pragma unroll
                for (int j = 0; j < 4; ++j) gate[a][b][j] = sigmoidf_(acc[a][b][j]);
        zero_acc<2>(acc);
        gemm_acc<2>(acc, ab + (size_t)row0 * 512, 512, wpa + (size_t)n0 * 512, 512, 512, smem, tid);
#pragma unroll
        for (int a = 0; a < 4; ++a)
#pragma unroll
            for (int b = 0; b < 2; ++b) res[a][b] = gate[a][b] * acc[a][b];
        zero_acc<2>(acc);
        gemm_acc<2>(acc, hb + (size_t)row0 * 1024, 1024, wt + (size_t)(1792 + n0) * 1024, 1024, 1024, smem, tid);
#pragma unroll
        for (int a = 0; a < 4; ++a)
#pragma unroll
            for (int b = 0; b < 2; ++b)
#pragma unroll
                for (int j = 0; j < 4; ++j) gate[a][b][j] = sigmoidf_(acc[a][b][j]);
        zero_acc<2>(acc);
        gemm_acc<2>(acc, rw + (size_t)row0 * 512, 512, wpb + (size_t)n0 * 512, 512, 512, smem, tid);
#pragma unroll
        for (int mb = 0; mb < 4; ++mb) {
            const int m = row0 + wr * 64 + mb * 16 + fr;
#pragma unroll
            for (int nb = 0; nb < 2; ++nb) {
                const f32x4 o = res[mb][nb] + gate[mb][nb] * acc[mb][nb];
                *(u32x2*)(mg + (size_t)m * 1024 + n0 + wc * 32 + nb * 16 + fq * 4) = pack4(o);
            }
        }
    }
}

struct EpiOut {
    static constexpr bool PERM = false, AFTER_DRAIN = false;
    float* y; const float* mod; const float* xp; const float* xs;
    __device__ __forceinline__ void operator()(const f32x4 (&acc)[2][2][4][2], const pg8::Unit& u, int wr, int wc, int fr, int fq) const {
        const int row0 = u.pm * 256 + wr * 64 + fr, col0 = u.pn * 256 + wc * 32 + 4 * fq, ci = cond_of(u.pm * 256);
        const float* xb = u.pm * 256 < MC ? xp : xs - (size_t)MC * D;
#pragma unroll
        for (int bj = 0; bj < 2; ++bj)
#pragma unroll
            for (int n = 0; n < 2; ++n) {
                const int col = col0 + bj * 128 + n * 16;
                const f32x4 g1 = *(const f32x4*)(mod + ci * 6144 + 2048 + col);
#pragma unroll
                for (int ai = 0; ai < 2; ++ai)
#pragma unroll
                    for (int m = 0; m < 4; ++m) {
                        const size_t o = (size_t)(row0 + ai * 128 + m * 16) * D + col;
                        *(f32x4*)(y + o) = *(const f32x4*)(xb + o) + g1 * acc[ai][bj][m][n];
                    }
            }
    }
};
DI void phase_out(const Params& p, char* smem) {
    const int tid = threadIdx.x, wid = tid >> 6, lane = tid & 63, fr = lane & 15, fq = lane >> 4, wr = wid >> 1, wc = wid & 1;
    unsigned char* ws = p.ws;
    const bf16_t* mg = (const bf16_t*)(ws + OFF_MRG); const bf16_t* wo = (const bf16_t*)(ws + OFF_WOUT);
    const float* mod = (const float*)(ws + OFF_MOD);
    const int nM = M / 256, nN = 4, G = gridDim.x, nfirst = G < nM * nN ? G : nM * nN;
    {
        const pg8::Gemm8 g = {mg, wo, 1024, 128};
        const pg8::Order8 ord = {nM, nN, nfirst, G, (int)blockIdx.x};
        const EpiOut epi = {p.out + OUT_Y, mod, p.x_prompt, p.x_sample};
        pg8::gemm8((LAS unsigned char*)smem, g, ord, epi);
    }
    for (int t = blockIdx.x; t < 2 * (nM * nN - nfirst); t += G) {
        int pm, pn; pg8::unit_of(nfirst + (t >> 1), nM, nN, pm, pn);
        const int row0 = pm * 256, n0 = pn * 256 + (t & 1) * 128;
        f32x4 acc[4][4]; zero_acc<4>(acc);
        gemm_acc<4>(acc, mg + (size_t)row0 * 1024, 1024, wo + (size_t)n0 * 1024, 1024, 1024, smem, tid);
        const int ci = cond_of(row0);
#pragma unroll
        for (int nb = 0; nb < 4; ++nb) {
            const int n = n0 + wc * 64 + nb * 16 + fq * 4;
            const f32x4 g1 = *(const f32x4*)(mod + ci * 6144 + 2048 + n);
#pragma unroll
            for (int mb = 0; mb < 4; ++mb) {
                const int m = row0 + wr * 64 + mb * 16 + fr;
                const f32x4 xv = *(const f32x4*)(xrow(p, m) + n);
                *(f32x4*)(p.out + OUT_Y + (size_t)m * D + n) = xv + g1 * acc[mb][nb];
            }
        }
    }
}

DI u32x2 conv_act(const f32x4 (&um)[2], const f32x4 (&u0)[2], const f32x4 (&up)[2], const float* cw, const float* cb, int gcol) {
    f32x4 res[2];
#pragma unroll
    for (int part = 0; part < 2; ++part) {
        const int cc = gcol + part * DFF;
        const f32x4 w0 = *(const f32x4*)(cw + cc), w1 = *(const f32x4*)(cw + 5632 + cc), w2 = *(const f32x4*)(cw + 2 * 5632 + cc), bb = *(const f32x4*)(cb + cc);
        res[part] = um[part] * w0 + u0[part] * w1 + up[part] * w2 + bb;
    }
    f32x4 o;
#pragma unroll
    for (int j = 0; j < 4; ++j) { const float g = res[1][j]; o[j] = g * rcpf_(1.0f + __expf(-g)) * res[0][j]; }
    return pack4(o);
}
DI void phase_up(const Params& p, char* smem) {
    const int tid = threadIdx.x, wid = tid >> 6, lane = tid & 63, fr = lane & 15, fq = lane >> 4, wr = wid >> 1, wc = wid & 1;
    unsigned char* ws = p.ws;
    const bf16_t* hb = (const bf16_t*)(ws + OFF_H); const bf16_t* wu = (const bf16_t*)(ws + OFF_WUP);
    bf16_t* act = (bf16_t*)(ws + OFF_ACT); bf16_t* ub = (bf16_t*)(ws + OFF_U);
    bf16_t* ut = (bf16_t*)smem;
    const int MT = M / 256, NT = 44;
    for (int t = blockIdx.x; t < MT * NT; t += gridDim.x) {
        int mt, nt; tile_coords(t, MT, NT, mt, nt);
        const int row0 = mt * 256, n0 = nt * 64;
        f32x4 acc[4][4]; zero_acc<4>(acc);
        gemm_acc<4, 1>(acc, hb + (size_t)row0 * 1024, 1024, wu + (size_t)n0 * 1024, 1024, 1024, smem, tid);
        __syncthreads();
#pragma unroll
        for (int mb = 0; mb < 4; ++mb)
#pragma unroll
            for (int nb = 0; nb < 4; ++nb) *(u32x2*)(ut + (wr * 64 + mb * 16 + fr) * 136 + wc * 64 + nb * 16 + fq * 4) = pack4(acc[mb][nb]);
        __syncthreads();
        const int c4 = (tid & 15) * 4, lv = (c4 >> 5) * 64 + (c4 & 31), lg = lv + 32;
#pragma unroll 2
        for (int it = 0; it < 8; ++it) {
            const int row = it * 32 + (tid >> 4);
            f32x4 um[2], u0[2], up[2];
            const f32x4 z4 = (f32x4){0.f, 0.f, 0.f, 0.f};
            u0[0] = unpack4(*(const u32x2*)(ut + row * 136 + lv)); u0[1] = unpack4(*(const u32x2*)(ut + row * 136 + lg));
            um[0] = row > 0 ? unpack4(*(const u32x2*)(ut + (row - 1) * 136 + lv)) : z4; um[1] = row > 0 ? unpack4(*(const u32x2*)(ut + (row - 1) * 136 + lg)) : z4;
            up[0] = row < 255 ? unpack4(*(const u32x2*)(ut + (row + 1) * 136 + lv)) : z4; up[1] = row < 255 ? unpack4(*(const u32x2*)(ut + (row + 1) * 136 + lg)) : z4;
            *(u32x2*)(act + (size_t)(row0 + row) * DFF + n0 + c4) = conv_act(um, u0, up, p.ffn_conv_w, p.ffn_conv_b, n0 + c4);
        }
        if (row0 >= MC && tid < 256) {
            const int k = tid >> 6, rsel = k < 2 ? k : 252 + k, cp = (tid & 63) * 2;
            *(unsigned*)(ub + ((size_t)(mt * NT + nt) * 4 + k) * 128 + cp) = *(const unsigned*)(ut + rsel * 136 + cp);
        }
    }
}
DI void phase_fix(const Params& p) {
    unsigned char* ws = p.ws;
    bf16_t* act = (bf16_t*)(ws + OFF_ACT); const bf16_t* ub = (const bf16_t*)(ws + OFF_U);
    const int NT = 44;
    for (int i = blockIdx.x * NTHR + threadIdx.x; i < 64 * NT * 2 * 16; i += gridDim.x * NTHR) {
        const int cg = i & 15, which = (i >> 4) & 1, rest = i >> 5, nt = rest % NT, mt = 32 + rest / NT;
        const int row0 = mt * 256, tpos = (row0 - MC) & 2047;
        if (which == 0 ? tpos == 0 : tpos == 2048 - 256) continue;
        const bf16_t* own = ub + (size_t)(mt * NT + nt) * 4 * 128;
        const bf16_t *pv, *cu, *nx; int m;
        if (which == 0) { m = row0; pv = ub + ((size_t)((mt - 1) * NT + nt) * 4 + 3) * 128; cu = own; nx = own + 128; }
        else { m = row0 + 255; pv = own + 2 * 128; cu = own + 3 * 128; nx = ub + (size_t)((mt + 1) * NT + nt) * 4 * 128; }
        const int c4 = cg * 4, lv = (c4 >> 5) * 64 + (c4 & 31), lg = lv + 32;
        f32x4 um[2], u0[2], up[2];
        um[0] = unpack4(*(const u32x2*)(pv + lv)); um[1] = unpack4(*(const u32x2*)(pv + lg));
        u0[0] = unpack4(*(const u32x2*)(cu + lv)); u0[1] = unpack4(*(const u32x2*)(cu + lg));
        up[0] = unpack4(*(const u32x2*)(nx + lv)); up[1] = unpack4(*(const u32x2*)(nx + lg));
        *(u32x2*)(act + (size_t)m * DFF + nt * 64 + c4) = conv_act(um, u0, up, p.ffn_conv_w, p.ffn_conv_b, nt * 64 + c4);
    }
}
struct EpiDown {
    static constexpr bool PERM = false, AFTER_DRAIN = false;
    float* y; const float* mod;
    __device__ __forceinline__ void operator()(const f32x4 (&acc)[2][2][4][2], const pg8::Unit& u, int wr, int wc, int fr, int fq) const {
        const int row0 = u.pm * 256 + wr * 64 + fr, col0 = u.pn * 256 + wc * 32 + 4 * fq, ci = cond_of(u.pm * 256);
#pragma unroll
        for (int bj = 0; bj < 2; ++bj)
#pragma unroll
            for (int n = 0; n < 2; ++n) {
                const int col = col0 + bj * 128 + n * 16;
                const f32x4 g2 = *(const f32x4*)(mod + ci * 6144 + 5120 + col);
#pragma unroll
                for (int ai = 0; ai < 2; ++ai)
#pragma unroll
                    for (int m = 0; m < 4; ++m) { float* px = y + (size_t)(row0 + ai * 128 + m * 16) * D + col; *(f32x4*)px = *(const f32x4*)px + g2 * acc[ai][bj][m][n]; }
            }
    }
};
DI void phase_down(const Params& p, char* smem) {
    const int tid = threadIdx.x, wid = tid >> 6, lane = tid & 63, fr = lane & 15, fq = lane >> 4, wr = wid >> 1, wc = wid & 1;
    unsigned char* ws = p.ws;
    const bf16_t* act = (const bf16_t*)(ws + OFF_ACT); const bf16_t* wd = (const bf16_t*)(ws + OFF_WDN);
    const float* mod = (const float*)(ws + OFF_MOD);
    const int nM = M / 256, nN = 4, G = gridDim.x, nfirst = G < nM * nN ? G : nM * nN;
    {
        const pg8::Gemm8 g = {act, wd, DFF, 128};
        const pg8::Order8 ord = {nM, nN, nfirst, G, (int)blockIdx.x};
        const EpiDown epi = {p.out + OUT_Y, mod};
        pg8::gemm8((LAS unsigned char*)smem, g, ord, epi);
    }
    for (int t = blockIdx.x; t < 2 * (nM * nN - nfirst); t += G) {
        int pm, pn; pg8::unit_of(nfirst + (t >> 1), nM, nN, pm, pn);
        const int row0 = pm * 256, n0 = pn * 256 + (t & 1) * 128;
        f32x4 acc[4][4]; zero_acc<4>(acc);
        gemm_acc<4>(acc, act + (size_t)row0 * DFF, DFF, wd + (size_t)n0 * DFF, DFF, DFF, smem, tid);
        const int ci = cond_of(row0);
#pragma unroll
        for (int nb = 0; nb < 4; ++nb) {
            const int n = n0 + wc * 64 + nb * 16 + fq * 4;
            const f32x4 g2 = *(const f32x4*)(mod + ci * 6144 + 5120 + n);
#pragma unroll
            for (int mb = 0; mb < 4; ++mb) {
                const int m = row0 + wr * 64 + mb * 16 + fr;
                float* px = p.out + OUT_Y + (size_t)m * D + n;
                *(f32x4*)px = *(const f32x4*)px + g2 * acc[mb][nb];
            }
        }
    }
}

#define XB_TMO      128
#define XB_XCNT(j)  (256  + 64 * (j))
#define XB_XSUB(j)  (1280 + 64 * (j))
#define XB_XGEN(j)  (2304 + 64 * (j))
#define XB_TOP      3328
#define XB_TOPGEN   3392
#define XB_SPIN_CAP (1u << 20)
DI unsigned xb_ld(unsigned* p)              { return __hip_atomic_load(p, __ATOMIC_RELAXED, __HIP_MEMORY_SCOPE_AGENT); }
DI unsigned xb_add(unsigned* p, unsigned v) { return __hip_atomic_fetch_add(p, v, __ATOMIC_RELAXED, __HIP_MEMORY_SCOPE_AGENT); }
DI unsigned xb_xcc_id() { return (unsigned)__builtin_amdgcn_s_getreg((3 << 11) | 20) & 0xFu; }
#define XB_SPIN(cond, bar) do { unsigned _sp = 0; while (cond) { __builtin_amdgcn_s_sleep(1); \
    if ((++_sp & 255u) == 0u) { if (xb_ld(&(bar)[XB_TMO])) break; if (_sp > XB_SPIN_CAP) { atomicAdd(&(bar)[XB_TMO], 1u); break; } } } } while (0)
struct XcdBarrier { unsigned* bar; unsigned x; volatile LAS unsigned* st; };
DI XcdBarrier xcd_barrier_post(unsigned* bar, volatile LAS unsigned* st) {
    XcdBarrier b; b.bar = bar; b.x = xb_xcc_id(); b.st = st;
    if (threadIdx.x == 0) (void)xb_add(&bar[XB_XCNT(b.x)], 1u);
    return b;
}
DI void xcd_barrier_complete(unsigned* bar, unsigned x, unsigned& nloc, unsigned& nx) {
    const unsigned G = gridDim.x * gridDim.y * gridDim.z;
    unsigned sum, cnt, mine, sp = 0u;
    for (;;) {
        sum = 0u; cnt = 0u; mine = 0u;
#pragma unroll
        for (unsigned j = 0; j < 16; ++j) { const unsigned c = xb_ld(&bar[XB_XCNT(j)]); sum += c; cnt += (c > 0u) ? 1u : 0u; mine = (j == x) ? c : mine; }
        if (sum == G) break;
        __builtin_amdgcn_s_sleep(1);
        if ((++sp & 255u) == 0u) { if (xb_ld(&bar[XB_TMO])) break; if (sp > XB_SPIN_CAP) { atomicAdd(&bar[XB_TMO], 1u); break; } }
    }
    nloc = mine > 0u ? mine : 1u; nx = cnt > 0u ? cnt : 1u;
}
DI void xcd_barrier(const XcdBarrier& b) {
    asm volatile("s_waitcnt vmcnt(0)" ::: "memory");
    __syncthreads();
    if (threadIdx.x == 0) {
        unsigned* bar = b.bar;
        __builtin_amdgcn_s_waitcnt(0);
        unsigned nloc = b.st[0], nx = b.st[1];
        if (nloc == 0u) { xcd_barrier_complete(bar, b.x, nloc, nx); b.st[0] = nloc; b.st[1] = nx; }
        const unsigned old = xb_add(&bar[XB_XSUB(b.x)], 1u);
        const unsigned gen = old / nloc;
        if (old + 1u == (gen + 1u) * nloc) {
            __builtin_amdgcn_fence(__ATOMIC_RELEASE, "agent");
            asm volatile("s_waitcnt vmcnt(0)" ::: "memory");
            const unsigned og = xb_add(&bar[XB_TOP], 1u);
            const unsigned tg = og / nx;
            if (og + 1u == (tg + 1u) * nx) xb_add(&bar[XB_TOPGEN], 1u);
            else XB_SPIN(xb_ld(&bar[XB_TOPGEN]) == tg, bar);
            __builtin_amdgcn_fence(__ATOMIC_ACQUIRE, "agent");
            xb_add(&bar[XB_XGEN(b.x)], 1u);
            asm volatile("s_waitcnt vmcnt(0)" ::: "memory");
        } else {
            XB_SPIN(xb_ld(&bar[XB_XGEN(b.x)]) == gen, bar);
            __builtin_amdgcn_fence(__ATOMIC_ACQUIRE, "agent");
            asm volatile("s_waitcnt vmcnt(0)" ::: "memory");
        }
    }
    __syncthreads();
}

constexpr int N_PHASES = 23;
__global__ void __launch_bounds__(NTHR) fwd_kernel(Params p) {
    extern __shared__ __attribute__((aligned(16))) char smem[];
    volatile LAS unsigned* xst = (volatile LAS unsigned*)(smem + LDS_MAIN);
    if (threadIdx.x == 0) { xst[0] = 0u; xst[1] = 0u; }
    __syncthreads();
    const XcdBarrier xb = xcd_barrier_post((unsigned*)(p.ws + OFF_BAR), xst);
    asm volatile("s_nop 0\n\ts_nop 0\n\ts_nop 0\n\ts_nop 0\n\ts_nop 0");
#ifndef PH_MASK
#define PH_MASK 0xffff
#endif
#ifndef REP_MASK
#define REP_MASK 0
#endif
#define RUN_PHASE(ph, bit, call) if (p.ph_lo <= (ph) && (ph) < p.ph_hi) { if ((ph) > p.ph_lo) xcd_barrier(xb); if (PH_MASK & (bit)) { call; if (REP_MASK & (bit)) { call; } } }
    RUN_PHASE(0, 1, phase_prep(p, smem))
    RUN_PHASE(1, 2, phase_norm<1>(p))
    RUN_PHASE(2, 4, phase_p1(p, smem))
    RUN_PHASE(4, 16, phase_mix(p, smem))
    RUN_PHASE(5, 32, phase_post(p, smem))
    RUN_PHASE(6, 64, phase_merge(p, smem))
    RUN_PHASE(7, 128, phase_out(p, smem))
    RUN_PHASE(8, 256, phase_norm<2>(p))
    RUN_PHASE(9, 512, phase_up(p, smem))
    RUN_PHASE(10, 1024, phase_fix(p))
    RUN_PHASE(21, 2048, phase_down(p, smem))
    RUN_PHASE(22, 4096, phase_norm<3>(p))
}

extern "C" void kernel_launch(void* const* d_in, const int* in_sizes, int n_in, void* d_out, int out_size, void* d_ws, size_t ws_size, hipStream_t stream) {
    static int grid = 0;
    if (grid == 0) {
        if (n_in != 32 || ws_size < WS_NEED) { fprintf(stderr, "kernel_launch: unexpected inputs (n_in %d, ws %zu, need %zu)\n", n_in, ws_size, (size_t)WS_NEED); grid = -1; return; }
        int dev = 0, cus = 0, per_cu = 0;
        hipGetDevice(&dev);
        hipDeviceGetAttribute(&cus, hipDeviceAttributeMultiprocessorCount, dev);
        hipFuncSetAttribute((const void*)fwd_kernel, hipFuncAttributeMaxDynamicSharedMemorySize, LDS_BYTES);
        hipOccupancyMaxActiveBlocksPerMultiprocessor(&per_cu, (const void*)fwd_kernel, NTHR, LDS_BYTES);
        if (per_cu < 1) { fprintf(stderr, "kernel_launch: occupancy query says %d blocks per CU\n", per_cu); grid = -1; return; }
        grid = cus;
        grid &= ~7;
    }
    if (grid < 0) return;
    if (hipMemsetAsync((char*)d_ws + OFF_BAR, 0, (XCD_BAR_WORDS + 64) * 4, stream) != hipSuccess) { fprintf(stderr, "kernel_launch: memset failed\n"); return; }
    Params p{};
    const float** pp = (const float**)&p;
    for (int i = 0; i < 32; ++i) pp[i] = (const float*)d_in[i];
    p.out = (float*)d_out; p.ws = (unsigned char*)d_ws;
#if N_LAUNCH_SPLIT
    for (int ph = 0; ph < N_PHASES; ++ph) {
        p.ph_lo = ph; p.ph_hi = ph + 1;
        hipLaunchKernelGGL(fwd_kernel, dim3(grid), dim3(NTHR), LDS_BYTES, stream, p);
    }
#else
    p.ph_lo = 0; p.ph_hi = N_PHASES;
    void* args[] = {&p};
    hipError_t e = hipLaunchCooperativeKernel((const void*)fwd_kernel, dim3(grid), dim3(NTHR), args, LDS_BYTES, stream);
    if (e != hipSuccess) fprintf(stderr, "cooperative launch failed: %s (grid %d)\n", hipGetErrorString(e), grid);
#endif
}
```

```cpp
#include <hip/hip_runtime.h>
#include <hip/hip_cooperative_groups.h>
#include <cstdio>
namespace cg = cooperative_groups;

#define DI __device__ __forceinline__
typedef unsigned short bf16_t;
typedef short bf16x8 __attribute__((ext_vector_type(8)));
typedef short s16x4 __attribute__((ext_vector_type(4)));
typedef float f32x4 __attribute__((ext_vector_type(4)));
typedef float f32x2 __attribute__((ext_vector_type(2)));
typedef float f32x16 __attribute__((ext_vector_type(16)));
typedef unsigned u32x4 __attribute__((ext_vector_type(4)));
typedef unsigned u32x2 __attribute__((ext_vector_type(2)));

#ifndef N_LAUNCH_SPLIT
#define N_LAUNCH_SPLIT 0
#endif

constexpr int NTHR = 512;
constexpr int D = 1024;
constexpr int MC = 8192;
constexpr int ML = 16384;
constexpr int M = MC + ML;
constexpr int WIN = 4736;
constexpr int ZRC = 1920;
constexpr int DFF = 2816;
constexpr int LDS_MAIN = 147456;
constexpr int LDS_BYTES = LDS_MAIN + 16;
constexpr float LOG2E = 1.4426950408889634f;

constexpr size_t al256(size_t x) { return (x + 255) & ~(size_t)255; }
constexpr size_t OFF_WUP   = 0;
constexpr size_t OFF_WDN   = OFF_WUP + al256((size_t)5632 * 1024 * 2);
constexpr size_t OFF_MOD   = OFF_WDN + al256((size_t)1024 * 2816 * 2);
constexpr size_t OFF_ROPE  = OFF_MOD + al256((size_t)9 * 6144 * 4);
constexpr size_t OFF_W2T   = OFF_ROPE + al256((size_t)64 * 16 * 8);
constexpr size_t OFF_A2T   = OFF_W2T + al256((size_t)2 * 512 * 64 * 2);
constexpr size_t OFF_G2T   = OFF_A2T + al256((size_t)2 * 512 * 64 * 2);
constexpr size_t OFF_KC    = OFF_G2T + al256((size_t)512 * 128 * 2);
constexpr size_t OFF_VCT   = OFF_KC + al256((size_t)8 * 512 * 128 * 2);
constexpr size_t OFF_BAR   = OFF_VCT + al256((size_t)8 * 512 * 128 * 2);
constexpr size_t OFF_H     = OFF_BAR + al256((size_t)(3456 + 64) * 4);
constexpr size_t OFF_X     = OFF_H + al256((size_t)M * 1024 * 2);
constexpr size_t OFF_WIN   = OFF_X;
constexpr size_t OFF_WPA   = OFF_WIN + al256((size_t)WIN * 1024 * 2);
constexpr size_t OFF_WPB   = OFF_WPA + al256((size_t)1024 * 512 * 2);
constexpr size_t OFF_WOUT  = OFF_WPB + al256((size_t)1024 * 512 * 2);
constexpr size_t OFF_Q     = OFF_WOUT + al256((size_t)1024 * 1024 * 2);
constexpr size_t OFF_RW    = OFF_Q;
constexpr size_t OFF_KB    = OFF_Q + al256((size_t)M * 512 * 2);
constexpr size_t OFF_VT    = OFF_KB + al256((size_t)M * 128 * 2);
constexpr size_t OFF_ATTN  = OFF_VT + al256((size_t)M * 128 * 2);
constexpr size_t OFF_SG    = OFF_ATTN + al256((size_t)M * 512 * 2);
constexpr size_t OFF_BN    = OFF_SG + al256((size_t)M * 128 * 2);
constexpr size_t OFF_YS    = OFF_BN + al256((size_t)M * 16 * 4);
constexpr size_t OFF_MRG   = OFF_YS;
constexpr size_t END_EARLY = OFF_YS + al256((size_t)2 * M * 512 * 4);
constexpr size_t OFF_ACT   = OFF_X;
constexpr size_t OFF_U     = OFF_ACT + al256((size_t)M * DFF * 2);
constexpr size_t END_FFN   = OFF_U + al256((size_t)96 * 44 * 4 * 128 * 2);
constexpr size_t WS_NEED   = END_EARLY > END_FFN ? END_EARLY : END_FFN;
static_assert(WS_NEED <= (size_t)256 * 1024 * 1024, "workspace over 256 MiB");

constexpr size_t OUT_Y  = 0;
constexpr size_t OUT_K  = (size_t)M * 1024;
constexpr size_t OUT_V  = OUT_K + (size_t)MC * 128;
constexpr size_t OUT_S  = OUT_V + (size_t)MC * 128;

struct Params {
    const float *x_prompt, *x_sample, *c, *cache_k, *cache_v, *state_rwkv, *c_ctx, *w_ada, *b_ada, *g_norm1, *w_in, *attn_sink,
        *w_proj_a, *w_proj_b, *rwkv_mu, *rwkv_w0, *rwkv_w2, *rwkv_a0, *rwkv_a2, *rwkv_k_k, *rwkv_k_a, *rwkv_r_k, *rwkv_g2,
        *rwkv_ln_g, *rwkv_ln_b, *w_out, *g_norm2, *w_ffn_up, *ffn_conv_w, *ffn_conv_b, *w_ffn_down, *g_final;
    float* out;
    unsigned char* ws;
    int ph_lo, ph_hi;
};

#define XCD_BAR_WORDS 3456
#define LAS __attribute__((address_space(3)))
DI bf16_t f2bf(float f) { unsigned u = __float_as_uint(f); u += 0x7fffu + ((u >> 16) & 1u); return (bf16_t)(u >> 16); }
DI float bf2f(unsigned b) { return __uint_as_float(b << 16); }
typedef __bf16 bf16v2_t __attribute__((ext_vector_type(2)));
DI unsigned pack2(float lo, float hi) { f32x2 v; v.x = lo; v.y = hi; return __builtin_bit_cast(unsigned, __builtin_convertvector(v, bf16v2_t)); }
DI u32x2 pack4(f32x4 v) { u32x2 r; r.x = pack2(v[0], v[1]); r.y = pack2(v[2], v[3]); return r; }
DI f32x4 unpack4(u32x2 v) { f32x4 r; r[0] = bf2f(v.x & 0xffffu); r[1] = bf2f(v.x >> 16); r[2] = bf2f(v.y & 0xffffu); r[3] = bf2f(v.y >> 16); return r; }
DI float rcpf_(float x) { return __builtin_amdgcn_rcpf(x); }
DI float sigmoidf_(float x) { return rcpf_(1.0f + __expf(-x)); }
DI const float* xrow(const Params& p, int r) { return r < MC ? p.x_prompt + (size_t)r * D : p.x_sample + (size_t)(r - MC) * D; }
DI int cond_of(int r) { return r < MC ? 0 : 1 + ((r - MC) >> 11); }
DI void seq_of(int r, int& r0, int& T) { if (r < MC) { r0 = r & ~255; T = 256; } else { r0 = MC + ((r - MC) & ~2047); T = 2048; } }
DI float wave_sum(float v) {
#pragma unroll
    for (int o = 32; o >= 1; o >>= 1) v += __shfl_xor(v, o);
    return v;
}

DI void transpose_tile(const float* __restrict__ src, int K, int N, bf16_t* __restrict__ dst, int kt, int nt, float* tile, int tid) {
    const int k0 = kt * 64, n0 = nt * 64;
#pragma unroll
    for (int i = 0; i < 8; ++i) { const int k = (tid >> 6) + 8 * i, n = tid & 63; tile[k * 65 + n] = src[(size_t)(k0 + k) * N + n0 + n]; }
    __syncthreads();
#pragma unroll
    for (int i = 0; i < 8; ++i) { const int n = (tid >> 6) + 8 * i, k = tid & 63; dst[(size_t)(n0 + n) * K + k0 + k] = f2bf(tile[k * 65 + n]); }
    __syncthreads();
}

DI void phase_prep(const Params& p, char* smem) {
    const int tid = threadIdx.x, nb = gridDim.x, bid = blockIdx.x;
    unsigned char* ws = p.ws;
    {
        float* tile = (float*)smem;
        const int cnt[11] = {16 * 74, 8 * 16, 8 * 16, 16 * 16, 16 * 88, 44 * 16, 8, 8, 8, 8, 16};
        int total = 0;
#pragma unroll
        for (int i = 0; i < 11; ++i) total += cnt[i];
        for (int it = bid; it < total; it += nb) {
            int i = it, mi = 0;
#pragma unroll
            for (int q = 0; q < 10; ++q) { if (mi == q && i >= cnt[q]) { i -= cnt[q]; mi = q + 1; } }
            const float* src; bf16_t* dst; int K, N;
            switch (mi) {
                case 0: src = p.w_in; K = 1024; N = WIN; dst = (bf16_t*)(ws + OFF_WIN); break;
                case 1: src = p.w_proj_a; K = 512; N = 1024; dst = (bf16_t*)(ws + OFF_WPA); break;
                case 2: src = p.w_proj_b; K = 512; N = 1024; dst = (bf16_t*)(ws + OFF_WPB); break;
                case 3: src = p.w_out; K = 1024; N = 1024; dst = (bf16_t*)(ws + OFF_WOUT); break;
                case 4: src = p.w_ffn_up; K = 1024; N = 5632; dst = (bf16_t*)(ws + OFF_WUP); break;
                case 5: src = p.w_ffn_down; K = 2816; N = 1024; dst = (bf16_t*)(ws + OFF_WDN); break;
                case 6: src = p.rwkv_w2; K = 64; N = 512; dst = (bf16_t*)(ws + OFF_W2T); break;
                case 7: src = p.rwkv_w2 + 64 * 512; K = 64; N = 512; dst = (bf16_t*)(ws + OFF_W2T) + 512 * 64; break;
                case 8: src = p.rwkv_a2; K = 64; N = 512; dst = (bf16_t*)(ws + OFF_A2T); break;
                case 9: src = p.rwkv_a2 + 64 * 512; K = 64; N = 512; dst = (bf16_t*)(ws + OFF_A2T) + 512 * 64; break;
                default: src = p.rwkv_g2; K = 128; N = 512; dst = (bf16_t*)(ws + OFF_G2T); break;
            }
            const int ntn = N / 64;
            transpose_tile(src, K, N, dst, i / ntn, i % ntn, tile, tid);
        }
    }
    {
        bf16_t* kc = (bf16_t*)(ws + OFF_KC); bf16_t* vct = (bf16_t*)(ws + OFF_VCT);
        for (int i = bid * NTHR + tid; i < 8 * 512 * 128; i += nb * NTHR) {
            kc[i] = f2bf(p.cache_k[i]);
            const int key = i & 511, d = (i >> 9) & 63, kvh = (i >> 15) & 1, b = i >> 16;
            vct[i] = f2bf(p.cache_v[((size_t)(b * 512 + key) * 2 + kvh) * 64 + d]);
        }
    }
    {
        f32x2* tab = (f32x2*)(ws + OFF_ROPE);
        for (int i = bid * NTHR + tid; i < 1024; i += nb * NTHR) {
            const int pos = i >> 4, fi = i & 15;
            const double fr = pow(10000.0, -(double)fi / 16.0), ang = (double)pos * fr;
            f32x2 v; v.x = (float)cos(ang); v.y = (float)sin(ang); tab[i] = v;
        }
    }
    {
        float* s = (float*)smem;
        float* red = (float*)(smem + 36864);
        float* mod = (float*)(ws + OFF_MOD);
        for (int it = bid; it < 96; it += nb) {
            __syncthreads();
            for (int i = tid; i < 9 * 1024; i += NTHR) {
                const int ci = i >> 10, k = i & 1023;
                const float v = ci == 0 ? p.c_ctx[k] : p.c[(ci - 1) * 1024 + k];
                s[i] = v / (1.0f + __expf(-v));
            }
            __syncthreads();
            const int n = tid & 63, kq = tid >> 6, n0 = it * 64;
            float acc[9];
#pragma unroll
            for (int ci = 0; ci < 9; ++ci) acc[ci] = 0.f;
            for (int k = kq * 128; k < kq * 128 + 128; ++k) {
                const float w = p.w_ada[(size_t)k * 6144 + n0 + n];
#pragma unroll
                for (int ci = 0; ci < 9; ++ci) acc[ci] += s[ci * 1024 + k] * w;
            }
#pragma unroll
            for (int ci = 0; ci < 9; ++ci) red[(kq * 9 + ci) * 64 + n] = acc[ci];
            __syncthreads();
            for (int i = tid; i < 9 * 64; i += NTHR) {
                const int ci = i >> 6, nn = i & 63;
                float v = p.b_ada[n0 + nn];
#pragma unroll
                for (int q = 0; q < 8; ++q) v += red[(q * 9 + ci) * 64 + nn];
                mod[ci * 6144 + n0 + nn] = v;
            }
        }
        __syncthreads();
    }
}

template <int WHICH> DI void phase_norm(const Params& p) {
    const int tid = threadIdx.x, lane = tid & 63, wv = tid >> 6;
    const float* mod = (const float*)(p.ws + OFF_MOD);
    bf16_t* hb = (bf16_t*)(p.ws + OFF_H);
    const int ntask = M / 8;
    for (int task = blockIdx.x * 8 + wv; task < ntask; task += gridDim.x * 8) {
        const int r_first = task * 8, ci = cond_of(r_first);
        f32x4 fa[4], fb[4];
#pragma unroll
        for (int i = 0; i < 4; ++i) {
            const int col = i * 256 + lane * 4;
            if (WHICH == 3) { fa[i] = *(const f32x4*)(p.g_final + col); fb[i] = (f32x4){0.f, 0.f, 0.f, 0.f}; }
            else {
                const f32x4 g = *(const f32x4*)((WHICH == 1 ? p.g_norm1 : p.g_norm2) + col);
                const f32x4 sc = *(const f32x4*)(mod + ci * 6144 + (WHICH == 1 ? 1024 : 4096) + col);
                fb[i] = *(const f32x4*)(mod + ci * 6144 + (WHICH == 1 ? 0 : 3072) + col);
                fa[i] = g * (sc + 1.0f);
            }
        }
        for (int rr = 0; rr < 8; ++rr) {
            const int r = r_first + rr;
            const float* src = WHICH == 1 ? xrow(p, r) : p.out + OUT_Y + (size_t)r * D;
            f32x4 v[4]; float ss = 0.f;
#pragma unroll
            for (int i = 0; i < 4; ++i) { v[i] = *(const f32x4*)(src + i * 256 + lane * 4); ss += v[i][0] * v[i][0] + v[i][1] * v[i][1] + v[i][2] * v[i][2] + v[i][3] * v[i][3]; }
            ss = wave_sum(ss);
            const float rstd = __builtin_amdgcn_rsqf(ss * (1.0f / 1024.0f) + 1e-6f);
#pragma unroll
            for (int i = 0; i < 4; ++i) {
                const f32x4 o = v[i] * rstd * fa[i] + fb[i];
                if (WHICH == 3) *(f32x4*)(p.out + OUT_Y + (size_t)r * D + i * 256 + lane * 4) = o;
                else *(u32x2*)(hb + (size_t)r * D + i * 256 + lane * 4) = pack4(o);
            }
        }
    }
}

template <int NB, int BMAP> DI void gemm_stage(const bf16_t* A, int lda, const bf16_t* Bt, int ldb, int k0, char* sbuf, int tid) {
#pragma unroll
    for (int i = 0; i < 4; ++i) {
        const int c = tid + i * 512, row = c >> 3, pos = c & 7, kc = pos ^ ((row >> 1) & 7);
        __builtin_amdgcn_global_load_lds((const unsigned*)(A + (size_t)row * lda + k0 + kc * 8), (unsigned*)(sbuf + c * 16), 16, 0, 0);
    }
#pragma unroll
    for (int i = 0; i < NB / 2; ++i) {
        const int c = tid + i * 512, row = c >> 3, pos = c & 7, kc = pos ^ ((row >> 1) & 7);
        const int brow = BMAP ? (((row >> 5) & 1) * BMAP + (row >> 6) * 32 + (row & 31)) : row;
        __builtin_amdgcn_global_load_lds((const unsigned*)(Bt + (size_t)brow * ldb + k0 + kc * 8), (unsigned*)(sbuf + 32768 + c * 16), 16, 0, 0);
    }
}
template <int NB, int BMAP = 0> DI void gemm_acc(f32x4 (&acc)[4][NB], const bf16_t* A, int lda, const bf16_t* Bt, int ldb, int K, char* smem, int tid) {
    const int wid = tid >> 6, lane = tid & 63, fr = lane & 15, fq = lane >> 4, wr = wid >> 1, wc = wid & 1;
    const int swz = (fr >> 1) & 7;
    const int nk = K >> 6;
    __syncthreads();
    gemm_stage<NB, BMAP>(A, lda, Bt, ldb, 0, smem, tid);
    if (nk > 1) gemm_stage<NB, BMAP>(A, lda, Bt, ldb, 64, smem + 49152, tid);
    int cur = 0;
#pragma unroll 1
    for (int t = 0; t < nk; ++t) {
        if (t + 1 < nk) { if (NB == 4) asm volatile("s_waitcnt vmcnt(6)" ::: "memory"); else asm volatile("s_waitcnt vmcnt(5)" ::: "memory"); }
        else asm volatile("s_waitcnt vmcnt(0)" ::: "memory");
        __builtin_amdgcn_s_barrier();
        asm volatile("" ::: "memory");
        const int nxt2 = cur >= 1 ? cur - 1 : 2;
        const bool late = __builtin_amdgcn_readfirstlane(wid) >= 4;
        if (t + 2 < nk && !late) gemm_stage<NB, BMAP>(A, lda, Bt, ldb, (t + 2) * 64, smem + nxt2 * 49152, tid);
        const char* sA = smem + cur * 49152;
        const char* sB = sA + 32768;
#pragma unroll
        for (int ks = 0; ks < 2; ++ks) {
            if (ks == 1 && t + 2 < nk && late) gemm_stage<NB, BMAP>(A, lda, Bt, ldb, (t + 2) * 64, smem + nxt2 * 49152, tid);
            bf16x8 af[4], bfr[NB];
            const int coff = ((ks * 4 + fq) ^ swz) << 4;
#pragma unroll
            for (int mb = 0; mb < 4; ++mb) af[mb] = *(const bf16x8*)(sA + (wr * 64 + mb * 16 + fr) * 128 + coff);
#pragma unroll
            for (int nb = 0; nb < NB; ++nb) bfr[nb] = *(const bf16x8*)(sB + (wc * 16 * NB + nb * 16 + fr) * 128 + coff);
            __builtin_amdgcn_s_setprio(1);
#pragma unroll
            for (int mb = 0; mb < 4; ++mb)
#pragma unroll
                for (int nb = 0; nb < NB; ++nb) acc[mb][nb] = __builtin_amdgcn_mfma_f32_16x16x32_bf16(bfr[nb], af[mb], acc[mb][nb], 0, 0, 0);
            __builtin_amdgcn_s_setprio(0);
        }
        cur = cur == 2 ? 0 : cur + 1;
    }
}
template <int NB> DI void zero_acc(f32x4 (&acc)[4][NB]) {
#pragma unroll
    for (int a = 0; a < 4; ++a)
#pragma unroll
        for (int b = 0; b < NB; ++b) acc[a][b] = (f32x4){0.f, 0.f, 0.f, 0.f};
}
DI void tile_coords(int t, int MT, int NT, int& mt, int& nt) {
    const int x = t & 7, u = t >> 3, mpx = MT >> 3;
    const int bm = (mpx % 4 == 0) ? 4 : ((mpx % 2 == 0) ? 2 : 1);
    const int per_band = bm * NT, band = u / per_band, rem = u - band * per_band;
    nt = rem / bm; mt = x * mpx + band * bm + (rem % bm);
}


namespace pg8 {
#define PG8_LAS __attribute__((address_space(3)))
constexpr int BM = 256, BK = 64, HALF = 128, HTB = HALF * BK * 2  , STAGE_BYTES = 8 * HTB, NXCD = 8, WGM = 8;
__host__ __device__ __forceinline__ int lds_byte(int r, int c) { const int st = (r >> 4) * 2 + (c >> 5), rr = r & 15, cc = c & 31, ob = rr * 64 + cc * 2; return st * 1024 + (ob ^ (((ob >> 9) & 1) << 5)); }
__host__ __device__ __forceinline__ void stage_rc(int b, int& R, int& C) { const int st = b / 1024, sb = b % 1024, swz = sb ^ (((sb >> 9) & 1) << 5); R = (st >> 1) * 16 + swz / 64; C = (st & 1) * 32 + (swz % 64) / 2; }
__host__ __device__ __forceinline__ int perm32(int rho) { const int n = rho >> 4, i = rho & 15; return 8 * (i >> 2) + 4 * n + (i & 3); }


struct Unit { int pm, pn, brow; };
struct Gemm8 { const bf16_t* A; const bf16_t* Bt; int K; int bhalf; };
__device__ __forceinline__ void unit_of(int L, int nM, int nN, int& pm, int& pn) {
    const int nwg = nM * nN;
    int wgid = L; { const int q = nwg / NXCD, r = nwg % NXCD, xcd = wgid % NXCD, off = wgid / NXCD; wgid = (xcd < r ? xcd * (q + 1) : r * (q + 1) + (xcd - r) * q) + off; }
    const int nig = WGM * nN, gid = wgid / nig, fm = gid * WGM, gsz = (nM - fm) < WGM ? (nM - fm) : WGM;
    pm = fm + ((wgid % nig) % gsz); pn = (wgid % nig) / gsz;
}
struct Order8 {
    int nM, nN, nlim, G, c;
    __device__ __forceinline__ bool next(int i, Unit& u) const {
        const long L = (long)i * G + c; if (L >= nlim) return false;
        unit_of((int)L, nM, nN, u.pm, u.pn); u.brow = u.pn * 256; return true;
    }
    __device__ __forceinline__ void a_ready(const Unit&) const {}
    __device__ __forceinline__ void done(const Unit&) const {}
};
template <class Epi, class Sched>
__device__ __forceinline__ void gemm8(PG8_LAS unsigned char* lds, const Gemm8 g, const Sched& S, const Epi& E) {
    const int tid = threadIdx.x, wid = __builtin_amdgcn_readfirstlane(tid >> 6), lane = tid & 63, wr = wid >> 2, wc = wid & 3, fr = lane & 15, fq = lane >> 4;
    const int K = g.K, nt = K / BK;
    unsigned voffA[2], voffB[2];
#pragma unroll
    for (int i = 0; i < 2; ++i) { int R, C; stage_rc(tid * 16 + i * 8192, R, C); const int Rb = Epi::PERM ? ((R & ~31) + perm32(R & 31)) : R;
        voffA[i] = (unsigned)(R * K + C) * 2u; voffB[i] = (unsigned)(Rb * K + C) * 2u; }
    const size_t kstep = (size_t)(BK * 2);
    const size_t hstep = (size_t)HALF * K * 2;
    const size_t tstep = 2 * hstep;
    const size_t hstepB = (size_t)g.bhalf * K * 2;
    const size_t rowB = (size_t)K * 2;
    const unsigned ldsw = (unsigned)wid * 1024u;
    const int aoff = lds_byte(wr * 64 + fr, fq * 8), boff = lds_byte(wc * 32 + fr, fq * 8);
#define PG8_SA(b, h) (((b) * 2 + (h)) * HTB)
#define PG8_SB(b, h) ((4 + (b) * 2 + (h)) * HTB)
#define PG8_STAGE(bufoff, gbase, voff) do { _Pragma("unroll") for (int _i = 0; _i < 2; ++_i) \
        __builtin_amdgcn_global_load_lds((const unsigned*)((const char*)(gbase) + (voff)[_i]), (PG8_LAS unsigned*)(lds + (bufoff) + ldsw + _i * 8192), 16, 0, 0); } while (0)
#define PG8_LDA(dst, b, h) do { _Pragma("unroll") for (int m = 0; m < 4; ++m) _Pragma("unroll") for (int k = 0; k < 2; ++k) dst[m][k] = *(const PG8_LAS bf16x8*)(lds + PG8_SA(b, h) + aoff + m * 2048 + k * 1024); } while (0)
#define PG8_LDB(dst, b, h) do { _Pragma("unroll") for (int n = 0; n < 2; ++n) _Pragma("unroll") for (int k = 0; k < 2; ++k) dst[n][k] = *(const PG8_LAS bf16x8*)(lds + PG8_SB(b, h) + boff + n * 2048 + k * 1024); } while (0)
#define PG8_MMA(ai, bj, At, Bt) do { __builtin_amdgcn_s_setprio(1); _Pragma("unroll") for (int m = 0; m < 4; ++m) _Pragma("unroll") for (int n = 0; n < 2; ++n) _Pragma("unroll") for (int k = 0; k < 2; ++k) \
        acc[ai][bj][m][n] = __builtin_amdgcn_mfma_f32_16x16x32_bf16(Bt[n][k], At[m][k], acc[ai][bj][m][n], 0, 0, 0); __builtin_amdgcn_s_setprio(0); } while (0)
#define PG8_WAIT_V(n) asm volatile("s_waitcnt vmcnt(" #n ")" ::: "memory")
#define PG8_WAIT_L(n) asm volatile("s_waitcnt lgkmcnt(" #n ")" ::: "memory")
#define PG8_BAR __builtin_amdgcn_s_barrier()
#define PG8_SCHED __builtin_amdgcn_sched_barrier(0)
    Unit cur, nxt; int ui = 0;
    if (!S.next(0, cur)) return;
    f32x4 acc[2][2][4][2];
#pragma unroll
    for (int a = 0; a < 2; ++a)
#pragma unroll
        for (int b = 0; b < 2; ++b)
#pragma unroll
            for (int m = 0; m < 4; ++m)
#pragma unroll
                for (int n = 0; n < 2; ++n) acc[a][b][m][n] = (f32x4){0.f, 0.f, 0.f, 0.f};
    bf16x8 At[4][2], B0[2][2], B1[2][2];
    const char* cA = (const char*)g.A + (size_t)cur.pm * tstep; const char* cB = (const char*)g.Bt + (size_t)cur.brow * rowB;
    S.a_ready(cur);
    PG8_STAGE(PG8_SB(0, 0), cB, voffB); PG8_STAGE(PG8_SA(0, 0), cA, voffA); PG8_STAGE(PG8_SB(0, 1), cB + hstepB, voffB); PG8_STAGE(PG8_SA(0, 1), cA + hstep, voffA);
    if (wr == 1) PG8_BAR;
    PG8_WAIT_V(4); PG8_BAR;
    PG8_STAGE(PG8_SB(1, 0), cB + kstep, voffB); PG8_STAGE(PG8_SA(1, 0), cA + kstep, voffA); PG8_STAGE(PG8_SB(1, 1), cB + hstepB + kstep, voffB);
    PG8_WAIT_V(6); PG8_BAR;
    for (;;) {
        const bool has_next = S.next(ui + 1, nxt);
        const char* nA = has_next ? (const char*)g.A + (size_t)nxt.pm * tstep : cA; const char* nB = has_next ? (const char*)g.Bt + (size_t)nxt.brow * rowB : cB;
        for (int t = 0; t < nt; t += 2) {
            const bool last = (t == nt - 2);
            const char* a1 = cA + (size_t)(t + 1) * kstep;
            const char* a2 = last ? nA : cA + (size_t)(t + 2) * kstep; const char* b2 = last ? nB : cB + (size_t)(t + 2) * kstep;
            const char* a3 = a2 + kstep; const char* b3 = b2 + kstep;
            if (last && has_next) S.a_ready(nxt);
            PG8_LDB(B0, 0, 0); PG8_SCHED; PG8_LDA(At, 0, 0); PG8_STAGE(PG8_SA(1, 1), a1 + hstep, voffA);
            PG8_WAIT_L(8); PG8_BAR; PG8_WAIT_L(0); PG8_MMA(0, 0, At, B0); PG8_BAR; PG8_SCHED;
            PG8_LDB(B1, 0, 1); PG8_STAGE(PG8_SB(0, 0), b2, voffB);
            PG8_BAR; PG8_WAIT_L(0); PG8_MMA(0, 1, At, B1); PG8_BAR;
            PG8_LDA(At, 0, 1); PG8_STAGE(PG8_SA(0, 0), a2, voffA);
            PG8_BAR; PG8_WAIT_L(0); PG8_MMA(1, 0, At, B0); PG8_BAR; PG8_SCHED;
            PG8_STAGE(PG8_SB(0, 1), b2 + hstepB, voffB);
            PG8_WAIT_V(6); PG8_BAR; PG8_MMA(1, 1, At, B1); PG8_BAR;
            PG8_LDB(B0, 1, 0); PG8_SCHED; PG8_LDA(At, 1, 0); PG8_STAGE(PG8_SA(0, 1), a2 + hstep, voffA);
            PG8_WAIT_L(8); PG8_BAR; PG8_WAIT_L(0); PG8_MMA(0, 0, At, B0); PG8_BAR; PG8_SCHED;
            PG8_LDB(B1, 1, 1); PG8_STAGE(PG8_SB(1, 0), b3, voffB);
            PG8_BAR; PG8_WAIT_L(0); PG8_MMA(0, 1, At, B1); PG8_BAR;
            PG8_LDA(At, 1, 1); PG8_STAGE(PG8_SA(1, 0), a3, voffA);
            PG8_BAR; PG8_WAIT_L(0); PG8_MMA(1, 0, At, B0); PG8_BAR; PG8_SCHED;
            PG8_STAGE(PG8_SB(1, 1), b3 + hstepB, voffB);
            PG8_WAIT_V(6); PG8_BAR; PG8_MMA(1, 1, At, B1); PG8_BAR;
        }
        if constexpr (!Epi::AFTER_DRAIN) { E(acc, cur, wr, wc, fr, fq); S.done(cur); }
        if (!has_next) break;
#pragma unroll
        for (int a = 0; a < 2; ++a)
#pragma unroll
            for (int b = 0; b < 2; ++b)
#pragma unroll
                for (int m = 0; m < 4; ++m)
#pragma unroll
                    for (int n = 0; n < 2; ++n) acc[a][b][m][n] = (f32x4){0.f, 0.f, 0.f, 0.f};
        cur = nxt; cA = nA; cB = nB; ++ui;
    }
    PG8_WAIT_V(0);
    if (wr == 0) PG8_BAR;
    PG8_BAR;
    if constexpr (Epi::AFTER_DRAIN) { E.fused(acc, cur, wr, wc, fr, fq, lds, wid, lane); S.done(cur); }
#undef PG8_SA
#undef PG8_SB
#undef PG8_STAGE
#undef PG8_LDA
#undef PG8_LDB
#undef PG8_MMA
#undef PG8_WAIT_V
#undef PG8_WAIT_L
#undef PG8_BAR
#undef PG8_SCHED
}

}

DI void phase_p1(const Params& p, char* smem) {
    const int tid = threadIdx.x, wid = tid >> 6, lane = tid & 63, fr = lane & 15, fq = lane >> 4, wr = wid >> 1, wc = wid & 1;
    unsigned char* ws = p.ws;
    const bf16_t* hb = (const bf16_t*)(ws + OFF_H);
    const bf16_t* wt = (const bf16_t*)(ws + OFF_WIN);
    const f32x2* tab = (const f32x2*)(ws + OFF_ROPE);
    bf16_t* qb = (bf16_t*)(ws + OFF_Q); bf16_t* kb = (bf16_t*)(ws + OFF_KB); bf16_t* vT = (bf16_t*)(ws + OFF_VT);
    bf16_t* zr = (bf16_t*)(p.out + OUT_Y);
    const int MT = M / 256, NT = 21;
    for (int t = blockIdx.x; t < MT * NT; t += gridDim.x) {
        int mt, nt; tile_coords(t, MT, NT, mt, nt);
        const int row0 = mt * 256, ncol0 = nt < 6 ? nt * 128 : 2816 + (nt - 6) * 128;
        f32x4 acc[4][4]; zero_acc<4>(acc);
        gemm_acc<4>(acc, hb + (size_t)row0 * 1024, 1024, wt + (size_t)ncol0 * 1024, 1024, 1024, smem, tid);
        const bool latent = row0 >= MC;
#pragma unroll
        for (int mb = 0; mb < 4; ++mb) {
            const int m = row0 + wr * 64 + mb * 16 + fr;
            if (nt < 5 && latent) {
                const int tt = (m - MC) & 2047, prow = tt >> 6, pcol = tt & 63;
#pragma unroll
                for (int j = 0; j < 4; ++j) {
                    const f32x2 cr = tab[prow * 16 + fq * 4 + j], cc = tab[pcol * 16 + fq * 4 + j];
                    const float a1 = acc[mb][0][j], a2 = acc[mb][1][j], b1 = acc[mb][2][j], b2 = acc[mb][3][j];
                    acc[mb][0][j] = a1 * cr.x - a2 * cr.y; acc[mb][1][j] = a2 * cr.x + a1 * cr.y;
                    acc[mb][2][j] = b1 * cc.x - b2 * cc.y; acc[mb][3][j] = b2 * cc.x + b1 * cc.y;
                }
            }
#pragma unroll
            for (int nb = 0; nb < 4; ++nb) {
                const int nl = wc * 64 + nb * 16 + fq * 4;
                const f32x4 v = acc[mb][nb];
                if (nt < 4) { *(u32x2*)(qb + (size_t)m * 512 + nt * 128 + nl) = pack4(v); }
                else if (nt == 4) {
                    if (!latent) *(f32x4*)(p.out + OUT_K + (size_t)m * 128 + nl) = v;
                    *(u32x2*)(kb + (size_t)m * 128 + nl) = pack4(v);
                } else if (nt == 5) {
                    if (!latent) *(f32x4*)(p.out + OUT_V + (size_t)m * 128 + nl) = v;
                    int r0, T; seq_of(m, r0, T);
#pragma unroll
                    for (int j = 0; j < 4; ++j) vT[(size_t)r0 * 128 + (size_t)(nl + j) * T + (m - r0)] = f2bf(v[j]);
                } else { *(u32x2*)(zr + (size_t)m * ZRC + (nt - 6) * 128 + nl) = pack4(v); }
            }
        }
    }
}

#define MFMA32(a, b, c) __builtin_amdgcn_mfma_f32_32x32x16_bf16((a), (b), (c), 0, 0, 0)
DI int crow(int i, int h) { return (i & 3) + 8 * (i >> 2) + 4 * h; }

DI void attn_item(const Params& p, char* smem, int it) {
    const int tid = threadIdx.x, wv = tid >> 6, lane = tid & 63, r = lane & 31, hh = lane >> 5;
    unsigned char* ws = p.ws;
    const bf16_t* qb = (const bf16_t*)(ws + OFF_Q); const bf16_t* kb = (const bf16_t*)(ws + OFF_KB); const bf16_t* vT = (const bf16_t*)(ws + OFF_VT);
    const bf16_t* kc = (const bf16_t*)(ws + OFF_KC); const bf16_t* vct = (const bf16_t*)(ws + OFF_VCT);
    bf16_t* ab = (bf16_t*)(ws + OFF_ATTN);
    bf16_t* Ks = (bf16_t*)smem;
    bf16_t* Vt = (bf16_t*)(smem + 9216);
    const float SC = 0.125f * LOG2E;
    {
        int r0, T, q0, kvh, bl;
        const bool lat = it < 512;
        if (lat) { bl = it >> 6; const int rem = it & 63; q0 = (rem >> 1) * 64; kvh = rem & 1; r0 = MC + bl * 2048; T = 2048; }
        else { const int i2 = it - 512; bl = 0; const int s = i2 >> 3, rem = i2 & 7; q0 = (rem >> 1) * 64; kvh = rem & 1; r0 = s * 256; T = 256; }
        const int head = kvh * 4 + (wv & 3), sub = wv >> 2, qs = q0 + 32 * sub;
        bf16x8 qf[4];
#pragma unroll
        for (int kk = 0; kk < 4; ++kk) qf[kk] = *(const bf16x8*)(qb + (size_t)(r0 + qs + r) * 512 + head * 64 + 16 * kk + 8 * hh);
        const float sinkl = p.attn_sink[head] * LOG2E;
        float mrun = sinkl, lrun = hh == 0 ? 1.0f : 0.0f;
        f32x16 o0, o1;
#pragma unroll
        for (int i = 0; i < 16; ++i) { o0[i] = 0.f; o1[i] = 0.f; }
        const int nwin = lat ? 5 : 4, ntile = lat ? 13 : 4;
        for (int ti = 0; ti < ntile; ++ti) {
            const bf16_t* ksrc; const bf16_t* vsrc; int vstride, ks0; bool window;
            if (ti < nwin) {
                ks0 = lat ? q0 - 128 + 64 * ti : 64 * ti; window = lat;
                if (ks0 < 0 || ks0 >= T) continue;
                ksrc = kb + (size_t)(r0 + ks0) * 128 + kvh * 64; vsrc = vT + (size_t)r0 * 128 + (size_t)(kvh * 64) * T + ks0; vstride = T;
            } else {
                ks0 = 64 * (ti - nwin); window = false;
                ksrc = kc + (size_t)(bl * 512 + ks0) * 128 + kvh * 64; vsrc = vct + (size_t)((bl * 2 + kvh) * 64) * 512 + ks0; vstride = 512;
            }
            __syncthreads();
            {
                const int rw_ = tid >> 3, ch = tid & 7;
                *(u32x4*)(Ks + rw_ * 72 + ch * 8) = *(const u32x4*)(ksrc + (size_t)rw_ * 128 + ch * 8);
                *(u32x4*)(Vt + rw_ * 72 + ch * 8) = *(const u32x4*)(vsrc + (size_t)rw_ * vstride + ch * 8);
            }
            __syncthreads();
#pragma unroll
            for (int sk = 0; sk < 2; ++sk) {
                const int kb0 = ks0 + 32 * sk;
                bool need_mask = false;
                if (window) {
                    if (kb0 > qs + 31 + 128 || kb0 + 31 < qs - 128) continue;
                    need_mask = (kb0 < qs + 31 - 128) || (kb0 + 31 > qs + 128);
                }
                f32x16 x;
#pragma unroll
                for (int i = 0; i < 16; ++i) x[i] = 0.f;
#pragma unroll
                for (int kk = 0; kk < 4; ++kk) {
                    const bf16x8 kf = *(const bf16x8*)(Ks + (32 * sk + r) * 72 + 16 * kk + 8 * hh);
                    x = MFMA32(kf, qf[kk], x);
                }
                float mx = -3.0e38f;
#pragma unroll
                for (int i = 0; i < 16; ++i) {
                    float s = x[i] * SC;
                    if (need_mask) { const int dk = kb0 + crow(i, hh) - (qs + r); if (dk > 128 || dk < -128) s = -3.0e38f; }
                    x[i] = s; mx = fmaxf(mx, s);
                }
                mx = fmaxf(mx, __shfl_xor(mx, 32));
                const float mnew = fmaxf(mrun, mx), alpha = exp2f(mrun - mnew);
                mrun = mnew;
                float ps = 0.f;
#pragma unroll
                for (int i = 0; i < 16; ++i) { const float pv = exp2f(x[i] - mnew); x[i] = pv; ps += pv; }
                lrun = lrun * alpha + ps;
#pragma unroll
                for (int i = 0; i < 16; ++i) { o0[i] *= alpha; o1[i] *= alpha; }
#pragma unroll
                for (int s = 0; s < 2; ++s) {
                    u32x4 pk;
                    pk[0] = pack2(x[8 * s + 0], x[8 * s + 1]); pk[1] = pack2(x[8 * s + 2], x[8 * s + 3]);
                    pk[2] = pack2(x[8 * s + 4], x[8 * s + 5]); pk[3] = pack2(x[8 * s + 6], x[8 * s + 7]);
                    const bf16x8 pf = __builtin_bit_cast(bf16x8, pk);
                    {
                        const s16x4 lo = *(const s16x4*)(Vt + r * 72 + 32 * sk + 16 * s + 4 * hh);
                        const s16x4 hi = *(const s16x4*)(Vt + r * 72 + 32 * sk + 16 * s + 8 + 4 * hh);
                        const bf16x8 vf = __builtin_shufflevector(lo, hi, 0, 1, 2, 3, 4, 5, 6, 7);
                        o0 = MFMA32(vf, pf, o0);
                    }
                    {
                        const s16x4 lo = *(const s16x4*)(Vt + (32 + r) * 72 + 32 * sk + 16 * s + 4 * hh);
                        const s16x4 hi = *(const s16x4*)(Vt + (32 + r) * 72 + 32 * sk + 16 * s + 8 + 4 * hh);
                        const bf16x8 vf = __builtin_shufflevector(lo, hi, 0, 1, 2, 3, 4, 5, 6, 7);
                        o1 = MFMA32(vf, pf, o1);
                    }
                }
            }
        }
        const float ltot = lrun + __shfl_xor(lrun, 32), inv = rcpf_(ltot);
        bf16_t* orow = ab + (size_t)(r0 + qs + r) * 512 + head * 64;
#pragma unroll
        for (int g = 0; g < 4; ++g) {
            f32x4 a, b;
#pragma unroll
            for (int j = 0; j < 4; ++j) { a[j] = o0[4 * g + j] * inv; b[j] = o1[4 * g + j] * inv; }
            *(u32x2*)(orow + 8 * g + 4 * hh) = pack4(a);
            *(u32x2*)(orow + 32 + 8 * g + 4 * hh) = pack4(b);
        }
    }
    __syncthreads();
}

DI void sg_pass(const Params& p) {
    const int tid = threadIdx.x;
    unsigned char* ws = p.ws;
    {
        const bf16_t* zr = (const bf16_t*)(p.out + OUT_Y);
        bf16_t* sg = (bf16_t*)(ws + OFF_SG);
        const float* mu0 = p.rwkv_mu; const float* mu1 = p.rwkv_mu + ZRC;
        for (int i = blockIdx.x * NTHR + tid; i < M * 32; i += gridDim.x * NTHR) {
            const int m = i >> 5, c = (i & 31) * 4;
            int r0, T; seq_of(m, r0, T);
            const bf16_t* zp = zr + (size_t)m * ZRC + 1792 + c;
            const f32x4 z = unpack4(*(const u32x2*)zp);
            f32x4 zprev = (f32x4){0.f, 0.f, 0.f, 0.f}, znext = zprev;
            if (m > r0) zprev = unpack4(*(const u32x2*)(zp - ZRC));
            if (m < r0 + T - 1) znext = unpack4(*(const u32x2*)(zp + ZRC));
            const f32x4 a0 = *(const f32x4*)(mu0 + 1792 + c), a1 = *(const f32x4*)(mu1 + 1792 + c);
            f32x4 o;
#pragma unroll
            for (int j = 0; j < 4; ++j) { const float zs = z[j] + a0[j] * (zprev[j] - z[j]) + a1[j] * (znext[j] - z[j]); o[j] = sigmoidf_(zs); }
            *(u32x2*)(sg + (size_t)m * 128 + c) = pack4(o);
        }
    }
}


template <int CTRL> DI float dpp_f(float x) { return __builtin_bit_cast(float, __builtin_amdgcn_mov_dpp(__builtin_bit_cast(int, x), CTRL, 0xf, 0xf, true)); }
DI float swap32_sum(float x) {
    float a = x, b = x;
    asm volatile("s_nop 1\n\tv_permlane32_swap_b32 %0, %1\n\ts_nop 1" : "+v"(a), "+v"(b));
    return a + b;
}
DI float row16_allsum(float x) { x += dpp_f<0x128>(x); x += dpp_f<0x124>(x); x += dpp_f<0x122>(x); x += dpp_f<0x121>(x); return x; }
template <int E> DI float qbc(f32x2 v) { return dpp_f<(E >> 1) * 0x55>((E & 1) ? v.y : v.x); }

#define QP0 " quad_perm:[0,0,0,0] row_mask:0xf bank_mask:0xf bound_ctrl:1\n\t"
#define QP1 " quad_perm:[1,1,1,1] row_mask:0xf bank_mask:0xf bound_ctrl:1\n\t"
#define QP2 " quad_perm:[2,2,2,2] row_mask:0xf bank_mask:0xf bound_ctrl:1\n\t"
#define QP3 " quad_perm:[3,3,3,3] row_mask:0xf bank_mask:0xf bound_ctrl:1\n\t"
#define ROR4 " row_ror:4 row_mask:0xf bank_mask:0xf bound_ctrl:1\n\t"
#define ROR8 " row_ror:8 row_mask:0xf bank_mask:0xf bound_ctrl:1\n\t"
DI float scan_sa(const float (&S)[8], f32x2 A) {
    float sa, t1, t2, t3;
    asm volatile(
        "s_nop 1\n\t"
        "v_mul_f32_dpp %0, %12, %4" QP0
        "v_mul_f32_dpp %1, %13, %5" QP0
        "v_mul_f32_dpp %2, %12, %6" QP1
        "v_mul_f32_dpp %3, %13, %7" QP1
        "v_fmac_f32_dpp %0, %12, %8" QP2
        "v_fmac_f32_dpp %1, %13, %9" QP2
        "v_fmac_f32_dpp %2, %12, %10" QP3
        "v_fmac_f32_dpp %3, %13, %11" QP3
        "v_add_f32 %0, %0, %1\n\t"
        "v_add_f32 %2, %2, %3\n\t"
        "v_add_f32 %0, %0, %2\n\t"
        "s_nop 1\n\t"
        "v_add_f32_dpp %0, %0, %0" ROR4
        "s_nop 1\n\t"
        "v_add_f32_dpp %0, %0, %0" ROR8
        "v_mov_b32 %1, %0\n\t"
        "s_nop 1\n\t"
        "v_permlane32_swap_b32 %0, %1\n\t"
        "s_nop 1\n\t"
        "v_add_f32 %0, %0, %1"
        : "=&v"(sa), "=&v"(t1), "=&v"(t2), "=&v"(t3)
        : "v"(S[0]), "v"(S[1]), "v"(S[2]), "v"(S[3]), "v"(S[4]), "v"(S[5]), "v"(S[6]), "v"(S[7]), "v"(A.x), "v"(A.y));
    return sa;
}
DI float scan_upd(float (&S)[8], float sa, float vv, f32x2 B, f32x2 K, f32x2 W, f32x2 R) {
    float n0, n1, n2, n3, n4, n5, n6, n7, y0, y1, y2, y3;
    asm volatile(
        "s_nop 1\n\t"
        "v_mul_f32_dpp %0, %22, %20" QP0  "v_mul_f32_dpp %1, %23, %20" QP0  "v_mul_f32_dpp %2, %22, %20" QP1  "v_mul_f32_dpp %3, %23, %20" QP1
        "v_mul_f32_dpp %4, %22, %20" QP2  "v_mul_f32_dpp %5, %23, %20" QP2  "v_mul_f32_dpp %6, %22, %20" QP3  "v_mul_f32_dpp %7, %23, %20" QP3
        "v_fmac_f32_dpp %0, %24, %21" QP0  "v_fmac_f32_dpp %1, %25, %21" QP0  "v_fmac_f32_dpp %2, %24, %21" QP1  "v_fmac_f32_dpp %3, %25, %21" QP1
        "v_fmac_f32_dpp %4, %24, %21" QP2  "v_fmac_f32_dpp %5, %25, %21" QP2  "v_fmac_f32_dpp %6, %24, %21" QP3  "v_fmac_f32_dpp %7, %25, %21" QP3
        "v_fmac_f32_dpp %0, %26, %12" QP0  "v_fmac_f32_dpp %1, %27, %13" QP0  "v_fmac_f32_dpp %2, %26, %14" QP1  "v_fmac_f32_dpp %3, %27, %15" QP1
        "v_fmac_f32_dpp %4, %26, %16" QP2  "v_fmac_f32_dpp %5, %27, %17" QP2  "v_fmac_f32_dpp %6, %26, %18" QP3  "v_fmac_f32_dpp %7, %27, %19" QP3
        "v_mul_f32_dpp %8, %28, %0" QP0   "v_mul_f32_dpp %9, %29, %1" QP0   "v_mul_f32_dpp %10, %28, %2" QP1  "v_mul_f32_dpp %11, %29, %3" QP1
        "v_fmac_f32_dpp %8, %28, %4" QP2  "v_fmac_f32_dpp %9, %29, %5" QP2  "v_fmac_f32_dpp %10, %28, %6" QP3 "v_fmac_f32_dpp %11, %29, %7" QP3
        "v_add_f32 %8, %8, %9\n\t"
        "v_add_f32 %10, %10, %11\n\t"
        "v_add_f32 %8, %8, %10\n\t"
        "s_nop 1\n\t"
        "v_add_f32_dpp %8, %8, %8" ROR4
        "s_nop 1\n\t"
        "v_add_f32_dpp %8, %8, %8" ROR8
        "v_mov_b32 %9, %8\n\t"
        "s_nop 1\n\t"
        "v_permlane32_swap_b32 %8, %9\n\t"
        "s_nop 1\n\t"
        "v_add_f32 %8, %8, %9"
        : "=&v"(n0), "=&v"(n1), "=&v"(n2), "=&v"(n3), "=&v"(n4), "=&v"(n5), "=&v"(n6), "=&v"(n7), "=&v"(y0), "=&v"(y1), "=&v"(y2), "=&v"(y3)
        : "v"(S[0]), "v"(S[1]), "v"(S[2]), "v"(S[3]), "v"(S[4]), "v"(S[5]), "v"(S[6]), "v"(S[7]), "v"(sa), "v"(vv),
          "v"(B.x), "v"(B.y), "v"(K.x), "v"(K.y), "v"(W.x), "v"(W.y), "v"(R.x), "v"(R.y));
    S[0] = n0; S[1] = n1; S[2] = n2; S[3] = n3; S[4] = n4; S[5] = n5; S[6] = n6; S[7] = n7;
    return y0;
}

constexpr int SC_OPW = 0, SC_OPK = 8192, SC_OPA = 16384, SC_OPB = 24576, SC_OPR = 32768, SC_OPV = 40960;
constexpr int SC_AW = 49152, SC_AA = SC_AW + 32 * 144;
constexpr int SC_LO = SC_AA + 32 * 144;
constexpr int SC_YB = SC_LO + 2 * 32 * 68 * 4;
static_assert(SC_YB + 8192 <= LDS_MAIN, "scan LDS");

DI void lds_barrier() { asm volatile("s_waitcnt lgkmcnt(0)\n\ts_barrier" ::: "memory"); }

constexpr int S2_OP = 0;
constexpr int S2_AW = 49152, S2_AA = S2_AW + 2304;
constexpr int S2_LO = S2_AA + 2304;
constexpr int S2_YB = S2_LO + 8704;
static_assert(S2_YB + 8192 <= LDS_MAIN, "scan LDS");

DI void scan_item(const Params& p, char* smem, int r0, int T, int dsel, int h, const float* state0, float* state_out) {
    const int tid = threadIdx.x, wv = tid >> 6, lane = tid & 63;
    const bool is_scan = wv < 4;
    unsigned char* ws = p.ws;
    const bf16_t* zr = (const bf16_t*)(p.out + OUT_Y);
    float* ys = (float*)(ws + OFF_YS) + (size_t)dsel * M * 512;
    float* bn = (float*)(ws + OFF_BN);
    float* op = (float*)(smem + S2_OP);
    bf16_t* Aw = (bf16_t*)(smem + S2_AW); bf16_t* Aa = (bf16_t*)(smem + S2_AA);
    float* Lo = (float*)(smem + S2_LO); float* yb = (float*)(smem + S2_YB);
    const int nchunk = T >> 4;

    const int rr = (lane & 3) | ((lane >> 4) << 2), jq = (lane >> 2) & 3, irow = 16 * (wv & 3) + rr, jb = 16 * jq;
    f32x4 S0, S1, S2, S3;
    if (state0 && is_scan) {
        const float* sp = state0 + irow * 64 + jb;
        S0 = *(const f32x4*)sp; S1 = *(const f32x4*)(sp + 4); S2 = *(const f32x4*)(sp + 8); S3 = *(const f32x4*)(sp + 12);
    } else { S0 = (f32x4){0.f, 0.f, 0.f, 0.f}; S1 = S0; S2 = S0; S3 = S0; }

    const int ptid = tid & 255, tt = ptid >> 4, cg4 = (ptid & 15) * 4;
    const int segc[5] = {h * 64 + cg4, 512 + h * 64 + cg4, 1024 + h * 64 + cg4, 1536 + dsel * 64 + cg4, 1664 + dsel * 64 + cg4};
    const int pL = (wv >> 1) & 1, pnh = wv & 1, fr = lane & 15, fq = lane >> 4;
    const bf16_t* wt = (const bf16_t*)(ws + (pL == 0 ? OFF_W2T : OFF_A2T)) + (size_t)(dsel * 512 + h * 64) * 64;
    u32x2 zc[5], zp[5], zn[5];
    f32x4 kreg, kkreg, rreg;
    auto load_chunk = [&](int c) {
        const int st = 16 * c + tt, tok = dsel ? T - 1 - st : st;
        const bf16_t* base = zr + (size_t)(r0 + tok) * ZRC;
#pragma unroll
        for (int s = 0; s < 5; ++s) {
            zc[s] = *(const u32x2*)(base + segc[s]);
            zp[s] = (u32x2){0u, 0u}; zn[s] = (u32x2){0u, 0u};
            if (tok > 0) zp[s] = *(const u32x2*)(base - ZRC + segc[s]);
            if (tok < T - 1) zn[s] = *(const u32x2*)(base + ZRC + segc[s]);
        }
    };
    auto prodA = [&](int buf) {
        f32x4 zs[5];
#pragma unroll
        for (int s = 0; s < 5; ++s) {
            const f32x4 mu0 = *(const f32x4*)(p.rwkv_mu + segc[s]), mu1 = *(const f32x4*)(p.rwkv_mu + ZRC + segc[s]);
            const f32x4 z = unpack4(zc[s]), a = unpack4(zp[s]), b = unpack4(zn[s]);
            zs[s] = z + mu0 * (a - z) + mu1 * (b - z);
        }
        const f32x4 kkv = *(const f32x4*)(p.rwkv_k_k + h * 64 + cg4);
        f32x4 kk = zs[1] * kkv;
        float n2 = kk[0] * kk[0] + kk[1] * kk[1] + kk[2] * kk[2] + kk[3] * kk[3];
        n2 = row16_allsum(n2);
        kk = kk * __builtin_amdgcn_rsqf(fmaxf(n2, 1e-24f));
        f32x4 tw;
#pragma unroll
        for (int j = 0; j < 4; ++j) tw[j] = 1.0f - 2.0f * rcpf_(1.0f + __expf(2.0f * zs[3][j]));
        *(u32x2*)(Aw + tt * 72 + cg4) = pack4(tw);
        *(u32x2*)(Aa + tt * 72 + cg4) = pack4(zs[4]);
        float* ob = op + buf * 6144 + tt * 64 + cg4;
        *(f32x4*)(ob + 4 * 1024) = zs[0];
        *(f32x4*)(ob + 5 * 1024) = zs[2];
        *(f32x4*)(ob + 2 * 1024) = -kk;
        kreg = zs[1]; kkreg = kk; rreg = zs[0];
    };
    auto prodB = [&]() {
        const bf16_t* As = pL == 0 ? Aw : Aa;
        const bf16x8 a0 = *(const bf16x8*)(As + fr * 72 + fq * 8), a1 = *(const bf16x8*)(As + fr * 72 + 32 + fq * 8);
#pragma unroll
        for (int n2 = 0; n2 < 2; ++n2) {
            f32x4 x = (f32x4){0.f, 0.f, 0.f, 0.f};
            const bf16_t* wr_ = wt + (size_t)((pnh * 2 + n2) * 16 + fr) * 64 + fq * 8;
            x = __builtin_amdgcn_mfma_f32_16x16x32_bf16(a0, *(const bf16x8*)wr_, x, 0, 0, 0);
            x = __builtin_amdgcn_mfma_f32_16x16x32_bf16(a1, *(const bf16x8*)(wr_ + 32), x, 0, 0, 0);
#pragma unroll
            for (int j = 0; j < 4; ++j) Lo[(pL * 16 + fq * 4 + j) * 68 + (pnh * 2 + n2) * 16 + fr] = x[j];
        }
    };
    auto prodC = [&](int c, int buf) {
        const int st = 16 * c + tt, tok = dsel ? T - 1 - st : st, m = r0 + tok;
        const f32x4 w0v = *(const f32x4*)(p.rwkv_w0 + dsel * 512 + h * 64 + cg4), a0v = *(const f32x4*)(p.rwkv_a0 + dsel * 512 + h * 64 + cg4);
        const f32x4 kav = *(const f32x4*)(p.rwkv_k_a + h * 64 + cg4), rkv = *(const f32x4*)(p.rwkv_r_k + h * 64 + cg4);
        const f32x4 lw = *(const f32x4*)(Lo + tt * 68 + cg4), la = *(const f32x4*)(Lo + (16 + tt) * 68 + cg4);
        f32x4 wd, kd, bb; float bs = 0.f;
#pragma unroll
        for (int j = 0; j < 4; ++j) {
            wd[j] = __expf(-0.6065306597126334f * sigmoidf_(w0v[j] + lw[j]));
            const float a = sigmoidf_(a0v[j] + la[j]);
            kd[j] = kreg[j] * (1.0f + (a - 1.0f) * kav[j]);
            bb[j] = a * kkreg[j];
            bs += rreg[j] * kd[j] * rkv[j];
        }
        float* ob = op + buf * 6144 + tt * 64 + cg4;
        *(f32x4*)(ob) = wd;
        *(f32x4*)(ob + 1024) = kd;
        *(f32x4*)(ob + 3 * 1024) = bb;
        bs = row16_allsum(bs);
        if ((ptid & 15) == 0) bn[(size_t)m * 16 + dsel * 8 + h] = bs;
    };
    auto flush_ys = [&](int c) {
        const int st = 16 * c + tt, tok = dsel ? T - 1 - st : st, m = r0 + tok;
        *(f32x4*)(ys + (size_t)m * 512 + h * 64 + cg4) = *(const f32x4*)(yb + (c & 1) * 1024 + tt * 64 + cg4);
    };
    auto chunk_steps = [&](int buf) {
        const float* ob = op + buf * 6144 + jb;
        const float* ov = op + buf * 6144 + 5 * 1024 + irow;
        float* yo = yb + buf * 1024 + irow;
        f32x4 W0 = *(const f32x4*)(ob), W1 = *(const f32x4*)(ob + 4), W2 = *(const f32x4*)(ob + 8), W3 = *(const f32x4*)(ob + 12);
        f32x4 K0 = *(const f32x4*)(ob + 1024), K1 = *(const f32x4*)(ob + 1028), K2 = *(const f32x4*)(ob + 1032), K3 = *(const f32x4*)(ob + 1036);
        f32x4 A0 = *(const f32x4*)(ob + 2048), A1 = *(const f32x4*)(ob + 2052), A2 = *(const f32x4*)(ob + 2056), A3 = *(const f32x4*)(ob + 2060);
        f32x4 B0 = *(const f32x4*)(ob + 3072), B1 = *(const f32x4*)(ob + 3076), B2 = *(const f32x4*)(ob + 3080), B3 = *(const f32x4*)(ob + 3084);
        f32x4 R0 = *(const f32x4*)(ob + 4096), R1 = *(const f32x4*)(ob + 4100), R2 = *(const f32x4*)(ob + 4104), R3 = *(const f32x4*)(ob + 4108);
        float vv = ov[0];
#pragma unroll 2
        for (int s = 0; s < 16; ++s) {
            const float* o = ob + ((s + 1) & 15) * 64;
            const f32x4 W0n = *(const f32x4*)(o), W1n = *(const f32x4*)(o + 4), W2n = *(const f32x4*)(o + 8), W3n = *(const f32x4*)(o + 12);
            const f32x4 K0n = *(const f32x4*)(o + 1024), K1n = *(const f32x4*)(o + 1028), K2n = *(const f32x4*)(o + 1032), K3n = *(const f32x4*)(o + 1036);
            const f32x4 A0n = *(const f32x4*)(o + 2048), A1n = *(const f32x4*)(o + 2052), A2n = *(const f32x4*)(o + 2056), A3n = *(const f32x4*)(o + 2060);
            const f32x4 B0n = *(const f32x4*)(o + 3072), B1n = *(const f32x4*)(o + 3076), B2n = *(const f32x4*)(o + 3080), B3n = *(const f32x4*)(o + 3084);
            const f32x4 R0n = *(const f32x4*)(o + 4096), R1n = *(const f32x4*)(o + 4100), R2n = *(const f32x4*)(o + 4104), R3n = *(const f32x4*)(o + 4108);
            const float vn = ov[((s + 1) & 15) * 64];
            const f32x4 pa = (S0 * A0 + S1 * A1) + (S2 * A2 + S3 * A3);
            float sa = (pa[0] + pa[1]) + (pa[2] + pa[3]);
            sa += dpp_f<0x124>(sa); sa += dpp_f<0x128>(sa);
            S0 = S0 * W0 + (B0 * sa + K0 * vv);
            S1 = S1 * W1 + (B1 * sa + K1 * vv);
            S2 = S2 * W2 + (B2 * sa + K2 * vv);
            S3 = S3 * W3 + (B3 * sa + K3 * vv);
            const f32x4 py = (S0 * R0 + S1 * R1) + (S2 * R2 + S3 * R3);
            float y = (py[0] + py[1]) + (py[2] + py[3]);
            y += dpp_f<0x124>(y); y += dpp_f<0x128>(y);
            if (jq == 0) yo[s * 64] = y;
            W0 = W0n; W1 = W1n; W2 = W2n; W3 = W3n; K0 = K0n; K1 = K1n; K2 = K2n; K3 = K3n; A0 = A0n; A1 = A1n; A2 = A2n; A3 = A3n;
            B0 = B0n; B1 = B1n; B2 = B2n; B3 = B3n; R0 = R0n; R1 = R1n; R2 = R2n; R3 = R3n; vv = vn;
            if (s == 4 || s == 9) lds_barrier();
        }
    };

    lds_barrier();
    if (is_scan) {
        lds_barrier(); lds_barrier(); lds_barrier();
#pragma unroll 1
        for (int c = 0; c < nchunk; ++c) {
            chunk_steps(c & 1);
            lds_barrier();
        }
        if (state_out) {
            float* sp = state_out + irow * 64 + jb;
            *(f32x4*)sp = S0; *(f32x4*)(sp + 4) = S1; *(f32x4*)(sp + 8) = S2; *(f32x4*)(sp + 12) = S3;
        }
    } else {
        load_chunk(0); prodA(0);
        lds_barrier();
        prodB();
        lds_barrier();
        prodC(0, 0); if (nchunk > 1) load_chunk(1);
        lds_barrier();
#pragma unroll 1
        for (int c = 0; c < nchunk; ++c) {
            const int b = c & 1;
            const bool more = c + 1 < nchunk;
            if (c > 0) flush_ys(c - 1);
            if (more) prodA(b ^ 1);
            lds_barrier();
            if (more) prodB();
            lds_barrier();
            if (more) { prodC(c + 1, b ^ 1); if (c + 2 < nchunk) load_chunk(c + 2); }
            lds_barrier();
        }
        flush_ys(nchunk - 1);
    }
    lds_barrier();
}

DI void scan_dispatch(const Params& p, char* smem, int it) {
    if (it < 128) {
        const int b = it >> 4, dsel = (it >> 3) & 1, h = it & 7;
        scan_item(p, smem, MC + b * 2048, 2048, dsel, h, p.state_rwkv + (size_t)((b * 2 + dsel) * 8 + h) * 4096, nullptr);
    } else {
        const int i2 = it - 128, s = i2 >> 4, dsel = (i2 >> 3) & 1, h = i2 & 7;
        scan_item(p, smem, s * 256, 256, dsel, h, nullptr, p.out + OUT_S + (size_t)((s * 2 + dsel) * 8 + h) * 4096);
    }
}
DI void phase_mix(const Params& p, char* smem) {
    unsigned* ctr = (unsigned*)(p.ws + OFF_BAR) + XCD_BAR_WORDS;
    volatile LAS unsigned* slot = (volatile LAS unsigned*)(smem + LDS_MAIN + 8);
    for (;;) {
        if (threadIdx.x == 0) *slot = __hip_atomic_fetch_add(ctr, 1u, __ATOMIC_RELAXED, __HIP_MEMORY_SCOPE_AGENT);
        __syncthreads();
        const int it = (int)*slot;
        __syncthreads();
        if (it >= 640 + 768) break;
        if (it < 640) scan_dispatch(p, smem, it);
        else attn_item(p, smem, it - 640);
    }
    sg_pass(p);
}

DI void phase_post(const Params& p, char* smem) {
    const int tid = threadIdx.x, wid = tid >> 6, lane = tid & 63, fr = lane & 15, fq = lane >> 4, wr = wid >> 1, wc = wid & 1;
    unsigned char* ws = p.ws;
    const bf16_t* sg = (const bf16_t*)(ws + OFF_SG); const bf16_t* g2t = (const bf16_t*)(ws + OFF_G2T);
    const float* ys0 = (const float*)(ws + OFF_YS); const float* ys1 = ys0 + (size_t)M * 512;
    const float* bn = (const float*)(ws + OFF_BN);
    const bf16_t* zr = (const bf16_t*)(p.out + OUT_Y);
    bf16_t* rw = (bf16_t*)(ws + OFF_RW);
    const int MT = M / 256, NT = 4;
    for (int t = blockIdx.x; t < MT * NT; t += gridDim.x) {
        int mt, nt; tile_coords(t, MT, NT, mt, nt);
        const int row0 = mt * 256;
        f32x4 acc[4][4]; zero_acc<4>(acc);
        gemm_acc<4>(acc, sg + (size_t)row0 * 128, 128, g2t + (size_t)(nt * 128) * 128, 128, 128, smem, tid);
        const int head = nt * 2 + wc;
#pragma unroll
        for (int mb = 0; mb < 4; ++mb) {
            const int m = row0 + wr * 64 + mb * 16 + fr;
            int r0, T; seq_of(m, r0, T);
            f32x4 y[4]; float s1 = 0.f;
#pragma unroll
            for (int nb = 0; nb < 4; ++nb) {
                const size_t o = (size_t)m * 512 + head * 64 + nb * 16 + fq * 4;
                y[nb] = *(const f32x4*)(ys0 + o) + *(const f32x4*)(ys1 + o);
                s1 += y[nb][0] + y[nb][1] + y[nb][2] + y[nb][3];
            }
            s1 += __shfl_xor(s1, 16); s1 += __shfl_xor(s1, 32);
            const float mean = s1 * (1.0f / 64.0f);
            float s2 = 0.f;
#pragma unroll
            for (int nb = 0; nb < 4; ++nb) { const f32x4 dlt = y[nb] - mean; s2 += dlt[0] * dlt[0] + dlt[1] * dlt[1] + dlt[2] * dlt[2] + dlt[3] * dlt[3]; }
            s2 += __shfl_xor(s2, 16); s2 += __shfl_xor(s2, 32);
            const float rstd = __builtin_amdgcn_rsqf(s2 * (1.0f / 64.0f) + 64e-5f);
            const float bonus = bn[(size_t)m * 16 + head] + bn[(size_t)m * 16 + 8 + head];
#pragma unroll
            for (int nb = 0; nb < 4; ++nb) {
                const int c = head * 64 + nb * 16 + fq * 4;
                const bf16_t* zp = zr + (size_t)m * ZRC + 1024 + c;
                const f32x4 z = unpack4(*(const u32x2*)zp);
                f32x4 zprev = (f32x4){0.f, 0.f, 0.f, 0.f}, znext = zprev;
                if (m > r0) zprev = unpack4(*(const u32x2*)(zp - ZRC));
                if (m < r0 + T - 1) znext = unpack4(*(const u32x2*)(zp + ZRC));
                const f32x4 a0 = *(const f32x4*)(p.rwkv_mu + 1024 + c), a1 = *(const f32x4*)(p.rwkv_mu + ZRC + 1024 + c);
                const f32x4 v = z + a0 * (zprev - z) + a1 * (znext - z);
                const f32x4 lg = *(const f32x4*)(p.rwkv_ln_g + c), lb = *(const f32x4*)(p.rwkv_ln_b + c);
                const f32x4 yn = (y[nb] - mean) * rstd * lg + lb;
                const f32x4 o = (yn + v * bonus) * acc[mb][nb];
                *(u32x2*)(rw + (size_t)m * 512 + c) = pack4(o);
            }
        }
    }
}

DI void phase_merge(const Params& p, char* smem) {
    const int tid = threadIdx.x, wid = tid >> 6, lane = tid & 63, fr = lane & 15, fq = lane >> 4, wr = wid >> 1, wc = wid & 1;
    unsigned char* ws = p.ws;
    const bf16_t* hb = (const bf16_t*)(ws + OFF_H); const bf16_t* wt = (const bf16_t*)(ws + OFF_WIN);
    const bf16_t* ab = (const bf16_t*)(ws + OFF_ATTN); const bf16_t* rw = (const bf16_t*)(ws + OFF_RW);
    const bf16_t* wpa = (const bf16_t*)(ws + OFF_WPA); const bf16_t* wpb = (const bf16_t*)(ws + OFF_WPB);
    bf16_t* mg = (bf16_t*)(ws + OFF_MRG);
    const int MT = M / 256, NT = 16;
    for (int t = blockIdx.x; t < MT * NT; t += gridDim.x) {
        int mt, nt; tile_coords(t, MT, NT, mt, nt);
        const int row0 = mt * 256, n0 = nt * 64;
        u32x2 gpa[4][2], gpb[4][2];
        {
            f32x4 gacc[4][4]; zero_acc<4>(gacc);
            gemm_acc<4, 1024>(gacc, hb + (size_t)row0 * 1024, 1024, wt + (size_t)(768 + n0) * 1024, 1024, 1024, smem, tid);
#pragma unroll
            for (int a = 0; a < 4; ++a)
#pragma unroll
                for (int b = 0; b < 2; ++b) {
                    f32x4 ga, gb;
#pragma unroll
                    for (int j = 0; j < 4; ++j) { ga[j] = sigmoidf_(gacc[a][b][j]); gb[j] = sigmoidf_(gacc[a][b + 2][j]); }
                    gpa[a][b] = pack4(ga); gpb[a][b] = pack4(gb);
                }
        }
        f32x4 acc[4][2], res[4][2];
        zero_acc<2>(acc);
        gemm_acc<2>(acc, ab + (size_t)row0 * 512, 512, wpa + (size_t)n0 * 512, 512, 512, smem, tid);
#pragma unroll
        for (int a = 0; a < 4; ++a)
#pragma unroll
            for (int b = 0; b < 2; ++b) res[a][b] = unpack4(gpa[a][b]) * acc[a][b];
        zero_acc<2>(acc);
        gemm_acc<2>(acc, rw + (size_t)row0 * 512, 512, wpb + (size_t)n0 * 512, 512, 512, smem, tid);
#pragma unroll
        for (int mb = 0; mb < 4; ++mb) {
            const int m = row0 + wr * 64 + mb * 16 + fr;
#pragma unroll
            for (int nb = 0; nb < 2; ++nb) {
                const f32x4 o = res[mb][nb] + unpack4(gpb[mb][nb]) * acc[mb][nb];
                *(u32x2*)(mg + (size_t)m * 1024 + n0 + wc * 32 + nb * 16 + fq * 4) = pack4(o);
            }
        }
    }
}

struct EpiOut {
    static constexpr bool PERM = false, AFTER_DRAIN = false;
    float* y; const float* mod; const float* xp; const float* xs;
    __device__ __forceinline__ void operator()(const f32x4 (&acc)[2][2][4][2], const pg8::Unit& u, int wr, int wc, int fr, int fq) const {
        const int row0 = u.pm * 256 + wr * 64 + fr, col0 = u.pn * 256 + wc * 32 + 4 * fq, ci = cond_of(u.pm * 256);
        const float* xb = u.pm * 256 < MC ? xp : xs - (size_t)MC * D;
#pragma unroll
        for (int bj = 0; bj < 2; ++bj)
#pragma unroll
            for (int n = 0; n < 2; ++n) {
                const int col = col0 + bj * 128 + n * 16;
                const f32x4 g1 = *(const f32x4*)(mod + ci * 6144 + 2048 + col);
#pragma unroll
                for (int ai = 0; ai < 2; ++ai)
#pragma unroll
                    for (int m = 0; m < 4; ++m) {
                        const size_t o = (size_t)(row0 + ai * 128 + m * 16) * D + col;
                        *(f32x4*)(y + o) = *(const f32x4*)(xb + o) + g1 * acc[ai][bj][m][n];
                    }
            }
    }
};
DI void phase_out(const Params& p, char* smem) {
    const int tid = threadIdx.x, wid = tid >> 6, lane = tid & 63, fr = lane & 15, fq = lane >> 4, wr = wid >> 1, wc = wid & 1;
    unsigned char* ws = p.ws;
    const bf16_t* mg = (const bf16_t*)(ws + OFF_MRG); const bf16_t* wo = (const bf16_t*)(ws + OFF_WOUT);
    const float* mod = (const float*)(ws + OFF_MOD);
    const int nM = M / 256, nN = 4, G = gridDim.x, nfirst = G < nM * nN ? G : nM * nN;
    {
        const pg8::Gemm8 g = {mg, wo, 1024, 128};
        const pg8::Order8 ord = {nM, nN, nfirst, G, (int)blockIdx.x};
        const EpiOut epi = {p.out + OUT_Y, mod, p.x_prompt, p.x_sample};
        pg8::gemm8((LAS unsigned char*)smem, g, ord, epi);
    }
    for (int t = blockIdx.x; t < 2 * (nM * nN - nfirst); t += G) {
        int pm, pn; pg8::unit_of(nfirst + (t >> 1), nM, nN, pm, pn);
        const int row0 = pm * 256, n0 = pn * 256 + (t & 1) * 128;
        f32x4 acc[4][4]; zero_acc<4>(acc);
        gemm_acc<4>(acc, mg + (size_t)row0 * 1024, 1024, wo + (size_t)n0 * 1024, 1024, 1024, smem, tid);
        const int ci = cond_of(row0);
#pragma unroll
        for (int nb = 0; nb < 4; ++nb) {
            const int n = n0 + wc * 64 + nb * 16 + fq * 4;
            const f32x4 g1 = *(const f32x4*)(mod + ci * 6144 + 2048 + n);
#pragma unroll
            for (int mb = 0; mb < 4; ++mb) {
                const int m = row0 + wr * 64 + mb * 16 + fr;
                const f32x4 xv = *(const f32x4*)(xrow(p, m) + n);
                *(f32x4*)(p.out + OUT_Y + (size_t)m * D + n) = xv + g1 * acc[mb][nb];
            }
        }
    }
}

DI u32x2 conv_act(const f32x4 (&um)[2], const f32x4 (&u0)[2], const f32x4 (&up)[2], const float* cw, const float* cb, int gcol) {
    f32x4 res[2];
#pragma unroll
    for (int part = 0; part < 2; ++part) {
        const int cc = gcol + part * DFF;
        const f32x4 w0 = *(const f32x4*)(cw + cc), w1 = *(const f32x4*)(cw + 5632 + cc), w2 = *(const f32x4*)(cw + 2 * 5632 + cc), bb = *(const f32x4*)(cb + cc);
        res[part] = um[part] * w0 + u0[part] * w1 + up[part] * w2 + bb;
    }
    f32x4 o;
#pragma unroll
    for (int j = 0; j < 4; ++j) { const float g = res[1][j]; o[j] = g * rcpf_(1.0f + __expf(-g)) * res[0][j]; }
    return pack4(o);
}
DI void phase_up(const Params& p, char* smem) {
    const int tid = threadIdx.x, wid = tid >> 6, lane = tid & 63, fr = lane & 15, fq = lane >> 4, wr = wid >> 1, wc = wid & 1;
    unsigned char* ws = p.ws;
    const bf16_t* hb = (const bf16_t*)(ws + OFF_H); const bf16_t* wu = (const bf16_t*)(ws + OFF_WUP);
    bf16_t* act = (bf16_t*)(ws + OFF_ACT); bf16_t* ub = (bf16_t*)(ws + OFF_U);
    bf16_t* ut = (bf16_t*)smem;
    const int MT = M / 256, NT = 44;
    for (int t = blockIdx.x; t < MT * NT; t += gridDim.x) {
        int mt, nt; tile_coords(t, MT, NT, mt, nt);
        const int row0 = mt * 256, n0 = nt * 64;
        f32x4 acc[4][4]; zero_acc<4>(acc);
        gemm_acc<4, DFF>(acc, hb + (size_t)row0 * 1024, 1024, wu + (size_t)n0 * 1024, 1024, 1024, smem, tid);
        __syncthreads();
#pragma unroll
        for (int mb = 0; mb < 4; ++mb)
#pragma unroll
            for (int nb = 0; nb < 4; ++nb) *(u32x2*)(ut + (wr * 64 + mb * 16 + fr) * 136 + wc * 64 + nb * 16 + fq * 4) = pack4(acc[mb][nb]);
        __syncthreads();
        const int c4 = (tid & 15) * 4, lv = (c4 >> 5) * 64 + (c4 & 31), lg = lv + 32;
#pragma unroll 2
        for (int it = 0; it < 8; ++it) {
            const int row = it * 32 + (tid >> 4);
            f32x4 um[2], u0[2], up[2];
            const f32x4 z4 = (f32x4){0.f, 0.f, 0.f, 0.f};
            u0[0] = unpack4(*(const u32x2*)(ut + row * 136 + lv)); u0[1] = unpack4(*(const u32x2*)(ut + row * 136 + lg));
            um[0] = row > 0 ? unpack4(*(const u32x2*)(ut + (row - 1) * 136 + lv)) : z4; um[1] = row > 0 ? unpack4(*(const u32x2*)(ut + (row - 1) * 136 + lg)) : z4;
            up[0] = row < 255 ? unpack4(*(const u32x2*)(ut + (row + 1) * 136 + lv)) : z4; up[1] = row < 255 ? unpack4(*(const u32x2*)(ut + (row + 1) * 136 + lg)) : z4;
            *(u32x2*)(act + (size_t)(row0 + row) * DFF + n0 + c4) = conv_act(um, u0, up, p.ffn_conv_w, p.ffn_conv_b, n0 + c4);
        }
        if (row0 >= MC && tid < 256) {
            const int k = tid >> 6, rsel = k < 2 ? k : 252 + k, cp = (tid & 63) * 2;
            *(unsigned*)(ub + ((size_t)(mt * NT + nt) * 4 + k) * 128 + cp) = *(const unsigned*)(ut + rsel * 136 + cp);
        }
    }
}
DI void phase_fix(const Params& p) {
    unsigned char* ws = p.ws;
    bf16_t* act = (bf16_t*)(ws + OFF_ACT); const bf16_t* ub = (const bf16_t*)(ws + OFF_U);
    const int NT = 44;
    for (int i = blockIdx.x * NTHR + threadIdx.x; i < 64 * NT * 2 * 16; i += gridDim.x * NTHR) {
        const int cg = i & 15, which = (i >> 4) & 1, rest = i >> 5, nt = rest % NT, mt = 32 + rest / NT;
        const int row0 = mt * 256, tpos = (row0 - MC) & 2047;
        if (which == 0 ? tpos == 0 : tpos == 2048 - 256) continue;
        const bf16_t* own = ub + (size_t)(mt * NT + nt) * 4 * 128;
        const bf16_t *pv, *cu, *nx; int m;
        if (which == 0) { m = row0; pv = ub + ((size_t)((mt - 1) * NT + nt) * 4 + 3) * 128; cu = own; nx = own + 128; }
        else { m = row0 + 255; pv = own + 2 * 128; cu = own + 3 * 128; nx = ub + (size_t)((mt + 1) * NT + nt) * 4 * 128; }
        const int c4 = cg * 4, lv = (c4 >> 5) * 64 + (c4 & 31), lg = lv + 32;
        f32x4 um[2], u0[2], up[2];
        um[0] = unpack4(*(const u32x2*)(pv + lv)); um[1] = unpack4(*(const u32x2*)(pv + lg));
        u0[0] = unpack4(*(const u32x2*)(cu + lv)); u0[1] = unpack4(*(const u32x2*)(cu + lg));
        up[0] = unpack4(*(const u32x2*)(nx + lv)); up[1] = unpack4(*(const u32x2*)(nx + lg));
        *(u32x2*)(act + (size_t)m * DFF + nt * 64 + c4) = conv_act(um, u0, up, p.ffn_conv_w, p.ffn_conv_b, nt * 64 + c4);
    }
}
struct EpiDown {
    static constexpr bool PERM = false, AFTER_DRAIN = false;
    float* y; const float* mod;
    __device__ __forceinline__ void operator()(const f32x4 (&acc)[2][2][4][2], const pg8::Unit& u, int wr, int wc, int fr, int fq) const {
        const int row0 = u.pm * 256 + wr * 64 + fr, col0 = u.pn * 256 + wc * 32 + 4 * fq, ci = cond_of(u.pm * 256);
#pragma unroll
        for (int bj = 0; bj < 2; ++bj)
#pragma unroll
            for (int n = 0; n < 2; ++n) {
                const int col = col0 + bj * 128 + n * 16;
                const f32x4 g2 = *(const f32x4*)(mod + ci * 6144 + 5120 + col);
#pragma unroll
                for (int ai = 0; ai < 2; ++ai)
#pragma unroll
                    for (int m = 0; m < 4; ++m) { float* px = y + (size_t)(row0 + ai * 128 + m * 16) * D + col; *(f32x4*)px = *(const f32x4*)px + g2 * acc[ai][bj][m][n]; }
            }
    }
};
DI void phase_down(const Params& p, char* smem) {
    const int tid = threadIdx.x, wid = tid >> 6, lane = tid & 63, fr = lane & 15, fq = lane >> 4, wr = wid >> 1, wc = wid & 1;
    unsigned char* ws = p.ws;
    const bf16_t* act = (const bf16_t*)(ws + OFF_ACT); const bf16_t* wd = (const bf16_t*)(ws + OFF_WDN);
    const float* mod = (const float*)(ws + OFF_MOD);
    const int nM = M / 256, nN = 4, G = gridDim.x, nfirst = G < nM * nN ? G : nM * nN;
    {
        const pg8::Gemm8 g = {act, wd, DFF, 128};
        const pg8::Order8 ord = {nM, nN, nfirst, G, (int)blockIdx.x};
        const EpiDown epi = {p.out + OUT_Y, mod};
        pg8::gemm8((LAS unsigned char*)smem, g, ord, epi);
    }
    for (int t = blockIdx.x; t < 2 * (nM * nN - nfirst); t += G) {
        int pm, pn; pg8::unit_of(nfirst + (t >> 1), nM, nN, pm, pn);
        const int row0 = pm * 256, n0 = pn * 256 + (t & 1) * 128;
        f32x4 acc[4][4]; zero_acc<4>(acc);
        gemm_acc<4>(acc, act + (size_t)row0 * DFF, DFF, wd + (size_t)n0 * DFF, DFF, DFF, smem, tid);
        const int ci = cond_of(row0);
#pragma unroll
        for (int nb = 0; nb < 4; ++nb) {
            const int n = n0 + wc * 64 + nb * 16 + fq * 4;
            const f32x4 g2 = *(const f32x4*)(mod + ci * 6144 + 5120 + n);
#pragma unroll
            for (int mb = 0; mb < 4; ++mb) {
                const int m = row0 + wr * 64 + mb * 16 + fr;
                float* px = p.out + OUT_Y + (size_t)m * D + n;
                *(f32x4*)px = *(const f32x4*)px + g2 * acc[mb][nb];
            }
        }
    }
}

#define XB_TMO      128
#define XB_XCNT(j)  (256  + 64 * (j))
#define XB_XSUB(j)  (1280 + 64 * (j))
#define XB_XGEN(j)  (2304 + 64 * (j))
#define XB_TOP      3328
#define XB_TOPGEN   3392
#define XB_SPIN_CAP (1u << 20)
DI unsigned xb_ld(unsigned* p)              { return __hip_atomic_load(p, __ATOMIC_RELAXED, __HIP_MEMORY_SCOPE_AGENT); }
DI unsigned xb_add(unsigned* p, unsigned v) { return __hip_atomic_fetch_add(p, v, __ATOMIC_RELAXED, __HIP_MEMORY_SCOPE_AGENT); }
DI unsigned xb_xcc_id() { return (unsigned)__builtin_amdgcn_s_getreg((3 << 11) | 20) & 0xFu; }
#define XB_SPIN(cond, bar) do { unsigned _sp = 0; while (cond) { __builtin_amdgcn_s_sleep(1); \
    if ((++_sp & 255u) == 0u) { if (xb_ld(&(bar)[XB_TMO])) break; if (_sp > XB_SPIN_CAP) { atomicAdd(&(bar)[XB_TMO], 1u); break; } } } } while (0)
struct XcdBarrier { unsigned* bar; unsigned x; volatile LAS unsigned* st; };
DI XcdBarrier xcd_barrier_post(unsigned* bar, volatile LAS unsigned* st) {
    XcdBarrier b; b.bar = bar; b.x = xb_xcc_id(); b.st = st;
    if (threadIdx.x == 0) (void)xb_add(&bar[XB_XCNT(b.x)], 1u);
    return b;
}
DI void xcd_barrier_complete(unsigned* bar, unsigned x, unsigned& nloc, unsigned& nx) {
    const unsigned G = gridDim.x * gridDim.y * gridDim.z;
    unsigned sum, cnt, mine, sp = 0u;
    for (;;) {
        sum = 0u; cnt = 0u; mine = 0u;
#pragma unroll
        for (unsigned j = 0; j < 16; ++j) { const unsigned c = xb_ld(&bar[XB_XCNT(j)]); sum += c; cnt += (c > 0u) ? 1u : 0u; mine = (j == x) ? c : mine; }
        if (sum == G) break;
        __builtin_amdgcn_s_sleep(1);
        if ((++sp & 255u) == 0u) { if (xb_ld(&bar[XB_TMO])) break; if (sp > XB_SPIN_CAP) { atomicAdd(&bar[XB_TMO], 1u); break; } }
    }
    nloc = mine > 0u ? mine : 1u; nx = cnt > 0u ? cnt : 1u;
}
DI void xcd_barrier(const XcdBarrier& b) {
    asm volatile("s_waitcnt vmcnt(0)" ::: "memory");
    __syncthreads();
    if (threadIdx.x == 0) {
        unsigned* bar = b.bar;
        __builtin_amdgcn_s_waitcnt(0);
        unsigned nloc = b.st[0], nx = b.st[1];
        if (nloc == 0u) { xcd_barrier_complete(bar, b.x, nloc, nx); b.st[0] = nloc; b.st[1] = nx; }
        const unsigned old = xb_add(&bar[XB_XSUB(b.x)], 1u);
        const unsigned gen = old / nloc;
        if (old + 1u == (gen + 1u) * nloc) {
            __builtin_amdgcn_fence(__ATOMIC_RELEASE, "agent");
            asm volatile("s_waitcnt vmcnt(0)" ::: "memory");
            const unsigned og = xb_add(&bar[XB_TOP], 1u);
            const unsigned tg = og / nx;
            if (og + 1u == (tg + 1u) * nx) xb_add(&bar[XB_TOPGEN], 1u);
            else XB_SPIN(xb_ld(&bar[XB_TOPGEN]) == tg, bar);
            __builtin_amdgcn_fence(__ATOMIC_ACQUIRE, "agent");
            xb_add(&bar[XB_XGEN(b.x)], 1u);
            asm volatile("s_waitcnt vmcnt(0)" ::: "memory");
        } else {
            XB_SPIN(xb_ld(&bar[XB_XGEN(b.x)]) == gen, bar);
            __builtin_amdgcn_fence(__ATOMIC_ACQUIRE, "agent");
            asm volatile("s_waitcnt vmcnt(0)" ::: "memory");
        }
    }
    __syncthreads();
}

constexpr int N_PHASES = 23;
__global__ void __launch_bounds__(NTHR) fwd_kernel(Params p) {
    extern __shared__ __attribute__((aligned(16))) char smem[];
    volatile LAS unsigned* xst = (volatile LAS unsigned*)(smem + LDS_MAIN);
    if (threadIdx.x == 0) { xst[0] = 0u; xst[1] = 0u; }
    __syncthreads();
    const XcdBarrier xb = xcd_barrier_post((unsigned*)(p.ws + OFF_BAR), xst);
    asm volatile("s_nop 0\n\ts_nop 0\n\ts_nop 0\n\ts_nop 0\n\ts_nop 0");
#ifndef PH_MASK
#define PH_MASK 0xffff
#endif
#ifndef REP_MASK
#define REP_MASK 0
#endif
#define RUN_PHASE(ph, bit, call) if (p.ph_lo <= (ph) && (ph) < p.ph_hi) { if ((ph) > p.ph_lo) xcd_barrier(xb); if (PH_MASK & (bit)) { call; if (REP_MASK & (bit)) { call; } } }
    RUN_PHASE(0, 1, phase_prep(p, smem))
    RUN_PHASE(1, 2, phase_norm<1>(p))
    RUN_PHASE(2, 4, phase_p1(p, smem))
    RUN_PHASE(4, 16, phase_mix(p, smem))
    RUN_PHASE(5, 32, phase_post(p, smem))
    RUN_PHASE(6, 64, phase_merge(p, smem))
    RUN_PHASE(7, 128, phase_out(p, smem))
    RUN_PHASE(8, 256, phase_norm<2>(p))
    RUN_PHASE(9, 512, phase_up(p, smem))
    RUN_PHASE(10, 1024, phase_fix(p))
    RUN_PHASE(21, 2048, phase_down(p, smem))
    RUN_PHASE(22, 4096, phase_norm<3>(p))
}

extern "C" void kernel_launch(void* const* d_in, const int* in_sizes, int n_in, void* d_out, int out_size, void* d_ws, size_t ws_size, hipStream_t stream) {
    static int grid = 0;
    if (grid == 0) {
        if (n_in != 32 || ws_size < WS_NEED) { fprintf(stderr, "kernel_launch: unexpected inputs (n_in %d, ws %zu, need %zu)\n", n_in, ws_size, (size_t)WS_NEED); grid = -1; return; }
        int dev = 0, cus = 0, per_cu = 0;
        hipGetDevice(&dev);
        hipDeviceGetAttribute(&cus, hipDeviceAttributeMultiprocessorCount, dev);
        hipFuncSetAttribute((const void*)fwd_kernel, hipFuncAttributeMaxDynamicSharedMemorySize, LDS_BYTES);
        hipOccupancyMaxActiveBlocksPerMultiprocessor(&per_cu, (const void*)fwd_kernel, NTHR, LDS_BYTES);
        if (per_cu < 1) { fprintf(stderr, "kernel_launch: occupancy query says %d blocks per CU\n", per_cu); grid = -1; return; }
        grid = cus;
        grid &= ~7;
    }
    if (grid < 0) return;
    if (hipMemsetAsync((char*)d_ws + OFF_BAR, 0, (XCD_BAR_WORDS + 64) * 4, stream) != hipSuccess) { fprintf(stderr, "kernel_launch: memset failed\n"); return; }
    Params p{};
    const float** pp = (const float**)&p;
    for (int i = 0; i < 32; ++i) pp[i] = (const float*)d_in[i];
    p.out = (float*)d_out; p.ws = (unsigned char*)d_ws;
#if N_LAUNCH_SPLIT
    for (int ph = 0; ph < N_PHASES; ++ph) {
        p.ph_lo = ph; p.ph_hi = ph + 1;
        hipLaunchKernelGGL(fwd_kernel, dim3(grid), dim3(NTHR), LDS_BYTES, stream, p);
    }
#else
    p.ph_lo = 0; p.ph_hi = N_PHASES;
    void* args[] = {&p};
    hipError_t e = hipLaunchCooperativeKernel((const void*)fwd_kernel, dim3(grid), dim3(NTHR), args, LDS_BYTES, stream);
    if (e != hipSuccess) fprintf(stderr, "cooperative launch failed: %s (grid %d)\n", hipGetErrorString(e), grid);
#endif
}
```

```cpp
#include <hip/hip_runtime.h>
#include <hip/hip_cooperative_groups.h>
#include <cstdio>
namespace cg = cooperative_groups;

#define DI __device__ __forceinline__
typedef unsigned short bf16_t;
typedef short bf16x8 __attribute__((ext_vector_type(8)));
typedef short s16x4 __attribute__((ext_vector_type(4)));
typedef float f32x4 __attribute__((ext_vector_type(4)));
typedef float f32x2 __attribute__((ext_vector_type(2)));
typedef float f32x16 __attribute__((ext_vector_type(16)));
typedef unsigned u32x4 __attribute__((ext_vector_type(4)));
typedef unsigned u32x2 __attribute__((ext_vector_type(2)));

#ifndef N_LAUNCH_SPLIT
#define N_LAUNCH_SPLIT 0
#endif

constexpr int NTHR = 512;
constexpr int D = 1024;
constexpr int MC = 8192;
constexpr int ML = 16384;
constexpr int M = MC + ML;
constexpr int WIN = 4736;
constexpr int ZRC = 1920;
constexpr int DFF = 2816;
constexpr int LDS_MAIN = 147456;
constexpr int LDS_BYTES = LDS_MAIN + 16;
constexpr float LOG2E = 1.4426950408889634f;

constexpr size_t al256(size_t x) { return (x + 255) & ~(size_t)255; }
constexpr size_t OFF_WUP   = 0;
constexpr size_t OFF_WDN   = OFF_WUP + al256((size_t)5632 * 1024 * 2);
constexpr size_t OFF_MOD   = OFF_WDN + al256((size_t)1024 * 2816 * 2);
constexpr size_t OFF_ROPE  = OFF_MOD + al256((size_t)9 * 6144 * 4);
constexpr size_t OFF_W2T   = OFF_ROPE + al256((size_t)64 * 16 * 8);
constexpr size_t OFF_A2T   = OFF_W2T + al256((size_t)2 * 512 * 64 * 2);
constexpr size_t OFF_G2T   = OFF_A2T + al256((size_t)2 * 512 * 64 * 2);
constexpr size_t OFF_KC    = OFF_G2T + al256((size_t)512 * 128 * 2);
constexpr size_t OFF_VCT   = OFF_KC + al256((size_t)8 * 512 * 128 * 2);
constexpr size_t OFF_BAR   = OFF_VCT + al256((size_t)8 * 512 * 128 * 2);
constexpr size_t OFF_H     = OFF_BAR + al256((size_t)(3456 + 64) * 4);
constexpr size_t OFF_X     = OFF_H + al256((size_t)M * 1024 * 2);
constexpr size_t OFF_WIN   = OFF_X;
constexpr size_t OFF_WPA   = OFF_WIN + al256((size_t)WIN * 1024 * 2);
constexpr size_t OFF_WPB   = OFF_WPA + al256((size_t)1024 * 512 * 2);
constexpr size_t OFF_WOUT  = OFF_WPB + al256((size_t)1024 * 512 * 2);
constexpr size_t OFF_Q     = OFF_WOUT + al256((size_t)1024 * 1024 * 2);
constexpr size_t OFF_RW    = OFF_Q;
constexpr size_t OFF_KB    = OFF_Q + al256((size_t)M * 512 * 2);
constexpr size_t OFF_VT    = OFF_KB + al256((size_t)M * 128 * 2);
constexpr size_t OFF_ATTN  = OFF_VT + al256((size_t)M * 128 * 2);
constexpr size_t OFF_SG    = OFF_ATTN + al256((size_t)M * 512 * 2);
constexpr size_t OFF_BN    = OFF_SG + al256((size_t)M * 128 * 2);
constexpr size_t OFF_YS    = OFF_BN + al256((size_t)M * 16 * 4);
constexpr size_t OFF_MRG   = OFF_YS;
constexpr size_t END_EARLY = OFF_YS + al256((size_t)2 * M * 512 * 4);
constexpr size_t OFF_ACT   = OFF_X;
constexpr size_t OFF_U     = OFF_ACT + al256((size_t)M * DFF * 2);
constexpr size_t END_FFN   = OFF_U + al256((size_t)96 * 44 * 4 * 128 * 2);
constexpr size_t WS_NEED   = END_EARLY > END_FFN ? END_EARLY : END_FFN;
static_assert(WS_NEED <= (size_t)256 * 1024 * 1024, "workspace over 256 MiB");

constexpr size_t OUT_Y  = 0;
constexpr size_t OUT_K  = (size_t)M * 1024;
constexpr size_t OUT_V  = OUT_K + (size_t)MC * 128;
constexpr size_t OUT_S  = OUT_V + (size_t)MC * 128;

struct Params {
    const float *x_prompt, *x_sample, *c, *cache_k, *cache_v, *state_rwkv, *c_ctx, *w_ada, *b_ada, *g_norm1, *w_in, *attn_sink,
        *w_proj_a, *w_proj_b, *rwkv_mu, *rwkv_w0, *rwkv_w2, *rwkv_a0, *rwkv_a2, *rwkv_k_k, *rwkv_k_a, *rwkv_r_k, *rwkv_g2,
        *rwkv_ln_g, *rwkv_ln_b, *w_out, *g_norm2, *w_ffn_up, *ffn_conv_w, *ffn_conv_b, *w_ffn_down, *g_final;
    float* out;
    unsigned char* ws;
    int ph_lo, ph_hi;
};

#define XCD_BAR_WORDS 3456
#define LAS __attribute__((address_space(3)))
DI bf16_t f2bf(float f) { unsigned u = __float_as_uint(f); u += 0x7fffu + ((u >> 16) & 1u); return (bf16_t)(u >> 16); }
DI float bf2f(unsigned b) { return __uint_as_float(b << 16); }
typedef __bf16 bf16v2_t __attribute__((ext_vector_type(2)));
DI unsigned pack2(float lo, float hi) { f32x2 v; v.x = lo; v.y = hi; return __builtin_bit_cast(unsigned, __builtin_convertvector(v, bf16v2_t)); }
DI u32x2 pack4(f32x4 v) { u32x2 r; r.x = pack2(v[0], v[1]); r.y = pack2(v[2], v[3]); return r; }
DI f32x4 unpack4(u32x2 v) { f32x4 r; r[0] = bf2f(v.x & 0xffffu); r[1] = bf2f(v.x >> 16); r[2] = bf2f(v.y & 0xffffu); r[3] = bf2f(v.y >> 16); return r; }
DI float rcpf_(float x) { return __builtin_amdgcn_rcpf(x); }
DI float sigmoidf_(float x) { return rcpf_(1.0f + __expf(-x)); }
DI const float* xrow(const Params& p, int r) { return r < MC ? p.x_prompt + (size_t)r * D : p.x_sample + (size_t)(r - MC) * D; }
DI int cond_of(int r) { return r < MC ? 0 : 1 + ((r - MC) >> 11); }
DI void seq_of(int r, int& r0, int& T) { if (r < MC) { r0 = r & ~255; T = 256; } else { r0 = MC + ((r - MC) & ~2047); T = 2048; } }
DI float wave_sum(float v) {
#pragma unroll
    for (int o = 32; o >= 1; o >>= 1) v += __shfl_xor(v, o);
    return v;
}

DI void transpose_tile(const float* __restrict__ src, int K, int N, bf16_t* __restrict__ dst, int kt, int nt, float* tile, int tid) {
    const int k0 = kt * 64, n0 = nt * 64;
#pragma unroll
    for (int i = 0; i < 8; ++i) { const int k = (tid >> 6) + 8 * i, n = tid & 63; tile[k * 65 + n] = src[(size_t)(k0 + k) * N + n0 + n]; }
    __syncthreads();
#pragma unroll
    for (int i = 0; i < 8; ++i) { const int n = (tid >> 6) + 8 * i, k = tid & 63; dst[(size_t)(n0 + n) * K + k0 + k] = f2bf(tile[k * 65 + n]); }
    __syncthreads();
}

DI void phase_prep(const Params& p, char* smem) {
    const int tid = threadIdx.x, nb = gridDim.x, bid = blockIdx.x;
    unsigned char* ws = p.ws;
    {
        float* tile = (float*)smem;
        const int cnt[11] = {16 * 74, 8 * 16, 8 * 16, 16 * 16, 16 * 88, 44 * 16, 8, 8, 8, 8, 16};
        int total = 0;
#pragma unroll
        for (int i = 0; i < 11; ++i) total += cnt[i];
        for (int it = bid; it < total; it += nb) {
            int i = it, mi = 0;
#pragma unroll
            for (int q = 0; q < 10; ++q) { if (mi == q && i >= cnt[q]) { i -= cnt[q]; mi = q + 1; } }
            const float* src; bf16_t* dst; int K, N;
            switch (mi) {
                case 0: src = p.w_in; K = 1024; N = WIN; dst = (bf16_t*)(ws + OFF_WIN); break;
                case 1: src = p.w_proj_a; K = 512; N = 1024; dst = (bf16_t*)(ws + OFF_WPA); break;
                case 2: src = p.w_proj_b; K = 512; N = 1024; dst = (bf16_t*)(ws + OFF_WPB); break;
                case 3: src = p.w_out; K = 1024; N = 1024; dst = (bf16_t*)(ws + OFF_WOUT); break;
                case 4: src = p.w_ffn_up; K = 1024; N = 5632; dst = (bf16_t*)(ws + OFF_WUP); break;
                case 5: src = p.w_ffn_down; K = 2816; N = 1024; dst = (bf16_t*)(ws + OFF_WDN); break;
                case 6: src = p.rwkv_w2; K = 64; N = 512; dst = (bf16_t*)(ws + OFF_W2T); break;
                case 7: src = p.rwkv_w2 + 64 * 512; K = 64; N = 512; dst = (bf16_t*)(ws + OFF_W2T) + 512 * 64; break;
                case 8: src = p.rwkv_a2; K = 64; N = 512; dst = (bf16_t*)(ws + OFF_A2T); break;
                case 9: src = p.rwkv_a2 + 64 * 512; K = 64; N = 512; dst = (bf16_t*)(ws + OFF_A2T) + 512 * 64; break;
                default: src = p.rwkv_g2; K = 128; N = 512; dst = (bf16_t*)(ws + OFF_G2T); break;
            }
            const int ntn = N / 64;
            transpose_tile(src, K, N, dst, i / ntn, i % ntn, tile, tid);
        }
    }
    {
        bf16_t* kc = (bf16_t*)(ws + OFF_KC); bf16_t* vct = (bf16_t*)(ws + OFF_VCT);
        for (int i = bid * NTHR + tid; i < 8 * 512 * 128; i += nb * NTHR) {
            kc[i] = f2bf(p.cache_k[i]);
            const int key = i & 511, d = (i >> 9) & 63, kvh = (i >> 15) & 1, b = i >> 16;
            vct[i] = f2bf(p.cache_v[((size_t)(b * 512 + key) * 2 + kvh) * 64 + d]);
        }
    }
    {
        f32x2* tab = (f32x2*)(ws + OFF_ROPE);
        for (int i = bid * NTHR + tid; i < 1024; i += nb * NTHR) {
            const int pos = i >> 4, fi = i & 15;
            const double fr = pow(10000.0, -(double)fi / 16.0), ang = (double)pos * fr;
            f32x2 v; v.x = (float)cos(ang); v.y = (float)sin(ang); tab[i] = v;
        }
    }
    {
        float* s = (float*)smem;
        float* red = (float*)(smem + 36864);
        float* mod = (float*)(ws + OFF_MOD);
        for (int it = bid; it < 96; it += nb) {
            __syncthreads();
            for (int i = tid; i < 9 * 1024; i += NTHR) {
                const int ci = i >> 10, k = i & 1023;
                const float v = ci == 0 ? p.c_ctx[k] : p.c[(ci - 1) * 1024 + k];
                s[i] = v / (1.0f + __expf(-v));
            }
            __syncthreads();
            const int n = tid & 63, kq = tid >> 6, n0 = it * 64;
            float acc[9];
#pragma unroll
            for (int ci = 0; ci < 9; ++ci) acc[ci] = 0.f;
            for (int k = kq * 128; k < kq * 128 + 128; ++k) {
                const float w = p.w_ada[(size_t)k * 6144 + n0 + n];
#pragma unroll
                for (int ci = 0; ci < 9; ++ci) acc[ci] += s[ci * 1024 + k] * w;
            }
#pragma unroll
            for (int ci = 0; ci < 9; ++ci) red[(kq * 9 + ci) * 64 + n] = acc[ci];
            __syncthreads();
            for (int i = tid; i < 9 * 64; i += NTHR) {
                const int ci = i >> 6, nn = i & 63;
                float v = p.b_ada[n0 + nn];
#pragma unroll
                for (int q = 0; q < 8; ++q) v += red[(q * 9 + ci) * 64 + nn];
                mod[ci * 6144 + n0 + nn] = v;
            }
        }
        __syncthreads();
    }
}

template <int WHICH> DI void phase_norm(const Params& p) {
    const int tid = threadIdx.x, lane = tid & 63, wv = tid >> 6;
    const float* mod = (const float*)(p.ws + OFF_MOD);
    bf16_t* hb = (bf16_t*)(p.ws + OFF_H);
    const int ntask = M / 8;
    for (int task = blockIdx.x * 8 + wv; task < ntask; task += gridDim.x * 8) {
        const int r_first = task * 8, ci = cond_of(r_first);
        f32x4 fa[4], fb[4];
#pragma unroll
        for (int i = 0; i < 4; ++i) {
            const int col = i * 256 + lane * 4;
            if (WHICH == 3) { fa[i] = *(const f32x4*)(p.g_final + col); fb[i] = (f32x4){0.f, 0.f, 0.f, 0.f}; }
            else {
                const f32x4 g = *(const f32x4*)((WHICH == 1 ? p.g_norm1 : p.g_norm2) + col);
                const f32x4 sc = *(const f32x4*)(mod + ci * 6144 + (WHICH == 1 ? 1024 : 4096) + col);
                fb[i] = *(const f32x4*)(mod + ci * 6144 + (WHICH == 1 ? 0 : 3072) + col);
                fa[i] = g * (sc + 1.0f);
            }
        }
        for (int rr = 0; rr < 8; ++rr) {
            const int r = r_first + rr;
            const float* src = WHICH == 1 ? xrow(p, r) : p.out + OUT_Y + (size_t)r * D;
            f32x4 v[4]; float ss = 0.f;
#pragma unroll
            for (int i = 0; i < 4; ++i) { v[i] = *(const f32x4*)(src + i * 256 + lane * 4); ss += v[i][0] * v[i][0] + v[i][1] * v[i][1] + v[i][2] * v[i][2] + v[i][3] * v[i][3]; }
            ss = wave_sum(ss);
            const float rstd = __builtin_amdgcn_rsqf(ss * (1.0f / 1024.0f) + 1e-6f);
#pragma unroll
            for (int i = 0; i < 4; ++i) {
                const f32x4 o = v[i] * rstd * fa[i] + fb[i];
                if (WHICH == 3) *(f32x4*)(p.out + OUT_Y + (size_t)r * D + i * 256 + lane * 4) = o;
                else *(u32x2*)(hb + (size_t)r * D + i * 256 + lane * 4) = pack4(o);
            }
        }
    }
}

template <int NB, int BMAP> DI void gemm_stage(const bf16_t* A, int lda, const bf16_t* Bt, int ldb, int k0, char* sbuf, int tid) {
#pragma unroll
    for (int i = 0; i < 4; ++i) {
        const int c = tid + i * 512, row = c >> 3, pos = c & 7, kc = pos ^ ((row >> 1) & 7);
        __builtin_amdgcn_global_load_lds((const unsigned*)(A + (size_t)row * lda + k0 + kc * 8), (unsigned*)(sbuf + c * 16), 16, 0, 0);
    }
#pragma unroll
    for (int i = 0; i < NB / 2; ++i) {
        const int c = tid + i * 512, row = c >> 3, pos = c & 7, kc = pos ^ ((row >> 1) & 7);
        const int brow = BMAP ? (((row >> 5) & 1) * BMAP + (row >> 6) * 32 + (row & 31)) : row;
        __builtin_amdgcn_global_load_lds((const unsigned*)(Bt + (size_t)brow * ldb + k0 + kc * 8), (unsigned*)(sbuf + 32768 + c * 16), 16, 0, 0);
    }
}
template <int NB, int BMAP = 0> DI void gemm_acc(f32x4 (&acc)[4][NB], const bf16_t* A, int lda, const bf16_t* Bt, int ldb, int K, char* smem, int tid) {
    const int wid = tid >> 6, lane = tid & 63, fr = lane & 15, fq = lane >> 4, wr = wid >> 1, wc = wid & 1;
    const int swz = (fr >> 1) & 7;
    const int nk = K >> 6;
    __syncthreads();
    gemm_stage<NB, BMAP>(A, lda, Bt, ldb, 0, smem, tid);
    if (nk > 1) gemm_stage<NB, BMAP>(A, lda, Bt, ldb, 64, smem + 49152, tid);
    int cur = 0;
#pragma unroll 1
    for (int t = 0; t < nk; ++t) {
        if (t + 1 < nk) { if (NB == 4) asm volatile("s_waitcnt vmcnt(6)" ::: "memory"); else asm volatile("s_waitcnt vmcnt(5)" ::: "memory"); }
        else asm volatile("s_waitcnt vmcnt(0)" ::: "memory");
        __builtin_amdgcn_s_barrier();
        asm volatile("" ::: "memory");
        const int nxt2 = cur >= 1 ? cur - 1 : 2;
        const bool late = __builtin_amdgcn_readfirstlane(wid) >= 4;
        if (t + 2 < nk && !late) gemm_stage<NB, BMAP>(A, lda, Bt, ldb, (t + 2) * 64, smem + nxt2 * 49152, tid);
        const char* sA = smem + cur * 49152;
        const char* sB = sA + 32768;
#pragma unroll
        for (int ks = 0; ks < 2; ++ks) {
            if (ks == 1 && t + 2 < nk && late) gemm_stage<NB, BMAP>(A, lda, Bt, ldb, (t + 2) * 64, smem + nxt2 * 49152, tid);
            bf16x8 af[4], bfr[NB];
            const int coff = ((ks * 4 + fq) ^ swz) << 4;
#pragma unroll
            for (int mb = 0; mb < 4; ++mb) af[mb] = *(const bf16x8*)(sA + (wr * 64 + mb * 16 + fr) * 128 + coff);
#pragma unroll
            for (int nb = 0; nb < NB; ++nb) bfr[nb] = *(const bf16x8*)(sB + (wc * 16 * NB + nb * 16 + fr) * 128 + coff);
            __builtin_amdgcn_s_setprio(1);
#pragma unroll
            for (int mb = 0; mb < 4; ++mb)
#pragma unroll
                for (int nb = 0; nb < NB; ++nb) acc[mb][nb] = __builtin_amdgcn_mfma_f32_16x16x32_bf16(bfr[nb], af[mb], acc[mb][nb], 0, 0, 0);
            __builtin_amdgcn_s_setprio(0);
        }
        cur = cur == 2 ? 0 : cur + 1;
    }
}
template <int BMAP> DI void gemm_stage8(const bf16_t* A, int lda, const bf16_t* Bt, int ldb, int k0, char* sbuf, int tid) {
    const int r0 = tid >> 3, kcs = (tid & 7) ^ ((r0 >> 1) & 7);
    const unsigned offA = (unsigned)(r0 * lda + kcs * 8), offB = (unsigned)(r0 * ldb + kcs * 8);
    char* dst = sbuf + tid * 16;
#pragma unroll
    for (int i = 0; i < 4; ++i)
        __builtin_amdgcn_global_load_lds((const unsigned*)(A + (size_t)(64 * i) * lda + k0 + offA), (unsigned*)(dst + i * 8192), 16, 0, 0);
#pragma unroll
    for (int i = 0; i < 4; ++i) {
        const int urow = BMAP ? (i & 1) * BMAP + (i >> 1) * 64 : 64 * i;
        __builtin_amdgcn_global_load_lds((const unsigned*)(Bt + (size_t)urow * ldb + k0 + offB), (unsigned*)(dst + 32768 + i * 8192), 16, 0, 0);
    }
}
template <int BMAP> DI void gemm_acc8(f32x4 (&acc)[4][8], const bf16_t* A, int lda, const bf16_t* Bt, int ldb, int K, char* smem, int tid) {
    const int wid = tid >> 6, lane = tid & 63, fr = lane & 15, fq = lane >> 4, wr = wid >> 1, wc = wid & 1;
    const int swz = (fr >> 1) & 7;
    const int nk = K >> 6;
    __syncthreads();
    gemm_stage8<BMAP>(A, lda, Bt, ldb, 0, smem, tid);
    const bool late = __builtin_amdgcn_readfirstlane(wid) >= 4;
#pragma unroll 1
    for (int t = 0; t < nk; ++t) {
        asm volatile("s_waitcnt vmcnt(0)" ::: "memory");
        __builtin_amdgcn_s_barrier();
        asm volatile("" ::: "memory");
        char* sN = smem + ((t + 1) & 1) * 65536;
        if (t + 1 < nk && !late) gemm_stage8<BMAP>(A, lda, Bt, ldb, (t + 1) * 64, sN, tid);
        const char* sA = smem + (t & 1) * 65536;
        const char* sB = sA + 32768;
#pragma unroll
        for (int ks = 0; ks < 2; ++ks) {
            if (ks == 1 && t + 1 < nk && late) gemm_stage8<BMAP>(A, lda, Bt, ldb, (t + 1) * 64, sN, tid);
            bf16x8 af[4], bfr[8];
            const int coff = ((ks * 4 + fq) ^ swz) << 4;
#pragma unroll
            for (int mb = 0; mb < 4; ++mb) af[mb] = *(const bf16x8*)(sA + (wr * 64 + mb * 16 + fr) * 128 + coff);
#pragma unroll
            for (int nb = 0; nb < 8; ++nb) bfr[nb] = *(const bf16x8*)(sB + (wc * 128 + nb * 16 + fr) * 128 + coff);
            __builtin_amdgcn_s_setprio(1);
#pragma unroll
            for (int mb = 0; mb < 4; ++mb)
#pragma unroll
                for (int nb = 0; nb < 8; ++nb) acc[mb][nb] = __builtin_amdgcn_mfma_f32_16x16x32_bf16(bfr[nb], af[mb], acc[mb][nb], 0, 0, 0);
            __builtin_amdgcn_s_setprio(0);
        }
    }
}
template <int NB> DI void zero_acc(f32x4 (&acc)[4][NB]) {
#pragma unroll
    for (int a = 0; a < 4; ++a)
#pragma unroll
        for (int b = 0; b < NB; ++b) acc[a][b] = (f32x4){0.f, 0.f, 0.f, 0.f};
}
DI void tile_coords(int t, int MT, int NT, int& mt, int& nt) {
    const int x = t & 7, u = t >> 3, mpx = MT >> 3;
    const int bm = (mpx % 4 == 0) ? 4 : ((mpx % 2 == 0) ? 2 : 1);
    const int per_band = bm * NT, band = u / per_band, rem = u - band * per_band;
    nt = rem / bm; mt = x * mpx + band * bm + (rem % bm);
}


namespace pg8 {
#define PG8_LAS __attribute__((address_space(3)))
constexpr int BM = 256, BK = 64, HALF = 128, HTB = HALF * BK * 2  , STAGE_BYTES = 8 * HTB, NXCD = 8, WGM = 8;
__host__ __device__ __forceinline__ int lds_byte(int r, int c) { const int st = (r >> 4) * 2 + (c >> 5), rr = r & 15, cc = c & 31, ob = rr * 64 + cc * 2; return st * 1024 + (ob ^ (((ob >> 9) & 1) << 5)); }
__host__ __device__ __forceinline__ void stage_rc(int b, int& R, int& C) { const int st = b / 1024, sb = b % 1024, swz = sb ^ (((sb >> 9) & 1) << 5); R = (st >> 1) * 16 + swz / 64; C = (st & 1) * 32 + (swz % 64) / 2; }
__host__ __device__ __forceinline__ int perm32(int rho) { const int n = rho >> 4, i = rho & 15; return 8 * (i >> 2) + 4 * n + (i & 3); }


struct Unit { int pm, pn, brow; };
struct Gemm8 { const bf16_t* A; const bf16_t* Bt; int K; int bhalf; };
__device__ __forceinline__ void unit_of(int L, int nM, int nN, int& pm, int& pn) {
    const int nwg = nM * nN;
    int wgid = L; { const int q = nwg / NXCD, r = nwg % NXCD, xcd = wgid % NXCD, off = wgid / NXCD; wgid = (xcd < r ? xcd * (q + 1) : r * (q + 1) + (xcd - r) * q) + off; }
    const int nig = WGM * nN, gid = wgid / nig, fm = gid * WGM, gsz = (nM - fm) < WGM ? (nM - fm) : WGM;
    pm = fm + ((wgid % nig) % gsz); pn = (wgid % nig) / gsz;
}
struct Order8 {
    int nM, nN, nlim, G, c;
    __device__ __forceinline__ bool next(int i, Unit& u) const {
        const long L = (long)i * G + c; if (L >= nlim) return false;
        unit_of((int)L, nM, nN, u.pm, u.pn); u.brow = u.pn * 256; return true;
    }
    __device__ __forceinline__ void a_ready(const Unit&) const {}
    __device__ __forceinline__ void done(const Unit&) const {}
};
template <class Epi, class Sched>
__device__ __forceinline__ void gemm8(PG8_LAS unsigned char* lds, const Gemm8 g, const Sched& S, const Epi& E) {
    const int tid = threadIdx.x, wid = __builtin_amdgcn_readfirstlane(tid >> 6), lane = tid & 63, wr = wid >> 2, wc = wid & 3, fr = lane & 15, fq = lane >> 4;
    const int K = g.K, nt = K / BK;
    unsigned voffA[2], voffB[2];
#pragma unroll
    for (int i = 0; i < 2; ++i) { int R, C; stage_rc(tid * 16 + i * 8192, R, C); const int Rb = Epi::PERM ? ((R & ~31) + perm32(R & 31)) : R;
        voffA[i] = (unsigned)(R * K + C) * 2u; voffB[i] = (unsigned)(Rb * K + C) * 2u; }
    const size_t kstep = (size_t)(BK * 2);
    const size_t hstep = (size_t)HALF * K * 2;
    const size_t tstep = 2 * hstep;
    const size_t hstepB = (size_t)g.bhalf * K * 2;
    const size_t rowB = (size_t)K * 2;
    const unsigned ldsw = (unsigned)wid * 1024u;
    const int aoff = lds_byte(wr * 64 + fr, fq * 8), boff = lds_byte(wc * 32 + fr, fq * 8);
#define PG8_SA(b, h) (((b) * 2 + (h)) * HTB)
#define PG8_SB(b, h) ((4 + (b) * 2 + (h)) * HTB)
#define PG8_STAGE(bufoff, gbase, voff) do { _Pragma("unroll") for (int _i = 0; _i < 2; ++_i) \
        __builtin_amdgcn_global_load_lds((const unsigned*)((const char*)(gbase) + (voff)[_i]), (PG8_LAS unsigned*)(lds + (bufoff) + ldsw + _i * 8192), 16, 0, 0); } while (0)
#define PG8_LDA(dst, b, h) do { _Pragma("unroll") for (int m = 0; m < 4; ++m) _Pragma("unroll") for (int k = 0; k < 2; ++k) dst[m][k] = *(const PG8_LAS bf16x8*)(lds + PG8_SA(b, h) + aoff + m * 2048 + k * 1024); } while (0)
#define PG8_LDB(dst, b, h) do { _Pragma("unroll") for (int n = 0; n < 2; ++n) _Pragma("unroll") for (int k = 0; k < 2; ++k) dst[n][k] = *(const PG8_LAS bf16x8*)(lds + PG8_SB(b, h) + boff + n * 2048 + k * 1024); } while (0)
#define PG8_MMA(ai, bj, At, Bt) do { __builtin_amdgcn_s_setprio(1); _Pragma("unroll") for (int m = 0; m < 4; ++m) _Pragma("unroll") for (int n = 0; n < 2; ++n) _Pragma("unroll") for (int k = 0; k < 2; ++k) \
        acc[ai][bj][m][n] = __builtin_amdgcn_mfma_f32_16x16x32_bf16(Bt[n][k], At[m][k], acc[ai][bj][m][n], 0, 0, 0); __builtin_amdgcn_s_setprio(0); } while (0)
#define PG8_WAIT_V(n) asm volatile("s_waitcnt vmcnt(" #n ")" ::: "memory")
#define PG8_WAIT_L(n) asm volatile("s_waitcnt lgkmcnt(" #n ")" ::: "memory")
#define PG8_BAR __builtin_amdgcn_s_barrier()
#define PG8_SCHED __builtin_amdgcn_sched_barrier(0)
    Unit cur, nxt; int ui = 0;
    if (!S.next(0, cur)) return;
    f32x4 acc[2][2][4][2];
#pragma unroll
    for (int a = 0; a < 2; ++a)
#pragma unroll
        for (int b = 0; b < 2; ++b)
#pragma unroll
            for (int m = 0; m < 4; ++m)
#pragma unroll
                for (int n = 0; n < 2; ++n) acc[a][b][m][n] = (f32x4){0.f, 0.f, 0.f, 0.f};
    bf16x8 At[4][2], B0[2][2], B1[2][2];
    const char* cA = (const char*)g.A + (size_t)cur.pm * tstep; const char* cB = (const char*)g.Bt + (size_t)cur.brow * rowB;
    S.a_ready(cur);
    PG8_STAGE(PG8_SB(0, 0), cB, voffB); PG8_STAGE(PG8_SA(0, 0), cA, voffA); PG8_STAGE(PG8_SB(0, 1), cB + hstepB, voffB); PG8_STAGE(PG8_SA(0, 1), cA + hstep, voffA);
    if (wr == 1) PG8_BAR;
    PG8_WAIT_V(4); PG8_BAR;
    PG8_STAGE(PG8_SB(1, 0), cB + kstep, voffB); PG8_STAGE(PG8_SA(1, 0), cA + kstep, voffA); PG8_STAGE(PG8_SB(1, 1), cB + hstepB + kstep, voffB);
    PG8_WAIT_V(6); PG8_BAR;
    for (;;) {
        const bool has_next = S.next(ui + 1, nxt);
        const char* nA = has_next ? (const char*)g.A + (size_t)nxt.pm * tstep : cA; const char* nB = has_next ? (const char*)g.Bt + (size_t)nxt.brow * rowB : cB;
        for (int t = 0; t < nt; t += 2) {
            const bool last = (t == nt - 2);
            const char* a1 = cA + (size_t)(t + 1) * kstep;
            const char* a2 = last ? nA : cA + (size_t)(t + 2) * kstep; const char* b2 = last ? nB : cB + (size_t)(t + 2) * kstep;
            const char* a3 = a2 + kstep; const char* b3 = b2 + kstep;
            if (last && has_next) S.a_ready(nxt);
            PG8_LDB(B0, 0, 0); PG8_SCHED; PG8_LDA(At, 0, 0); PG8_STAGE(PG8_SA(1, 1), a1 + hstep, voffA);
            PG8_WAIT_L(8); PG8_BAR; PG8_WAIT_L(0); PG8_MMA(0, 0, At, B0); PG8_BAR; PG8_SCHED;
            PG8_LDB(B1, 0, 1); PG8_STAGE(PG8_SB(0, 0), b2, voffB);
            PG8_BAR; PG8_WAIT_L(0); PG8_MMA(0, 1, At, B1); PG8_BAR;
            PG8_LDA(At, 0, 1); PG8_STAGE(PG8_SA(0, 0), a2, voffA);
            PG8_BAR; PG8_WAIT_L(0); PG8_MMA(1, 0, At, B0); PG8_BAR; PG8_SCHED;
            PG8_STAGE(PG8_SB(0, 1), b2 + hstepB, voffB);
            PG8_WAIT_V(6); PG8_BAR; PG8_MMA(1, 1, At, B1); PG8_BAR;
            PG8_LDB(B0, 1, 0); PG8_SCHED; PG8_LDA(At, 1, 0); PG8_STAGE(PG8_SA(0, 1), a2 + hstep, voffA);
            PG8_WAIT_L(8); PG8_BAR; PG8_WAIT_L(0); PG8_MMA(0, 0, At, B0); PG8_BAR; PG8_SCHED;
            PG8_LDB(B1, 1, 1); PG8_STAGE(PG8_SB(1, 0), b3, voffB);
            PG8_BAR; PG8_WAIT_L(0); PG8_MMA(0, 1, At, B1); PG8_BAR;
            PG8_LDA(At, 1, 1); PG8_STAGE(PG8_SA(1, 0), a3, voffA);
            PG8_BAR; PG8_WAIT_L(0); PG8_MMA(1, 0, At, B0); PG8_BAR; PG8_SCHED;
            PG8_STAGE(PG8_SB(1, 1), b3 + hstepB, voffB);
            PG8_WAIT_V(6); PG8_BAR; PG8_MMA(1, 1, At, B1); PG8_BAR;
        }
        if constexpr (!Epi::AFTER_DRAIN) { E(acc, cur, wr, wc, fr, fq); S.done(cur); }
        if (!has_next) break;
#pragma unroll
        for (int a = 0; a < 2; ++a)
#pragma unroll
            for (int b = 0; b < 2; ++b)
#pragma unroll
                for (int m = 0; m < 4; ++m)
#pragma unroll
                    for (int n = 0; n < 2; ++n) acc[a][b][m][n] = (f32x4){0.f, 0.f, 0.f, 0.f};
        cur = nxt; cA = nA; cB = nB; ++ui;
    }
    PG8_WAIT_V(0);
    if (wr == 0) PG8_BAR;
    PG8_BAR;
    if constexpr (Epi::AFTER_DRAIN) { E.fused(acc, cur, wr, wc, fr, fq, lds, wid, lane); S.done(cur); }
#undef PG8_SA
#undef PG8_SB
#undef PG8_STAGE
#undef PG8_LDA
#undef PG8_LDB
#undef PG8_MMA
#undef PG8_WAIT_V
#undef PG8_WAIT_L
#undef PG8_BAR
#undef PG8_SCHED
}

}

DI void phase_p1(const Params& p, char* smem) {
    const int tid = threadIdx.x, wid = tid >> 6, lane = tid & 63, fr = lane & 15, fq = lane >> 4, wr = wid >> 1, wc = wid & 1;
    unsigned char* ws = p.ws;
    const bf16_t* hb = (const bf16_t*)(ws + OFF_H);
    const bf16_t* wt = (const bf16_t*)(ws + OFF_WIN);
    const f32x2* tab = (const f32x2*)(ws + OFF_ROPE);
    bf16_t* qb = (bf16_t*)(ws + OFF_Q); bf16_t* kb = (bf16_t*)(ws + OFF_KB); bf16_t* vT = (bf16_t*)(ws + OFF_VT);
    bf16_t* zr = (bf16_t*)(p.out + OUT_Y);
    const int MT = M / 256, NT = 21;
    for (int t = blockIdx.x; t < MT * NT; t += gridDim.x) {
        int mt, nt; tile_coords(t, MT, NT, mt, nt);
        const int row0 = mt * 256, ncol0 = nt < 6 ? nt * 128 : 2816 + (nt - 6) * 128;
        f32x4 acc[4][4]; zero_acc<4>(acc);
        gemm_acc<4>(acc, hb + (size_t)row0 * 1024, 1024, wt + (size_t)ncol0 * 1024, 1024, 1024, smem, tid);
        const bool latent = row0 >= MC;
#pragma unroll
        for (int mb = 0; mb < 4; ++mb) {
            const int m = row0 + wr * 64 + mb * 16 + fr;
            if (nt < 5 && latent) {
                const int tt = (m - MC) & 2047, prow = tt >> 6, pcol = tt & 63;
#pragma unroll
                for (int j = 0; j < 4; ++j) {
                    const f32x2 cr = tab[prow * 16 + fq * 4 + j], cc = tab[pcol * 16 + fq * 4 + j];
                    const float a1 = acc[mb][0][j], a2 = acc[mb][1][j], b1 = acc[mb][2][j], b2 = acc[mb][3][j];
                    acc[mb][0][j] = a1 * cr.x - a2 * cr.y; acc[mb][1][j] = a2 * cr.x + a1 * cr.y;
                    acc[mb][2][j] = b1 * cc.x - b2 * cc.y; acc[mb][3][j] = b2 * cc.x + b1 * cc.y;
                }
            }
#pragma unroll
            for (int nb = 0; nb < 4; ++nb) {
                const int nl = wc * 64 + nb * 16 + fq * 4;
                const f32x4 v = acc[mb][nb];
                if (nt < 4) { *(u32x2*)(qb + (size_t)m * 512 + nt * 128 + nl) = pack4(v); }
                else if (nt == 4) {
                    if (!latent) *(f32x4*)(p.out + OUT_K + (size_t)m * 128 + nl) = v;
                    *(u32x2*)(kb + (size_t)m * 128 + nl) = pack4(v);
                } else if (nt == 5) {
                    if (!latent) *(f32x4*)(p.out + OUT_V + (size_t)m * 128 + nl) = v;
                    int r0, T; seq_of(m, r0, T);
#pragma unroll
                    for (int j = 0; j < 4; ++j) vT[(size_t)r0 * 128 + (size_t)(nl + j) * T + (m - r0)] = f2bf(v[j]);
                } else { *(u32x2*)(zr + (size_t)m * ZRC + (nt - 6) * 128 + nl) = pack4(v); }
            }
        }
    }
}

#define MFMA32(a, b, c) __builtin_amdgcn_mfma_f32_32x32x16_bf16((a), (b), (c), 0, 0, 0)
DI int crow(int i, int h) { return (i & 3) + 8 * (i >> 2) + 4 * h; }

DI void attn_item(const Params& p, char* smem, int it) {
    const int tid = threadIdx.x, wv = tid >> 6, lane = tid & 63, r = lane & 31, hh = lane >> 5;
    unsigned char* ws = p.ws;
    const bf16_t* qb = (const bf16_t*)(ws + OFF_Q); const bf16_t* kb = (const bf16_t*)(ws + OFF_KB); const bf16_t* vT = (const bf16_t*)(ws + OFF_VT);
    const bf16_t* kc = (const bf16_t*)(ws + OFF_KC); const bf16_t* vct = (const bf16_t*)(ws + OFF_VCT);
    bf16_t* ab = (bf16_t*)(ws + OFF_ATTN);
    bf16_t* Ks = (bf16_t*)smem;
    bf16_t* Vt = (bf16_t*)(smem + 9216);
    const float SC = 0.125f * LOG2E;
    {
        int r0, T, q0, kvh, bl;
        const bool lat = it < 512;
        if (lat) { bl = it >> 6; const int rem = it & 63; q0 = (rem >> 1) * 64; kvh = rem & 1; r0 = MC + bl * 2048; T = 2048; }
        else { const int i2 = it - 512; bl = 0; const int s = i2 >> 3, rem = i2 & 7; q0 = (rem >> 1) * 64; kvh = rem & 1; r0 = s * 256; T = 256; }
        const int head = kvh * 4 + (wv & 3), sub = wv >> 2, qs = q0 + 32 * sub;
        bf16x8 qf[4];
#pragma unroll
        for (int kk = 0; kk < 4; ++kk) qf[kk] = *(const bf16x8*)(qb + (size_t)(r0 + qs + r) * 512 + head * 64 + 16 * kk + 8 * hh);
        const float sinkl = p.attn_sink[head] * LOG2E;
        float mrun = sinkl, lrun = hh == 0 ? 1.0f : 0.0f;
        f32x16 o0, o1;
#pragma unroll
        for (int i = 0; i < 16; ++i) { o0[i] = 0.f; o1[i] = 0.f; }
        const int nwin = lat ? 5 : 4, ntile = lat ? 13 : 4;
        for (int ti = 0; ti < ntile; ++ti) {
            const bf16_t* ksrc; const bf16_t* vsrc; int vstride, ks0; bool window;
            if (ti < nwin) {
                ks0 = lat ? q0 - 128 + 64 * ti : 64 * ti; window = lat;
                if (ks0 < 0 || ks0 >= T) continue;
                ksrc = kb + (size_t)(r0 + ks0) * 128 + kvh * 64; vsrc = vT + (size_t)r0 * 128 + (size_t)(kvh * 64) * T + ks0; vstride = T;
            } else {
                ks0 = 64 * (ti - nwin); window = false;
                ksrc = kc + (size_t)(bl * 512 + ks0) * 128 + kvh * 64; vsrc = vct + (size_t)((bl * 2 + kvh) * 64) * 512 + ks0; vstride = 512;
            }
            __syncthreads();
            {
                const int rw_ = tid >> 3, ch = tid & 7;
                *(u32x4*)(Ks + rw_ * 72 + ch * 8) = *(const u32x4*)(ksrc + (size_t)rw_ * 128 + ch * 8);
                *(u32x4*)(Vt + rw_ * 72 + ch * 8) = *(const u32x4*)(vsrc + (size_t)rw_ * vstride + ch * 8);
            }
            __syncthreads();
#pragma unroll
            for (int sk = 0; sk < 2; ++sk) {
                const int kb0 = ks0 + 32 * sk;
                bool need_mask = false;
                if (window) {
                    if (kb0 > qs + 31 + 128 || kb0 + 31 < qs - 128) continue;
                    need_mask = (kb0 < qs + 31 - 128) || (kb0 + 31 > qs + 128);
                }
                f32x16 x;
#pragma unroll
                for (int i = 0; i < 16; ++i) x[i] = 0.f;
#pragma unroll
                for (int kk = 0; kk < 4; ++kk) {
                    const bf16x8 kf = *(const bf16x8*)(Ks + (32 * sk + r) * 72 + 16 * kk + 8 * hh);
                    x = MFMA32(kf, qf[kk], x);
                }
                float mx = -3.0e38f;
#pragma unroll
                for (int i = 0; i < 16; ++i) {
                    float s = x[i] * SC;
                    if (need_mask) { const int dk = kb0 + crow(i, hh) - (qs + r); if (dk > 128 || dk < -128) s = -3.0e38f; }
                    x[i] = s; mx = fmaxf(mx, s);
                }
                mx = fmaxf(mx, __shfl_xor(mx, 32));
                const float mnew = fmaxf(mrun, mx), alpha = exp2f(mrun - mnew);
                mrun = mnew;
                float ps = 0.f;
#pragma unroll
                for (int i = 0; i < 16; ++i) { const float pv = exp2f(x[i] - mnew); x[i] = pv; ps += pv; }
                lrun = lrun * alpha + ps;
#pragma unroll
                for (int i = 0; i < 16; ++i) { o0[i] *= alpha; o1[i] *= alpha; }
#pragma unroll
                for (int s = 0; s < 2; ++s) {
                    u32x4 pk;
                    pk[0] = pack2(x[8 * s + 0], x[8 * s + 1]); pk[1] = pack2(x[8 * s + 2], x[8 * s + 3]);
                    pk[2] = pack2(x[8 * s + 4], x[8 * s + 5]); pk[3] = pack2(x[8 * s + 6], x[8 * s + 7]);
                    const bf16x8 pf = __builtin_bit_cast(bf16x8, pk);
                    {
                        const s16x4 lo = *(const s16x4*)(Vt + r * 72 + 32 * sk + 16 * s + 4 * hh);
                        const s16x4 hi = *(const s16x4*)(Vt + r * 72 + 32 * sk + 16 * s + 8 + 4 * hh);
                        const bf16x8 vf = __builtin_shufflevector(lo, hi, 0, 1, 2, 3, 4, 5, 6, 7);
                        o0 = MFMA32(vf, pf, o0);
                    }
                    {
                        const s16x4 lo = *(const s16x4*)(Vt + (32 + r) * 72 + 32 * sk + 16 * s + 4 * hh);
                        const s16x4 hi = *(const s16x4*)(Vt + (32 + r) * 72 + 32 * sk + 16 * s + 8 + 4 * hh);
                        const bf16x8 vf = __builtin_shufflevector(lo, hi, 0, 1, 2, 3, 4, 5, 6, 7);
                        o1 = MFMA32(vf, pf, o1);
                    }
                }
            }
        }
        const float ltot = lrun + __shfl_xor(lrun, 32), inv = rcpf_(ltot);
        bf16_t* orow = ab + (size_t)(r0 + qs + r) * 512 + head * 64;
#pragma unroll
        for (int g = 0; g < 4; ++g) {
            f32x4 a, b;
#pragma unroll
            for (int j = 0; j < 4; ++j) { a[j] = o0[4 * g + j] * inv; b[j] = o1[4 * g + j] * inv; }
            *(u32x2*)(orow + 8 * g + 4 * hh) = pack4(a);
            *(u32x2*)(orow + 32 + 8 * g + 4 * hh) = pack4(b);
        }
    }
    __syncthreads();
}

DI void sg_pass(const Params& p) {
    const int tid = threadIdx.x;
    unsigned char* ws = p.ws;
    {
        const bf16_t* zr = (const bf16_t*)(p.out + OUT_Y);
        bf16_t* sg = (bf16_t*)(ws + OFF_SG);
        const float* mu0 = p.rwkv_mu; const float* mu1 = p.rwkv_mu + ZRC;
        for (int i = blockIdx.x * NTHR + tid; i < M * 32; i += gridDim.x * NTHR) {
            const int m = i >> 5, c = (i & 31) * 4;
            int r0, T; seq_of(m, r0, T);
            const bf16_t* zp = zr + (size_t)m * ZRC + 1792 + c;
            const f32x4 z = unpack4(*(const u32x2*)zp);
            f32x4 zprev = (f32x4){0.f, 0.f, 0.f, 0.f}, znext = zprev;
            if (m > r0) zprev = unpack4(*(const u32x2*)(zp - ZRC));
            if (m < r0 + T - 1) znext = unpack4(*(const u32x2*)(zp + ZRC));
            const f32x4 a0 = *(const f32x4*)(mu0 + 1792 + c), a1 = *(const f32x4*)(mu1 + 1792 + c);
            f32x4 o;
#pragma unroll
            for (int j = 0; j < 4; ++j) { const float zs = z[j] + a0[j] * (zprev[j] - z[j]) + a1[j] * (znext[j] - z[j]); o[j] = sigmoidf_(zs); }
            *(u32x2*)(sg + (size_t)m * 128 + c) = pack4(o);
        }
    }
}


template <int CTRL> DI float dpp_f(float x) { return __builtin_bit_cast(float, __builtin_amdgcn_mov_dpp(__builtin_bit_cast(int, x), CTRL, 0xf, 0xf, true)); }
DI float swap32_sum(float x) {
    float a = x, b = x;
    asm volatile("s_nop 1\n\tv_permlane32_swap_b32 %0, %1\n\ts_nop 1" : "+v"(a), "+v"(b));
    return a + b;
}
DI float row16_allsum(float x) { x += dpp_f<0x128>(x); x += dpp_f<0x124>(x); x += dpp_f<0x122>(x); x += dpp_f<0x121>(x); return x; }
template <int E> DI float qbc(f32x2 v) { return dpp_f<(E >> 1) * 0x55>((E & 1) ? v.y : v.x); }

#define QP0 " quad_perm:[0,0,0,0] row_mask:0xf bank_mask:0xf bound_ctrl:1\n\t"
#define QP1 " quad_perm:[1,1,1,1] row_mask:0xf bank_mask:0xf bound_ctrl:1\n\t"
#define QP2 " quad_perm:[2,2,2,2] row_mask:0xf bank_mask:0xf bound_ctrl:1\n\t"
#define QP3 " quad_perm:[3,3,3,3] row_mask:0xf bank_mask:0xf bound_ctrl:1\n\t"
#define ROR4 " row_ror:4 row_mask:0xf bank_mask:0xf bound_ctrl:1\n\t"
#define ROR8 " row_ror:8 row_mask:0xf bank_mask:0xf bound_ctrl:1\n\t"
DI float scan_sa(const float (&S)[8], f32x2 A) {
    float sa, t1, t2, t3;
    asm volatile(
        "s_nop 1\n\t"
        "v_mul_f32_dpp %0, %12, %4" QP0
        "v_mul_f32_dpp %1, %13, %5" QP0
        "v_mul_f32_dpp %2, %12, %6" QP1
        "v_mul_f32_dpp %3, %13, %7" QP1
        "v_fmac_f32_dpp %0, %12, %8" QP2
        "v_fmac_f32_dpp %1, %13, %9" QP2
        "v_fmac_f32_dpp %2, %12, %10" QP3
        "v_fmac_f32_dpp %3, %13, %11" QP3
        "v_add_f32 %0, %0, %1\n\t"
        "v_add_f32 %2, %2, %3\n\t"
        "v_add_f32 %0, %0, %2\n\t"
        "s_nop 1\n\t"
        "v_add_f32_dpp %0, %0, %0" ROR4
        "s_nop 1\n\t"
        "v_add_f32_dpp %0, %0, %0" ROR8
        "v_mov_b32 %1, %0\n\t"
        "s_nop 1\n\t"
        "v_permlane32_swap_b32 %0, %1\n\t"
        "s_nop 1\n\t"
        "v_add_f32 %0, %0, %1"
        : "=&v"(sa), "=&v"(t1), "=&v"(t2), "=&v"(t3)
        : "v"(S[0]), "v"(S[1]), "v"(S[2]), "v"(S[3]), "v"(S[4]), "v"(S[5]), "v"(S[6]), "v"(S[7]), "v"(A.x), "v"(A.y));
    return sa;
}
DI float scan_upd(float (&S)[8], float sa, float vv, f32x2 B, f32x2 K, f32x2 W, f32x2 R) {
    float n0, n1, n2, n3, n4, n5, n6, n7, y0, y1, y2, y3;
    asm volatile(
        "s_nop 1\n\t"
        "v_mul_f32_dpp %0, %22, %20" QP0  "v_mul_f32_dpp %1, %23, %20" QP0  "v_mul_f32_dpp %2, %22, %20" QP1  "v_mul_f32_dpp %3, %23, %20" QP1
        "v_mul_f32_dpp %4, %22, %20" QP2  "v_mul_f32_dpp %5, %23, %20" QP2  "v_mul_f32_dpp %6, %22, %20" QP3  "v_mul_f32_dpp %7, %23, %20" QP3
        "v_fmac_f32_dpp %0, %24, %21" QP0  "v_fmac_f32_dpp %1, %25, %21" QP0  "v_fmac_f32_dpp %2, %24, %21" QP1  "v_fmac_f32_dpp %3, %25, %21" QP1
        "v_fmac_f32_dpp %4, %24, %21" QP2  "v_fmac_f32_dpp %5, %25, %21" QP2  "v_fmac_f32_dpp %6, %24, %21" QP3  "v_fmac_f32_dpp %7, %25, %21" QP3
        "v_fmac_f32_dpp %0, %26, %12" QP0  "v_fmac_f32_dpp %1, %27, %13" QP0  "v_fmac_f32_dpp %2, %26, %14" QP1  "v_fmac_f32_dpp %3, %27, %15" QP1
        "v_fmac_f32_dpp %4, %26, %16" QP2  "v_fmac_f32_dpp %5, %27, %17" QP2  "v_fmac_f32_dpp %6, %26, %18" QP3  "v_fmac_f32_dpp %7, %27, %19" QP3
        "v_mul_f32_dpp %8, %28, %0" QP0   "v_mul_f32_dpp %9, %29, %1" QP0   "v_mul_f32_dpp %10, %28, %2" QP1  "v_mul_f32_dpp %11, %29, %3" QP1
        "v_fmac_f32_dpp %8, %28, %4" QP2  "v_fmac_f32_dpp %9, %29, %5" QP2  "v_fmac_f32_dpp %10, %28, %6" QP3 "v_fmac_f32_dpp %11, %29, %7" QP3
        "v_add_f32 %8, %8, %9\n\t"
        "v_add_f32 %10, %10, %11\n\t"
        "v_add_f32 %8, %8, %10\n\t"
        "s_nop 1\n\t"
        "v_add_f32_dpp %8, %8, %8" ROR4
        "s_nop 1\n\t"
        "v_add_f32_dpp %8, %8, %8" ROR8
        "v_mov_b32 %9, %8\n\t"
        "s_nop 1\n\t"
        "v_permlane32_swap_b32 %8, %9\n\t"
        "s_nop 1\n\t"
        "v_add_f32 %8, %8, %9"
        : "=&v"(n0), "=&v"(n1), "=&v"(n2), "=&v"(n3), "=&v"(n4), "=&v"(n5), "=&v"(n6), "=&v"(n7), "=&v"(y0), "=&v"(y1), "=&v"(y2), "=&v"(y3)
        : "v"(S[0]), "v"(S[1]), "v"(S[2]), "v"(S[3]), "v"(S[4]), "v"(S[5]), "v"(S[6]), "v"(S[7]), "v"(sa), "v"(vv),
          "v"(B.x), "v"(B.y), "v"(K.x), "v"(K.y), "v"(W.x), "v"(W.y), "v"(R.x), "v"(R.y));
    S[0] = n0; S[1] = n1; S[2] = n2; S[3] = n3; S[4] = n4; S[5] = n5; S[6] = n6; S[7] = n7;
    return y0;
}

constexpr int SC_OPW = 0, SC_OPK = 8192, SC_OPA = 16384, SC_OPB = 24576, SC_OPR = 32768, SC_OPV = 40960;
constexpr int SC_AW = 49152, SC_AA = SC_AW + 32 * 144;
constexpr int SC_LO = SC_AA + 32 * 144;
constexpr int SC_YB = SC_LO + 2 * 32 * 68 * 4;
static_assert(SC_YB + 8192 <= LDS_MAIN, "scan LDS");

DI void lds_barrier() { asm volatile("s_waitcnt lgkmcnt(0)\n\ts_barrier" ::: "memory"); }

constexpr int S2_OP = 0;
constexpr int S2_AW = 49152, S2_AA = S2_AW + 2304;
constexpr int S2_LO = S2_AA + 2304;
constexpr int S2_YB = S2_LO + 8704;
static_assert(S2_YB + 8192 <= LDS_MAIN, "scan LDS");

DI void scan_item(const Params& p, char* smem, int r0, int T, int dsel, int h, const float* state0, float* state_out) {
    const int tid = threadIdx.x, wv = tid >> 6, lane = tid & 63;
    const bool is_scan = wv < 4;
    unsigned char* ws = p.ws;
    const bf16_t* zr = (const bf16_t*)(p.out + OUT_Y);
    float* ys = (float*)(ws + OFF_YS) + (size_t)dsel * M * 512;
    float* bn = (float*)(ws + OFF_BN);
    float* op = (float*)(smem + S2_OP);
    bf16_t* Aw = (bf16_t*)(smem + S2_AW); bf16_t* Aa = (bf16_t*)(smem + S2_AA);
    float* Lo = (float*)(smem + S2_LO); float* yb = (float*)(smem + S2_YB);
    const int nchunk = T >> 4;

    const int rr = (lane & 3) | ((lane >> 4) << 2), jq = (lane >> 2) & 3, irow = 16 * (wv & 3) + rr, jb = 16 * jq;
    f32x4 S0, S1, S2, S3;
    if (state0 && is_scan) {
        const float* sp = state0 + irow * 64 + jb;
        S0 = *(const f32x4*)sp; S1 = *(const f32x4*)(sp + 4); S2 = *(const f32x4*)(sp + 8); S3 = *(const f32x4*)(sp + 12);
    } else { S0 = (f32x4){0.f, 0.f, 0.f, 0.f}; S1 = S0; S2 = S0; S3 = S0; }

    const int ptid = tid & 255, tt = ptid >> 4, cg4 = (ptid & 15) * 4;
    const int segc[5] = {h * 64 + cg4, 512 + h * 64 + cg4, 1024 + h * 64 + cg4, 1536 + dsel * 64 + cg4, 1664 + dsel * 64 + cg4};
    const int pL = (wv >> 1) & 1, pnh = wv & 1, fr = lane & 15, fq = lane >> 4;
    const bf16_t* wt = (const bf16_t*)(ws + (pL == 0 ? OFF_W2T : OFF_A2T)) + (size_t)(dsel * 512 + h * 64) * 64;
    u32x2 zc[5], zp[5], zn[5];
    f32x4 kreg, kkreg, rreg;
    auto load_chunk = [&](int c) {
        const int st = 16 * c + tt, tok = dsel ? T - 1 - st : st;
        const bf16_t* base = zr + (size_t)(r0 + tok) * ZRC;
#pragma unroll
        for (int s = 0; s < 5; ++s) {
            zc[s] = *(const u32x2*)(base + segc[s]);
            zp[s] = (u32x2){0u, 0u}; zn[s] = (u32x2){0u, 0u};
            if (tok > 0) zp[s] = *(const u32x2*)(base - ZRC + segc[s]);
            if (tok < T - 1) zn[s] = *(const u32x2*)(base + ZRC + segc[s]);
        }
    };
    auto prodA = [&](int buf) {
        f32x4 zs[5];
#pragma unroll
        for (int s = 0; s < 5; ++s) {
            const f32x4 mu0 = *(const f32x4*)(p.rwkv_mu + segc[s]), mu1 = *(const f32x4*)(p.rwkv_mu + ZRC + segc[s]);
            const f32x4 z = unpack4(zc[s]), a = unpack4(zp[s]), b = unpack4(zn[s]);
            zs[s] = z + mu0 * (a - z) + mu1 * (b - z);
        }
        const f32x4 kkv = *(const f32x4*)(p.rwkv_k_k + h * 64 + cg4);
        f32x4 kk = zs[1] * kkv;
        float n2 = kk[0] * kk[0] + kk[1] * kk[1] + kk[2] * kk[2] + kk[3] * kk[3];
        n2 = row16_allsum(n2);
        kk = kk * __builtin_amdgcn_rsqf(fmaxf(n2, 1e-24f));
        f32x4 tw;
#pragma unroll
        for (int j = 0; j < 4; ++j) tw[j] = 1.0f - 2.0f * rcpf_(1.0f + __expf(2.0f * zs[3][j]));
        *(u32x2*)(Aw + tt * 72 + cg4) = pack4(tw);
        *(u32x2*)(Aa + tt * 72 + cg4) = pack4(zs[4]);
        float* ob = op + buf * 6144 + tt * 64 + cg4;
        *(f32x4*)(ob + 4 * 1024) = zs[0];
        *(f32x4*)(ob + 5 * 1024) = zs[2];
        *(f32x4*)(ob + 2 * 1024) = -kk;
        kreg = zs[1]; kkreg = kk; rreg = zs[0];
    };
    auto prodB = [&]() {
        const bf16_t* As = pL == 0 ? Aw : Aa;
        const bf16x8 a0 = *(const bf16x8*)(As + fr * 72 + fq * 8), a1 = *(const bf16x8*)(As + fr * 72 + 32 + fq * 8);
#pragma unroll
        for (int n2 = 0; n2 < 2; ++n2) {
            f32x4 x = (f32x4){0.f, 0.f, 0.f, 0.f};
            const bf16_t* wr_ = wt + (size_t)((pnh * 2 + n2) * 16 + fr) * 64 + fq * 8;
            x = __builtin_amdgcn_mfma_f32_16x16x32_bf16(a0, *(const bf16x8*)wr_, x, 0, 0, 0);
            x = __builtin_amdgcn_mfma_f32_16x16x32_bf16(a1, *(const bf16x8*)(wr_ + 32), x, 0, 0, 0);
#pragma unroll
            for (int j = 0; j < 4; ++j) Lo[(pL * 16 + fq * 4 + j) * 68 + (pnh * 2 + n2) * 16 + fr] = x[j];
        }
    };
    auto prodC = [&](int c, int buf) {
        const int st = 16 * c + tt, tok = dsel ? T - 1 - st : st, m = r0 + tok;
        const f32x4 w0v = *(const f32x4*)(p.rwkv_w0 + dsel * 512 + h * 64 + cg4), a0v = *(const f32x4*)(p.rwkv_a0 + dsel * 512 + h * 64 + cg4);
        const f32x4 kav = *(const f32x4*)(p.rwkv_k_a + h * 64 + cg4), rkv = *(const f32x4*)(p.rwkv_r_k + h * 64 + cg4);
        const f32x4 lw = *(const f32x4*)(Lo + tt * 68 + cg4), la = *(const f32x4*)(Lo + (16 + tt) * 68 + cg4);
        f32x4 wd, kd, bb; float bs = 0.f;
#pragma unroll
        for (int j = 0; j < 4; ++j) {
            wd[j] = __expf(-0.6065306597126334f * sigmoidf_(w0v[j] + lw[j]));
            const float a = sigmoidf_(a0v[j] + la[j]);
            kd[j] = kreg[j] * (1.0f + (a - 1.0f) * kav[j]);
            bb[j] = a * kkreg[j];
            bs += rreg[j] * kd[j] * rkv[j];
        }
        float* ob = op + buf * 6144 + tt * 64 + cg4;
        *(f32x4*)(ob) = wd;
        *(f32x4*)(ob + 1024) = kd;
        *(f32x4*)(ob + 3 * 1024) = bb;
        bs = row16_allsum(bs);
        if ((ptid & 15) == 0) bn[(size_t)m * 16 + dsel * 8 + h] = bs;
    };
    auto flush_ys = [&](int c) {
        const int st = 16 * c + tt, tok = dsel ? T - 1 - st : st, m = r0 + tok;
        *(f32x4*)(ys + (size_t)m * 512 + h * 64 + cg4) = *(const f32x4*)(yb + (c & 1) * 1024 + tt * 64 + cg4);
    };
    auto chunk_steps = [&](int buf) {
        const float* ob = op + buf * 6144 + jb;
        const float* ov = op + buf * 6144 + 5 * 1024 + irow;
        float* yo = yb + buf * 1024 + irow;
        f32x4 W0 = *(const f32x4*)(ob), W1 = *(const f32x4*)(ob + 4), W2 = *(const f32x4*)(ob + 8), W3 = *(const f32x4*)(ob + 12);
        f32x4 K0 = *(const f32x4*)(ob + 1024), K1 = *(const f32x4*)(ob + 1028), K2 = *(const f32x4*)(ob + 1032), K3 = *(const f32x4*)(ob + 1036);
        f32x4 A0 = *(const f32x4*)(ob + 2048), A1 = *(const f32x4*)(ob + 2052), A2 = *(const f32x4*)(ob + 2056), A3 = *(const f32x4*)(ob + 2060);
        f32x4 B0 = *(const f32x4*)(ob + 3072), B1 = *(const f32x4*)(ob + 3076), B2 = *(const f32x4*)(ob + 3080), B3 = *(const f32x4*)(ob + 3084);
        f32x4 R0 = *(const f32x4*)(ob + 4096), R1 = *(const f32x4*)(ob + 4100), R2 = *(const f32x4*)(ob + 4104), R3 = *(const f32x4*)(ob + 4108);
        float vv = ov[0];
#pragma unroll 2
        for (int s = 0; s < 16; ++s) {
            const float* o = ob + ((s + 1) & 15) * 64;
            const f32x4 W0n = *(const f32x4*)(o), W1n = *(const f32x4*)(o + 4), W2n = *(const f32x4*)(o + 8), W3n = *(const f32x4*)(o + 12);
            const f32x4 K0n = *(const f32x4*)(o + 1024), K1n = *(const f32x4*)(o + 1028), K2n = *(const f32x4*)(o + 1032), K3n = *(const f32x4*)(o + 1036);
            const f32x4 A0n = *(const f32x4*)(o + 2048), A1n = *(const f32x4*)(o + 2052), A2n = *(const f32x4*)(o + 2056), A3n = *(const f32x4*)(o + 2060);
            const f32x4 B0n = *(const f32x4*)(o + 3072), B1n = *(const f32x4*)(o + 3076), B2n = *(const f32x4*)(o + 3080), B3n = *(const f32x4*)(o + 3084);
            const f32x4 R0n = *(const f32x4*)(o + 4096), R1n = *(const f32x4*)(o + 4100), R2n = *(const f32x4*)(o + 4104), R3n = *(const f32x4*)(o + 4108);
            const float vn = ov[((s + 1) & 15) * 64];
            const f32x4 pa = (S0 * A0 + S1 * A1) + (S2 * A2 + S3 * A3);
            float sa = (pa[0] + pa[1]) + (pa[2] + pa[3]);
            sa += dpp_f<0x124>(sa); sa += dpp_f<0x128>(sa);
            S0 = S0 * W0 + (B0 * sa + K0 * vv);
            S1 = S1 * W1 + (B1 * sa + K1 * vv);
            S2 = S2 * W2 + (B2 * sa + K2 * vv);
            S3 = S3 * W3 + (B3 * sa + K3 * vv);
            const f32x4 py = (S0 * R0 + S1 * R1) + (S2 * R2 + S3 * R3);
            float y = (py[0] + py[1]) + (py[2] + py[3]);
            y += dpp_f<0x124>(y); y += dpp_f<0x128>(y);
            if (jq == 0) yo[s * 64] = y;
            W0 = W0n; W1 = W1n; W2 = W2n; W3 = W3n; K0 = K0n; K1 = K1n; K2 = K2n; K3 = K3n; A0 = A0n; A1 = A1n; A2 = A2n; A3 = A3n;
            B0 = B0n; B1 = B1n; B2 = B2n; B3 = B3n; R0 = R0n; R1 = R1n; R2 = R2n; R3 = R3n; vv = vn;
            if (s == 4 || s == 9) lds_barrier();
        }
    };

    lds_barrier();
    if (is_scan) {
        lds_barrier(); lds_barrier(); lds_barrier();
#pragma unroll 1
        for (int c = 0; c < nchunk; ++c) {
            chunk_steps(c & 1);
            lds_barrier();
        }
        if (state_out) {
            float* sp = state_out + irow * 64 + jb;
            *(f32x4*)sp = S0; *(f32x4*)(sp + 4) = S1; *(f32x4*)(sp + 8) = S2; *(f32x4*)(sp + 12) = S3;
        }
    } else {
        load_chunk(0); prodA(0);
        lds_barrier();
        prodB();
        lds_barrier();
        prodC(0, 0); if (nchunk > 1) load_chunk(1);
        lds_barrier();
#pragma unroll 1
        for (int c = 0; c < nchunk; ++c) {
            const int b = c & 1;
            const bool more = c + 1 < nchunk;
            if (c > 0) flush_ys(c - 1);
            if (more) prodA(b ^ 1);
            lds_barrier();
            if (more) prodB();
            lds_barrier();
            if (more) { prodC(c + 1, b ^ 1); if (c + 2 < nchunk) load_chunk(c + 2); }
            lds_barrier();
        }
        flush_ys(nchunk - 1);
    }
    lds_barrier();
}

DI void scan_dispatch(const Params& p, char* smem, int it) {
    if (it < 128) {
        const int b = it >> 4, dsel = (it >> 3) & 1, h = it & 7;
        scan_item(p, smem, MC + b * 2048, 2048, dsel, h, p.state_rwkv + (size_t)((b * 2 + dsel) * 8 + h) * 4096, nullptr);
    } else {
        const int i2 = it - 128, s = i2 >> 4, dsel = (i2 >> 3) & 1, h = i2 & 7;
        scan_item(p, smem, s * 256, 256, dsel, h, nullptr, p.out + OUT_S + (size_t)((s * 2 + dsel) * 8 + h) * 4096);
    }
}
DI void phase_mix(const Params& p, char* smem) {
    unsigned* ctr = (unsigned*)(p.ws + OFF_BAR) + XCD_BAR_WORDS;
    volatile LAS unsigned* slot = (volatile LAS unsigned*)(smem + LDS_MAIN + 8);
    for (;;) {
        if (threadIdx.x == 0) *slot = __hip_atomic_fetch_add(ctr, 1u, __ATOMIC_RELAXED, __HIP_MEMORY_SCOPE_AGENT);
        __syncthreads();
        const int it = (int)*slot;
        __syncthreads();
        if (it >= 640 + 768) break;
        if (it < 640) scan_dispatch(p, smem, it);
        else attn_item(p, smem, it - 640);
    }
    sg_pass(p);
}

DI void phase_post(const Params& p, char* smem) {
    const int tid = threadIdx.x, wid = tid >> 6, lane = tid & 63, fr = lane & 15, fq = lane >> 4, wr = wid >> 1, wc = wid & 1;
    unsigned char* ws = p.ws;
    const bf16_t* sg = (const bf16_t*)(ws + OFF_SG); const bf16_t* g2t = (const bf16_t*)(ws + OFF_G2T);
    const float* ys0 = (const float*)(ws + OFF_YS); const float* ys1 = ys0 + (size_t)M * 512;
    const float* bn = (const float*)(ws + OFF_BN);
    const bf16_t* zr = (const bf16_t*)(p.out + OUT_Y);
    bf16_t* rw = (bf16_t*)(ws + OFF_RW);
    const int MT = M / 256, NT = 4;
    for (int t = blockIdx.x; t < MT * NT; t += gridDim.x) {
        int mt, nt; tile_coords(t, MT, NT, mt, nt);
        const int row0 = mt * 256;
        f32x4 acc[4][4]; zero_acc<4>(acc);
        gemm_acc<4>(acc, sg + (size_t)row0 * 128, 128, g2t + (size_t)(nt * 128) * 128, 128, 128, smem, tid);
        const int head = nt * 2 + wc;
#pragma unroll
        for (int mb = 0; mb < 4; ++mb) {
            const int m = row0 + wr * 64 + mb * 16 + fr;
            int r0, T; seq_of(m, r0, T);
            f32x4 y[4]; float s1 = 0.f;
#pragma unroll
            for (int nb = 0; nb < 4; ++nb) {
                const size_t o = (size_t)m * 512 + head * 64 + nb * 16 + fq * 4;
                y[nb] = *(const f32x4*)(ys0 + o) + *(const f32x4*)(ys1 + o);
                s1 += y[nb][0] + y[nb][1] + y[nb][2] + y[nb][3];
            }
            s1 += __shfl_xor(s1, 16); s1 += __shfl_xor(s1, 32);
            const float mean = s1 * (1.0f / 64.0f);
            float s2 = 0.f;
#pragma unroll
            for (int nb = 0; nb < 4; ++nb) { const f32x4 dlt = y[nb] - mean; s2 += dlt[0] * dlt[0] + dlt[1] * dlt[1] + dlt[2] * dlt[2] + dlt[3] * dlt[3]; }
            s2 += __shfl_xor(s2, 16); s2 += __shfl_xor(s2, 32);
            const float rstd = __builtin_amdgcn_rsqf(s2 * (1.0f / 64.0f) + 64e-5f);
            const float bonus = bn[(size_t)m * 16 + head] + bn[(size_t)m * 16 + 8 + head];
#pragma unroll
            for (int nb = 0; nb < 4; ++nb) {
                const int c = head * 64 + nb * 16 + fq * 4;
                const bf16_t* zp = zr + (size_t)m * ZRC + 1024 + c;
                const f32x4 z = unpack4(*(const u32x2*)zp);
                f32x4 zprev = (f32x4){0.f, 0.f, 0.f, 0.f}, znext = zprev;
                if (m > r0) zprev = unpack4(*(const u32x2*)(zp - ZRC));
                if (m < r0 + T - 1) znext = unpack4(*(const u32x2*)(zp + ZRC));
                const f32x4 a0 = *(const f32x4*)(p.rwkv_mu + 1024 + c), a1 = *(const f32x4*)(p.rwkv_mu + ZRC + 1024 + c);
                const f32x4 v = z + a0 * (zprev - z) + a1 * (znext - z);
                const f32x4 lg = *(const f32x4*)(p.rwkv_ln_g + c), lb = *(const f32x4*)(p.rwkv_ln_b + c);
                const f32x4 yn = (y[nb] - mean) * rstd * lg + lb;
                const f32x4 o = (yn + v * bonus) * acc[mb][nb];
                *(u32x2*)(rw + (size_t)m * 512 + c) = pack4(o);
            }
        }
    }
}

DI void phase_merge(const Params& p, char* smem) {
    const int tid = threadIdx.x, wid = tid >> 6, lane = tid & 63, fr = lane & 15, fq = lane >> 4, wr = wid >> 1, wc = wid & 1;
    unsigned char* ws = p.ws;
    const bf16_t* hb = (const bf16_t*)(ws + OFF_H); const bf16_t* wt = (const bf16_t*)(ws + OFF_WIN);
    const bf16_t* ab = (const bf16_t*)(ws + OFF_ATTN); const bf16_t* rw = (const bf16_t*)(ws + OFF_RW);
    const bf16_t* wpa = (const bf16_t*)(ws + OFF_WPA); const bf16_t* wpb = (const bf16_t*)(ws + OFF_WPB);
    bf16_t* mg = (bf16_t*)(ws + OFF_MRG);
    const int MT = M / 256, NT = 16;
    for (int t = blockIdx.x; t < MT * NT; t += gridDim.x) {
        int mt, nt; tile_coords(t, MT, NT, mt, nt);
        const int row0 = mt * 256, n0 = nt * 64;
        u32x2 gpa[4][2], gpb[4][2];
        {
            f32x4 gacc[4][4]; zero_acc<4>(gacc);
            gemm_acc<4, 1024>(gacc, hb + (size_t)row0 * 1024, 1024, wt + (size_t)(768 + n0) * 1024, 1024, 1024, smem, tid);
#pragma unroll
            for (int a = 0; a < 4; ++a)
#pragma unroll
                for (int b = 0; b < 2; ++b) {
                    f32x4 ga, gb;
#pragma unroll
                    for (int j = 0; j < 4; ++j) { ga[j] = sigmoidf_(gacc[a][b][j]); gb[j] = sigmoidf_(gacc[a][b + 2][j]); }
                    gpa[a][b] = pack4(ga); gpb[a][b] = pack4(gb);
                }
        }
        f32x4 acc[4][2], res[4][2];
        zero_acc<2>(acc);
        gemm_acc<2>(acc, ab + (size_t)row0 * 512, 512, wpa + (size_t)n0 * 512, 512, 512, smem, tid);
#pragma unroll
        for (int a = 0; a < 4; ++a)
#pragma unroll
            for (int b = 0; b < 2; ++b) res[a][b] = unpack4(gpa[a][b]) * acc[a][b];
        zero_acc<2>(acc);
        gemm_acc<2>(acc, rw + (size_t)row0 * 512, 512, wpb + (size_t)n0 * 512, 512, 512, smem, tid);
#pragma unroll
        for (int mb = 0; mb < 4; ++mb) {
            const int m = row0 + wr * 64 + mb * 16 + fr;
#pragma unroll
            for (int nb = 0; nb < 2; ++nb) {
                const f32x4 o = res[mb][nb] + unpack4(gpb[mb][nb]) * acc[mb][nb];
                *(u32x2*)(mg + (size_t)m * 1024 + n0 + wc * 32 + nb * 16 + fq * 4) = pack4(o);
            }
        }
    }
}

struct EpiOut {
    static constexpr bool PERM = false, AFTER_DRAIN = false;
    float* y; const float* mod; const float* xp; const float* xs;
    __device__ __forceinline__ void operator()(const f32x4 (&acc)[2][2][4][2], const pg8::Unit& u, int wr, int wc, int fr, int fq) const {
        const int row0 = u.pm * 256 + wr * 64 + fr, col0 = u.pn * 256 + wc * 32 + 4 * fq, ci = cond_of(u.pm * 256);
        const float* xb = u.pm * 256 < MC ? xp : xs - (size_t)MC * D;
#pragma unroll
        for (int bj = 0; bj < 2; ++bj)
#pragma unroll
            for (int n = 0; n < 2; ++n) {
                const int col = col0 + bj * 128 + n * 16;
                const f32x4 g1 = *(const f32x4*)(mod + ci * 6144 + 2048 + col);
#pragma unroll
                for (int ai = 0; ai < 2; ++ai)
#pragma unroll
                    for (int m = 0; m < 4; ++m) {
                        const size_t o = (size_t)(row0 + ai * 128 + m * 16) * D + col;
                        *(f32x4*)(y + o) = *(const f32x4*)(xb + o) + g1 * acc[ai][bj][m][n];
                    }
            }
    }
};
DI void phase_out(const Params& p, char* smem) {
    const int tid = threadIdx.x, wid = tid >> 6, lane = tid & 63, fr = lane & 15, fq = lane >> 4, wr = wid >> 1, wc = wid & 1;
    unsigned char* ws = p.ws;
    const bf16_t* mg = (const bf16_t*)(ws + OFF_MRG); const bf16_t* wo = (const bf16_t*)(ws + OFF_WOUT);
    const float* mod = (const float*)(ws + OFF_MOD);
    const int nM = M / 256, nN = 4, G = gridDim.x, nfirst = G < nM * nN ? G : nM * nN;
    {
        const pg8::Gemm8 g = {mg, wo, 1024, 128};
        const pg8::Order8 ord = {nM, nN, nfirst, G, (int)blockIdx.x};
        const EpiOut epi = {p.out + OUT_Y, mod, p.x_prompt, p.x_sample};
        pg8::gemm8((LAS unsigned char*)smem, g, ord, epi);
    }
    for (int t = blockIdx.x; t < 2 * (nM * nN - nfirst); t += G) {
        int pm, pn; pg8::unit_of(nfirst + (t >> 1), nM, nN, pm, pn);
        const int row0 = pm * 256, n0 = pn * 256 + (t & 1) * 128;
        f32x4 acc[4][4]; zero_acc<4>(acc);
        gemm_acc<4>(acc, mg + (size_t)row0 * 1024, 1024, wo + (size_t)n0 * 1024, 1024, 1024, smem, tid);
        const int ci = cond_of(row0);
#pragma unroll
        for (int nb = 0; nb < 4; ++nb) {
            const int n = n0 + wc * 64 + nb * 16 + fq * 4;
            const f32x4 g1 = *(const f32x4*)(mod + ci * 6144 + 2048 + n);
#pragma unroll
            for (int mb = 0; mb < 4; ++mb) {
                const int m = row0 + wr * 64 + mb * 16 + fr;
                const f32x4 xv = *(const f32x4*)(xrow(p, m) + n);
                *(f32x4*)(p.out + OUT_Y + (size_t)m * D + n) = xv + g1 * acc[mb][nb];
            }
        }
    }
}

DI u32x2 conv_act(const f32x4 (&um)[2], const f32x4 (&u0)[2], const f32x4 (&up)[2], const float* cw, const float* cb, int gcol) {
    f32x4 res[2];
#pragma unroll
    for (int part = 0; part < 2; ++part) {
        const int cc = gcol + part * DFF;
        const f32x4 w0 = *(const f32x4*)(cw + cc), w1 = *(const f32x4*)(cw + 5632 + cc), w2 = *(const f32x4*)(cw + 2 * 5632 + cc), bb = *(const f32x4*)(cb + cc);
        res[part] = um[part] * w0 + u0[part] * w1 + up[part] * w2 + bb;
    }
    f32x4 o;
#pragma unroll
    for (int j = 0; j < 4; ++j) { const float g = res[1][j]; o[j] = g * rcpf_(1.0f + __expf(-g)) * res[0][j]; }
    return pack4(o);
}
DI void phase_up(const Params& p, char* smem) {
    const int tid = threadIdx.x, wid = tid >> 6, lane = tid & 63, fr = lane & 15, fq = lane >> 4, wr = wid >> 1, wc = wid & 1;
    unsigned char* ws = p.ws;
    const bf16_t* hb = (const bf16_t*)(ws + OFF_H); const bf16_t* wu = (const bf16_t*)(ws + OFF_WUP);
    bf16_t* act = (bf16_t*)(ws + OFF_ACT); bf16_t* ub = (bf16_t*)(ws + OFF_U);
    bf16_t* ut = (bf16_t*)smem;
    const int MT = M / 256, NT = 22;
    for (int t = blockIdx.x; t < MT * NT; t += gridDim.x) {
        int mt, nt; tile_coords(t, MT, NT, mt, nt);
        const int row0 = mt * 256, n0 = nt * 128;
        f32x4 acc[4][8];
#pragma unroll
        for (int a = 0; a < 4; ++a)
#pragma unroll
            for (int b = 0; b < 8; ++b) acc[a][b] = (f32x4){0.f, 0.f, 0.f, 0.f};
        gemm_acc8<DFF>(acc, hb + (size_t)row0 * 1024, 1024, wu + (size_t)n0 * 1024, 1024, 1024, smem, tid);
        __syncthreads();
#pragma unroll
        for (int mb = 0; mb < 4; ++mb)
#pragma unroll
            for (int nb = 0; nb < 8; ++nb) *(u32x2*)(ut + (wr * 64 + mb * 16 + fr) * 264 + wc * 128 + nb * 16 + fq * 4) = pack4(acc[mb][nb]);
        __syncthreads();
        const int c4 = (tid & 31) * 4, lv = (c4 >> 6) * 128 + (c4 & 63), lg = lv + 64;
#pragma unroll 2
        for (int it = 0; it < 16; ++it) {
            const int row = it * 16 + (tid >> 5);
            f32x4 um[2], u0[2], up[2];
            const f32x4 z4 = (f32x4){0.f, 0.f, 0.f, 0.f};
            u0[0] = unpack4(*(const u32x2*)(ut + row * 264 + lv)); u0[1] = unpack4(*(const u32x2*)(ut + row * 264 + lg));
            um[0] = row > 0 ? unpack4(*(const u32x2*)(ut + (row - 1) * 264 + lv)) : z4; um[1] = row > 0 ? unpack4(*(const u32x2*)(ut + (row - 1) * 264 + lg)) : z4;
            up[0] = row < 255 ? unpack4(*(const u32x2*)(ut + (row + 1) * 264 + lv)) : z4; up[1] = row < 255 ? unpack4(*(const u32x2*)(ut + (row + 1) * 264 + lg)) : z4;
            *(u32x2*)(act + (size_t)(row0 + row) * DFF + n0 + c4) = conv_act(um, u0, up, p.ffn_conv_w, p.ffn_conv_b, n0 + c4);
        }
        if (row0 >= MC) {
            const int k = tid >> 7, rsel = k < 2 ? k : 252 + k, sub = (tid >> 6) & 1, lo = (tid & 63) * 2;
            const int cq = (lo >> 6) * 32 + (lo & 31), isg = (lo >> 5) & 1;
            *(unsigned*)(ub + ((size_t)(mt * 44 + nt * 2 + sub) * 4 + k) * 128 + lo) = *(const unsigned*)(ut + rsel * 264 + sub * 128 + cq + isg * 64);
        }
    }
}
DI void phase_fix(const Params& p) {
    unsigned char* ws = p.ws;
    bf16_t* act = (bf16_t*)(ws + OFF_ACT); const bf16_t* ub = (const bf16_t*)(ws + OFF_U);
    const int NT = 44;
    for (int i = blockIdx.x * NTHR + threadIdx.x; i < 64 * NT * 2 * 16; i += gridDim.x * NTHR) {
        const int cg = i & 15, which = (i >> 4) & 1, rest = i >> 5, nt = rest % NT, mt = 32 + rest / NT;
        const int row0 = mt * 256, tpos = (row0 - MC) & 2047;
        if (which == 0 ? tpos == 0 : tpos == 2048 - 256) continue;
        const bf16_t* own = ub + (size_t)(mt * NT + nt) * 4 * 128;
        const bf16_t *pv, *cu, *nx; int m;
        if (which == 0) { m = row0; pv = ub + ((size_t)((mt - 1) * NT + nt) * 4 + 3) * 128; cu = own; nx = own + 128; }
        else { m = row0 + 255; pv = own + 2 * 128; cu = own + 3 * 128; nx = ub + (size_t)((mt + 1) * NT + nt) * 4 * 128; }
        const int c4 = cg * 4, lv = (c4 >> 5) * 64 + (c4 & 31), lg = lv + 32;
        f32x4 um[2], u0[2], up[2];
        um[0] = unpack4(*(const u32x2*)(pv + lv)); um[1] = unpack4(*(const u32x2*)(pv + lg));
        u0[0] = unpack4(*(const u32x2*)(cu + lv)); u0[1] = unpack4(*(const u32x2*)(cu + lg));
        up[0] = unpack4(*(const u32x2*)(nx + lv)); up[1] = unpack4(*(const u32x2*)(nx + lg));
        *(u32x2*)(act + (size_t)m * DFF + nt * 64 + c4) = conv_act(um, u0, up, p.ffn_conv_w, p.ffn_conv_b, nt * 64 + c4);
    }
}
struct EpiDown {
    static constexpr bool PERM = false, AFTER_DRAIN = false;
    float* y; const float* mod;
    __device__ __forceinline__ void operator()(const f32x4 (&acc)[2][2][4][2], const pg8::Unit& u, int wr, int wc, int fr, int fq) const {
        const int row0 = u.pm * 256 + wr * 64 + fr, col0 = u.pn * 256 + wc * 32 + 4 * fq, ci = cond_of(u.pm * 256);
#pragma unroll
        for (int bj = 0; bj < 2; ++bj)
#pragma unroll
            for (int n = 0; n < 2; ++n) {
                const int col = col0 + bj * 128 + n * 16;
                const f32x4 g2 = *(const f32x4*)(mod + ci * 6144 + 5120 + col);
#pragma unroll
                for (int ai = 0; ai < 2; ++ai)
#pragma unroll
                    for (int m = 0; m < 4; ++m) { float* px = y + (size_t)(row0 + ai * 128 + m * 16) * D + col; *(f32x4*)px = *(const f32x4*)px + g2 * acc[ai][bj][m][n]; }
            }
    }
};
DI void phase_down(const Params& p, char* smem) {
    const int tid = threadIdx.x, wid = tid >> 6, lane = tid & 63, fr = lane & 15, fq = lane >> 4, wr = wid >> 1, wc = wid & 1;
    unsigned char* ws = p.ws;
    const bf16_t* act = (const bf16_t*)(ws + OFF_ACT); const bf16_t* wd = (const bf16_t*)(ws + OFF_WDN);
    const float* mod = (const float*)(ws + OFF_MOD);
    const int nM = M / 256, nN = 4, G = gridDim.x, nfirst = G < nM * nN ? G : nM * nN;
    {
        const pg8::Gemm8 g = {act, wd, DFF, 128};
        const pg8::Order8 ord = {nM, nN, nfirst, G, (int)blockIdx.x};
        const EpiDown epi = {p.out + OUT_Y, mod};
        pg8::gemm8((LAS unsigned char*)smem, g, ord, epi);
    }
    for (int t = blockIdx.x; t < 2 * (nM * nN - nfirst); t += G) {
        int pm, pn; pg8::unit_of(nfirst + (t >> 1), nM, nN, pm, pn);
        const int row0 = pm * 256, n0 = pn * 256 + (t & 1) * 128;
        f32x4 acc[4][4]; zero_acc<4>(acc);
        gemm_acc<4>(acc, act + (size_t)row0 * DFF, DFF, wd + (size_t)n0 * DFF, DFF, DFF, smem, tid);
        const int ci = cond_of(row0);
#pragma unroll
        for (int nb = 0; nb < 4; ++nb) {
            const int n = n0 + wc * 64 + nb * 16 + fq * 4;
            const f32x4 g2 = *(const f32x4*)(mod + ci * 6144 + 5120 + n);
#pragma unroll
            for (int mb = 0; mb < 4; ++mb) {
                const int m = row0 + wr * 64 + mb * 16 + fr;
                float* px = p.out + OUT_Y + (size_t)m * D + n;
                *(f32x4*)px = *(const f32x4*)px + g2 * acc[mb][nb];
            }
        }
    }
}

#define XB_TMO      128
#define XB_XCNT(j)  (256  + 64 * (j))
#define XB_XSUB(j)  (1280 + 64 * (j))
#define XB_XGEN(j)  (2304 + 64 * (j))
#define XB_TOP      3328
#define XB_TOPGEN   3392
#define XB_SPIN_CAP (1u << 20)
DI unsigned xb_ld(unsigned* p)              { return __hip_atomic_load(p, __ATOMIC_RELAXED, __HIP_MEMORY_SCOPE_AGENT); }
DI unsigned xb_add(unsigned* p, unsigned v) { return __hip_atomic_fetch_add(p, v, __ATOMIC_RELAXED, __HIP_MEMORY_SCOPE_AGENT); }
DI unsigned xb_xcc_id() { return (unsigned)__builtin_amdgcn_s_getreg((3 << 11) | 20) & 0xFu; }
#define XB_SPIN(cond, bar) do { unsigned _sp = 0; while (cond) { __builtin_amdgcn_s_sleep(1); \
    if ((++_sp & 255u) == 0u) { if (xb_ld(&(bar)[XB_TMO])) break; if (_sp > XB_SPIN_CAP) { atomicAdd(&(bar)[XB_TMO], 1u); break; } } } } while (0)
struct XcdBarrier { unsigned* bar; unsigned x; volatile LAS unsigned* st; };
DI XcdBarrier xcd_barrier_post(unsigned* bar, volatile LAS unsigned* st) {
    XcdBarrier b; b.bar = bar; b.x = xb_xcc_id(); b.st = st;
    if (threadIdx.x == 0) (void)xb_add(&bar[XB_XCNT(b.x)], 1u);
    return b;
}
DI void xcd_barrier_complete(unsigned* bar, unsigned x, unsigned& nloc, unsigned& nx) {
    const unsigned G = gridDim.x * gridDim.y * gridDim.z;
    unsigned sum, cnt, mine, sp = 0u;
    for (;;) {
        sum = 0u; cnt = 0u; mine = 0u;
#pragma unroll
        for (unsigned j = 0; j < 16; ++j) { const unsigned c = xb_ld(&bar[XB_XCNT(j)]); sum += c; cnt += (c > 0u) ? 1u : 0u; mine = (j == x) ? c : mine; }
        if (sum == G) break;
        __builtin_amdgcn_s_sleep(1);
        if ((++sp & 255u) == 0u) { if (xb_ld(&bar[XB_TMO])) break; if (sp > XB_SPIN_CAP) { atomicAdd(&bar[XB_TMO], 1u); break; } }
    }
    nloc = mine > 0u ? mine : 1u; nx = cnt > 0u ? cnt : 1u;
}
DI void xcd_barrier(const XcdBarrier& b) {
    asm volatile("s_waitcnt vmcnt(0)" ::: "memory");
    __syncthreads();
    if (threadIdx.x == 0) {
        unsigned* bar = b.bar;
        __builtin_amdgcn_s_waitcnt(0);
        unsigned nloc = b.st[0], nx = b.st[1];
        if (nloc == 0u) { xcd_barrier_complete(bar, b.x, nloc, nx); b.st[0] = nloc; b.st[1] = nx; }
        const unsigned old = xb_add(&bar[XB_XSUB(b.x)], 1u);
        const unsigned gen = old / nloc;
        if (old + 1u == (gen + 1u) * nloc) {
            __builtin_amdgcn_fence(__ATOMIC_RELEASE, "agent");
            asm volatile("s_waitcnt vmcnt(0)" ::: "memory");
            const unsigned og = xb_add(&bar[XB_TOP], 1u);
            const unsigned tg = og / nx;
            if (og + 1u == (tg + 1u) * nx) xb_add(&bar[XB_TOPGEN], 1u);
            else XB_SPIN(xb_ld(&bar[XB_TOPGEN]) == tg, bar);
            __builtin_amdgcn_fence(__ATOMIC_ACQUIRE, "agent");
            xb_add(&bar[XB_XGEN(b.x)], 1u);
            asm volatile("s_waitcnt vmcnt(0)" ::: "memory");
        } else {
            XB_SPIN(xb_ld(&bar[XB_XGEN(b.x)]) == gen, bar);
            __builtin_amdgcn_fence(__ATOMIC_ACQUIRE, "agent");
            asm volatile("s_waitcnt vmcnt(0)" ::: "memory");
        }
    }
    __syncthreads();
}

constexpr int N_PHASES = 23;
__global__ void __launch_bounds__(NTHR) fwd_kernel(Params p) {
    extern __shared__ __attribute__((aligned(16))) char smem[];
    volatile LAS unsigned* xst = (volatile LAS unsigned*)(smem + LDS_MAIN);
    if (threadIdx.x == 0) { xst[0] = 0u; xst[1] = 0u; }
    __syncthreads();
    const XcdBarrier xb = xcd_barrier_post((unsigned*)(p.ws + OFF_BAR), xst);
    asm volatile("s_nop 0\n\ts_nop 0\n\ts_nop 0\n\ts_nop 0\n\ts_nop 0");
#ifndef PH_MASK
#define PH_MASK 0xffff
#endif
#ifndef REP_MASK
#define REP_MASK 0
#endif
#define RUN_PHASE(ph, bit, call) if (p.ph_lo <= (ph) && (ph) < p.ph_hi) { if ((ph) > p.ph_lo) xcd_barrier(xb); if (PH_MASK & (bit)) { call; if (REP_MASK & (bit)) { call; } } }
    RUN_PHASE(0, 1, phase_prep(p, smem))
    RUN_PHASE(1, 2, phase_norm<1>(p))
    RUN_PHASE(2, 4, phase_p1(p, smem))
    RUN_PHASE(4, 16, phase_mix(p, smem))
    RUN_PHASE(5, 32, phase_post(p, smem))
    RUN_PHASE(6, 64, phase_merge(p, smem))
    RUN_PHASE(7, 128, phase_out(p, smem))
    RUN_PHASE(8, 256, phase_norm<2>(p))
    RUN_PHASE(9, 512, phase_up(p, smem))
    RUN_PHASE(10, 1024, phase_fix(p))
    RUN_PHASE(21, 2048, phase_down(p, smem))
    RUN_PHASE(22, 4096, phase_norm<3>(p))
}

extern "C" void kernel_launch(void* const* d_in, const int* in_sizes, int n_in, void* d_out, int out_size, void* d_ws, size_t ws_size, hipStream_t stream) {
    static int grid = 0;
    if (grid == 0) {
        if (n_in != 32 || ws_size < WS_NEED) { fprintf(stderr, "kernel_launch: unexpected inputs (n_in %d, ws %zu, need %zu)\n", n_in, ws_size, (size_t)WS_NEED); grid = -1; return; }
        int dev = 0, cus = 0, per_cu = 0;
        hipGetDevice(&dev);
        hipDeviceGetAttribute(&cus, hipDeviceAttributeMultiprocessorCount, dev);
        hipFuncSetAttribute((const void*)fwd_kernel, hipFuncAttributeMaxDynamicSharedMemorySize, LDS_BYTES);
        hipOccupancyMaxActiveBlocksPerMultiprocessor(&per_cu, (const void*)fwd_kernel, NTHR, LDS_BYTES);
        if (per_cu < 1) { fprintf(stderr, "kernel_launch: occupancy query says %d blocks per CU\n", per_cu); grid = -1; return; }
        grid = cus;
        grid &= ~7;
    }
    if (grid < 0) return;
    if (hipMemsetAsync((char*)d_ws + OFF_BAR, 0, (XCD_BAR_WORDS + 64) * 4, stream) != hipSuccess) { fprintf(stderr, "kernel_launch: memset failed\n"); return; }
    Params p{};
    const float** pp = (const float**)&p;
    for (int i = 0; i < 32; ++i) pp[i] = (const float*)d_in[i];
    p.out = (float*)d_out; p.ws = (unsigned char*)d_ws;
#if N_LAUNCH_SPLIT
    for (int ph = 0; ph < N_PHASES; ++ph) {
        p.ph_lo = ph; p.ph_hi = ph + 1;
        hipLaunchKernelGGL(fwd_kernel, dim3(grid), dim3(NTHR), LDS_BYTES, stream, p);
    }
#else
    p.ph_lo = 0; p.ph_hi = N_PHASES;
    void* args[] = {&p};
    hipError_t e = hipLaunchCooperativeKernel((const void*)fwd_kernel, dim3(grid), dim3(NTHR), args, LDS_BYTES, stream);
    if (e != hipSuccess) fprintf(stderr, "cooperative launch failed: %s (grid %d)\n", hipGetErrorString(e), grid);
#endif
}
```

```cpp
#include <hip/hip_runtime.h>
#include <hip/hip_cooperative_groups.h>
#include <cstdio>
namespace cg = cooperative_groups;

#define DI __device__ __forceinline__
typedef unsigned short bf16_t;
typedef short bf16x8 __attribute__((ext_vector_type(8)));
typedef short s16x4 __attribute__((ext_vector_type(4)));
typedef float f32x4 __attribute__((ext_vector_type(4)));
typedef float f32x2 __attribute__((ext_vector_type(2)));
typedef float f32x16 __attribute__((ext_vector_type(16)));
typedef unsigned u32x4 __attribute__((ext_vector_type(4)));
typedef unsigned u32x2 __attribute__((ext_vector_type(2)));

#ifndef N_LAUNCH_SPLIT
#define N_LAUNCH_SPLIT 0
#endif

constexpr int NTHR = 512;
constexpr int D = 1024;
constexpr int MC = 8192;
constexpr int ML = 16384;
constexpr int M = MC + ML;
constexpr int WIN = 4736;
constexpr int ZRC = 1920;
constexpr int DFF = 2816;
constexpr int LDS_MAIN = 147456;
constexpr int LDS_BYTES = LDS_MAIN + 16;
constexpr float LOG2E = 1.4426950408889634f;

constexpr size_t al256(size_t x) { return (x + 255) & ~(size_t)255; }
constexpr size_t OFF_WUP   = 0;
constexpr size_t OFF_WDN   = OFF_WUP + al256((size_t)5632 * 1024 * 2);
constexpr size_t OFF_MOD   = OFF_WDN + al256((size_t)1024 * 2816 * 2);
constexpr size_t OFF_ROPE  = OFF_MOD + al256((size_t)9 * 6144 * 4);
constexpr size_t OFF_W2T   = OFF_ROPE + al256((size_t)64 * 16 * 8);
constexpr size_t OFF_A2T   = OFF_W2T + al256((size_t)2 * 512 * 64 * 2);
constexpr size_t OFF_G2T   = OFF_A2T + al256((size_t)2 * 512 * 64 * 2);
constexpr size_t OFF_KC    = OFF_G2T + al256((size_t)512 * 128 * 2);
constexpr size_t OFF_VCT   = OFF_KC + al256((size_t)8 * 512 * 128 * 2);
constexpr size_t OFF_BAR   = OFF_VCT + al256((size_t)8 * 512 * 128 * 2);
constexpr size_t OFF_H     = OFF_BAR + al256((size_t)(3456 + 64) * 4);
constexpr size_t OFF_X     = OFF_H + al256((size_t)M * 1024 * 2);
constexpr size_t OFF_WIN   = OFF_X;
constexpr size_t OFF_WPA   = OFF_WIN + al256((size_t)WIN * 1024 * 2);
constexpr size_t OFF_WPB   = OFF_WPA + al256((size_t)1024 * 512 * 2);
constexpr size_t OFF_WOUT  = OFF_WPB + al256((size_t)1024 * 512 * 2);
constexpr size_t OFF_Q     = OFF_WOUT + al256((size_t)1024 * 1024 * 2);
constexpr size_t OFF_RW    = OFF_Q;
constexpr size_t OFF_KB    = OFF_Q + al256((size_t)M * 512 * 2);
constexpr size_t OFF_VT    = OFF_KB + al256((size_t)M * 128 * 2);
constexpr size_t OFF_ATTN  = OFF_VT + al256((size_t)M * 128 * 2);
constexpr size_t OFF_SG    = OFF_ATTN + al256((size_t)M * 512 * 2);
constexpr size_t OFF_BN    = OFF_SG + al256((size_t)M * 128 * 2);
constexpr size_t OFF_YS    = OFF_BN + al256((size_t)M * 16 * 4);
constexpr size_t OFF_MRG   = OFF_YS;
constexpr size_t END_EARLY = OFF_YS + al256((size_t)2 * M * 512 * 4);
constexpr size_t OFF_ACT   = OFF_X;
constexpr size_t OFF_U     = OFF_ACT + al256((size_t)M * DFF * 2);
constexpr size_t END_FFN   = OFF_U + al256((size_t)96 * 44 * 4 * 128 * 2);
constexpr size_t WS_NEED   = END_EARLY > END_FFN ? END_EARLY : END_FFN;
static_assert(WS_NEED <= (size_t)256 * 1024 * 1024, "workspace over 256 MiB");

constexpr size_t OUT_Y  = 0;
constexpr size_t OUT_K  = (size_t)M * 1024;
constexpr size_t OUT_V  = OUT_K + (size_t)MC * 128;
constexpr size_t OUT_S  = OUT_V + (size_t)MC * 128;

struct Params {
    const float *x_prompt, *x_sample, *c, *cache_k, *cache_v, *state_rwkv, *c_ctx, *w_ada, *b_ada, *g_norm1, *w_in, *attn_sink,
        *w_proj_a, *w_proj_b, *rwkv_mu, *rwkv_w0, *rwkv_w2, *rwkv_a0, *rwkv_a2, *rwkv_k_k, *rwkv_k_a, *rwkv_r_k, *rwkv_g2,
        *rwkv_ln_g, *rwkv_ln_b, *w_out, *g_norm2, *w_ffn_up, *ffn_conv_w, *ffn_conv_b, *w_ffn_down, *g_final;
    float* out;
    unsigned char* ws;
    int ph_lo, ph_hi;
};

#define XCD_BAR_WORDS 3456
#define LAS __attribute__((address_space(3)))
DI bf16_t f2bf(float f) { unsigned u = __float_as_uint(f); u += 0x7fffu + ((u >> 16) & 1u); return (bf16_t)(u >> 16); }
DI float bf2f(unsigned b) { return __uint_as_float(b << 16); }
typedef __bf16 bf16v2_t __attribute__((ext_vector_type(2)));
DI unsigned pack2(float lo, float hi) { f32x2 v; v.x = lo; v.y = hi; return __builtin_bit_cast(unsigned, __builtin_convertvector(v, bf16v2_t)); }
DI u32x2 pack4(f32x4 v) { u32x2 r; r.x = pack2(v[0], v[1]); r.y = pack2(v[2], v[3]); return r; }
DI f32x4 unpack4(u32x2 v) { f32x4 r; r[0] = bf2f(v.x & 0xffffu); r[1] = bf2f(v.x >> 16); r[2] = bf2f(v.y & 0xffffu); r[3] = bf2f(v.y >> 16); return r; }
DI float rcpf_(float x) { return __builtin_amdgcn_rcpf(x); }
DI float sigmoidf_(float x) { return rcpf_(1.0f + __expf(-x)); }
DI const float* xrow(const Params& p, int r) { return r < MC ? p.x_prompt + (size_t)r * D : p.x_sample + (size_t)(r - MC) * D; }
DI int cond_of(int r) { return r < MC ? 0 : 1 + ((r - MC) >> 11); }
DI void seq_of(int r, int& r0, int& T) { if (r < MC) { r0 = r & ~255; T = 256; } else { r0 = MC + ((r - MC) & ~2047); T = 2048; } }
DI float wave_sum(float v) {
#pragma unroll
    for (int o = 32; o >= 1; o >>= 1) v += __shfl_xor(v, o);
    return v;
}

DI void transpose_tile(const float* __restrict__ src, int K, int N, bf16_t* __restrict__ dst, int kt, int nt, float* tile, int tid) {
    const int k0 = kt * 64, n0 = nt * 64;
#pragma unroll
    for (int i = 0; i < 8; ++i) { const int k = (tid >> 6) + 8 * i, n = tid & 63; tile[k * 65 + n] = src[(size_t)(k0 + k) * N + n0 + n]; }
    __syncthreads();
#pragma unroll
    for (int i = 0; i < 8; ++i) { const int n = (tid >> 6) + 8 * i, k = tid & 63; dst[(size_t)(n0 + n) * K + k0 + k] = f2bf(tile[k * 65 + n]); }
    __syncthreads();
}

DI void phase_prep(const Params& p, char* smem) {
    const int tid = threadIdx.x, nb = gridDim.x, bid = blockIdx.x;
    unsigned char* ws = p.ws;
    {
        float* tile = (float*)smem;
        const int cnt[11] = {16 * 74, 8 * 16, 8 * 16, 16 * 16, 16 * 88, 44 * 16, 8, 8, 8, 8, 16};
        int total = 0;
#pragma unroll
        for (int i = 0; i < 11; ++i) total += cnt[i];
        for (int it = bid; it < total; it += nb) {
            int i = it, mi = 0;
#pragma unroll
            for (int q = 0; q < 10; ++q) { if (mi == q && i >= cnt[q]) { i -= cnt[q]; mi = q + 1; } }
            const float* src; bf16_t* dst; int K, N;
            switch (mi) {
                case 0: src = p.w_in; K = 1024; N = WIN; dst = (bf16_t*)(ws + OFF_WIN); break;
                case 1: src = p.w_proj_a; K = 512; N = 1024; dst = (bf16_t*)(ws + OFF_WPA); break;
                case 2: src = p.w_proj_b; K = 512; N = 1024; dst = (bf16_t*)(ws + OFF_WPB); break;
                case 3: src = p.w_out; K = 1024; N = 1024; dst = (bf16_t*)(ws + OFF_WOUT); break;
                case 4: src = p.w_ffn_up; K = 1024; N = 5632; dst = (bf16_t*)(ws + OFF_WUP); break;
                case 5: src = p.w_ffn_down; K = 2816; N = 1024; dst = (bf16_t*)(ws + OFF_WDN); break;
                case 6: src = p.rwkv_w2; K = 64; N = 512; dst = (bf16_t*)(ws + OFF_W2T); break;
                case 7: src = p.rwkv_w2 + 64 * 512; K = 64; N = 512; dst = (bf16_t*)(ws + OFF_W2T) + 512 * 64; break;
                case 8: src = p.rwkv_a2; K = 64; N = 512; dst = (bf16_t*)(ws + OFF_A2T); break;
                case 9: src = p.rwkv_a2 + 64 * 512; K = 64; N = 512; dst = (bf16_t*)(ws + OFF_A2T) + 512 * 64; break;
                default: src = p.rwkv_g2; K = 128; N = 512; dst = (bf16_t*)(ws + OFF_G2T); break;
            }
            const int ntn = N / 64;
            transpose_tile(src, K, N, dst, i / ntn, i % ntn, tile, tid);
        }
    }
    {
        bf16_t* kc = (bf16_t*)(ws + OFF_KC); bf16_t* vct = (bf16_t*)(ws + OFF_VCT);
        for (int i = bid * NTHR + tid; i < 8 * 512 * 128; i += nb * NTHR) {
            kc[i] = f2bf(p.cache_k[i]);
            const int key = i & 511, d = (i >> 9) & 63, kvh = (i >> 15) & 1, b = i >> 16;
            vct[i] = f2bf(p.cache_v[((size_t)(b * 512 + key) * 2 + kvh) * 64 + d]);
        }
    }
    {
        f32x2* tab = (f32x2*)(ws + OFF_ROPE);
        for (int i = bid * NTHR + tid; i < 1024; i += nb * NTHR) {
            const int pos = i >> 4, fi = i & 15;
            const double fr = pow(10000.0, -(double)fi / 16.0), ang = (double)pos * fr;
            f32x2 v; v.x = (float)cos(ang); v.y = (float)sin(ang); tab[i] = v;
        }
    }
    {
        float* s = (float*)smem;
        float* red = (float*)(smem + 36864);
        float* mod = (float*)(ws + OFF_MOD);
        for (int it = bid; it < 96; it += nb) {
            __syncthreads();
            for (int i = tid; i < 9 * 1024; i += NTHR) {
                const int ci = i >> 10, k = i & 1023;
                const float v = ci == 0 ? p.c_ctx[k] : p.c[(ci - 1) * 1024 + k];
                s[i] = v / (1.0f + __expf(-v));
            }
            __syncthreads();
            const int n = tid & 63, kq = tid >> 6, n0 = it * 64;
            float acc[9];
#pragma unroll
            for (int ci = 0; ci < 9; ++ci) acc[ci] = 0.f;
            for (int k = kq * 128; k < kq * 128 + 128; ++k) {
                const float w = p.w_ada[(size_t)k * 6144 + n0 + n];
#pragma unroll
                for (int ci = 0; ci < 9; ++ci) acc[ci] += s[ci * 1024 + k] * w;
            }
#pragma unroll
            for (int ci = 0; ci < 9; ++ci) red[(kq * 9 + ci) * 64 + n] = acc[ci];
            __syncthreads();
            for (int i = tid; i < 9 * 64; i += NTHR) {
                const int ci = i >> 6, nn = i & 63;
                float v = p.b_ada[n0 + nn];
#pragma unroll
                for (int q = 0; q < 8; ++q) v += red[(q * 9 + ci) * 64 + nn];
                mod[ci * 6144 + n0 + nn] = v;
            }
        }
        __syncthreads();
    }
}

template <int WHICH> DI void phase_norm(const Params& p) {
    const int tid = threadIdx.x, lane = tid & 63, wv = tid >> 6;
    const float* mod = (const float*)(p.ws + OFF_MOD);
    bf16_t* hb = (bf16_t*)(p.ws + OFF_H);
    const int ntask = M / 8;
    for (int task = blockIdx.x * 8 + wv; task < ntask; task += gridDim.x * 8) {
        const int r_first = task * 8, ci = cond_of(r_first);
        f32x4 fa[4], fb[4];
#pragma unroll
        for (int i = 0; i < 4; ++i) {
            const int col = i * 256 + lane * 4;
            if (WHICH == 3) { fa[i] = *(const f32x4*)(p.g_final + col); fb[i] = (f32x4){0.f, 0.f, 0.f, 0.f}; }
            else {
                const f32x4 g = *(const f32x4*)((WHICH == 1 ? p.g_norm1 : p.g_norm2) + col);
                const f32x4 sc = *(const f32x4*)(mod + ci * 6144 + (WHICH == 1 ? 1024 : 4096) + col);
                fb[i] = *(const f32x4*)(mod + ci * 6144 + (WHICH == 1 ? 0 : 3072) + col);
                fa[i] = g * (sc + 1.0f);
            }
        }
        for (int rr = 0; rr < 8; ++rr) {
            const int r = r_first + rr;
            const float* src = WHICH == 1 ? xrow(p, r) : p.out + OUT_Y + (size_t)r * D;
            f32x4 v[4]; float ss = 0.f;
#pragma unroll
            for (int i = 0; i < 4; ++i) { v[i] = *(const f32x4*)(src + i * 256 + lane * 4); ss += v[i][0] * v[i][0] + v[i][1] * v[i][1] + v[i][2] * v[i][2] + v[i][3] * v[i][3]; }
            ss = wave_sum(ss);
            const float rstd = __builtin_amdgcn_rsqf(ss * (1.0f / 1024.0f) + 1e-6f);
#pragma unroll
            for (int i = 0; i < 4; ++i) {
                const f32x4 o = v[i] * rstd * fa[i] + fb[i];
                if (WHICH == 3) *(f32x4*)(p.out + OUT_Y + (size_t)r * D + i * 256 + lane * 4) = o;
                else *(u32x2*)(hb + (size_t)r * D + i * 256 + lane * 4) = pack4(o);
            }
        }
    }
}

template <int NB, int BMAP> DI void gemm_stage(const bf16_t* A, int lda, const bf16_t* Bt, int ldb, int k0, char* sbuf, int tid) {
#pragma unroll
    for (int i = 0; i < 4; ++i) {
        const int c = tid + i * 512, row = c >> 3, pos = c & 7, kc = pos ^ ((row >> 1) & 7);
        __builtin_amdgcn_global_load_lds((const unsigned*)(A + (size_t)row * lda + k0 + kc * 8), (unsigned*)(sbuf + c * 16), 16, 0, 0);
    }
#pragma unroll
    for (int i = 0; i < NB / 2; ++i) {
        const int c = tid + i * 512, row = c >> 3, pos = c & 7, kc = pos ^ ((row >> 1) & 7);
        const int brow = BMAP ? (((row >> 5) & 1) * BMAP + (row >> 6) * 32 + (row & 31)) : row;
        __builtin_amdgcn_global_load_lds((const unsigned*)(Bt + (size_t)brow * ldb + k0 + kc * 8), (unsigned*)(sbuf + 32768 + c * 16), 16, 0, 0);
    }
}
template <int NB, int BMAP = 0> DI void gemm_acc(f32x4 (&acc)[4][NB], const bf16_t* A, int lda, const bf16_t* Bt, int ldb, int K, char* smem, int tid) {
    const int wid = tid >> 6, lane = tid & 63, fr = lane & 15, fq = lane >> 4, wr = wid >> 1, wc = wid & 1;
    const int swz = (fr >> 1) & 7;
    const int nk = K >> 6;
    __syncthreads();
    gemm_stage<NB, BMAP>(A, lda, Bt, ldb, 0, smem, tid);
    if (nk > 1) gemm_stage<NB, BMAP>(A, lda, Bt, ldb, 64, smem + 49152, tid);
    int cur = 0;
#pragma unroll 1
    for (int t = 0; t < nk; ++t) {
        if (t + 1 < nk) { if (NB == 4) asm volatile("s_waitcnt vmcnt(6)" ::: "memory"); else asm volatile("s_waitcnt vmcnt(5)" ::: "memory"); }
        else asm volatile("s_waitcnt vmcnt(0)" ::: "memory");
        __builtin_amdgcn_s_barrier();
        asm volatile("" ::: "memory");
        const int nxt2 = cur >= 1 ? cur - 1 : 2;
        const bool late = __builtin_amdgcn_readfirstlane(wid) >= 4;
        if (t + 2 < nk && !late) gemm_stage<NB, BMAP>(A, lda, Bt, ldb, (t + 2) * 64, smem + nxt2 * 49152, tid);
        const char* sA = smem + cur * 49152;
        const char* sB = sA + 32768;
#pragma unroll
        for (int ks = 0; ks < 2; ++ks) {
            if (ks == 1 && t + 2 < nk && late) gemm_stage<NB, BMAP>(A, lda, Bt, ldb, (t + 2) * 64, smem + nxt2 * 49152, tid);
            bf16x8 af[4], bfr[NB];
            const int coff = ((ks * 4 + fq) ^ swz) << 4;
#pragma unroll
            for (int mb = 0; mb < 4; ++mb) af[mb] = *(const bf16x8*)(sA + (wr * 64 + mb * 16 + fr) * 128 + coff);
#pragma unroll
            for (int nb = 0; nb < NB; ++nb) bfr[nb] = *(const bf16x8*)(sB + (wc * 16 * NB + nb * 16 + fr) * 128 + coff);
            __builtin_amdgcn_s_setprio(1);
#pragma unroll
            for (int mb = 0; mb < 4; ++mb)
#pragma unroll
                for (int nb = 0; nb < NB; ++nb) acc[mb][nb] = __builtin_amdgcn_mfma_f32_16x16x32_bf16(bfr[nb], af[mb], acc[mb][nb], 0, 0, 0);
            __builtin_amdgcn_s_setprio(0);
        }
        cur = cur == 2 ? 0 : cur + 1;
    }
}
template <int BMAP> DI void gemm_stage8(const bf16_t* A, int lda, const bf16_t* Bt, int ldb, int k0, char* sbuf, int tid) {
    const int r0 = tid >> 3, kcs = (tid & 7) ^ ((r0 >> 1) & 7);
    const unsigned offA = (unsigned)(r0 * lda + kcs * 8), offB = (unsigned)(r0 * ldb + kcs * 8);
    char* dst = sbuf + tid * 16;
#pragma unroll
    for (int i = 0; i < 4; ++i)
        __builtin_amdgcn_global_load_lds((const unsigned*)(A + (size_t)(64 * i) * lda + k0 + offA), (unsigned*)(dst + i * 8192), 16, 0, 0);
#pragma unroll
    for (int i = 0; i < 4; ++i) {
        const int urow = BMAP ? (i & 1) * BMAP + (i >> 1) * 64 : 64 * i;
        __builtin_amdgcn_global_load_lds((const unsigned*)(Bt + (size_t)urow * ldb + k0 + offB), (unsigned*)(dst + 32768 + i * 8192), 16, 0, 0);
    }
}
template <int BMAP> DI void gemm_acc8(f32x4 (&acc)[4][8], const bf16_t* A, int lda, const bf16_t* Bt, int ldb, int K, char* smem, int tid) {
    const int wid = tid >> 6, lane = tid & 63, fr = lane & 15, fq = lane >> 4, wr = wid >> 1, wc = wid & 1;
    const int swz = (fr >> 1) & 7;
    const int nk = K >> 6;
    __syncthreads();
    gemm_stage8<BMAP>(A, lda, Bt, ldb, 0, smem, tid);
    const bool late = __builtin_amdgcn_readfirstlane(wid) >= 4;
#pragma unroll 1
    for (int t = 0; t < nk; ++t) {
        asm volatile("s_waitcnt vmcnt(0)" ::: "memory");
        __builtin_amdgcn_s_barrier();
        asm volatile("" ::: "memory");
        char* sN = smem + ((t + 1) & 1) * 65536;
        if (t + 1 < nk && !late) gemm_stage8<BMAP>(A, lda, Bt, ldb, (t + 1) * 64, sN, tid);
        const char* sA = smem + (t & 1) * 65536;
        const char* sB = sA + 32768;
#pragma unroll
        for (int ks = 0; ks < 2; ++ks) {
            if (ks == 1 && t + 1 < nk && late) gemm_stage8<BMAP>(A, lda, Bt, ldb, (t + 1) * 64, sN, tid);
            bf16x8 af[4], bfr[8];
            const int coff = ((ks * 4 + fq) ^ swz) << 4;
#pragma unroll
            for (int mb = 0; mb < 4; ++mb) af[mb] = *(const bf16x8*)(sA + (wr * 64 + mb * 16 + fr) * 128 + coff);
#pragma unroll
            for (int nb = 0; nb < 8; ++nb) bfr[nb] = *(const bf16x8*)(sB + (wc * 128 + nb * 16 + fr) * 128 + coff);
            __builtin_amdgcn_s_setprio(1);
#pragma unroll
            for (int mb = 0; mb < 4; ++mb)
#pragma unroll
                for (int nb = 0; nb < 8; ++nb) acc[mb][nb] = __builtin_amdgcn_mfma_f32_16x16x32_bf16(bfr[nb], af[mb], acc[mb][nb], 0, 0, 0);
            __builtin_amdgcn_s_setprio(0);
        }
    }
}
template <int NB> DI void zero_acc(f32x4 (&acc)[4][NB]) {
#pragma unroll
    for (int a = 0; a < 4; ++a)
#pragma unroll
        for (int b = 0; b < NB; ++b) acc[a][b] = (f32x4){0.f, 0.f, 0.f, 0.f};
}
DI void tile_coords(int t, int MT, int NT, int& mt, int& nt) {
    const int x = t & 7, u = t >> 3, mpx = MT >> 3;
    const int bm = (mpx % 4 == 0) ? 4 : ((mpx % 2 == 0) ? 2 : 1);
    const int per_band = bm * NT, band = u / per_band, rem = u - band * per_band;
    nt = rem / bm; mt = x * mpx + band * bm + (rem % bm);
}


namespace pg8 {
#define PG8_LAS __attribute__((address_space(3)))
constexpr int BM = 256, BK = 64, HALF = 128, HTB = HALF * BK * 2  , STAGE_BYTES = 8 * HTB, NXCD = 8, WGM = 8;
__host__ __device__ __forceinline__ int lds_byte(int r, int c) { const int st = (r >> 4) * 2 + (c >> 5), rr = r & 15, cc = c & 31, ob = rr * 64 + cc * 2; return st * 1024 + (ob ^ (((ob >> 9) & 1) << 5)); }
__host__ __device__ __forceinline__ void stage_rc(int b, int& R, int& C) { const int st = b / 1024, sb = b % 1024, swz = sb ^ (((sb >> 9) & 1) << 5); R = (st >> 1) * 16 + swz / 64; C = (st & 1) * 32 + (swz % 64) / 2; }
__host__ __device__ __forceinline__ int perm32(int rho) { const int n = rho >> 4, i = rho & 15; return 8 * (i >> 2) + 4 * n + (i & 3); }


struct Unit { int pm, pn, brow; };
struct Gemm8 { const bf16_t* A; const bf16_t* Bt; int K; int bhalf; };
__device__ __forceinline__ void unit_of(int L, int nM, int nN, int& pm, int& pn) {
    const int nwg = nM * nN;
    int wgid = L; { const int q = nwg / NXCD, r = nwg % NXCD, xcd = wgid % NXCD, off = wgid / NXCD; wgid = (xcd < r ? xcd * (q + 1) : r * (q + 1) + (xcd - r) * q) + off; }
    const int nig = WGM * nN, gid = wgid / nig, fm = gid * WGM, gsz = (nM - fm) < WGM ? (nM - fm) : WGM;
    pm = fm + ((wgid % nig) % gsz); pn = (wgid % nig) / gsz;
}
struct Order8 {
    int nM, nN, nlim, G, c, p1map;
    __device__ __forceinline__ bool next(int i, Unit& u) const {
        const long L = (long)i * G + c; if (L >= nlim) return false;
        unit_of((int)L, nM, nN, u.pm, u.pn); u.brow = p1map ? (u.pn < 3 ? u.pn * 256 : 2816 + (u.pn - 3) * 256) : u.pn * 256; return true;
    }
    __device__ __forceinline__ void a_ready(const Unit&) const {}
    __device__ __forceinline__ void done(const Unit&) const {}
};
template <class Epi, class Sched>
__device__ __forceinline__ void gemm8(PG8_LAS unsigned char* lds, const Gemm8 g, const Sched& S, const Epi& E) {
    const int tid = threadIdx.x, wid = __builtin_amdgcn_readfirstlane(tid >> 6), lane = tid & 63, wr = wid >> 2, wc = wid & 3, fr = lane & 15, fq = lane >> 4;
    const int K = g.K, nt = K / BK;
    unsigned voffA[2], voffB[2];
#pragma unroll
    for (int i = 0; i < 2; ++i) { int R, C; stage_rc(tid * 16 + i * 8192, R, C); const int Rb = Epi::PERM ? ((R & ~31) + perm32(R & 31)) : R;
        voffA[i] = (unsigned)(R * K + C) * 2u; voffB[i] = (unsigned)(Rb * K + C) * 2u; }
    const size_t kstep = (size_t)(BK * 2);
    const size_t hstep = (size_t)HALF * K * 2;
    const size_t tstep = 2 * hstep;
    const size_t hstepB = (size_t)g.bhalf * K * 2;
    const size_t rowB = (size_t)K * 2;
    const unsigned ldsw = (unsigned)wid * 1024u;
    const int aoff = lds_byte(wr * 64 + fr, fq * 8), boff = lds_byte(wc * 32 + fr, fq * 8);
#define PG8_SA(b, h) (((b) * 2 + (h)) * HTB)
#define PG8_SB(b, h) ((4 + (b) * 2 + (h)) * HTB)
#define PG8_STAGE(bufoff, gbase, voff) do { _Pragma("unroll") for (int _i = 0; _i < 2; ++_i) \
        __builtin_amdgcn_global_load_lds((const unsigned*)((const char*)(gbase) + (voff)[_i]), (PG8_LAS unsigned*)(lds + (bufoff) + ldsw + _i * 8192), 16, 0, 0); } while (0)
#define PG8_LDA(dst, b, h) do { _Pragma("unroll") for (int m = 0; m < 4; ++m) _Pragma("unroll") for (int k = 0; k < 2; ++k) dst[m][k] = *(const PG8_LAS bf16x8*)(lds + PG8_SA(b, h) + aoff + m * 2048 + k * 1024); } while (0)
#define PG8_LDB(dst, b, h) do { _Pragma("unroll") for (int n = 0; n < 2; ++n) _Pragma("unroll") for (int k = 0; k < 2; ++k) dst[n][k] = *(const PG8_LAS bf16x8*)(lds + PG8_SB(b, h) + boff + n * 2048 + k * 1024); } while (0)
#define PG8_MMA(ai, bj, At, Bt) do { __builtin_amdgcn_s_setprio(1); _Pragma("unroll") for (int m = 0; m < 4; ++m) _Pragma("unroll") for (int n = 0; n < 2; ++n) _Pragma("unroll") for (int k = 0; k < 2; ++k) \
        acc[ai][bj][m][n] = __builtin_amdgcn_mfma_f32_16x16x32_bf16(Bt[n][k], At[m][k], acc[ai][bj][m][n], 0, 0, 0); __builtin_amdgcn_s_setprio(0); } while (0)
#define PG8_WAIT_V(n) asm volatile("s_waitcnt vmcnt(" #n ")" ::: "memory")
#define PG8_WAIT_L(n) asm volatile("s_waitcnt lgkmcnt(" #n ")" ::: "memory")
#define PG8_BAR __builtin_amdgcn_s_barrier()
#define PG8_SCHED __builtin_amdgcn_sched_barrier(0)
    Unit cur, nxt; int ui = 0;
    if (!S.next(0, cur)) return;
    f32x4 acc[2][2][4][2];
#pragma unroll
    for (int a = 0; a < 2; ++a)
#pragma unroll
        for (int b = 0; b < 2; ++b)
#pragma unroll
            for (int m = 0; m < 4; ++m)
#pragma unroll
                for (int n = 0; n < 2; ++n) acc[a][b][m][n] = (f32x4){0.f, 0.f, 0.f, 0.f};
    bf16x8 At[4][2], B0[2][2], B1[2][2];
    const char* cA = (const char*)g.A + (size_t)cur.pm * tstep; const char* cB = (const char*)g.Bt + (size_t)cur.brow * rowB;
    S.a_ready(cur);
    PG8_STAGE(PG8_SB(0, 0), cB, voffB); PG8_STAGE(PG8_SA(0, 0), cA, voffA); PG8_STAGE(PG8_SB(0, 1), cB + hstepB, voffB); PG8_STAGE(PG8_SA(0, 1), cA + hstep, voffA);
    if (wr == 1) PG8_BAR;
    PG8_WAIT_V(4); PG8_BAR;
    PG8_STAGE(PG8_SB(1, 0), cB + kstep, voffB); PG8_STAGE(PG8_SA(1, 0), cA + kstep, voffA); PG8_STAGE(PG8_SB(1, 1), cB + hstepB + kstep, voffB);
    PG8_WAIT_V(6); PG8_BAR;
    for (;;) {
        const bool has_next = S.next(ui + 1, nxt);
        const char* nA = has_next ? (const char*)g.A + (size_t)nxt.pm * tstep : cA; const char* nB = has_next ? (const char*)g.Bt + (size_t)nxt.brow * rowB : cB;
        for (int t = 0; t < nt; t += 2) {
            const bool last = (t == nt - 2);
            const char* a1 = cA + (size_t)(t + 1) * kstep;
            const char* a2 = last ? nA : cA + (size_t)(t + 2) * kstep; const char* b2 = last ? nB : cB + (size_t)(t + 2) * kstep;
            const char* a3 = a2 + kstep; const char* b3 = b2 + kstep;
            if (last && has_next) S.a_ready(nxt);
            PG8_LDB(B0, 0, 0); PG8_SCHED; PG8_LDA(At, 0, 0); PG8_STAGE(PG8_SA(1, 1), a1 + hstep, voffA);
            PG8_WAIT_L(8); PG8_BAR; PG8_WAIT_L(0); PG8_MMA(0, 0, At, B0); PG8_BAR; PG8_SCHED;
            PG8_LDB(B1, 0, 1); PG8_STAGE(PG8_SB(0, 0), b2, voffB);
            PG8_BAR; PG8_WAIT_L(0); PG8_MMA(0, 1, At, B1); PG8_BAR;
            PG8_LDA(At, 0, 1); PG8_STAGE(PG8_SA(0, 0), a2, voffA);
            PG8_BAR; PG8_WAIT_L(0); PG8_MMA(1, 0, At, B0); PG8_BAR; PG8_SCHED;
            PG8_STAGE(PG8_SB(0, 1), b2 + hstepB, voffB);
            PG8_WAIT_V(6); PG8_BAR; PG8_MMA(1, 1, At, B1); PG8_BAR;
            PG8_LDB(B0, 1, 0); PG8_SCHED; PG8_LDA(At, 1, 0); PG8_STAGE(PG8_SA(0, 1), a2 + hstep, voffA);
            PG8_WAIT_L(8); PG8_BAR; PG8_WAIT_L(0); PG8_MMA(0, 0, At, B0); PG8_BAR; PG8_SCHED;
            PG8_LDB(B1, 1, 1); PG8_STAGE(PG8_SB(1, 0), b3, voffB);
            PG8_BAR; PG8_WAIT_L(0); PG8_MMA(0, 1, At, B1); PG8_BAR;
            PG8_LDA(At, 1, 1); PG8_STAGE(PG8_SA(1, 0), a3, voffA);
            PG8_BAR; PG8_WAIT_L(0); PG8_MMA(1, 0, At, B0); PG8_BAR; PG8_SCHED;
            PG8_STAGE(PG8_SB(1, 1), b3 + hstepB, voffB);
            PG8_WAIT_V(6); PG8_BAR; PG8_MMA(1, 1, At, B1); PG8_BAR;
        }
        if constexpr (!Epi::AFTER_DRAIN) { E(acc, cur, wr, wc, fr, fq); S.done(cur); }
        if (!has_next) break;
#pragma unroll
        for (int a = 0; a < 2; ++a)
#pragma unroll
            for (int b = 0; b < 2; ++b)
#pragma unroll
                for (int m = 0; m < 4; ++m)
#pragma unroll
                    for (int n = 0; n < 2; ++n) acc[a][b][m][n] = (f32x4){0.f, 0.f, 0.f, 0.f};
        cur = nxt; cA = nA; cB = nB; ++ui;
    }
    PG8_WAIT_V(0);
    if (wr == 0) PG8_BAR;
    PG8_BAR;
    if constexpr (Epi::AFTER_DRAIN) { E.fused(acc, cur, wr, wc, fr, fq, lds, wid, lane); S.done(cur); }
#undef PG8_SA
#undef PG8_SB
#undef PG8_STAGE
#undef PG8_LDA
#undef PG8_LDB
#undef PG8_MMA
#undef PG8_WAIT_V
#undef PG8_WAIT_L
#undef PG8_BAR
#undef PG8_SCHED
}

}

DI void p1_tile(const Params& p, char* smem, int mt, int nt) {
    const int tid = threadIdx.x, wid = tid >> 6, lane = tid & 63, fr = lane & 15, fq = lane >> 4, wr = wid >> 1, wc = wid & 1;
    unsigned char* ws = p.ws;
    const bf16_t* hb = (const bf16_t*)(ws + OFF_H);
    const bf16_t* wt = (const bf16_t*)(ws + OFF_WIN);
    const f32x2* tab = (const f32x2*)(ws + OFF_ROPE);
    bf16_t* qb = (bf16_t*)(ws + OFF_Q); bf16_t* kb = (bf16_t*)(ws + OFF_KB); bf16_t* vT = (bf16_t*)(ws + OFF_VT);
    bf16_t* zr = (bf16_t*)(p.out + OUT_Y);
    {
        const int row0 = mt * 256, ncol0 = nt < 6 ? nt * 128 : 2816 + (nt - 6) * 128;
        f32x4 acc[4][4]; zero_acc<4>(acc);
        gemm_acc<4>(acc, hb + (size_t)row0 * 1024, 1024, wt + (size_t)ncol0 * 1024, 1024, 1024, smem, tid);
        const bool latent = row0 >= MC;
#pragma unroll
        for (int mb = 0; mb < 4; ++mb) {
            const int m = row0 + wr * 64 + mb * 16 + fr;
            if (nt < 5 && latent) {
                const int tt = (m - MC) & 2047, prow = tt >> 6, pcol = tt & 63;
#pragma unroll
                for (int j = 0; j < 4; ++j) {
                    const f32x2 cr = tab[prow * 16 + fq * 4 + j], cc = tab[pcol * 16 + fq * 4 + j];
                    const float a1 = acc[mb][0][j], a2 = acc[mb][1][j], b1 = acc[mb][2][j], b2 = acc[mb][3][j];
                    acc[mb][0][j] = a1 * cr.x - a2 * cr.y; acc[mb][1][j] = a2 * cr.x + a1 * cr.y;
                    acc[mb][2][j] = b1 * cc.x - b2 * cc.y; acc[mb][3][j] = b2 * cc.x + b1 * cc.y;
                }
            }
#pragma unroll
            for (int nb = 0; nb < 4; ++nb) {
                const int nl = wc * 64 + nb * 16 + fq * 4;
                const f32x4 v = acc[mb][nb];
                if (nt < 4) { *(u32x2*)(qb + (size_t)m * 512 + nt * 128 + nl) = pack4(v); }
                else if (nt == 4) {
                    if (!latent) *(f32x4*)(p.out + OUT_K + (size_t)m * 128 + nl) = v;
                    *(u32x2*)(kb + (size_t)m * 128 + nl) = pack4(v);
                } else if (nt == 5) {
                    if (!latent) *(f32x4*)(p.out + OUT_V + (size_t)m * 128 + nl) = v;
                    int r0, T; seq_of(m, r0, T);
#pragma unroll
                    for (int j = 0; j < 4; ++j) vT[(size_t)r0 * 128 + (size_t)(nl + j) * T + (m - r0)] = f2bf(v[j]);
                } else { *(u32x2*)(zr + (size_t)m * ZRC + (nt - 6) * 128 + nl) = pack4(v); }
            }
        }
    }
}
struct EpiP1 {
    static constexpr bool PERM = false, AFTER_DRAIN = false;
    float* out; bf16_t *qb, *kb, *vT, *zr; const f32x2* tab;
    __device__ __forceinline__ void operator()(const f32x4 (&acc)[2][2][4][2], const pg8::Unit& u, int wr, int wc, int fr, int fq) const {
        const bool latent = u.pm * 256 >= MC;
        int r0, T; seq_of(u.pm * 256, r0, T);
#pragma unroll
        for (int ai = 0; ai < 2; ++ai)
#pragma unroll
            for (int m = 0; m < 4; ++m) {
                const int row = u.pm * 256 + ai * 128 + wr * 64 + m * 16 + fr;
                const int tt = (row - MC) & 2047, pos = (wc & 1) ? (tt & 63) : (tt >> 6);
#pragma unroll
                for (int bj = 0; bj < 2; ++bj) {
                    f32x4 v0 = acc[ai][bj][m][0], v1 = acc[ai][bj][m][1];
                    const int col = bj * 128 + wc * 32 + fq * 4;
                    if (latent && (u.pn < 2 || (u.pn == 2 && bj == 0))) {
#pragma unroll
                        for (int j = 0; j < 4; ++j) {
                            const f32x2 cs = tab[pos * 16 + fq * 4 + j];
                            const float a1 = v0[j], a2 = v1[j];
                            v0[j] = a1 * cs.x - a2 * cs.y; v1[j] = a2 * cs.x + a1 * cs.y;
                        }
                    }
                    if (u.pn < 2) {
                        *(u32x2*)(qb + (size_t)row * 512 + u.pn * 256 + col) = pack4(v0); *(u32x2*)(qb + (size_t)row * 512 + u.pn * 256 + col + 16) = pack4(v1);
                    } else if (u.pn == 2 && bj == 0) {
                        const int c = wc * 32 + fq * 4;
                        if (!latent) { *(f32x4*)(out + OUT_K + (size_t)row * 128 + c) = v0; *(f32x4*)(out + OUT_K + (size_t)row * 128 + c + 16) = v1; }
                        *(u32x2*)(kb + (size_t)row * 128 + c) = pack4(v0); *(u32x2*)(kb + (size_t)row * 128 + c + 16) = pack4(v1);
                    } else if (u.pn == 2) {
                        const int c = wc * 32 + fq * 4;
                        if (!latent) { *(f32x4*)(out + OUT_V + (size_t)row * 128 + c) = v0; *(f32x4*)(out + OUT_V + (size_t)row * 128 + c + 16) = v1; }
#pragma unroll
                        for (int j = 0; j < 4; ++j) {
                            vT[(size_t)r0 * 128 + (size_t)(c + j) * T + (row - r0)] = f2bf(v0[j]);
                            vT[(size_t)r0 * 128 + (size_t)(c + 16 + j) * T + (row - r0)] = f2bf(v1[j]);
                        }
                    } else {
                        const int c = (u.pn - 3) * 256 + col;
                        *(u32x2*)(zr + (size_t)row * ZRC + c) = pack4(v0); *(u32x2*)(zr + (size_t)row * ZRC + c + 16) = pack4(v1);
                    }
                }
            }
    }
};
DI void phase_p1(const Params& p, char* smem) {
    unsigned char* ws = p.ws;
    const int nM = M / 256, nN = 10, G = gridDim.x, nfirst = ((nM * nN) / G) * G;
    {
        const pg8::Gemm8 g = {(const bf16_t*)(ws + OFF_H), (const bf16_t*)(ws + OFF_WIN), 1024, 128};
        const pg8::Order8 ord = {nM, nN, nfirst, G, (int)blockIdx.x, 1};
        const EpiP1 epi = {p.out, (bf16_t*)(ws + OFF_Q), (bf16_t*)(ws + OFF_KB), (bf16_t*)(ws + OFF_VT), (bf16_t*)(p.out + OUT_Y), (const f32x2*)(ws + OFF_ROPE)};
        pg8::gemm8((LAS unsigned char*)smem, g, ord, epi);
    }
    const int nrest = 2 * (nM * nN - nfirst);
    for (int t = blockIdx.x; t < nrest + nM; t += G) {
        if (t < nrest) {
            int pm, pn; pg8::unit_of(nfirst + (t >> 1), nM, nN, pm, pn);
            p1_tile(p, smem, pm, (pn < 3 ? 2 * pn : 6 + 2 * (pn - 3)) + (t & 1));
        } else p1_tile(p, smem, t - nrest, 20);
    }
}

#define MFMA32(a, b, c) __builtin_amdgcn_mfma_f32_32x32x16_bf16((a), (b), (c), 0, 0, 0)
DI int crow(int i, int h) { return (i & 3) + 8 * (i >> 2) + 4 * h; }

DI void attn_item(const Params& p, char* smem, int it) {
    const int tid = threadIdx.x, wv = tid >> 6, lane = tid & 63, r = lane & 31, hh = lane >> 5;
    unsigned char* ws = p.ws;
    const bf16_t* qb = (const bf16_t*)(ws + OFF_Q); const bf16_t* kb = (const bf16_t*)(ws + OFF_KB); const bf16_t* vT = (const bf16_t*)(ws + OFF_VT);
    const bf16_t* kc = (const bf16_t*)(ws + OFF_KC); const bf16_t* vct = (const bf16_t*)(ws + OFF_VCT);
    bf16_t* ab = (bf16_t*)(ws + OFF_ATTN);
    bf16_t* Ks = (bf16_t*)smem;
    bf16_t* Vt = (bf16_t*)(smem + 9216);
    const float SC = 0.125f * LOG2E;
    {
        int r0, T, q0, kvh, bl;
        const bool lat = it < 512;
        if (lat) { bl = it >> 6; const int rem = it & 63; q0 = (rem >> 1) * 64; kvh = rem & 1; r0 = MC + bl * 2048; T = 2048; }
        else { const int i2 = it - 512; bl = 0; const int s = i2 >> 3, rem = i2 & 7; q0 = (rem >> 1) * 64; kvh = rem & 1; r0 = s * 256; T = 256; }
        const int head = kvh * 4 + (wv & 3), sub = wv >> 2, qs = q0 + 32 * sub;
        bf16x8 qf[4];
#pragma unroll
        for (int kk = 0; kk < 4; ++kk) qf[kk] = *(const bf16x8*)(qb + (size_t)(r0 + qs + r) * 512 + head * 64 + 16 * kk + 8 * hh);
        const float sinkl = p.attn_sink[head] * LOG2E;
        float mrun = sinkl, lrun = hh == 0 ? 1.0f : 0.0f;
        f32x16 o0, o1;
#pragma unroll
        for (int i = 0; i < 16; ++i) { o0[i] = 0.f; o1[i] = 0.f; }
        const int nwin = lat ? 5 : 4, ntile = lat ? 13 : 4;
        for (int ti = 0; ti < ntile; ++ti) {
            const bf16_t* ksrc; const bf16_t* vsrc; int vstride, ks0; bool window;
            if (ti < nwin) {
                ks0 = lat ? q0 - 128 + 64 * ti : 64 * ti; window = lat;
                if (ks0 < 0 || ks0 >= T) continue;
                ksrc = kb + (size_t)(r0 + ks0) * 128 + kvh * 64; vsrc = vT + (size_t)r0 * 128 + (size_t)(kvh * 64) * T + ks0; vstride = T;
            } else {
                ks0 = 64 * (ti - nwin); window = false;
                ksrc = kc + (size_t)(bl * 512 + ks0) * 128 + kvh * 64; vsrc = vct + (size_t)((bl * 2 + kvh) * 64) * 512 + ks0; vstride = 512;
            }
            __syncthreads();
            {
                const int rw_ = tid >> 3, ch = tid & 7;
                *(u32x4*)(Ks + rw_ * 72 + ch * 8) = *(const u32x4*)(ksrc + (size_t)rw_ * 128 + ch * 8);
                *(u32x4*)(Vt + rw_ * 72 + ch * 8) = *(const u32x4*)(vsrc + (size_t)rw_ * vstride + ch * 8);
            }
            __syncthreads();
#pragma unroll
            for (int sk = 0; sk < 2; ++sk) {
                const int kb0 = ks0 + 32 * sk;
                bool need_mask = false;
                if (window) {
                    if (kb0 > qs + 31 + 128 || kb0 + 31 < qs - 128) continue;
                    need_mask = (kb0 < qs + 31 - 128) || (kb0 + 31 > qs + 128);
                }
                f32x16 x;
#pragma unroll
                for (int i = 0; i < 16; ++i) x[i] = 0.f;
#pragma unroll
                for (int kk = 0; kk < 4; ++kk) {
                    const bf16x8 kf = *(const bf16x8*)(Ks + (32 * sk + r) * 72 + 16 * kk + 8 * hh);
                    x = MFMA32(kf, qf[kk], x);
                }
                float mx = -3.0e38f;
#pragma unroll
                for (int i = 0; i < 16; ++i) {
                    float s = x[i] * SC;
                    if (need_mask) { const int dk = kb0 + crow(i, hh) - (qs + r); if (dk > 128 || dk < -128) s = -3.0e38f; }
                    x[i] = s; mx = fmaxf(mx, s);
                }
                mx = fmaxf(mx, __shfl_xor(mx, 32));
                const float mnew = fmaxf(mrun, mx), alpha = exp2f(mrun - mnew);
                mrun = mnew;
                float ps = 0.f;
#pragma unroll
                for (int i = 0; i < 16; ++i) { const float pv = exp2f(x[i] - mnew); x[i] = pv; ps += pv; }
                lrun = lrun * alpha + ps;
#pragma unroll
                for (int i = 0; i < 16; ++i) { o0[i] *= alpha; o1[i] *= alpha; }
#pragma unroll
                for (int s = 0; s < 2; ++s) {
                    u32x4 pk;
                    pk[0] = pack2(x[8 * s + 0], x[8 * s + 1]); pk[1] = pack2(x[8 * s + 2], x[8 * s + 3]);
                    pk[2] = pack2(x[8 * s + 4], x[8 * s + 5]); pk[3] = pack2(x[8 * s + 6], x[8 * s + 7]);
                    const bf16x8 pf = __builtin_bit_cast(bf16x8, pk);
                    {
                        const s16x4 lo = *(const s16x4*)(Vt + r * 72 + 32 * sk + 16 * s + 4 * hh);
                        const s16x4 hi = *(const s16x4*)(Vt + r * 72 + 32 * sk + 16 * s + 8 + 4 * hh);
                        const bf16x8 vf = __builtin_shufflevector(lo, hi, 0, 1, 2, 3, 4, 5, 6, 7);
                        o0 = MFMA32(vf, pf, o0);
                    }
                    {
                        const s16x4 lo = *(const s16x4*)(Vt + (32 + r) * 72 + 32 * sk + 16 * s + 4 * hh);
                        const s16x4 hi = *(const s16x4*)(Vt + (32 + r) * 72 + 32 * sk + 16 * s + 8 + 4 * hh);
                        const bf16x8 vf = __builtin_shufflevector(lo, hi, 0, 1, 2, 3, 4, 5, 6, 7);
                        o1 = MFMA32(vf, pf, o1);
                    }
                }
            }
        }
        const float ltot = lrun + __shfl_xor(lrun, 32), inv = rcpf_(ltot);
        bf16_t* orow = ab + (size_t)(r0 + qs + r) * 512 + head * 64;
#pragma unroll
        for (int g = 0; g < 4; ++g) {
            f32x4 a, b;
#pragma unroll
            for (int j = 0; j < 4; ++j) { a[j] = o0[4 * g + j] * inv; b[j] = o1[4 * g + j] * inv; }
            *(u32x2*)(orow + 8 * g + 4 * hh) = pack4(a);
            *(u32x2*)(orow + 32 + 8 * g + 4 * hh) = pack4(b);
        }
    }
    __syncthreads();
}

DI void sg_pass(const Params& p) {
    const int tid = threadIdx.x;
    unsigned char* ws = p.ws;
    {
        const bf16_t* zr = (const bf16_t*)(p.out + OUT_Y);
        bf16_t* sg = (bf16_t*)(ws + OFF_SG);
        const float* mu0 = p.rwkv_mu; const float* mu1 = p.rwkv_mu + ZRC;
        for (int i = blockIdx.x * NTHR + tid; i < M * 32; i += gridDim.x * NTHR) {
            const int m = i >> 5, c = (i & 31) * 4;
            int r0, T; seq_of(m, r0, T);
            const bf16_t* zp = zr + (size_t)m * ZRC + 1792 + c;
            const f32x4 z = unpack4(*(const u32x2*)zp);
            f32x4 zprev = (f32x4){0.f, 0.f, 0.f, 0.f}, znext = zprev;
            if (m > r0) zprev = unpack4(*(const u32x2*)(zp - ZRC));
            if (m < r0 + T - 1) znext = unpack4(*(const u32x2*)(zp + ZRC));
            const f32x4 a0 = *(const f32x4*)(mu0 + 1792 + c), a1 = *(const f32x4*)(mu1 + 1792 + c);
            f32x4 o;
#pragma unroll
            for (int j = 0; j < 4; ++j) { const float zs = z[j] + a0[j] * (zprev[j] - z[j]) + a1[j] * (znext[j] - z[j]); o[j] = sigmoidf_(zs); }
            *(u32x2*)(sg + (size_t)m * 128 + c) = pack4(o);
        }
    }
}


template <int CTRL> DI float dpp_f(float x) { return __builtin_bit_cast(float, __builtin_amdgcn_mov_dpp(__builtin_bit_cast(int, x), CTRL, 0xf, 0xf, true)); }
DI float swap32_sum(float x) {
    float a = x, b = x;
    asm volatile("s_nop 1\n\tv_permlane32_swap_b32 %0, %1\n\ts_nop 1" : "+v"(a), "+v"(b));
    return a + b;
}
DI float row16_allsum(float x) { x += dpp_f<0x128>(x); x += dpp_f<0x124>(x); x += dpp_f<0x122>(x); x += dpp_f<0x121>(x); return x; }
template <int E> DI float qbc(f32x2 v) { return dpp_f<(E >> 1) * 0x55>((E & 1) ? v.y : v.x); }

#define QP0 " quad_perm:[0,0,0,0] row_mask:0xf bank_mask:0xf bound_ctrl:1\n\t"
#define QP1 " quad_perm:[1,1,1,1] row_mask:0xf bank_mask:0xf bound_ctrl:1\n\t"
#define QP2 " quad_perm:[2,2,2,2] row_mask:0xf bank_mask:0xf bound_ctrl:1\n\t"
#define QP3 " quad_perm:[3,3,3,3] row_mask:0xf bank_mask:0xf bound_ctrl:1\n\t"
#define ROR4 " row_ror:4 row_mask:0xf bank_mask:0xf bound_ctrl:1\n\t"
#define ROR8 " row_ror:8 row_mask:0xf bank_mask:0xf bound_ctrl:1\n\t"
DI float scan_sa(const float (&S)[8], f32x2 A) {
    float sa, t1, t2, t3;
    asm volatile(
        "s_nop 1\n\t"
        "v_mul_f32_dpp %0, %12, %4" QP0
        "v_mul_f32_dpp %1, %13, %5" QP0
        "v_mul_f32_dpp %2, %12, %6" QP1
        "v_mul_f32_dpp %3, %13, %7" QP1
        "v_fmac_f32_dpp %0, %12, %8" QP2
        "v_fmac_f32_dpp %1, %13, %9" QP2
        "v_fmac_f32_dpp %2, %12, %10" QP3
        "v_fmac_f32_dpp %3, %13, %11" QP3
        "v_add_f32 %0, %0, %1\n\t"
        "v_add_f32 %2, %2, %3\n\t"
        "v_add_f32 %0, %0, %2\n\t"
        "s_nop 1\n\t"
        "v_add_f32_dpp %0, %0, %0" ROR4
        "s_nop 1\n\t"
        "v_add_f32_dpp %0, %0, %0" ROR8
        "v_mov_b32 %1, %0\n\t"
        "s_nop 1\n\t"
        "v_permlane32_swap_b32 %0, %1\n\t"
        "s_nop 1\n\t"
        "v_add_f32 %0, %0, %1"
        : "=&v"(sa), "=&v"(t1), "=&v"(t2), "=&v"(t3)
        : "v"(S[0]), "v"(S[1]), "v"(S[2]), "v"(S[3]), "v"(S[4]), "v"(S[5]), "v"(S[6]), "v"(S[7]), "v"(A.x), "v"(A.y));
    return sa;
}
DI float scan_upd(float (&S)[8], float sa, float vv, f32x2 B, f32x2 K, f32x2 W, f32x2 R) {
    float n0, n1, n2, n3, n4, n5, n6, n7, y0, y1, y2, y3;
    asm volatile(
        "s_nop 1\n\t"
        "v_mul_f32_dpp %0, %22, %20" QP0  "v_mul_f32_dpp %1, %23, %20" QP0  "v_mul_f32_dpp %2, %22, %20" QP1  "v_mul_f32_dpp %3, %23, %20" QP1
        "v_mul_f32_dpp %4, %22, %20" QP2  "v_mul_f32_dpp %5, %23, %20" QP2  "v_mul_f32_dpp %6, %22, %20" QP3  "v_mul_f32_dpp %7, %23, %20" QP3
        "v_fmac_f32_dpp %0, %24, %21" QP0  "v_fmac_f32_dpp %1, %25, %21" QP0  "v_fmac_f32_dpp %2, %24, %21" QP1  "v_fmac_f32_dpp %3, %25, %21" QP1
        "v_fmac_f32_dpp %4, %24, %21" QP2  "v_fmac_f32_dpp %5, %25, %21" QP2  "v_fmac_f32_dpp %6, %24, %21" QP3  "v_fmac_f32_dpp %7, %25, %21" QP3
        "v_fmac_f32_dpp %0, %26, %12" QP0  "v_fmac_f32_dpp %1, %27, %13" QP0  "v_fmac_f32_dpp %2, %26, %14" QP1  "v_fmac_f32_dpp %3, %27, %15" QP1
        "v_fmac_f32_dpp %4, %26, %16" QP2  "v_fmac_f32_dpp %5, %27, %17" QP2  "v_fmac_f32_dpp %6, %26, %18" QP3  "v_fmac_f32_dpp %7, %27, %19" QP3
        "v_mul_f32_dpp %8, %28, %0" QP0   "v_mul_f32_dpp %9, %29, %1" QP0   "v_mul_f32_dpp %10, %28, %2" QP1  "v_mul_f32_dpp %11, %29, %3" QP1
        "v_fmac_f32_dpp %8, %28, %4" QP2  "v_fmac_f32_dpp %9, %29, %5" QP2  "v_fmac_f32_dpp %10, %28, %6" QP3 "v_fmac_f32_dpp %11, %29, %7" QP3
        "v_add_f32 %8, %8, %9\n\t"
        "v_add_f32 %10, %10, %11\n\t"
        "v_add_f32 %8, %8, %10\n\t"
        "s_nop 1\n\t"
        "v_add_f32_dpp %8, %8, %8" ROR4
        "s_nop 1\n\t"
        "v_add_f32_dpp %8, %8, %8" ROR8
        "v_mov_b32 %9, %8\n\t"
        "s_nop 1\n\t"
        "v_permlane32_swap_b32 %8, %9\n\t"
        "s_nop 1\n\t"
        "v_add_f32 %8, %8, %9"
        : "=&v"(n0), "=&v"(n1), "=&v"(n2), "=&v"(n3), "=&v"(n4), "=&v"(n5), "=&v"(n6), "=&v"(n7), "=&v"(y0), "=&v"(y1), "=&v"(y2), "=&v"(y3)
        : "v"(S[0]), "v"(S[1]), "v"(S[2]), "v"(S[3]), "v"(S[4]), "v"(S[5]), "v"(S[6]), "v"(S[7]), "v"(sa), "v"(vv),
          "v"(B.x), "v"(B.y), "v"(K.x), "v"(K.y), "v"(W.x), "v"(W.y), "v"(R.x), "v"(R.y));
    S[0] = n0; S[1] = n1; S[2] = n2; S[3] = n3; S[4] = n4; S[5] = n5; S[6] = n6; S[7] = n7;
    return y0;
}

constexpr int SC_OPW = 0, SC_OPK = 8192, SC_OPA = 16384, SC_OPB = 24576, SC_OPR = 32768, SC_OPV = 40960;
constexpr int SC_AW = 49152, SC_AA = SC_AW + 32 * 144;
constexpr int SC_LO = SC_AA + 32 * 144;
constexpr int SC_YB = SC_LO + 2 * 32 * 68 * 4;
static_assert(SC_YB + 8192 <= LDS_MAIN, "scan LDS");

DI void lds_barrier() { asm volatile("s_waitcnt lgkmcnt(0)\n\ts_barrier" ::: "memory"); }

constexpr int S2_OP = 0;
constexpr int S2_AW = 49152, S2_AA = S2_AW + 2304;
constexpr int S2_LO = S2_AA + 2304;
constexpr int S2_YB = S2_LO + 8704;
static_assert(S2_YB + 8192 <= LDS_MAIN, "scan LDS");

DI void scan_item(const Params& p, char* smem, int r0, int T, int dsel, int h, const float* state0, float* state_out) {
    const int tid = threadIdx.x, wv = tid >> 6, lane = tid & 63;
    const bool is_scan = wv < 4;
    unsigned char* ws = p.ws;
    const bf16_t* zr = (const bf16_t*)(p.out + OUT_Y);
    float* ys = (float*)(ws + OFF_YS) + (size_t)dsel * M * 512;
    float* bn = (float*)(ws + OFF_BN);
    float* op = (float*)(smem + S2_OP);
    bf16_t* Aw = (bf16_t*)(smem + S2_AW); bf16_t* Aa = (bf16_t*)(smem + S2_AA);
    float* Lo = (float*)(smem + S2_LO); float* yb = (float*)(smem + S2_YB);
    const int nchunk = T >> 4;

    const int rr = (lane & 3) | ((lane >> 4) << 2), jq = (lane >> 2) & 3, irow = 16 * (wv & 3) + rr, jb = 16 * jq;
    f32x4 S0, S1, S2, S3;
    if (state0 && is_scan) {
        const float* sp = state0 + irow * 64 + jb;
        S0 = *(const f32x4*)sp; S1 = *(const f32x4*)(sp + 4); S2 = *(const f32x4*)(sp + 8); S3 = *(const f32x4*)(sp + 12);
    } else { S0 = (f32x4){0.f, 0.f, 0.f, 0.f}; S1 = S0; S2 = S0; S3 = S0; }

    const int ptid = tid & 255, tt = ptid >> 4, cg4 = (ptid & 15) * 4;
    const int segc[5] = {h * 64 + cg4, 512 + h * 64 + cg4, 1024 + h * 64 + cg4, 1536 + dsel * 64 + cg4, 1664 + dsel * 64 + cg4};
    const int pL = (wv >> 1) & 1, pnh = wv & 1, fr = lane & 15, fq = lane >> 4;
    const bf16_t* wt = (const bf16_t*)(ws + (pL == 0 ? OFF_W2T : OFF_A2T)) + (size_t)(dsel * 512 + h * 64) * 64;
    u32x2 zc[5], zp[5], zn[5];
    f32x4 kreg, kkreg, rreg;
    auto load_chunk = [&](int c) {
        const int st = 16 * c + tt, tok = dsel ? T - 1 - st : st;
        const bf16_t* base = zr + (size_t)(r0 + tok) * ZRC;
#pragma unroll
        for (int s = 0; s < 5; ++s) {
            zc[s] = *(const u32x2*)(base + segc[s]);
            zp[s] = (u32x2){0u, 0u}; zn[s] = (u32x2){0u, 0u};
            if (tok > 0) zp[s] = *(const u32x2*)(base - ZRC + segc[s]);
            if (tok < T - 1) zn[s] = *(const u32x2*)(base + ZRC + segc[s]);
        }
    };
    auto prodA = [&](int buf) {
        f32x4 zs[5];
#pragma unroll
        for (int s = 0; s < 5; ++s) {
            const f32x4 mu0 = *(const f32x4*)(p.rwkv_mu + segc[s]), mu1 = *(const f32x4*)(p.rwkv_mu + ZRC + segc[s]);
            const f32x4 z = unpack4(zc[s]), a = unpack4(zp[s]), b = unpack4(zn[s]);
            zs[s] = z + mu0 * (a - z) + mu1 * (b - z);
        }
        const f32x4 kkv = *(const f32x4*)(p.rwkv_k_k + h * 64 + cg4);
        f32x4 kk = zs[1] * kkv;
        float n2 = kk[0] * kk[0] + kk[1] * kk[1] + kk[2] * kk[2] + kk[3] * kk[3];
        n2 = row16_allsum(n2);
        kk = kk * __builtin_amdgcn_rsqf(fmaxf(n2, 1e-24f));
        f32x4 tw;
#pragma unroll
        for (int j = 0; j < 4; ++j) tw[j] = 1.0f - 2.0f * rcpf_(1.0f + __expf(2.0f * zs[3][j]));
        *(u32x2*)(Aw + tt * 72 + cg4) = pack4(tw);
        *(u32x2*)(Aa + tt * 72 + cg4) = pack4(zs[4]);
        float* ob = op + buf * 6144 + tt * 64 + cg4;
        *(f32x4*)(ob + 4 * 1024) = zs[0];
        *(f32x4*)(ob + 5 * 1024) = zs[2];
        *(f32x4*)(ob + 2 * 1024) = -kk;
        kreg = zs[1]; kkreg = kk; rreg = zs[0];
    };
    auto prodB = [&]() {
        const bf16_t* As = pL == 0 ? Aw : Aa;
        const bf16x8 a0 = *(const bf16x8*)(As + fr * 72 + fq * 8), a1 = *(const bf16x8*)(As + fr * 72 + 32 + fq * 8);
#pragma unroll
        for (int n2 = 0; n2 < 2; ++n2) {
            f32x4 x = (f32x4){0.f, 0.f, 0.f, 0.f};
            const bf16_t* wr_ = wt + (size_t)((pnh * 2 + n2) * 16 + fr) * 64 + fq * 8;
            x = __builtin_amdgcn_mfma_f32_16x16x32_bf16(a0, *(const bf16x8*)wr_, x, 0, 0, 0);
            x = __builtin_amdgcn_mfma_f32_16x16x32_bf16(a1, *(const bf16x8*)(wr_ + 32), x, 0, 0, 0);
#pragma unroll
            for (int j = 0; j < 4; ++j) Lo[(pL * 16 + fq * 4 + j) * 68 + (pnh * 2 + n2) * 16 + fr] = x[j];
        }
    };
    auto prodC = [&](int c, int buf) {
        const int st = 16 * c + tt, tok = dsel ? T - 1 - st : st, m = r0 + tok;
        const f32x4 w0v = *(const f32x4*)(p.rwkv_w0 + dsel * 512 + h * 64 + cg4), a0v = *(const f32x4*)(p.rwkv_a0 + dsel * 512 + h * 64 + cg4);
        const f32x4 kav = *(const f32x4*)(p.rwkv_k_a + h * 64 + cg4), rkv = *(const f32x4*)(p.rwkv_r_k + h * 64 + cg4);
        const f32x4 lw = *(const f32x4*)(Lo + tt * 68 + cg4), la = *(const f32x4*)(Lo + (16 + tt) * 68 + cg4);
        f32x4 wd, kd, bb; float bs = 0.f;
#pragma unroll
        for (int j = 0; j < 4; ++j) {
            wd[j] = __expf(-0.6065306597126334f * sigmoidf_(w0v[j] + lw[j]));
            const float a = sigmoidf_(a0v[j] + la[j]);
            kd[j] = kreg[j] * (1.0f + (a - 1.0f) * kav[j]);
            bb[j] = a * kkreg[j];
            bs += rreg[j] * kd[j] * rkv[j];
        }
        float* ob = op + buf * 6144 + tt * 64 + cg4;
        *(f32x4*)(ob) = wd;
        *(f32x4*)(ob + 1024) = kd;
        *(f32x4*)(ob + 3 * 1024) = bb;
        bs = row16_allsum(bs);
        if ((ptid & 15) == 0) bn[(size_t)m * 16 + dsel * 8 + h] = bs;
    };
    auto flush_ys = [&](int c) {
        const int st = 16 * c + tt, tok = dsel ? T - 1 - st : st, m = r0 + tok;
        *(f32x4*)(ys + (size_t)m * 512 + h * 64 + cg4) = *(const f32x4*)(yb + (c & 1) * 1024 + tt * 64 + cg4);
    };
    auto chunk_steps = [&](int buf) {
        const float* ob = op + buf * 6144 + jb;
        const float* ov = op + buf * 6144 + 5 * 1024 + irow;
        float* yo = yb + buf * 1024 + irow;
        f32x4 W0 = *(const f32x4*)(ob), W1 = *(const f32x4*)(ob + 4), W2 = *(const f32x4*)(ob + 8), W3 = *(const f32x4*)(ob + 12);
        f32x4 K0 = *(const f32x4*)(ob + 1024), K1 = *(const f32x4*)(ob + 1028), K2 = *(const f32x4*)(ob + 1032), K3 = *(const f32x4*)(ob + 1036);
        f32x4 A0 = *(const f32x4*)(ob + 2048), A1 = *(const f32x4*)(ob + 2052), A2 = *(const f32x4*)(ob + 2056), A3 = *(const f32x4*)(ob + 2060);
        f32x4 B0 = *(const f32x4*)(ob + 3072), B1 = *(const f32x4*)(ob + 3076), B2 = *(const f32x4*)(ob + 3080), B3 = *(const f32x4*)(ob + 3084);
        f32x4 R0 = *(const f32x4*)(ob + 4096), R1 = *(const f32x4*)(ob + 4100), R2 = *(const f32x4*)(ob + 4104), R3 = *(const f32x4*)(ob + 4108);
        float vv = ov[0];
#pragma unroll 2
        for (int s = 0; s < 16; ++s) {
            const float* o = ob + ((s + 1) & 15) * 64;
            const f32x4 W0n = *(const f32x4*)(o), W1n = *(const f32x4*)(o + 4), W2n = *(const f32x4*)(o + 8), W3n = *(const f32x4*)(o + 12);
            const f32x4 K0n = *(const f32x4*)(o + 1024), K1n = *(const f32x4*)(o + 1028), K2n = *(const f32x4*)(o + 1032), K3n = *(const f32x4*)(o + 1036);
            const f32x4 A0n = *(const f32x4*)(o + 2048), A1n = *(const f32x4*)(o + 2052), A2n = *(const f32x4*)(o + 2056), A3n = *(const f32x4*)(o + 2060);
            const f32x4 B0n = *(const f32x4*)(o + 3072), B1n = *(const f32x4*)(o + 3076), B2n = *(const f32x4*)(o + 3080), B3n = *(const f32x4*)(o + 3084);
            const f32x4 R0n = *(const f32x4*)(o + 4096), R1n = *(const f32x4*)(o + 4100), R2n = *(const f32x4*)(o + 4104), R3n = *(const f32x4*)(o + 4108);
            const float vn = ov[((s + 1) & 15) * 64];
            const f32x4 pa = (S0 * A0 + S1 * A1) + (S2 * A2 + S3 * A3);
            float sa = (pa[0] + pa[1]) + (pa[2] + pa[3]);
            sa += dpp_f<0x124>(sa); sa += dpp_f<0x128>(sa);
            S0 = S0 * W0 + (B0 * sa + K0 * vv);
            S1 = S1 * W1 + (B1 * sa + K1 * vv);
            S2 = S2 * W2 + (B2 * sa + K2 * vv);
            S3 = S3 * W3 + (B3 * sa + K3 * vv);
            const f32x4 py = (S0 * R0 + S1 * R1) + (S2 * R2 + S3 * R3);
            float y = (py[0] + py[1]) + (py[2] + py[3]);
            y += dpp_f<0x124>(y); y += dpp_f<0x128>(y);
            if (jq == 0) yo[s * 64] = y;
            W0 = W0n; W1 = W1n; W2 = W2n; W3 = W3n; K0 = K0n; K1 = K1n; K2 = K2n; K3 = K3n; A0 = A0n; A1 = A1n; A2 = A2n; A3 = A3n;
            B0 = B0n; B1 = B1n; B2 = B2n; B3 = B3n; R0 = R0n; R1 = R1n; R2 = R2n; R3 = R3n; vv = vn;
            if (s == 4 || s == 9) lds_barrier();
        }
    };

    lds_barrier();
    if (is_scan) {
        lds_barrier(); lds_barrier(); lds_barrier();
#pragma unroll 1
        for (int c = 0; c < nchunk; ++c) {
            chunk_steps(c & 1);
            lds_barrier();
        }
        if (state_out) {
            float* sp = state_out + irow * 64 + jb;
            *(f32x4*)sp = S0; *(f32x4*)(sp + 4) = S1; *(f32x4*)(sp + 8) = S2; *(f32x4*)(sp + 12) = S3;
        }
    } else {
        load_chunk(0); prodA(0);
        lds_barrier();
        prodB();
        lds_barrier();
        prodC(0, 0); if (nchunk > 1) load_chunk(1);
        lds_barrier();
#pragma unroll 1
        for (int c = 0; c < nchunk; ++c) {
            const int b = c & 1;
            const bool more = c + 1 < nchunk;
            if (c > 0) flush_ys(c - 1);
            if (more) prodA(b ^ 1);
            lds_barrier();
            if (more) prodB();
            lds_barrier();
            if (more) { prodC(c + 1, b ^ 1); if (c + 2 < nchunk) load_chunk(c + 2); }
            lds_barrier();
        }
        flush_ys(nchunk - 1);
    }
    lds_barrier();
}

DI void scan_dispatch(const Params& p, char* smem, int it) {
    if (it < 128) {
        const int b = it >> 4, dsel = (it >> 3) & 1, h = it & 7;
        scan_item(p, smem, MC + b * 2048, 2048, dsel, h, p.state_rwkv + (size_t)((b * 2 + dsel) * 8 + h) * 4096, nullptr);
    } else {
        const int i2 = it - 128, s = i2 >> 4, dsel = (i2 >> 3) & 1, h = i2 & 7;
        scan_item(p, smem, s * 256, 256, dsel, h, nullptr, p.out + OUT_S + (size_t)((s * 2 + dsel) * 8 + h) * 4096);
    }
}
DI void phase_mix(const Params& p, char* smem) {
    unsigned* ctr = (unsigned*)(p.ws + OFF_BAR) + XCD_BAR_WORDS;
    volatile LAS unsigned* slot = (volatile LAS unsigned*)(smem + LDS_MAIN + 8);
    for (;;) {
        if (threadIdx.x == 0) *slot = __hip_atomic_fetch_add(ctr, 1u, __ATOMIC_RELAXED, __HIP_MEMORY_SCOPE_AGENT);
        __syncthreads();
        const int it = (int)*slot;
        __syncthreads();
        if (it >= 640 + 768) break;
        if (it < 640) scan_dispatch(p, smem, it);
        else attn_item(p, smem, it - 640);
    }
    sg_pass(p);
}

DI void phase_post(const Params& p, char* smem) {
    const int tid = threadIdx.x, wid = tid >> 6, lane = tid & 63, fr = lane & 15, fq = lane >> 4, wr = wid >> 1, wc = wid & 1;
    unsigned char* ws = p.ws;
    const bf16_t* sg = (const bf16_t*)(ws + OFF_SG); const bf16_t* g2t = (const bf16_t*)(ws + OFF_G2T);
    const float* ys0 = (const float*)(ws + OFF_YS); const float* ys1 = ys0 + (size_t)M * 512;
    const float* bn = (const float*)(ws + OFF_BN);
    const bf16_t* zr = (const bf16_t*)(p.out + OUT_Y);
    bf16_t* rw = (bf16_t*)(ws + OFF_RW);
    const int MT = M / 256, NT = 4;
    for (int t = blockIdx.x; t < MT * NT; t += gridDim.x) {
        int mt, nt; tile_coords(t, MT, NT, mt, nt);
        const int row0 = mt * 256;
        f32x4 acc[4][4]; zero_acc<4>(acc);
        gemm_acc<4>(acc, sg + (size_t)row0 * 128, 128, g2t + (size_t)(nt * 128) * 128, 128, 128, smem, tid);
        const int head = nt * 2 + wc;
#pragma unroll
        for (int mb = 0; mb < 4; ++mb) {
            const int m = row0 + wr * 64 + mb * 16 + fr;
            int r0, T; seq_of(m, r0, T);
            f32x4 y[4]; float s1 = 0.f;
#pragma unroll
            for (int nb = 0; nb < 4; ++nb) {
                const size_t o = (size_t)m * 512 + head * 64 + nb * 16 + fq * 4;
                y[nb] = *(const f32x4*)(ys0 + o) + *(const f32x4*)(ys1 + o);
                s1 += y[nb][0] + y[nb][1] + y[nb][2] + y[nb][3];
            }
            s1 += __shfl_xor(s1, 16); s1 += __shfl_xor(s1, 32);
            const float mean = s1 * (1.0f / 64.0f);
            float s2 = 0.f;
#pragma unroll
            for (int nb = 0; nb < 4; ++nb) { const f32x4 dlt = y[nb] - mean; s2 += dlt[0] * dlt[0] + dlt[1] * dlt[1] + dlt[2] * dlt[2] + dlt[3] * dlt[3]; }
            s2 += __shfl_xor(s2, 16); s2 += __shfl_xor(s2, 32);
            const float rstd = __builtin_amdgcn_rsqf(s2 * (1.0f / 64.0f) + 64e-5f);
            const float bonus = bn[(size_t)m * 16 + head] + bn[(size_t)m * 16 + 8 + head];
#pragma unroll
            for (int nb = 0; nb < 4; ++nb) {
                const int c = head * 64 + nb * 16 + fq * 4;
                const bf16_t* zp = zr + (size_t)m * ZRC + 1024 + c;
                const f32x4 z = unpack4(*(const u32x2*)zp);
                f32x4 zprev = (f32x4){0.f, 0.f, 0.f, 0.f}, znext = zprev;
                if (m > r0) zprev = unpack4(*(const u32x2*)(zp - ZRC));
                if (m < r0 + T - 1) znext = unpack4(*(const u32x2*)(zp + ZRC));
                const f32x4 a0 = *(const f32x4*)(p.rwkv_mu + 1024 + c), a1 = *(const f32x4*)(p.rwkv_mu + ZRC + 1024 + c);
                const f32x4 v = z + a0 * (zprev - z) + a1 * (znext - z);
                const f32x4 lg = *(const f32x4*)(p.rwkv_ln_g + c), lb = *(const f32x4*)(p.rwkv_ln_b + c);
                const f32x4 yn = (y[nb] - mean) * rstd * lg + lb;
                const f32x4 o = (yn + v * bonus) * acc[mb][nb];
                *(u32x2*)(rw + (size_t)m * 512 + c) = pack4(o);
            }
        }
    }
}

DI void phase_merge(const Params& p, char* smem) {
    const int tid = threadIdx.x, wid = tid >> 6, lane = tid & 63, fr = lane & 15, fq = lane >> 4, wr = wid >> 1, wc = wid & 1;
    unsigned char* ws = p.ws;
    const bf16_t* hb = (const bf16_t*)(ws + OFF_H); const bf16_t* wt = (const bf16_t*)(ws + OFF_WIN);
    const bf16_t* ab = (const bf16_t*)(ws + OFF_ATTN); const bf16_t* rw = (const bf16_t*)(ws + OFF_RW);
    const bf16_t* wpa = (const bf16_t*)(ws + OFF_WPA); const bf16_t* wpb = (const bf16_t*)(ws + OFF_WPB);
    bf16_t* mg = (bf16_t*)(ws + OFF_MRG);
    const int MT = M / 256, NT = 16;
    for (int t = blockIdx.x; t < MT * NT; t += gridDim.x) {
        int mt, nt; tile_coords(t, MT, NT, mt, nt);
        const int row0 = mt * 256, n0 = nt * 64;
        u32x2 gpa[4][2], gpb[4][2];
        {
            f32x4 gacc[4][4]; zero_acc<4>(gacc);
            gemm_acc<4, 1024>(gacc, hb + (size_t)row0 * 1024, 1024, wt + (size_t)(768 + n0) * 1024, 1024, 1024, smem, tid);
#pragma unroll
            for (int a = 0; a < 4; ++a)
#pragma unroll
                for (int b = 0; b < 2; ++b) {
                    f32x4 ga, gb;
#pragma unroll
                    for (int j = 0; j < 4; ++j) { ga[j] = sigmoidf_(gacc[a][b][j]); gb[j] = sigmoidf_(gacc[a][b + 2][j]); }
                    gpa[a][b] = pack4(ga); gpb[a][b] = pack4(gb);
                }
        }
        f32x4 acc[4][2], res[4][2];
        zero_acc<2>(acc);
        gemm_acc<2>(acc, ab + (size_t)row0 * 512, 512, wpa + (size_t)n0 * 512, 512, 512, smem, tid);
#pragma unroll
        for (int a = 0; a < 4; ++a)
#pragma unroll
            for (int b = 0; b < 2; ++b) res[a][b] = unpack4(gpa[a][b]) * acc[a][b];
        zero_acc<2>(acc);
        gemm_acc<2>(acc, rw + (size_t)row0 * 512, 512, wpb + (size_t)n0 * 512, 512, 512, smem, tid);
#pragma unroll
        for (int mb = 0; mb < 4; ++mb) {
            const int m = row0 + wr * 64 + mb * 16 + fr;
#pragma unroll
            for (int nb = 0; nb < 2; ++nb) {
                const f32x4 o = res[mb][nb] + unpack4(gpb[mb][nb]) * acc[mb][nb];
                *(u32x2*)(mg + (size_t)m * 1024 + n0 + wc * 32 + nb * 16 + fq * 4) = pack4(o);
            }
        }
    }
}

struct EpiOut {
    static constexpr bool PERM = false, AFTER_DRAIN = false;
    float* y; const float* mod; const float* xp; const float* xs;
    __device__ __forceinline__ void operator()(const f32x4 (&acc)[2][2][4][2], const pg8::Unit& u, int wr, int wc, int fr, int fq) const {
        const int row0 = u.pm * 256 + wr * 64 + fr, col0 = u.pn * 256 + wc * 32 + 4 * fq, ci = cond_of(u.pm * 256);
        const float* xb = u.pm * 256 < MC ? xp : xs - (size_t)MC * D;
#pragma unroll
        for (int bj = 0; bj < 2; ++bj)
#pragma unroll
            for (int n = 0; n < 2; ++n) {
                const int col = col0 + bj * 128 + n * 16;
                const f32x4 g1 = *(const f32x4*)(mod + ci * 6144 + 2048 + col);
#pragma unroll
                for (int ai = 0; ai < 2; ++ai)
#pragma unroll
                    for (int m = 0; m < 4; ++m) {
                        const size_t o = (size_t)(row0 + ai * 128 + m * 16) * D + col;
                        *(f32x4*)(y + o) = *(const f32x4*)(xb + o) + g1 * acc[ai][bj][m][n];
                    }
            }
    }
};
DI void phase_out(const Params& p, char* smem) {
    const int tid = threadIdx.x, wid = tid >> 6, lane = tid & 63, fr = lane & 15, fq = lane >> 4, wr = wid >> 1, wc = wid & 1;
    unsigned char* ws = p.ws;
    const bf16_t* mg = (const bf16_t*)(ws + OFF_MRG); const bf16_t* wo = (const bf16_t*)(ws + OFF_WOUT);
    const float* mod = (const float*)(ws + OFF_MOD);
    const int nM = M / 256, nN = 4, G = gridDim.x, nfirst = G < nM * nN ? G : nM * nN;
    {
        const pg8::Gemm8 g = {mg, wo, 1024, 128};
        const pg8::Order8 ord = {nM, nN, nfirst, G, (int)blockIdx.x, 0};
        const EpiOut epi = {p.out + OUT_Y, mod, p.x_prompt, p.x_sample};
        pg8::gemm8((LAS unsigned char*)smem, g, ord, epi);
    }
    for (int t = blockIdx.x; t < 2 * (nM * nN - nfirst); t += G) {
        int pm, pn; pg8::unit_of(nfirst + (t >> 1), nM, nN, pm, pn);
        const int row0 = pm * 256, n0 = pn * 256 + (t & 1) * 128;
        f32x4 acc[4][4]; zero_acc<4>(acc);
        gemm_acc<4>(acc, mg + (size_t)row0 * 1024, 1024, wo + (size_t)n0 * 1024, 1024, 1024, smem, tid);
        const int ci = cond_of(row0);
#pragma unroll
        for (int nb = 0; nb < 4; ++nb) {
            const int n = n0 + wc * 64 + nb * 16 + fq * 4;
            const f32x4 g1 = *(const f32x4*)(mod + ci * 6144 + 2048 + n);
#pragma unroll
            for (int mb = 0; mb < 4; ++mb) {
                const int m = row0 + wr * 64 + mb * 16 + fr;
                const f32x4 xv = *(const f32x4*)(xrow(p, m) + n);
                *(f32x4*)(p.out + OUT_Y + (size_t)m * D + n) = xv + g1 * acc[mb][nb];
            }
        }
    }
}

DI u32x2 conv_act(const f32x4 (&um)[2], const f32x4 (&u0)[2], const f32x4 (&up)[2], const float* cw, const float* cb, int gcol) {
    f32x4 res[2];
#pragma unroll
    for (int part = 0; part < 2; ++part) {
        const int cc = gcol + part * DFF;
        const f32x4 w0 = *(const f32x4*)(cw + cc), w1 = *(const f32x4*)(cw + 5632 + cc), w2 = *(const f32x4*)(cw + 2 * 5632 + cc), bb = *(const f32x4*)(cb + cc);
        res[part] = um[part] * w0 + u0[part] * w1 + up[part] * w2 + bb;
    }
    f32x4 o;
#pragma unroll
    for (int j = 0; j < 4; ++j) { const float g = res[1][j]; o[j] = g * rcpf_(1.0f + __expf(-g)) * res[0][j]; }
    return pack4(o);
}
DI void up_tile64(const Params& p, char* smem, int mt, int nt) {
    const int tid = threadIdx.x, wid = tid >> 6, lane = tid & 63, fr = lane & 15, fq = lane >> 4, wr = wid >> 1, wc = wid & 1;
    unsigned char* ws = p.ws;
    const bf16_t* hb = (const bf16_t*)(ws + OFF_H); const bf16_t* wu = (const bf16_t*)(ws + OFF_WUP);
    bf16_t* act = (bf16_t*)(ws + OFF_ACT); bf16_t* ub = (bf16_t*)(ws + OFF_U);
    bf16_t* ut = (bf16_t*)smem;
    const int NT = 44;
    {
        const int row0 = mt * 256, n0 = nt * 64;
        f32x4 acc[4][4]; zero_acc<4>(acc);
        gemm_acc<4, DFF>(acc, hb + (size_t)row0 * 1024, 1024, wu + (size_t)n0 * 1024, 1024, 1024, smem, tid);
        __syncthreads();
#pragma unroll
        for (int mb = 0; mb < 4; ++mb)
#pragma unroll
            for (int nb = 0; nb < 4; ++nb) *(u32x2*)(ut + (wr * 64 + mb * 16 + fr) * 136 + wc * 64 + nb * 16 + fq * 4) = pack4(acc[mb][nb]);
        __syncthreads();
        const int c4 = (tid & 15) * 4, lv = (c4 >> 5) * 64 + (c4 & 31), lg = lv + 32;
#pragma unroll 2
        for (int it = 0; it < 8; ++it) {
            const int row = it * 32 + (tid >> 4);
            f32x4 um[2], u0[2], up[2];
            const f32x4 z4 = (f32x4){0.f, 0.f, 0.f, 0.f};
            u0[0] = unpack4(*(const u32x2*)(ut + row * 136 + lv)); u0[1] = unpack4(*(const u32x2*)(ut + row * 136 + lg));
            um[0] = row > 0 ? unpack4(*(const u32x2*)(ut + (row - 1) * 136 + lv)) : z4; um[1] = row > 0 ? unpack4(*(const u32x2*)(ut + (row - 1) * 136 + lg)) : z4;
            up[0] = row < 255 ? unpack4(*(const u32x2*)(ut + (row + 1) * 136 + lv)) : z4; up[1] = row < 255 ? unpack4(*(const u32x2*)(ut + (row + 1) * 136 + lg)) : z4;
            *(u32x2*)(act + (size_t)(row0 + row) * DFF + n0 + c4) = conv_act(um, u0, up, p.ffn_conv_w, p.ffn_conv_b, n0 + c4);
        }
        if (row0 >= MC && tid < 256) {
            const int k = tid >> 6, rsel = k < 2 ? k : 252 + k, cp = (tid & 63) * 2;
            *(unsigned*)(ub + ((size_t)(mt * NT + nt) * 4 + k) * 128 + cp) = *(const unsigned*)(ut + rsel * 136 + cp);
        }
    }
}
DI void up_tile128(const Params& p, char* smem, int mt, int nt) {
    const int tid = threadIdx.x, wid = tid >> 6, lane = tid & 63, fr = lane & 15, fq = lane >> 4, wr = wid >> 1, wc = wid & 1;
    unsigned char* ws = p.ws;
    const bf16_t* hb = (const bf16_t*)(ws + OFF_H); const bf16_t* wu = (const bf16_t*)(ws + OFF_WUP);
    bf16_t* act = (bf16_t*)(ws + OFF_ACT); bf16_t* ub = (bf16_t*)(ws + OFF_U);
    bf16_t* ut = (bf16_t*)smem;
    {
        const int row0 = mt * 256, n0 = nt * 128;
        f32x4 acc[4][8];
#pragma unroll
        for (int a = 0; a < 4; ++a)
#pragma unroll
            for (int b = 0; b < 8; ++b) acc[a][b] = (f32x4){0.f, 0.f, 0.f, 0.f};
        gemm_acc8<DFF>(acc, hb + (size_t)row0 * 1024, 1024, wu + (size_t)n0 * 1024, 1024, 1024, smem, tid);
        __syncthreads();
#pragma unroll
        for (int mb = 0; mb < 4; ++mb)
#pragma unroll
            for (int nb = 0; nb < 8; ++nb) *(u32x2*)(ut + (wr * 64 + mb * 16 + fr) * 264 + wc * 128 + nb * 16 + fq * 4) = pack4(acc[mb][nb]);
        __syncthreads();
        const int c4 = (tid & 31) * 4, lv = (c4 >> 6) * 128 + (c4 & 63), lg = lv + 64;
#pragma unroll 2
        for (int it = 0; it < 16; ++it) {
            const int row = it * 16 + (tid >> 5);
            f32x4 um[2], u0[2], up[2];
            const f32x4 z4 = (f32x4){0.f, 0.f, 0.f, 0.f};
            u0[0] = unpack4(*(const u32x2*)(ut + row * 264 + lv)); u0[1] = unpack4(*(const u32x2*)(ut + row * 264 + lg));
            um[0] = row > 0 ? unpack4(*(const u32x2*)(ut + (row - 1) * 264 + lv)) : z4; um[1] = row > 0 ? unpack4(*(const u32x2*)(ut + (row - 1) * 264 + lg)) : z4;
            up[0] = row < 255 ? unpack4(*(const u32x2*)(ut + (row + 1) * 264 + lv)) : z4; up[1] = row < 255 ? unpack4(*(const u32x2*)(ut + (row + 1) * 264 + lg)) : z4;
            *(u32x2*)(act + (size_t)(row0 + row) * DFF + n0 + c4) = conv_act(um, u0, up, p.ffn_conv_w, p.ffn_conv_b, n0 + c4);
        }
        if (row0 >= MC) {
            const int k = tid >> 7, rsel = k < 2 ? k : 252 + k, sub = (tid >> 6) & 1, lo = (tid & 63) * 2;
            const int cq = (lo >> 6) * 32 + (lo & 31), isg = (lo >> 5) & 1;
            *(unsigned*)(ub + ((size_t)(mt * 44 + nt * 2 + sub) * 4 + k) * 128 + lo) = *(const unsigned*)(ut + rsel * 264 + sub * 128 + cq + isg * 64);
        }
    }
}
DI void phase_up(const Params& p, char* smem) {
    const int MT = M / 256, NT = 22, G = gridDim.x, nfirst = ((MT * NT) / G) * G;
    for (int t = blockIdx.x; t < nfirst; t += G) { int mt, nt; tile_coords(t, MT, NT, mt, nt); up_tile128(p, smem, mt, nt); }
    for (int t = blockIdx.x; t < 2 * (MT * NT - nfirst); t += G) { int mt, nt; tile_coords(nfirst + (t >> 1), MT, NT, mt, nt); up_tile64(p, smem, mt, nt * 2 + (t & 1)); }
}
DI void phase_fix(const Params& p) {
    unsigned char* ws = p.ws;
    bf16_t* act = (bf16_t*)(ws + OFF_ACT); const bf16_t* ub = (const bf16_t*)(ws + OFF_U);
    const int NT = 44;
    for (int i = blockIdx.x * NTHR + threadIdx.x; i < 64 * NT * 2 * 16; i += gridDim.x * NTHR) {
        const int cg = i & 15, which = (i >> 4) & 1, rest = i >> 5, nt = rest % NT, mt = 32 + rest / NT;
        const int row0 = mt * 256, tpos = (row0 - MC) & 2047;
        if (which == 0 ? tpos == 0 : tpos == 2048 - 256) continue;
        const bf16_t* own = ub + (size_t)(mt * NT + nt) * 4 * 128;
        const bf16_t *pv, *cu, *nx; int m;
        if (which == 0) { m = row0; pv = ub + ((size_t)((mt - 1) * NT + nt) * 4 + 3) * 128; cu = own; nx = own + 128; }
        else { m = row0 + 255; pv = own + 2 * 128; cu = own + 3 * 128; nx = ub + (size_t)((mt + 1) * NT + nt) * 4 * 128; }
        const int c4 = cg * 4, lv = (c4 >> 5) * 64 + (c4 & 31), lg = lv + 32;
        f32x4 um[2], u0[2], up[2];
        um[0] = unpack4(*(const u32x2*)(pv + lv)); um[1] = unpack4(*(const u32x2*)(pv + lg));
        u0[0] = unpack4(*(const u32x2*)(cu + lv)); u0[1] = unpack4(*(const u32x2*)(cu + lg));
        up[0] = unpack4(*(const u32x2*)(nx + lv)); up[1] = unpack4(*(const u32x2*)(nx + lg));
        *(u32x2*)(act + (size_t)m * DFF + nt * 64 + c4) = conv_act(um, u0, up, p.ffn_conv_w, p.ffn_conv_b, nt * 64 + c4);
    }
}
struct EpiDown {
    static constexpr bool PERM = false, AFTER_DRAIN = false;
    float* y; const float* mod;
    __device__ __forceinline__ void operator()(const f32x4 (&acc)[2][2][4][2], const pg8::Unit& u, int wr, int wc, int fr, int fq) const {
        const int row0 = u.pm * 256 + wr * 64 + fr, col0 = u.pn * 256 + wc * 32 + 4 * fq, ci = cond_of(u.pm * 256);
#pragma unroll
        for (int bj = 0; bj < 2; ++bj)
#pragma unroll
            for (int n = 0; n < 2; ++n) {
                const int col = col0 + bj * 128 + n * 16;
                const f32x4 g2 = *(const f32x4*)(mod + ci * 6144 + 5120 + col);
#pragma unroll
                for (int ai = 0; ai < 2; ++ai)
#pragma unroll
                    for (int m = 0; m < 4; ++m) { float* px = y + (size_t)(row0 + ai * 128 + m * 16) * D + col; *(f32x4*)px = *(const f32x4*)px + g2 * acc[ai][bj][m][n]; }
            }
    }
};
DI void phase_down(const Params& p, char* smem) {
    const int tid = threadIdx.x, wid = tid >> 6, lane = tid & 63, fr = lane & 15, fq = lane >> 4, wr = wid >> 1, wc = wid & 1;
    unsigned char* ws = p.ws;
    const bf16_t* act = (const bf16_t*)(ws + OFF_ACT); const bf16_t* wd = (const bf16_t*)(ws + OFF_WDN);
    const float* mod = (const float*)(ws + OFF_MOD);
    const int nM = M / 256, nN = 4, G = gridDim.x, nfirst = G < nM * nN ? G : nM * nN;
    {
        const pg8::Gemm8 g = {act, wd, DFF, 128};
        const pg8::Order8 ord = {nM, nN, nfirst, G, (int)blockIdx.x, 0};
        const EpiDown epi = {p.out + OUT_Y, mod};
        pg8::gemm8((LAS unsigned char*)smem, g, ord, epi);
    }
    for (int t = blockIdx.x; t < 2 * (nM * nN - nfirst); t += G) {
        int pm, pn; pg8::unit_of(nfirst + (t >> 1), nM, nN, pm, pn);
        const int row0 = pm * 256, n0 = pn * 256 + (t & 1) * 128;
        f32x4 acc[4][4]; zero_acc<4>(acc);
        gemm_acc<4>(acc, act + (size_t)row0 * DFF, DFF, wd + (size_t)n0 * DFF, DFF, DFF, smem, tid);
        const int ci = cond_of(row0);
#pragma unroll
        for (int nb = 0; nb < 4; ++nb) {
            const int n = n0 + wc * 64 + nb * 16 + fq * 4;
            const f32x4 g2 = *(const f32x4*)(mod + ci * 6144 + 5120 + n);
#pragma unroll
            for (int mb = 0; mb < 4; ++mb) {
                const int m = row0 + wr * 64 + mb * 16 + fr;
                float* px = p.out + OUT_Y + (size_t)m * D + n;
                *(f32x4*)px = *(const f32x4*)px + g2 * acc[mb][nb];
            }
        }
    }
}

#define XB_TMO      128
#define XB_XCNT(j)  (256  + 64 * (j))
#define XB_XSUB(j)  (1280 + 64 * (j))
#define XB_XGEN(j)  (2304 + 64 * (j))
#define XB_TOP      3328
#define XB_TOPGEN   3392
#define XB_SPIN_CAP (1u << 20)
DI unsigned xb_ld(unsigned* p)              { return __hip_atomic_load(p, __ATOMIC_RELAXED, __HIP_MEMORY_SCOPE_AGENT); }
DI unsigned xb_add(unsigned* p, unsigned v) { return __hip_atomic_fetch_add(p, v, __ATOMIC_RELAXED, __HIP_MEMORY_SCOPE_AGENT); }
DI unsigned xb_xcc_id() { return (unsigned)__builtin_amdgcn_s_getreg((3 << 11) | 20) & 0xFu; }
#define XB_SPIN(cond, bar) do { unsigned _sp = 0; while (cond) { __builtin_amdgcn_s_sleep(1); \
    if ((++_sp & 255u) == 0u) { if (xb_ld(&(bar)[XB_TMO])) break; if (_sp > XB_SPIN_CAP) { atomicAdd(&(bar)[XB_TMO], 1u); break; } } } } while (0)
struct XcdBarrier { unsigned* bar; unsigned x; volatile LAS unsigned* st; };
DI XcdBarrier xcd_barrier_post(unsigned* bar, volatile LAS unsigned* st) {
    XcdBarrier b; b.bar = bar; b.x = xb_xcc_id(); b.st = st;
    if (threadIdx.x == 0) (void)xb_add(&bar[XB_XCNT(b.x)], 1u);
    return b;
}
DI void xcd_barrier_complete(unsigned* bar, unsigned x, unsigned& nloc, unsigned& nx) {
    const unsigned G = gridDim.x * gridDim.y * gridDim.z;
    unsigned sum, cnt, mine, sp = 0u;
    for (;;) {
        sum = 0u; cnt = 0u; mine = 0u;
#pragma unroll
        for (unsigned j = 0; j < 16; ++j) { const unsigned c = xb_ld(&bar[XB_XCNT(j)]); sum += c; cnt += (c > 0u) ? 1u : 0u; mine = (j == x) ? c : mine; }
        if (sum == G) break;
        __builtin_amdgcn_s_sleep(1);
        if ((++sp & 255u) == 0u) { if (xb_ld(&bar[XB_TMO])) break; if (sp > XB_SPIN_CAP) { atomicAdd(&bar[XB_TMO], 1u); break; } }
    }
    nloc = mine > 0u ? mine : 1u; nx = cnt > 0u ? cnt : 1u;
}
DI void xcd_barrier(const XcdBarrier& b) {
    asm volatile("s_waitcnt vmcnt(0)" ::: "memory");
    __syncthreads();
    if (threadIdx.x == 0) {
        unsigned* bar = b.bar;
        __builtin_amdgcn_s_waitcnt(0);
        unsigned nloc = b.st[0], nx = b.st[1];
        if (nloc == 0u) { xcd_barrier_complete(bar, b.x, nloc, nx); b.st[0] = nloc; b.st[1] = nx; }
        const unsigned old = xb_add(&bar[XB_XSUB(b.x)], 1u);
        const unsigned gen = old / nloc;
        if (old + 1u == (gen + 1u) * nloc) {
            __builtin_amdgcn_fence(__ATOMIC_RELEASE, "agent");
            asm volatile("s_waitcnt vmcnt(0)" ::: "memory");
            const unsigned og = xb_add(&bar[XB_TOP], 1u);
            const unsigned tg = og / nx;
            if (og + 1u == (tg + 1u) * nx) xb_add(&bar[XB_TOPGEN], 1u);
            else XB_SPIN(xb_ld(&bar[XB_TOPGEN]) == tg, bar);
            __builtin_amdgcn_fence(__ATOMIC_ACQUIRE, "agent");
            xb_add(&bar[XB_XGEN(b.x)], 1u);
            asm volatile("s_waitcnt vmcnt(0)" ::: "memory");
        } else {
            XB_SPIN(xb_ld(&bar[XB_XGEN(b.x)]) == gen, bar);
            __builtin_amdgcn_fence(__ATOMIC_ACQUIRE, "agent");
            asm volatile("s_waitcnt vmcnt(0)" ::: "memory");
        }
    }
    __syncthreads();
}

constexpr int N_PHASES = 23;
__global__ void __launch_bounds__(NTHR) fwd_kernel(Params p) {
    extern __shared__ __attribute__((aligned(16))) char smem[];
    volatile LAS unsigned* xst = (volatile LAS unsigned*)(smem + LDS_MAIN);
    if (threadIdx.x == 0) { xst[0] = 0u; xst[1] = 0u; }
    __syncthreads();
    const XcdBarrier xb = xcd_barrier_post((unsigned*)(p.ws + OFF_BAR), xst);
    asm volatile("s_nop 0\n\ts_nop 0\n\ts_nop 0\n\ts_nop 0\n\ts_nop 0");
#ifndef PH_MASK
#define PH_MASK 0xffff
#endif
#ifndef REP_MASK
#define REP_MASK 0
#endif
#define RUN_PHASE(ph, bit, call) if (p.ph_lo <= (ph) && (ph) < p.ph_hi) { if ((ph) > p.ph_lo) xcd_barrier(xb); if (PH_MASK & (bit)) { call; if (REP_MASK & (bit)) { call; } } }
    RUN_PHASE(0, 1, phase_prep(p, smem))
    RUN_PHASE(1, 2, phase_norm<1>(p))
    RUN_PHASE(2, 4, phase_p1(p, smem))
    RUN_PHASE(4, 16, phase_mix(p, smem))
    RUN_PHASE(5, 32, phase_post(p, smem))
    RUN_PHASE(6, 64, phase_merge(p, smem))
    RUN_PHASE(7, 128, phase_out(p, smem))
    RUN_PHASE(8, 256, phase_norm<2>(p))
    RUN_PHASE(9, 512, phase_up(p, smem))
    RUN_PHASE(10, 1024, phase_fix(p))
    RUN_PHASE(21, 2048, phase_down(p, smem))
    RUN_PHASE(22, 4096, phase_norm<3>(p))
}

extern "C" void kernel_launch(void* const* d_in, const int* in_sizes, int n_in, void* d_out, int out_size, void* d_ws, size_t ws_size, hipStream_t stream) {
    static int grid = 0;
    if (grid == 0) {
        if (n_in != 32 || ws_size < WS_NEED) { fprintf(stderr, "kernel_launch: unexpected inputs (n_in %d, ws %zu, need %zu)\n", n_in, ws_size, (size_t)WS_NEED); grid = -1; return; }
        int dev = 0, cus = 0, per_cu = 0;
        hipGetDevice(&dev);
        hipDeviceGetAttribute(&cus, hipDeviceAttributeMultiprocessorCount, dev);
        hipFuncSetAttribute((const void*)fwd_kernel, hipFuncAttributeMaxDynamicSharedMemorySize, LDS_BYTES);
        hipOccupancyMaxActiveBlocksPerMultiprocessor(&per_cu, (const void*)fwd_kernel, NTHR, LDS_BYTES);
        if (per_cu < 1) { fprintf(stderr, "kernel_launch: occupancy query says %d blocks per CU\n", per_cu); grid = -1; return; }
        grid = cus;
        grid &= ~7;
    }
    if (grid < 0) return;
    if (hipMemsetAsync((char*)d_ws + OFF_BAR, 0, (XCD_BAR_WORDS + 64) * 4, stream) != hipSuccess) { fprintf(stderr, "kernel_launch: memset failed\n"); return; }
    Params p{};
    const float** pp = (const float**)&p;
    for (int i = 0; i < 32; ++i) pp[i] = (const float*)d_in[i];
    p.out = (float*)d_out; p.ws = (unsigned char*)d_ws;
#if N_LAUNCH_SPLIT
    for (int ph = 0; ph < N_PHASES; ++ph) {
        p.ph_lo = ph; p.ph_hi = ph + 1;
        hipLaunchKernelGGL(fwd_kernel, dim3(grid), dim3(NTHR), LDS_BYTES, stream, p);
    }
#else
    p.ph_lo = 0; p.ph_hi = N_PHASES;
    void* args[] = {&p};
    hipError_t e = hipLaunchCooperativeKernel((const void*)fwd_kernel, dim3(grid), dim3(NTHR), args, LDS_BYTES, stream);
    if (e != hipSuccess) fprintf(stderr, "cooperative launch failed: %s (grid %d)\n", hipGetErrorString(e), grid);
#endif
}
```

```cpp
#include <hip/hip_runtime.h>
#include <hip/hip_cooperative_groups.h>
#include <cstdio>
namespace cg = cooperative_groups;

#define DI __device__ __forceinline__
typedef unsigned short bf16_t;
typedef short bf16x8 __attribute__((ext_vector_type(8)));
typedef short s16x4 __attribute__((ext_vector_type(4)));
typedef float f32x4 __attribute__((ext_vector_type(4)));
typedef float f32x2 __attribute__((ext_vector_type(2)));
typedef float f32x16 __attribute__((ext_vector_type(16)));
typedef unsigned u32x4 __attribute__((ext_vector_type(4)));
typedef unsigned u32x2 __attribute__((ext_vector_type(2)));

#ifndef N_LAUNCH_SPLIT
#define N_LAUNCH_SPLIT 0
#endif

constexpr int NTHR = 512;
constexpr int D = 1024;
constexpr int MC = 8192;
constexpr int ML = 16384;
constexpr int M = MC + ML;
constexpr int WIN = 4736;
constexpr int ZRC = 1920;
constexpr int DFF = 2816;
constexpr int LDS_MAIN = 147456;
constexpr int LDS_BYTES = LDS_MAIN + 16;
constexpr float LOG2E = 1.4426950408889634f;

constexpr size_t al256(size_t x) { return (x + 255) & ~(size_t)255; }
constexpr size_t OFF_WUP   = 0;
constexpr size_t OFF_WDN   = OFF_WUP + al256((size_t)5632 * 1024 * 2);
constexpr size_t OFF_MOD   = OFF_WDN + al256((size_t)1024 * 2816 * 2);
constexpr size_t OFF_ROPE  = OFF_MOD + al256((size_t)9 * 6144 * 4);
constexpr size_t OFF_W2T   = OFF_ROPE + al256((size_t)64 * 16 * 8);
constexpr size_t OFF_A2T   = OFF_W2T + al256((size_t)2 * 512 * 64 * 2);
constexpr size_t OFF_G2T   = OFF_A2T + al256((size_t)2 * 512 * 64 * 2);
constexpr size_t OFF_KC    = OFF_G2T + al256((size_t)512 * 128 * 2);
constexpr size_t OFF_VCT   = OFF_KC + al256((size_t)8 * 512 * 128 * 2);
constexpr size_t OFF_BAR   = OFF_VCT + al256((size_t)8 * 512 * 128 * 2);
constexpr size_t OFF_H     = OFF_BAR + al256((size_t)(3456 + 64) * 4);
constexpr size_t OFF_X     = OFF_H + al256((size_t)M * 1024 * 2);
constexpr size_t OFF_WIN   = OFF_X;
constexpr size_t OFF_WPA   = OFF_WIN + al256((size_t)WIN * 1024 * 2);
constexpr size_t OFF_WPB   = OFF_WPA + al256((size_t)1024 * 512 * 2);
constexpr size_t OFF_WOUT  = OFF_WPB + al256((size_t)1024 * 512 * 2);
constexpr size_t OFF_Q     = OFF_WOUT + al256((size_t)1024 * 1024 * 2);
constexpr size_t OFF_RW    = OFF_Q;
constexpr size_t OFF_KB    = OFF_Q + al256((size_t)M * 512 * 2);
constexpr size_t OFF_VT    = OFF_KB + al256((size_t)M * 128 * 2);
constexpr size_t OFF_ATTN  = OFF_VT + al256((size_t)M * 128 * 2);
constexpr size_t OFF_SG    = OFF_ATTN + al256((size_t)M * 512 * 2);
constexpr size_t OFF_BN    = OFF_SG + al256((size_t)M * 128 * 2);
constexpr size_t OFF_YS    = OFF_BN + al256((size_t)M * 16 * 4);
constexpr size_t OFF_MRG   = OFF_YS;
constexpr size_t END_EARLY = OFF_YS + al256((size_t)2 * M * 512 * 4);
constexpr size_t OFF_ACT   = OFF_X;
constexpr size_t OFF_U     = OFF_ACT + al256((size_t)M * DFF * 2);
constexpr size_t END_FFN   = OFF_U + al256((size_t)96 * 44 * 4 * 128 * 2);
constexpr size_t WS_NEED   = END_EARLY > END_FFN ? END_EARLY : END_FFN;
static_assert(WS_NEED <= (size_t)256 * 1024 * 1024, "workspace over 256 MiB");

constexpr size_t OUT_Y  = 0;
constexpr size_t OUT_K  = (size_t)M * 1024;
constexpr size_t OUT_V  = OUT_K + (size_t)MC * 128;
constexpr size_t OUT_S  = OUT_V + (size_t)MC * 128;

struct Params {
    const float *x_prompt, *x_sample, *c, *cache_k, *cache_v, *state_rwkv, *c_ctx, *w_ada, *b_ada, *g_norm1, *w_in, *attn_sink,
        *w_proj_a, *w_proj_b, *rwkv_mu, *rwkv_w0, *rwkv_w2, *rwkv_a0, *rwkv_a2, *rwkv_k_k, *rwkv_k_a, *rwkv_r_k, *rwkv_g2,
        *rwkv_ln_g, *rwkv_ln_b, *w_out, *g_norm2, *w_ffn_up, *ffn_conv_w, *ffn_conv_b, *w_ffn_down, *g_final;
    float* out;
    unsigned char* ws;
    int ph_lo, ph_hi;
};

#define XCD_BAR_WORDS 3456
#define LAS __attribute__((address_space(3)))
DI bf16_t f2bf(float f) { unsigned u = __float_as_uint(f); u += 0x7fffu + ((u >> 16) & 1u); return (bf16_t)(u >> 16); }
DI float bf2f(unsigned b) { return __uint_as_float(b << 16); }
typedef __bf16 bf16v2_t __attribute__((ext_vector_type(2)));
DI unsigned pack2(float lo, float hi) { f32x2 v; v.x = lo; v.y = hi; return __builtin_bit_cast(unsigned, __builtin_convertvector(v, bf16v2_t)); }
DI u32x2 pack4(f32x4 v) { u32x2 r; r.x = pack2(v[0], v[1]); r.y = pack2(v[2], v[3]); return r; }
DI f32x4 unpack4(u32x2 v) { f32x4 r; r[0] = bf2f(v.x & 0xffffu); r[1] = bf2f(v.x >> 16); r[2] = bf2f(v.y & 0xffffu); r[3] = bf2f(v.y >> 16); return r; }
DI float rcpf_(float x) { return __builtin_amdgcn_rcpf(x); }
DI float sigmoidf_(float x) { return rcpf_(1.0f + __expf(-x)); }
DI const float* xrow(const Params& p, int r) { return r < MC ? p.x_prompt + (size_t)r * D : p.x_sample + (size_t)(r - MC) * D; }
DI int cond_of(int r) { return r < MC ? 0 : 1 + ((r - MC) >> 11); }
DI void seq_of(int r, int& r0, int& T) { if (r < MC) { r0 = r & ~255; T = 256; } else { r0 = MC + ((r - MC) & ~2047); T = 2048; } }
DI float wave_sum(float v) {
#pragma unroll
    for (int o = 32; o >= 1; o >>= 1) v += __shfl_xor(v, o);
    return v;
}

DI void transpose_tile(const float* __restrict__ src, int K, int N, bf16_t* __restrict__ dst, int kt, int nt, float* tile, int tid) {
    const int k0 = kt * 64, n0 = nt * 64;
#pragma unroll
    for (int i = 0; i < 8; ++i) { const int k = (tid >> 6) + 8 * i, n = tid & 63; tile[k * 65 + n] = src[(size_t)(k0 + k) * N + n0 + n]; }
    __syncthreads();
#pragma unroll
    for (int i = 0; i < 8; ++i) { const int n = (tid >> 6) + 8 * i, k = tid & 63; dst[(size_t)(n0 + n) * K + k0 + k] = f2bf(tile[k * 65 + n]); }
    __syncthreads();
}

DI void phase_prep(const Params& p, char* smem) {
    const int tid = threadIdx.x, nb = gridDim.x, bid = blockIdx.x;
    unsigned char* ws = p.ws;
    {
        float* tile = (float*)smem;
        const int cnt[11] = {16 * 74, 8 * 16, 8 * 16, 16 * 16, 16 * 88, 44 * 16, 8, 8, 8, 8, 16};
        int total = 0;
#pragma unroll
        for (int i = 0; i < 11; ++i) total += cnt[i];
        for (int it = bid; it < total; it += nb) {
            int i = it, mi = 0;
#pragma unroll
            for (int q = 0; q < 10; ++q) { if (mi == q && i >= cnt[q]) { i -= cnt[q]; mi = q + 1; } }
            const float* src; bf16_t* dst; int K, N;
            switch (mi) {
                case 0: src = p.w_in; K = 1024; N = WIN; dst = (bf16_t*)(ws + OFF_WIN); break;
                case 1: src = p.w_proj_a; K = 512; N = 1024; dst = (bf16_t*)(ws + OFF_WPA); break;
                case 2: src = p.w_proj_b; K = 512; N = 1024; dst = (bf16_t*)(ws + OFF_WPB); break;
                case 3: src = p.w_out; K = 1024; N = 1024; dst = (bf16_t*)(ws + OFF_WOUT); break;
                case 4: src = p.w_ffn_up; K = 1024; N = 5632; dst = (bf16_t*)(ws + OFF_WUP); break;
                case 5: src = p.w_ffn_down; K = 2816; N = 1024; dst = (bf16_t*)(ws + OFF_WDN); break;
                case 6: src = p.rwkv_w2; K = 64; N = 512; dst = (bf16_t*)(ws + OFF_W2T); break;
                case 7: src = p.rwkv_w2 + 64 * 512; K = 64; N = 512; dst = (bf16_t*)(ws + OFF_W2T) + 512 * 64; break;
                case 8: src = p.rwkv_a2; K = 64; N = 512; dst = (bf16_t*)(ws + OFF_A2T); break;
                case 9: src = p.rwkv_a2 + 64 * 512; K = 64; N = 512; dst = (bf16_t*)(ws + OFF_A2T) + 512 * 64; break;
                default: src = p.rwkv_g2; K = 128; N = 512; dst = (bf16_t*)(ws + OFF_G2T); break;
            }
            const int ntn = N / 64;
            transpose_tile(src, K, N, dst, i / ntn, i % ntn, tile, tid);
        }
    }
    {
        bf16_t* kc = (bf16_t*)(ws + OFF_KC); bf16_t* vct = (bf16_t*)(ws + OFF_VCT);
        for (int i = bid * NTHR + tid; i < 8 * 512 * 128; i += nb * NTHR) {
            kc[i] = f2bf(p.cache_k[i]);
            const int key = i & 511, d = (i >> 9) & 63, kvh = (i >> 15) & 1, b = i >> 16;
            vct[i] = f2bf(p.cache_v[((size_t)(b * 512 + key) * 2 + kvh) * 64 + d]);
        }
    }
    {
        f32x2* tab = (f32x2*)(ws + OFF_ROPE);
        for (int i = bid * NTHR + tid; i < 1024; i += nb * NTHR) {
            const int pos = i >> 4, fi = i & 15;
            const double fr = pow(10000.0, -(double)fi / 16.0), ang = (double)pos * fr;
            f32x2 v; v.x = (float)cos(ang); v.y = (float)sin(ang); tab[i] = v;
        }
    }
    {
        float* s = (float*)smem;
        float* red = (float*)(smem + 36864);
        float* mod = (float*)(ws + OFF_MOD);
        for (int it = bid; it < 96; it += nb) {
            __syncthreads();
            for (int i = tid; i < 9 * 1024; i += NTHR) {
                const int ci = i >> 10, k = i & 1023;
                const float v = ci == 0 ? p.c_ctx[k] : p.c[(ci - 1) * 1024 + k];
                s[i] = v / (1.0f + __expf(-v));
            }
            __syncthreads();
            const int n = tid & 63, kq = tid >> 6, n0 = it * 64;
            float acc[9];
#pragma unroll
            for (int ci = 0; ci < 9; ++ci) acc[ci] = 0.f;
            for (int k = kq * 128; k < kq * 128 + 128; ++k) {
                const float w = p.w_ada[(size_t)k * 6144 + n0 + n];
#pragma unroll
                for (int ci = 0; ci < 9; ++ci) acc[ci] += s[ci * 1024 + k] * w;
            }
#pragma unroll
            for (int ci = 0; ci < 9; ++ci) red[(kq * 9 + ci) * 64 + n] = acc[ci];
            __syncthreads();
            for (int i = tid; i < 9 * 64; i += NTHR) {
                const int ci = i >> 6, nn = i & 63;
                float v = p.b_ada[n0 + nn];
#pragma unroll
                for (int q = 0; q < 8; ++q) v += red[(q * 9 + ci) * 64 + nn];
                mod[ci * 6144 + n0 + nn] = v;
            }
        }
        __syncthreads();
    }
}

template <int WHICH> DI void phase_norm(const Params& p) {
    const int tid = threadIdx.x, lane = tid & 63, wv = tid >> 6;
    const float* mod = (const float*)(p.ws + OFF_MOD);
    bf16_t* hb = (bf16_t*)(p.ws + OFF_H);
    const int ntask = M / 8;
    for (int task = blockIdx.x * 8 + wv; task < ntask; task += gridDim.x * 8) {
        const int r_first = task * 8, ci = cond_of(r_first);
        f32x4 fa[4], fb[4];
#pragma unroll
        for (int i = 0; i < 4; ++i) {
            const int col = i * 256 + lane * 4;
            if (WHICH == 3) { fa[i] = *(const f32x4*)(p.g_final + col); fb[i] = (f32x4){0.f, 0.f, 0.f, 0.f}; }
            else {
                const f32x4 g = *(const f32x4*)((WHICH == 1 ? p.g_norm1 : p.g_norm2) + col);
                const f32x4 sc = *(const f32x4*)(mod + ci * 6144 + (WHICH == 1 ? 1024 : 4096) + col);
                fb[i] = *(const f32x4*)(mod + ci * 6144 + (WHICH == 1 ? 0 : 3072) + col);
                fa[i] = g * (sc + 1.0f);
            }
        }
        for (int rr = 0; rr < 8; ++rr) {
            const int r = r_first + rr;
            const float* src = WHICH == 1 ? xrow(p, r) : p.out + OUT_Y + (size_t)r * D;
            f32x4 v[4]; float ss = 0.f;
#pragma unroll
            for (int i = 0; i < 4; ++i) { v[i] = *(const f32x4*)(src + i * 256 + lane * 4); ss += v[i][0] * v[i][0] + v[i][1] * v[i][1] + v[i][2] * v[i][2] + v[i][3] * v[i][3]; }
            ss = wave_sum(ss);
            const float rstd = __builtin_amdgcn_rsqf(ss * (1.0f / 1024.0f) + 1e-6f);
#pragma unroll
            for (int i = 0; i < 4; ++i) {
                const f32x4 o = v[i] * rstd * fa[i] + fb[i];
                if (WHICH == 3) *(f32x4*)(p.out + OUT_Y + (size_t)r * D + i * 256 + lane * 4) = o;
                else *(u32x2*)(hb + (size_t)r * D + i * 256 + lane * 4) = pack4(o);
            }
        }
    }
}

template <int NB, int BMAP> DI void gemm_stage(const bf16_t* A, int lda, const bf16_t* Bt, int ldb, int k0, char* sbuf, int tid) {
#pragma unroll
    for (int i = 0; i < 4; ++i) {
        const int c = tid + i * 512, row = c >> 3, pos = c & 7, kc = pos ^ ((row >> 1) & 7);
        __builtin_amdgcn_global_load_lds((const unsigned*)(A + (size_t)row * lda + k0 + kc * 8), (unsigned*)(sbuf + c * 16), 16, 0, 0);
    }
#pragma unroll
    for (int i = 0; i < NB / 2; ++i) {
        const int c = tid + i * 512, row = c >> 3, pos = c & 7, kc = pos ^ ((row >> 1) & 7);
        const int brow = BMAP ? (((row >> 5) & 1) * BMAP + (row >> 6) * 32 + (row & 31)) : row;
        __builtin_amdgcn_global_load_lds((const unsigned*)(Bt + (size_t)brow * ldb + k0 + kc * 8), (unsigned*)(sbuf + 32768 + c * 16), 16, 0, 0);
    }
}
template <int NB, int BMAP = 0> DI void gemm_acc(f32x4 (&acc)[4][NB], const bf16_t* A, int lda, const bf16_t* Bt, int ldb, int K, char* smem, int tid) {
    const int wid = tid >> 6, lane = tid & 63, fr = lane & 15, fq = lane >> 4, wr = wid >> 1, wc = wid & 1;
    const int swz = (fr >> 1) & 7;
    const int nk = K >> 6;
    __syncthreads();
    gemm_stage<NB, BMAP>(A, lda, Bt, ldb, 0, smem, tid);
    if (nk > 1) gemm_stage<NB, BMAP>(A, lda, Bt, ldb, 64, smem + 49152, tid);
    int cur = 0;
#pragma unroll 1
    for (int t = 0; t < nk; ++t) {
        if (t + 1 < nk) { if (NB == 4) asm volatile("s_waitcnt vmcnt(6)" ::: "memory"); else asm volatile("s_waitcnt vmcnt(5)" ::: "memory"); }
        else asm volatile("s_waitcnt vmcnt(0)" ::: "memory");
        __builtin_amdgcn_s_barrier();
        asm volatile("" ::: "memory");
        const int nxt2 = cur >= 1 ? cur - 1 : 2;
        const bool late = __builtin_amdgcn_readfirstlane(wid) >= 4;
        if (t + 2 < nk && !late) gemm_stage<NB, BMAP>(A, lda, Bt, ldb, (t + 2) * 64, smem + nxt2 * 49152, tid);
        const char* sA = smem + cur * 49152;
        const char* sB = sA + 32768;
#pragma unroll
        for (int ks = 0; ks < 2; ++ks) {
            if (ks == 1 && t + 2 < nk && late) gemm_stage<NB, BMAP>(A, lda, Bt, ldb, (t + 2) * 64, smem + nxt2 * 49152, tid);
            bf16x8 af[4], bfr[NB];
            const int coff = ((ks * 4 + fq) ^ swz) << 4;
#pragma unroll
            for (int mb = 0; mb < 4; ++mb) af[mb] = *(const bf16x8*)(sA + (wr * 64 + mb * 16 + fr) * 128 + coff);
#pragma unroll
            for (int nb = 0; nb < NB; ++nb) bfr[nb] = *(const bf16x8*)(sB + (wc * 16 * NB + nb * 16 + fr) * 128 + coff);
            __builtin_amdgcn_s_setprio(1);
#pragma unroll
            for (int mb = 0; mb < 4; ++mb)
#pragma unroll
                for (int nb = 0; nb < NB; ++nb) acc[mb][nb] = __builtin_amdgcn_mfma_f32_16x16x32_bf16(bfr[nb], af[mb], acc[mb][nb], 0, 0, 0);
            __builtin_amdgcn_s_setprio(0);
        }
        cur = cur == 2 ? 0 : cur + 1;
    }
}
template <int BMAP> DI void gemm_stage8(const bf16_t* A, int lda, const bf16_t* Bt, int ldb, int k0, char* sbuf, int tid) {
    const int r0 = tid >> 3, kcs = (tid & 7) ^ ((r0 >> 1) & 7);
    const unsigned offA = (unsigned)(r0 * lda + kcs * 8), offB = (unsigned)(r0 * ldb + kcs * 8);
    char* dst = sbuf + tid * 16;
#pragma unroll
    for (int i = 0; i < 4; ++i)
        __builtin_amdgcn_global_load_lds((const unsigned*)(A + (size_t)(64 * i) * lda + k0 + offA), (unsigned*)(dst + i * 8192), 16, 0, 0);
#pragma unroll
    for (int i = 0; i < 4; ++i) {
        const int urow = BMAP ? (i & 1) * BMAP + (i >> 1) * 64 : 64 * i;
        __builtin_amdgcn_global_load_lds((const unsigned*)(Bt + (size_t)urow * ldb + k0 + offB), (unsigned*)(dst + 32768 + i * 8192), 16, 0, 0);
    }
}
template <int BMAP> DI void gemm_acc8(f32x4 (&acc)[4][8], const bf16_t* A, int lda, const bf16_t* Bt, int ldb, int K, char* smem, int tid) {
    const int wid = tid >> 6, lane = tid & 63, fr = lane & 15, fq = lane >> 4, wr = wid >> 1, wc = wid & 1;
    const int swz = (fr >> 1) & 7;
    const int nk = K >> 6;
    __syncthreads();
    gemm_stage8<BMAP>(A, lda, Bt, ldb, 0, smem, tid);
    const bool late = __builtin_amdgcn_readfirstlane(wid) >= 4;
#pragma unroll 1
    for (int t = 0; t < nk; ++t) {
        asm volatile("s_waitcnt vmcnt(0)" ::: "memory");
        __builtin_amdgcn_s_barrier();
        asm volatile("" ::: "memory");
        char* sN = smem + ((t + 1) & 1) * 65536;
        if (t + 1 < nk && !late) gemm_stage8<BMAP>(A, lda, Bt, ldb, (t + 1) * 64, sN, tid);
        const char* sA = smem + (t & 1) * 65536;
        const char* sB = sA + 32768;
#pragma unroll
        for (int ks = 0; ks < 2; ++ks) {
            if (ks == 1 && t + 1 < nk && late) gemm_stage8<BMAP>(A, lda, Bt, ldb, (t + 1) * 64, sN, tid);
            bf16x8 af[4], bfr[8];
            const int coff = ((ks * 4 + fq) ^ swz) << 4;
#pragma unroll
            for (int mb = 0; mb < 4; ++mb) af[mb] = *(const bf16x8*)(sA + (wr * 64 + mb * 16 + fr) * 128 + coff);
#pragma unroll
            for (int nb = 0; nb < 8; ++nb) bfr[nb] = *(const bf16x8*)(sB + (wc * 128 + nb * 16 + fr) * 128 + coff);
            __builtin_amdgcn_s_setprio(1);
#pragma unroll
            for (int mb = 0; mb < 4; ++mb)
#pragma unroll
                for (int nb = 0; nb < 8; ++nb) acc[mb][nb] = __builtin_amdgcn_mfma_f32_16x16x32_bf16(bfr[nb], af[mb], acc[mb][nb], 0, 0, 0);
            __builtin_amdgcn_s_setprio(0);
        }
    }
}
template <int NB> DI void zero_acc(f32x4 (&acc)[4][NB]) {
#pragma unroll
    for (int a = 0; a < 4; ++a)
#pragma unroll
        for (int b = 0; b < NB; ++b) acc[a][b] = (f32x4){0.f, 0.f, 0.f, 0.f};
}
DI void tile_coords(int t, int MT, int NT, int& mt, int& nt) {
    const int x = t & 7, u = t >> 3, mpx = MT >> 3;
    const int bm = (mpx % 4 == 0) ? 4 : ((mpx % 2 == 0) ? 2 : 1);
    const int per_band = bm * NT, band = u / per_band, rem = u - band * per_band;
    nt = rem / bm; mt = x * mpx + band * bm + (rem % bm);
}


namespace pg8 {
#define PG8_LAS __attribute__((address_space(3)))
constexpr int BM = 256, BK = 64, HALF = 128, HTB = HALF * BK * 2  , STAGE_BYTES = 8 * HTB, NXCD = 8, WGM = 8;
__host__ __device__ __forceinline__ int lds_byte(int r, int c) { const int st = (r >> 4) * 2 + (c >> 5), rr = r & 15, cc = c & 31, ob = rr * 64 + cc * 2; return st * 1024 + (ob ^ (((ob >> 9) & 1) << 5)); }
__host__ __device__ __forceinline__ void stage_rc(int b, int& R, int& C) { const int st = b / 1024, sb = b % 1024, swz = sb ^ (((sb >> 9) & 1) << 5); R = (st >> 1) * 16 + swz / 64; C = (st & 1) * 32 + (swz % 64) / 2; }
__host__ __device__ __forceinline__ int perm32(int rho) { const int n = rho >> 4, i = rho & 15; return 8 * (i >> 2) + 4 * n + (i & 3); }


struct Unit { int pm, pn, brow; };
struct Gemm8 { const bf16_t* A; const bf16_t* Bt; int K; int bhalf; };
__device__ __forceinline__ void unit_of(int L, int nM, int nN, int& pm, int& pn) {
    const int nwg = nM * nN;
    int wgid = L; { const int q = nwg / NXCD, r = nwg % NXCD, xcd = wgid % NXCD, off = wgid / NXCD; wgid = (xcd < r ? xcd * (q + 1) : r * (q + 1) + (xcd - r) * q) + off; }
    const int nig = WGM * nN, gid = wgid / nig, fm = gid * WGM, gsz = (nM - fm) < WGM ? (nM - fm) : WGM;
    pm = fm + ((wgid % nig) % gsz); pn = (wgid % nig) / gsz;
}
struct Order8 {
    int nM, nN, nlim, G, c, p1map;
    __device__ __forceinline__ bool next(int i, Unit& u) const {
        const long L = (long)i * G + c; if (L >= nlim) return false;
        unit_of((int)L, nM, nN, u.pm, u.pn); u.brow = p1map ? (u.pn < 3 ? u.pn * 256 : 2816 + (u.pn - 3) * 256) : u.pn * 256; return true;
    }
    __device__ __forceinline__ void a_ready(const Unit&) const {}
    __device__ __forceinline__ void done(const Unit&) const {}
};
template <class Epi, class Sched>
__device__ __forceinline__ void gemm8(PG8_LAS unsigned char* lds, const Gemm8 g, const Sched& S, const Epi& E) {
    const int tid = threadIdx.x, wid = __builtin_amdgcn_readfirstlane(tid >> 6), lane = tid & 63, wr = wid >> 2, wc = wid & 3, fr = lane & 15, fq = lane >> 4;
    const int K = g.K, nt = K / BK;
    unsigned voffA[2], voffB[2];
#pragma unroll
    for (int i = 0; i < 2; ++i) { int R, C; stage_rc(tid * 16 + i * 8192, R, C); const int Rb = Epi::PERM ? ((R & ~31) + perm32(R & 31)) : R;
        voffA[i] = (unsigned)(R * K + C) * 2u; voffB[i] = (unsigned)(Rb * K + C) * 2u; }
    const size_t kstep = (size_t)(BK * 2);
    const size_t hstep = (size_t)HALF * K * 2;
    const size_t tstep = 2 * hstep;
    const size_t hstepB = (size_t)g.bhalf * K * 2;
    const size_t rowB = (size_t)K * 2;
    const unsigned ldsw = (unsigned)wid * 1024u;
    const int aoff = lds_byte(wr * 64 + fr, fq * 8), boff = lds_byte(wc * 32 + fr, fq * 8);
#define PG8_SA(b, h) (((b) * 2 + (h)) * HTB)
#define PG8_SB(b, h) ((4 + (b) * 2 + (h)) * HTB)
#define PG8_STAGE(bufoff, gbase, voff) do { _Pragma("unroll") for (int _i = 0; _i < 2; ++_i) \
        __builtin_amdgcn_global_load_lds((const unsigned*)((const char*)(gbase) + (voff)[_i]), (PG8_LAS unsigned*)(lds + (bufoff) + ldsw + _i * 8192), 16, 0, 0); } while (0)
#define PG8_LDA(dst, b, h) do { _Pragma("unroll") for (int m = 0; m < 4; ++m) _Pragma("unroll") for (int k = 0; k < 2; ++k) dst[m][k] = *(const PG8_LAS bf16x8*)(lds + PG8_SA(b, h) + aoff + m * 2048 + k * 1024); } while (0)
#define PG8_LDB(dst, b, h) do { _Pragma("unroll") for (int n = 0; n < 2; ++n) _Pragma("unroll") for (int k = 0; k < 2; ++k) dst[n][k] = *(const PG8_LAS bf16x8*)(lds + PG8_SB(b, h) + boff + n * 2048 + k * 1024); } while (0)
#define PG8_MMA(ai, bj, At, Bt) do { __builtin_amdgcn_s_setprio(1); _Pragma("unroll") for (int m = 0; m < 4; ++m) _Pragma("unroll") for (int n = 0; n < 2; ++n) _Pragma("unroll") for (int k = 0; k < 2; ++k) \
        acc[ai][bj][m][n] = __builtin_amdgcn_mfma_f32_16x16x32_bf16(Bt[n][k], At[m][k], acc[ai][bj][m][n], 0, 0, 0); __builtin_amdgcn_s_setprio(0); } while (0)
#define PG8_WAIT_V(n) asm volatile("s_waitcnt vmcnt(" #n ")" ::: "memory")
#define PG8_WAIT_L(n) asm volatile("s_waitcnt lgkmcnt(" #n ")" ::: "memory")
#define PG8_BAR __builtin_amdgcn_s_barrier()
#define PG8_SCHED __builtin_amdgcn_sched_barrier(0)
    Unit cur, nxt; int ui = 0;
    if (!S.next(0, cur)) return;
    f32x4 acc[2][2][4][2];
#pragma unroll
    for (int a = 0; a < 2; ++a)
#pragma unroll
        for (int b = 0; b < 2; ++b)
#pragma unroll
            for (int m = 0; m < 4; ++m)
#pragma unroll
                for (int n = 0; n < 2; ++n) acc[a][b][m][n] = (f32x4){0.f, 0.f, 0.f, 0.f};
    bf16x8 At[4][2], B0[2][2], B1[2][2];
    const char* cA = (const char*)g.A + (size_t)cur.pm * tstep; const char* cB = (const char*)g.Bt + (size_t)cur.brow * rowB;
    S.a_ready(cur);
    PG8_STAGE(PG8_SB(0, 0), cB, voffB); PG8_STAGE(PG8_SA(0, 0), cA, voffA); PG8_STAGE(PG8_SB(0, 1), cB + hstepB, voffB); PG8_STAGE(PG8_SA(0, 1), cA + hstep, voffA);
    if (wr == 1) PG8_BAR;
    PG8_WAIT_V(4); PG8_BAR;
    PG8_STAGE(PG8_SB(1, 0), cB + kstep, voffB); PG8_STAGE(PG8_SA(1, 0), cA + kstep, voffA); PG8_STAGE(PG8_SB(1, 1), cB + hstepB + kstep, voffB);
    PG8_WAIT_V(6); PG8_BAR;
    for (;;) {
        const bool has_next = S.next(ui + 1, nxt);
        const char* nA = has_next ? (const char*)g.A + (size_t)nxt.pm * tstep : cA; const char* nB = has_next ? (const char*)g.Bt + (size_t)nxt.brow * rowB : cB;
        for (int t = 0; t < nt; t += 2) {
            const bool last = (t == nt - 2);
            const char* a1 = cA + (size_t)(t + 1) * kstep;
            const char* a2 = last ? nA : cA + (size_t)(t + 2) * kstep; const char* b2 = last ? nB : cB + (size_t)(t + 2) * kstep;
            const char* a3 = a2 + kstep; const char* b3 = b2 + kstep;
            if (last && has_next) S.a_ready(nxt);
            PG8_LDB(B0, 0, 0); PG8_SCHED; PG8_LDA(At, 0, 0); PG8_STAGE(PG8_SA(1, 1), a1 + hstep, voffA);
            PG8_WAIT_L(8); PG8_BAR; PG8_WAIT_L(0); PG8_MMA(0, 0, At, B0); PG8_BAR; PG8_SCHED;
            PG8_LDB(B1, 0, 1); PG8_STAGE(PG8_SB(0, 0), b2, voffB);
            PG8_BAR; PG8_WAIT_L(0); PG8_MMA(0, 1, At, B1); PG8_BAR;
            PG8_LDA(At, 0, 1); PG8_STAGE(PG8_SA(0, 0), a2, voffA);
            PG8_BAR; PG8_WAIT_L(0); PG8_MMA(1, 0, At, B0); PG8_BAR; PG8_SCHED;
            PG8_STAGE(PG8_SB(0, 1), b2 + hstepB, voffB);
            PG8_WAIT_V(6); PG8_BAR; PG8_MMA(1, 1, At, B1); PG8_BAR;
            PG8_LDB(B0, 1, 0); PG8_SCHED; PG8_LDA(At, 1, 0); PG8_STAGE(PG8_SA(0, 1), a2 + hstep, voffA);
            PG8_WAIT_L(8); PG8_BAR; PG8_WAIT_L(0); PG8_MMA(0, 0, At, B0); PG8_BAR; PG8_SCHED;
            PG8_LDB(B1, 1, 1); PG8_STAGE(PG8_SB(1, 0), b3, voffB);
            PG8_BAR; PG8_WAIT_L(0); PG8_MMA(0, 1, At, B1); PG8_BAR;
            PG8_LDA(At, 1, 1); PG8_STAGE(PG8_SA(1, 0), a3, voffA);
            PG8_BAR; PG8_WAIT_L(0); PG8_MMA(1, 0, At, B0); PG8_BAR; PG8_SCHED;
            PG8_STAGE(PG8_SB(1, 1), b3 + hstepB, voffB);
            PG8_WAIT_V(6); PG8_BAR; PG8_MMA(1, 1, At, B1); PG8_BAR;
        }
        if constexpr (!Epi::AFTER_DRAIN) { E(acc, cur, wr, wc, fr, fq); S.done(cur); }
        if (!has_next) break;
#pragma unroll
        for (int a = 0; a < 2; ++a)
#pragma unroll
            for (int b = 0; b < 2; ++b)
#pragma unroll
                for (int m = 0; m < 4; ++m)
#pragma unroll
                    for (int n = 0; n < 2; ++n) acc[a][b][m][n] = (f32x4){0.f, 0.f, 0.f, 0.f};
        cur = nxt; cA = nA; cB = nB; ++ui;
    }
    PG8_WAIT_V(0);
    if (wr == 0) PG8_BAR;
    PG8_BAR;
    if constexpr (Epi::AFTER_DRAIN) { E.fused(acc, cur, wr, wc, fr, fq, lds, wid, lane); S.done(cur); }
#undef PG8_SA
#undef PG8_SB
#undef PG8_STAGE
#undef PG8_LDA
#undef PG8_LDB
#undef PG8_MMA
#undef PG8_WAIT_V
#undef PG8_WAIT_L
#undef PG8_BAR
#undef PG8_SCHED
}

}

DI void p1_tile(const Params& p, char* smem, int mt, int nt) {
    const int tid = threadIdx.x, wid = tid >> 6, lane = tid & 63, fr = lane & 15, fq = lane >> 4, wr = wid >> 1, wc = wid & 1;
    unsigned char* ws = p.ws;
    const bf16_t* hb = (const bf16_t*)(ws + OFF_H);
    const bf16_t* wt = (const bf16_t*)(ws + OFF_WIN);
    const f32x2* tab = (const f32x2*)(ws + OFF_ROPE);
    bf16_t* qb = (bf16_t*)(ws + OFF_Q); bf16_t* kb = (bf16_t*)(ws + OFF_KB); bf16_t* vT = (bf16_t*)(ws + OFF_VT);
    bf16_t* zr = (bf16_t*)(p.out + OUT_Y);
    {
        const int row0 = mt * 256, ncol0 = nt < 6 ? nt * 128 : 2816 + (nt - 6) * 128;
        f32x4 acc[4][4]; zero_acc<4>(acc);
        gemm_acc<4>(acc, hb + (size_t)row0 * 1024, 1024, wt + (size_t)ncol0 * 1024, 1024, 1024, smem, tid);
        const bool latent = row0 >= MC;
#pragma unroll
        for (int mb = 0; mb < 4; ++mb) {
            const int m = row0 + wr * 64 + mb * 16 + fr;
            if (nt < 5 && latent) {
                const int tt = (m - MC) & 2047, prow = tt >> 6, pcol = tt & 63;
#pragma unroll
                for (int j = 0; j < 4; ++j) {
                    const f32x2 cr = tab[prow * 16 + fq * 4 + j], cc = tab[pcol * 16 + fq * 4 + j];
                    const float a1 = acc[mb][0][j], a2 = acc[mb][1][j], b1 = acc[mb][2][j], b2 = acc[mb][3][j];
                    acc[mb][0][j] = a1 * cr.x - a2 * cr.y; acc[mb][1][j] = a2 * cr.x + a1 * cr.y;
                    acc[mb][2][j] = b1 * cc.x - b2 * cc.y; acc[mb][3][j] = b2 * cc.x + b1 * cc.y;
                }
            }
#pragma unroll
            for (int nb = 0; nb < 4; ++nb) {
                const int nl = wc * 64 + nb * 16 + fq * 4;
                const f32x4 v = acc[mb][nb];
                if (nt < 4) { *(u32x2*)(qb + (size_t)m * 512 + nt * 128 + nl) = pack4(v); }
                else if (nt == 4) {
                    if (!latent) *(f32x4*)(p.out + OUT_K + (size_t)m * 128 + nl) = v;
                    *(u32x2*)(kb + (size_t)m * 128 + nl) = pack4(v);
                } else if (nt == 5) {
                    if (!latent) *(f32x4*)(p.out + OUT_V + (size_t)m * 128 + nl) = v;
                    int r0, T; seq_of(m, r0, T);
#pragma unroll
                    for (int j = 0; j < 4; ++j) vT[(size_t)r0 * 128 + (size_t)(nl + j) * T + (m - r0)] = f2bf(v[j]);
                } else { *(u32x2*)(zr + (size_t)m * ZRC + (nt - 6) * 128 + nl) = pack4(v); }
            }
        }
    }
}
struct EpiP1 {
    static constexpr bool PERM = false, AFTER_DRAIN = false;
    float* out; bf16_t *qb, *kb, *vT, *zr; const f32x2* tab;
    __device__ __forceinline__ void operator()(const f32x4 (&acc)[2][2][4][2], const pg8::Unit& u, int wr, int wc, int fr, int fq) const {
        const bool latent = u.pm * 256 >= MC;
        int r0, T; seq_of(u.pm * 256, r0, T);
#pragma unroll
        for (int ai = 0; ai < 2; ++ai)
#pragma unroll
            for (int m = 0; m < 4; ++m) {
                const int row = u.pm * 256 + ai * 128 + wr * 64 + m * 16 + fr;
                const int tt = (row - MC) & 2047, pos = (wc & 1) ? (tt & 63) : (tt >> 6);
#pragma unroll
                for (int bj = 0; bj < 2; ++bj) {
                    f32x4 v0 = acc[ai][bj][m][0], v1 = acc[ai][bj][m][1];
                    const int col = bj * 128 + wc * 32 + fq * 4;
                    if (latent && (u.pn < 2 || (u.pn == 2 && bj == 0))) {
#pragma unroll
                        for (int j = 0; j < 4; ++j) {
                            const f32x2 cs = tab[pos * 16 + fq * 4 + j];
                            const float a1 = v0[j], a2 = v1[j];
                            v0[j] = a1 * cs.x - a2 * cs.y; v1[j] = a2 * cs.x + a1 * cs.y;
                        }
                    }
                    if (u.pn < 2) {
                        *(u32x2*)(qb + (size_t)row * 512 + u.pn * 256 + col) = pack4(v0); *(u32x2*)(qb + (size_t)row * 512 + u.pn * 256 + col + 16) = pack4(v1);
                    } else if (u.pn == 2 && bj == 0) {
                        const int c = wc * 32 + fq * 4;
                        if (!latent) { *(f32x4*)(out + OUT_K + (size_t)row * 128 + c) = v0; *(f32x4*)(out + OUT_K + (size_t)row * 128 + c + 16) = v1; }
                        *(u32x2*)(kb + (size_t)row * 128 + c) = pack4(v0); *(u32x2*)(kb + (size_t)row * 128 + c + 16) = pack4(v1);
                    } else if (u.pn == 2) {
                        const int c = wc * 32 + fq * 4;
                        if (!latent) { *(f32x4*)(out + OUT_V + (size_t)row * 128 + c) = v0; *(f32x4*)(out + OUT_V + (size_t)row * 128 + c + 16) = v1; }
#pragma unroll
                        for (int j = 0; j < 4; ++j) {
                            vT[(size_t)r0 * 128 + (size_t)(c + j) * T + (row - r0)] = f2bf(v0[j]);
                            vT[(size_t)r0 * 128 + (size_t)(c + 16 + j) * T + (row - r0)] = f2bf(v1[j]);
                        }
                    } else {
                        const int c = (u.pn - 3) * 256 + col;
                        *(u32x2*)(zr + (size_t)row * ZRC + c) = pack4(v0); *(u32x2*)(zr + (size_t)row * ZRC + c + 16) = pack4(v1);
                    }
                }
            }
    }
};
DI void phase_p1(const Params& p, char* smem) {
    unsigned char* ws = p.ws;
    const int nM = M / 256, nN = 10, G = gridDim.x, nfirst = ((nM * nN) / G) * G;
    {
        const pg8::Gemm8 g = {(const bf16_t*)(ws + OFF_H), (const bf16_t*)(ws + OFF_WIN), 1024, 128};
        const pg8::Order8 ord = {nM, nN, nfirst, G, (int)blockIdx.x, 1};
        const EpiP1 epi = {p.out, (bf16_t*)(ws + OFF_Q), (bf16_t*)(ws + OFF_KB), (bf16_t*)(ws + OFF_VT), (bf16_t*)(p.out + OUT_Y), (const f32x2*)(ws + OFF_ROPE)};
        pg8::gemm8((LAS unsigned char*)smem, g, ord, epi);
    }
    const int nrest = 2 * (nM * nN - nfirst);
    for (int t = blockIdx.x; t < nrest + nM; t += G) {
        if (t < nrest) {
            int pm, pn; pg8::unit_of(nfirst + (t >> 1), nM, nN, pm, pn);
            p1_tile(p, smem, pm, (pn < 3 ? 2 * pn : 6 + 2 * (pn - 3)) + (t & 1));
        } else p1_tile(p, smem, t - nrest, 20);
    }
}

#define MFMA32(a, b, c) __builtin_amdgcn_mfma_f32_32x32x16_bf16((a), (b), (c), 0, 0, 0)
DI int crow(int i, int h) { return (i & 3) + 8 * (i >> 2) + 4 * h; }

DI void attn_item(const Params& p, char* smem, int it) {
    const int tid = threadIdx.x, wv = tid >> 6, lane = tid & 63, r = lane & 31, hh = lane >> 5;
    unsigned char* ws = p.ws;
    const bf16_t* qb = (const bf16_t*)(ws + OFF_Q); const bf16_t* kb = (const bf16_t*)(ws + OFF_KB); const bf16_t* vT = (const bf16_t*)(ws + OFF_VT);
    const bf16_t* kc = (const bf16_t*)(ws + OFF_KC); const bf16_t* vct = (const bf16_t*)(ws + OFF_VCT);
    bf16_t* ab = (bf16_t*)(ws + OFF_ATTN);
    bf16_t* Ks = (bf16_t*)smem;
    bf16_t* Vt = (bf16_t*)(smem + 9216);
    const float SC = 0.125f * LOG2E;
    {
        int r0, T, q0, kvh, bl;
        const bool lat = it < 512;
        if (lat) { bl = it >> 6; const int rem = it & 63; q0 = (rem >> 1) * 64; kvh = rem & 1; r0 = MC + bl * 2048; T = 2048; }
        else { const int i2 = it - 512; bl = 0; const int s = i2 >> 3, rem = i2 & 7; q0 = (rem >> 1) * 64; kvh = rem & 1; r0 = s * 256; T = 256; }
        const int head = kvh * 4 + (wv & 3), sub = wv >> 2, qs = q0 + 32 * sub;
        bf16x8 qf[4];
#pragma unroll
        for (int kk = 0; kk < 4; ++kk) qf[kk] = *(const bf16x8*)(qb + (size_t)(r0 + qs + r) * 512 + head * 64 + 16 * kk + 8 * hh);
        const float sinkl = p.attn_sink[head] * LOG2E;
        float mrun = sinkl, lrun = hh == 0 ? 1.0f : 0.0f;
        f32x16 o0, o1;
#pragma unroll
        for (int i = 0; i < 16; ++i) { o0[i] = 0.f; o1[i] = 0.f; }
        const int nwin = lat ? 5 : 4, ntile = lat ? 13 : 4;
        for (int ti = 0; ti < ntile; ++ti) {
            const bf16_t* ksrc; const bf16_t* vsrc; int vstride, ks0; bool window;
            if (ti < nwin) {
                ks0 = lat ? q0 - 128 + 64 * ti : 64 * ti; window = lat;
                if (ks0 < 0 || ks0 >= T) continue;
                ksrc = kb + (size_t)(r0 + ks0) * 128 + kvh * 64; vsrc = vT + (size_t)r0 * 128 + (size_t)(kvh * 64) * T + ks0; vstride = T;
            } else {
                ks0 = 64 * (ti - nwin); window = false;
                ksrc = kc + (size_t)(bl * 512 + ks0) * 128 + kvh * 64; vsrc = vct + (size_t)((bl * 2 + kvh) * 64) * 512 + ks0; vstride = 512;
            }
            __syncthreads();
            {
                const int rw_ = tid >> 3, ch = tid & 7;
                *(u32x4*)(Ks + rw_ * 72 + ch * 8) = *(const u32x4*)(ksrc + (size_t)rw_ * 128 + ch * 8);
                *(u32x4*)(Vt + rw_ * 72 + ch * 8) = *(const u32x4*)(vsrc + (size_t)rw_ * vstride + ch * 8);
            }
            __syncthreads();
#pragma unroll
            for (int sk = 0; sk < 2; ++sk) {
                const int kb0 = ks0 + 32 * sk;
                bool need_mask = false;
                if (window) {
                    if (kb0 > qs + 31 + 128 || kb0 + 31 < qs - 128) continue;
                    need_mask = (kb0 < qs + 31 - 128) || (kb0 + 31 > qs + 128);
                }
                f32x16 x;
#pragma unroll
                for (int i = 0; i < 16; ++i) x[i] = 0.f;
#pragma unroll
                for (int kk = 0; kk < 4; ++kk) {
                    const bf16x8 kf = *(const bf16x8*)(Ks + (32 * sk + r) * 72 + 16 * kk + 8 * hh);
                    x = MFMA32(kf, qf[kk], x);
                }
                float mx = -3.0e38f;
#pragma unroll
                for (int i = 0; i < 16; ++i) {
                    float s = x[i] * SC;
                    if (need_mask) { const int dk = kb0 + crow(i, hh) - (qs + r); if (dk > 128 || dk < -128) s = -3.0e38f; }
                    x[i] = s; mx = fmaxf(mx, s);
                }
                mx = fmaxf(mx, __shfl_xor(mx, 32));
                const float mnew = fmaxf(mrun, mx), alpha = exp2f(mrun - mnew);
                mrun = mnew;
                float ps = 0.f;
#pragma unroll
                for (int i = 0; i < 16; ++i) { const float pv = exp2f(x[i] - mnew); x[i] = pv; ps += pv; }
                lrun = lrun * alpha + ps;
#pragma unroll
                for (int i = 0; i < 16; ++i) { o0[i] *= alpha; o1[i] *= alpha; }
#pragma unroll
                for (int s = 0; s < 2; ++s) {
                    u32x4 pk;
                    pk[0] = pack2(x[8 * s + 0], x[8 * s + 1]); pk[1] = pack2(x[8 * s + 2], x[8 * s + 3]);
                    pk[2] = pack2(x[8 * s + 4], x[8 * s + 5]); pk[3] = pack2(x[8 * s + 6], x[8 * s + 7]);
                    const bf16x8 pf = __builtin_bit_cast(bf16x8, pk);
                    {
                        const s16x4 lo = *(const s16x4*)(Vt + r * 72 + 32 * sk + 16 * s + 4 * hh);
                        const s16x4 hi = *(const s16x4*)(Vt + r * 72 + 32 * sk + 16 * s + 8 + 4 * hh);
                        const bf16x8 vf = __builtin_shufflevector(lo, hi, 0, 1, 2, 3, 4, 5, 6, 7);
                        o0 = MFMA32(vf, pf, o0);
                    }
                    {
                        const s16x4 lo = *(const s16x4*)(Vt + (32 + r) * 72 + 32 * sk + 16 * s + 4 * hh);
                        const s16x4 hi = *(const s16x4*)(Vt + (32 + r) * 72 + 32 * sk + 16 * s + 8 + 4 * hh);
                        const bf16x8 vf = __builtin_shufflevector(lo, hi, 0, 1, 2, 3, 4, 5, 6, 7);
                        o1 = MFMA32(vf, pf, o1);
                    }
                }
            }
        }
        const float ltot = lrun + __shfl_xor(lrun, 32), inv = rcpf_(ltot);
        bf16_t* orow = ab + (size_t)(r0 + qs + r) * 512 + head * 64;
#pragma unroll
        for (int g = 0; g < 4; ++g) {
            f32x4 a, b;
#pragma unroll
            for (int j = 0; j < 4; ++j) { a[j] = o0[4 * g + j] * inv; b[j] = o1[4 * g + j] * inv; }
            *(u32x2*)(orow + 8 * g + 4 * hh) = pack4(a);
            *(u32x2*)(orow + 32 + 8 * g + 4 * hh) = pack4(b);
        }
    }
    __syncthreads();
}

DI void sg_pass(const Params& p) {
    const int tid = threadIdx.x;
    unsigned char* ws = p.ws;
    {
        const bf16_t* zr = (const bf16_t*)(p.out + OUT_Y);
        bf16_t* sg = (bf16_t*)(ws + OFF_SG);
        const float* mu0 = p.rwkv_mu; const float* mu1 = p.rwkv_mu + ZRC;
        for (int i = blockIdx.x * NTHR + tid; i < M * 32; i += gridDim.x * NTHR) {
            const int m = i >> 5, c = (i & 31) * 4;
            int r0, T; seq_of(m, r0, T);
            const bf16_t* zp = zr + (size_t)m * ZRC + 1792 + c;
            const f32x4 z = unpack4(*(const u32x2*)zp);
            f32x4 zprev = (f32x4){0.f, 0.f, 0.f, 0.f}, znext = zprev;
            if (m > r0) zprev = unpack4(*(const u32x2*)(zp - ZRC));
            if (m < r0 + T - 1) znext = unpack4(*(const u32x2*)(zp + ZRC));
            const f32x4 a0 = *(const f32x4*)(mu0 + 1792 + c), a1 = *(const f32x4*)(mu1 + 1792 + c);
            f32x4 o;
#pragma unroll
            for (int j = 0; j < 4; ++j) { const float zs = z[j] + a0[j] * (zprev[j] - z[j]) + a1[j] * (znext[j] - z[j]); o[j] = sigmoidf_(zs); }
            *(u32x2*)(sg + (size_t)m * 128 + c) = pack4(o);
        }
    }
}


template <int CTRL> DI float dpp_f(float x) { return __builtin_bit_cast(float, __builtin_amdgcn_mov_dpp(__builtin_bit_cast(int, x), CTRL, 0xf, 0xf, true)); }
DI float swap32_sum(float x) {
    float a = x, b = x;
    asm volatile("s_nop 1\n\tv_permlane32_swap_b32 %0, %1\n\ts_nop 1" : "+v"(a), "+v"(b));
    return a + b;
}
DI float swap16_sum(float x) {
    float a = x, b = x;
    asm volatile("s_nop 1\n\tv_permlane16_swap_b32 %0, %1\n\ts_nop 1" : "+v"(a), "+v"(b));
    return a + b;
}
DI float row16_allsum(float x) { x += dpp_f<0x128>(x); x += dpp_f<0x124>(x); x += dpp_f<0x122>(x); x += dpp_f<0x121>(x); return x; }
template <int E> DI float qbc(f32x2 v) { return dpp_f<(E >> 1) * 0x55>((E & 1) ? v.y : v.x); }

#define QP0 " quad_perm:[0,0,0,0] row_mask:0xf bank_mask:0xf bound_ctrl:1\n\t"
#define QP1 " quad_perm:[1,1,1,1] row_mask:0xf bank_mask:0xf bound_ctrl:1\n\t"
#define QP2 " quad_perm:[2,2,2,2] row_mask:0xf bank_mask:0xf bound_ctrl:1\n\t"
#define QP3 " quad_perm:[3,3,3,3] row_mask:0xf bank_mask:0xf bound_ctrl:1\n\t"
#define ROR4 " row_ror:4 row_mask:0xf bank_mask:0xf bound_ctrl:1\n\t"
#define ROR8 " row_ror:8 row_mask:0xf bank_mask:0xf bound_ctrl:1\n\t"
DI float scan_sa(const float (&S)[8], f32x2 A) {
    float sa, t1, t2, t3;
    asm volatile(
        "s_nop 1\n\t"
        "v_mul_f32_dpp %0, %12, %4" QP0
        "v_mul_f32_dpp %1, %13, %5" QP0
        "v_mul_f32_dpp %2, %12, %6" QP1
        "v_mul_f32_dpp %3, %13, %7" QP1
        "v_fmac_f32_dpp %0, %12, %8" QP2
        "v_fmac_f32_dpp %1, %13, %9" QP2
        "v_fmac_f32_dpp %2, %12, %10" QP3
        "v_fmac_f32_dpp %3, %13, %11" QP3
        "v_add_f32 %0, %0, %1\n\t"
        "v_add_f32 %2, %2, %3\n\t"
        "v_add_f32 %0, %0, %2\n\t"
        "s_nop 1\n\t"
        "v_add_f32_dpp %0, %0, %0" ROR4
        "s_nop 1\n\t"
        "v_add_f32_dpp %0, %0, %0" ROR8
        "v_mov_b32 %1, %0\n\t"
        "s_nop 1\n\t"
        "v_permlane32_swap_b32 %0, %1\n\t"
        "s_nop 1\n\t"
        "v_add_f32 %0, %0, %1"
        : "=&v"(sa), "=&v"(t1), "=&v"(t2), "=&v"(t3)
        : "v"(S[0]), "v"(S[1]), "v"(S[2]), "v"(S[3]), "v"(S[4]), "v"(S[5]), "v"(S[6]), "v"(S[7]), "v"(A.x), "v"(A.y));
    return sa;
}
DI float scan_upd(float (&S)[8], float sa, float vv, f32x2 B, f32x2 K, f32x2 W, f32x2 R) {
    float n0, n1, n2, n3, n4, n5, n6, n7, y0, y1, y2, y3;
    asm volatile(
        "s_nop 1\n\t"
        "v_mul_f32_dpp %0, %22, %20" QP0  "v_mul_f32_dpp %1, %23, %20" QP0  "v_mul_f32_dpp %2, %22, %20" QP1  "v_mul_f32_dpp %3, %23, %20" QP1
        "v_mul_f32_dpp %4, %22, %20" QP2  "v_mul_f32_dpp %5, %23, %20" QP2  "v_mul_f32_dpp %6, %22, %20" QP3  "v_mul_f32_dpp %7, %23, %20" QP3
        "v_fmac_f32_dpp %0, %24, %21" QP0  "v_fmac_f32_dpp %1, %25, %21" QP0  "v_fmac_f32_dpp %2, %24, %21" QP1  "v_fmac_f32_dpp %3, %25, %21" QP1
        "v_fmac_f32_dpp %4, %24, %21" QP2  "v_fmac_f32_dpp %5, %25, %21" QP2  "v_fmac_f32_dpp %6, %24, %21" QP3  "v_fmac_f32_dpp %7, %25, %21" QP3
        "v_fmac_f32_dpp %0, %26, %12" QP0  "v_fmac_f32_dpp %1, %27, %13" QP0  "v_fmac_f32_dpp %2, %26, %14" QP1  "v_fmac_f32_dpp %3, %27, %15" QP1
        "v_fmac_f32_dpp %4, %26, %16" QP2  "v_fmac_f32_dpp %5, %27, %17" QP2  "v_fmac_f32_dpp %6, %26, %18" QP3  "v_fmac_f32_dpp %7, %27, %19" QP3
        "v_mul_f32_dpp %8, %28, %0" QP0   "v_mul_f32_dpp %9, %29, %1" QP0   "v_mul_f32_dpp %10, %28, %2" QP1  "v_mul_f32_dpp %11, %29, %3" QP1
        "v_fmac_f32_dpp %8, %28, %4" QP2  "v_fmac_f32_dpp %9, %29, %5" QP2  "v_fmac_f32_dpp %10, %28, %6" QP3 "v_fmac_f32_dpp %11, %29, %7" QP3
        "v_add_f32 %8, %8, %9\n\t"
        "v_add_f32 %10, %10, %11\n\t"
        "v_add_f32 %8, %8, %10\n\t"
        "s_nop 1\n\t"
        "v_add_f32_dpp %8, %8, %8" ROR4
        "s_nop 1\n\t"
        "v_add_f32_dpp %8, %8, %8" ROR8
        "v_mov_b32 %9, %8\n\t"
        "s_nop 1\n\t"
        "v_permlane32_swap_b32 %8, %9\n\t"
        "s_nop 1\n\t"
        "v_add_f32 %8, %8, %9"
        : "=&v"(n0), "=&v"(n1), "=&v"(n2), "=&v"(n3), "=&v"(n4), "=&v"(n5), "=&v"(n6), "=&v"(n7), "=&v"(y0), "=&v"(y1), "=&v"(y2), "=&v"(y3)
        : "v"(S[0]), "v"(S[1]), "v"(S[2]), "v"(S[3]), "v"(S[4]), "v"(S[5]), "v"(S[6]), "v"(S[7]), "v"(sa), "v"(vv),
          "v"(B.x), "v"(B.y), "v"(K.x), "v"(K.y), "v"(W.x), "v"(W.y), "v"(R.x), "v"(R.y));
    S[0] = n0; S[1] = n1; S[2] = n2; S[3] = n3; S[4] = n4; S[5] = n5; S[6] = n6; S[7] = n7;
    return y0;
}

constexpr int SC_OPW = 0, SC_OPK = 8192, SC_OPA = 16384, SC_OPB = 24576, SC_OPR = 32768, SC_OPV = 40960;
constexpr int SC_AW = 49152, SC_AA = SC_AW + 32 * 144;
constexpr int SC_LO = SC_AA + 32 * 144;
constexpr int SC_YB = SC_LO + 2 * 32 * 68 * 4;
static_assert(SC_YB + 8192 <= LDS_MAIN, "scan LDS");

DI void lds_barrier() { asm volatile("s_waitcnt lgkmcnt(0)\n\ts_barrier" ::: "memory"); }

constexpr int S2_OP = 0;
constexpr int S2_AW = 49152, S2_AA = S2_AW + 2304;
constexpr int S2_LO = S2_AA + 2304;
constexpr int S2_YB = S2_LO + 8704;
static_assert(S2_YB + 8192 <= LDS_MAIN, "scan LDS");

DI void scan_item(const Params& p, char* smem, int r0, int T, int dsel, int h, const float* state0, float* state_out) {
    const int tid = threadIdx.x, wv = tid >> 6, lane = tid & 63;
    const bool is_scan = wv < 4;
    unsigned char* ws = p.ws;
    const bf16_t* zr = (const bf16_t*)(p.out + OUT_Y);
    float* ys = (float*)(ws + OFF_YS) + (size_t)dsel * M * 512;
    float* bn = (float*)(ws + OFF_BN);
    float* op = (float*)(smem + S2_OP);
    bf16_t* Aw = (bf16_t*)(smem + S2_AW); bf16_t* Aa = (bf16_t*)(smem + S2_AA);
    float* Lo = (float*)(smem + S2_LO); float* yb = (float*)(smem + S2_YB);
    const int nchunk = T >> 4;

    const int rr = (lane & 3) | ((lane >> 4) << 2), jq = (lane >> 2) & 3, irow = 16 * (wv & 3) + rr, jb = 16 * jq;
    f32x4 S0, S1, S2, S3;
    if (state0 && is_scan) {
        const float* sp = state0 + irow * 64 + jb;
        S0 = *(const f32x4*)sp; S1 = *(const f32x4*)(sp + 4); S2 = *(const f32x4*)(sp + 8); S3 = *(const f32x4*)(sp + 12);
    } else { S0 = (f32x4){0.f, 0.f, 0.f, 0.f}; S1 = S0; S2 = S0; S3 = S0; }

    const int ptid = tid & 255, tt = ptid >> 4, cg4 = (ptid & 15) * 4;
    const int segc[5] = {h * 64 + cg4, 512 + h * 64 + cg4, 1024 + h * 64 + cg4, 1536 + dsel * 64 + cg4, 1664 + dsel * 64 + cg4};
    const int pL = (wv >> 1) & 1, pnh = wv & 1, fr = lane & 15, fq = lane >> 4;
    const bf16_t* wt = (const bf16_t*)(ws + (pL == 0 ? OFF_W2T : OFF_A2T)) + (size_t)(dsel * 512 + h * 64) * 64;
    u32x2 zc[5], zp[5], zn[5];
    f32x4 kreg, kkreg, rreg;
    auto load_chunk = [&](int c) {
        const int st = 16 * c + tt, tok = dsel ? T - 1 - st : st;
        const bf16_t* base = zr + (size_t)(r0 + tok) * ZRC;
#pragma unroll
        for (int s = 0; s < 5; ++s) {
            zc[s] = *(const u32x2*)(base + segc[s]);
            zp[s] = (u32x2){0u, 0u}; zn[s] = (u32x2){0u, 0u};
            if (tok > 0) zp[s] = *(const u32x2*)(base - ZRC + segc[s]);
            if (tok < T - 1) zn[s] = *(const u32x2*)(base + ZRC + segc[s]);
        }
    };
    auto prodA = [&](int buf) {
        f32x4 zs[5];
#pragma unroll
        for (int s = 0; s < 5; ++s) {
            const f32x4 mu0 = *(const f32x4*)(p.rwkv_mu + segc[s]), mu1 = *(const f32x4*)(p.rwkv_mu + ZRC + segc[s]);
            const f32x4 z = unpack4(zc[s]), a = unpack4(zp[s]), b = unpack4(zn[s]);
            zs[s] = z + mu0 * (a - z) + mu1 * (b - z);
        }
        const f32x4 kkv = *(const f32x4*)(p.rwkv_k_k + h * 64 + cg4);
        f32x4 kk = zs[1] * kkv;
        float n2 = kk[0] * kk[0] + kk[1] * kk[1] + kk[2] * kk[2] + kk[3] * kk[3];
        n2 = row16_allsum(n2);
        kk = kk * __builtin_amdgcn_rsqf(fmaxf(n2, 1e-24f));
        f32x4 tw;
#pragma unroll
        for (int j = 0; j < 4; ++j) tw[j] = 1.0f - 2.0f * rcpf_(1.0f + __expf(2.0f * zs[3][j]));
        *(u32x2*)(Aw + tt * 72 + cg4) = pack4(tw);
        *(u32x2*)(Aa + tt * 72 + cg4) = pack4(zs[4]);
        float* ob = op + buf * 6144 + tt * 64 + cg4;
        *(f32x4*)(ob + 4 * 1024) = zs[0];
        *(f32x4*)(ob + 5 * 1024) = zs[2];
        *(f32x4*)(ob + 2 * 1024) = -kk;
        kreg = zs[1]; kkreg = kk; rreg = zs[0];
    };
    auto prodB = [&]() {
        const bf16_t* As = pL == 0 ? Aw : Aa;
        const bf16x8 a0 = *(const bf16x8*)(As + fr * 72 + fq * 8), a1 = *(const bf16x8*)(As + fr * 72 + 32 + fq * 8);
#pragma unroll
        for (int n2 = 0; n2 < 2; ++n2) {
            f32x4 x = (f32x4){0.f, 0.f, 0.f, 0.f};
            const bf16_t* wr_ = wt + (size_t)((pnh * 2 + n2) * 16 + fr) * 64 + fq * 8;
            x = __builtin_amdgcn_mfma_f32_16x16x32_bf16(a0, *(const bf16x8*)wr_, x, 0, 0, 0);
            x = __builtin_amdgcn_mfma_f32_16x16x32_bf16(a1, *(const bf16x8*)(wr_ + 32), x, 0, 0, 0);
#pragma unroll
            for (int j = 0; j < 4; ++j) Lo[(pL * 16 + fq * 4 + j) * 68 + (pnh * 2 + n2) * 16 + fr] = x[j];
        }
    };
    auto prodC = [&](int c, int buf) {
        const int st = 16 * c + tt, tok = dsel ? T - 1 - st : st, m = r0 + tok;
        const f32x4 w0v = *(const f32x4*)(p.rwkv_w0 + dsel * 512 + h * 64 + cg4), a0v = *(const f32x4*)(p.rwkv_a0 + dsel * 512 + h * 64 + cg4);
        const f32x4 kav = *(const f32x4*)(p.rwkv_k_a + h * 64 + cg4), rkv = *(const f32x4*)(p.rwkv_r_k + h * 64 + cg4);
        const f32x4 lw = *(const f32x4*)(Lo + tt * 68 + cg4), la = *(const f32x4*)(Lo + (16 + tt) * 68 + cg4);
        f32x4 wd, kd, bb; float bs = 0.f;
#pragma unroll
        for (int j = 0; j < 4; ++j) {
            wd[j] = __expf(-0.6065306597126334f * sigmoidf_(w0v[j] + lw[j]));
            const float a = sigmoidf_(a0v[j] + la[j]);
            kd[j] = kreg[j] * (1.0f + (a - 1.0f) * kav[j]);
            bb[j] = a * kkreg[j];
            bs += rreg[j] * kd[j] * rkv[j];
        }
        float* ob = op + buf * 6144 + tt * 64 + cg4;
        *(f32x4*)(ob) = wd;
        *(f32x4*)(ob + 1024) = kd;
        *(f32x4*)(ob + 3 * 1024) = bb;
        bs = row16_allsum(bs);
        if ((ptid & 15) == 0) bn[(size_t)m * 16 + dsel * 8 + h] = bs;
    };
    auto flush_ys = [&](int c) {
        const int st = 16 * c + tt, tok = dsel ? T - 1 - st : st, m = r0 + tok;
        *(f32x4*)(ys + (size_t)m * 512 + h * 64 + cg4) = *(const f32x4*)(yb + (c & 1) * 1024 + tt * 64 + cg4);
    };
    auto chunk_steps = [&](int buf) {
        const float* ob = op + buf * 6144 + jb;
        const float* ov = op + buf * 6144 + 5 * 1024 + irow;
        float* yo = yb + buf * 1024 + irow;
        f32x4 W0 = *(const f32x4*)(ob), W1 = *(const f32x4*)(ob + 4), W2 = *(const f32x4*)(ob + 8), W3 = *(const f32x4*)(ob + 12);
        f32x4 K0 = *(const f32x4*)(ob + 1024), K1 = *(const f32x4*)(ob + 1028), K2 = *(const f32x4*)(ob + 1032), K3 = *(const f32x4*)(ob + 1036);
        f32x4 A0 = *(const f32x4*)(ob + 2048), A1 = *(const f32x4*)(ob + 2052), A2 = *(const f32x4*)(ob + 2056), A3 = *(const f32x4*)(ob + 2060);
        f32x4 B0 = *(const f32x4*)(ob + 3072), B1 = *(const f32x4*)(ob + 3076), B2 = *(const f32x4*)(ob + 3080), B3 = *(const f32x4*)(ob + 3084);
        f32x4 R0 = *(const f32x4*)(ob + 4096), R1 = *(const f32x4*)(ob + 4100), R2 = *(const f32x4*)(ob + 4104), R3 = *(const f32x4*)(ob + 4108);
        float vv = ov[0];
#pragma unroll 2
        for (int s = 0; s < 16; ++s) {
            const float* o = ob + ((s + 1) & 15) * 64;
            const f32x4 W0n = *(const f32x4*)(o), W1n = *(const f32x4*)(o + 4), W2n = *(const f32x4*)(o + 8), W3n = *(const f32x4*)(o + 12);
            const f32x4 K0n = *(const f32x4*)(o + 1024), K1n = *(const f32x4*)(o + 1028), K2n = *(const f32x4*)(o + 1032), K3n = *(const f32x4*)(o + 1036);
            const f32x4 A0n = *(const f32x4*)(o + 2048), A1n = *(const f32x4*)(o + 2052), A2n = *(const f32x4*)(o + 2056), A3n = *(const f32x4*)(o + 2060);
            const f32x4 B0n = *(const f32x4*)(o + 3072), B1n = *(const f32x4*)(o + 3076), B2n = *(const f32x4*)(o + 3080), B3n = *(const f32x4*)(o + 3084);
            const f32x4 R0n = *(const f32x4*)(o + 4096), R1n = *(const f32x4*)(o + 4100), R2n = *(const f32x4*)(o + 4104), R3n = *(const f32x4*)(o + 4108);
            const float vn = ov[((s + 1) & 15) * 64];
            const f32x4 pa = (S0 * A0 + S1 * A1) + (S2 * A2 + S3 * A3);
            float sa = (pa[0] + pa[1]) + (pa[2] + pa[3]);
            sa += dpp_f<0x124>(sa); sa += dpp_f<0x128>(sa);
            S0 = S0 * W0 + (B0 * sa + K0 * vv);
            S1 = S1 * W1 + (B1 * sa + K1 * vv);
            S2 = S2 * W2 + (B2 * sa + K2 * vv);
            S3 = S3 * W3 + (B3 * sa + K3 * vv);
            const f32x4 py = (S0 * R0 + S1 * R1) + (S2 * R2 + S3 * R3);
            float y = (py[0] + py[1]) + (py[2] + py[3]);
            y += dpp_f<0x124>(y); y += dpp_f<0x128>(y);
            if (jq == 0) yo[s * 64] = y;
            W0 = W0n; W1 = W1n; W2 = W2n; W3 = W3n; K0 = K0n; K1 = K1n; K2 = K2n; K3 = K3n; A0 = A0n; A1 = A1n; A2 = A2n; A3 = A3n;
            B0 = B0n; B1 = B1n; B2 = B2n; B3 = B3n; R0 = R0n; R1 = R1n; R2 = R2n; R3 = R3n; vv = vn;
            if (s == 4 || s == 9) lds_barrier();
        }
    };

    lds_barrier();
    if (is_scan) {
        lds_barrier(); lds_barrier(); lds_barrier();
#pragma unroll 1
        for (int c = 0; c < nchunk; ++c) {
            chunk_steps(c & 1);
            lds_barrier();
        }
        if (state_out) {
            float* sp = state_out + irow * 64 + jb;
            *(f32x4*)sp = S0; *(f32x4*)(sp + 4) = S1; *(f32x4*)(sp + 8) = S2; *(f32x4*)(sp + 12) = S3;
        }
    } else {
        load_chunk(0); prodA(0);
        lds_barrier();
        prodB();
        lds_barrier();
        prodC(0, 0); if (nchunk > 1) load_chunk(1);
        lds_barrier();
#pragma unroll 1
        for (int c = 0; c < nchunk; ++c) {
            const int b = c & 1;
            const bool more = c + 1 < nchunk;
            if (c > 0) flush_ys(c - 1);
            if (more) prodA(b ^ 1);
            lds_barrier();
            if (more) prodB();
            lds_barrier();
            if (more) { prodC(c + 1, b ^ 1); if (c + 2 < nchunk) load_chunk(c + 2); }
            lds_barrier();
        }
        flush_ys(nchunk - 1);
    }
    lds_barrier();
}

DI void scan_dispatch(const Params& p, char* smem, int it) {
    if (it < 128) {
        const int b = it >> 4, dsel = (it >> 3) & 1, h = it & 7;
        scan_item(p, smem, MC + b * 2048, 2048, dsel, h, p.state_rwkv + (size_t)((b * 2 + dsel) * 8 + h) * 4096, nullptr);
    } else {
        const int i2 = it - 128, s = i2 >> 4, dsel = (i2 >> 3) & 1, h = i2 & 7;
        scan_item(p, smem, s * 256, 256, dsel, h, nullptr, p.out + OUT_S + (size_t)((s * 2 + dsel) * 8 + h) * 4096);
    }
}
DI void phase_mix(const Params& p, char* smem) {
    unsigned* ctr = (unsigned*)(p.ws + OFF_BAR) + XCD_BAR_WORDS;
    volatile LAS unsigned* slot = (volatile LAS unsigned*)(smem + LDS_MAIN + 8);
    for (;;) {
        if (threadIdx.x == 0) *slot = __hip_atomic_fetch_add(ctr, 1u, __ATOMIC_RELAXED, __HIP_MEMORY_SCOPE_AGENT);
        __syncthreads();
        const int it = (int)*slot;
        __syncthreads();
        if (it >= 640 + 768) break;
        if (it < 640) scan_dispatch(p, smem, it);
        else attn_item(p, smem, it - 640);
    }
    sg_pass(p);
}

DI void phase_post(const Params& p, char* smem) {
    const int tid = threadIdx.x, wid = tid >> 6, lane = tid & 63, fr = lane & 15, fq = lane >> 4, wr = wid >> 1, wc = wid & 1;
    unsigned char* ws = p.ws;
    const bf16_t* sg = (const bf16_t*)(ws + OFF_SG); const bf16_t* g2t = (const bf16_t*)(ws + OFF_G2T);
    const float* ys0 = (const float*)(ws + OFF_YS); const float* ys1 = ys0 + (size_t)M * 512;
    const float* bn = (const float*)(ws + OFF_BN);
    const bf16_t* zr = (const bf16_t*)(p.out + OUT_Y);
    bf16_t* rw = (bf16_t*)(ws + OFF_RW);
    const int MT = M / 256, NT = 4;
    for (int t2 = blockIdx.x; t2 < 2 * MT * NT; t2 += gridDim.x) {
        const int t = t2 >> 1, half = t2 & 1;
        int mt, nt; tile_coords(t, MT, NT, mt, nt);
        const int row0 = mt * 256;
        f32x4 acc[4][4]; zero_acc<4>(acc);
        gemm_acc<4>(acc, sg + (size_t)row0 * 128, 128, g2t + (size_t)(nt * 128) * 128, 128, 128, smem, tid);
        const int head = nt * 2 + wc;
        int r0, T; seq_of(row0, r0, T);
        auto epi = [&](const f32x4 (&g0)[4], const f32x4 (&g1)[4]) {
            f32x4 ya[2][4], yb_[2][4]; u32x2 zc[2][4], zp[2][4], zn[2][4]; float b0[2], b1[2];
#pragma unroll
            for (int q = 0; q < 2; ++q) {
                const int m = row0 + wr * 64 + (half * 2 + q) * 16 + fr;
#pragma unroll
                for (int nb = 0; nb < 4; ++nb) {
                    const size_t o = (size_t)m * 512 + head * 64 + nb * 16 + fq * 4;
                    ya[q][nb] = *(const f32x4*)(ys0 + o); yb_[q][nb] = *(const f32x4*)(ys1 + o);
                    const bf16_t* zq = zr + (size_t)m * ZRC + 1024 + head * 64 + nb * 16 + fq * 4;
                    zc[q][nb] = *(const u32x2*)zq;
                    zp[q][nb] = (u32x2){0u, 0u}; zn[q][nb] = (u32x2){0u, 0u};
                    if (m > r0) zp[q][nb] = *(const u32x2*)(zq - ZRC);
                    if (m < r0 + T - 1) zn[q][nb] = *(const u32x2*)(zq + ZRC);
                }
                b0[q] = bn[(size_t)m * 16 + head]; b1[q] = bn[(size_t)m * 16 + 8 + head];
            }
#pragma unroll
            for (int q = 0; q < 2; ++q) {
                const int mb = half * 2 + q, m = row0 + wr * 64 + mb * 16 + fr;
                f32x4 y[4]; float s1 = 0.f;
#pragma unroll
                for (int nb = 0; nb < 4; ++nb) { y[nb] = ya[q][nb] + yb_[q][nb]; s1 += (y[nb][0] + y[nb][1]) + (y[nb][2] + y[nb][3]); }
                s1 = swap32_sum(swap16_sum(s1));
                const float mean = s1 * (1.0f / 64.0f);
                float s2 = 0.f;
#pragma unroll
                for (int nb = 0; nb < 4; ++nb) { const f32x4 dlt = y[nb] - mean; s2 += dlt[0] * dlt[0] + dlt[1] * dlt[1] + dlt[2] * dlt[2] + dlt[3] * dlt[3]; }
                s2 = swap32_sum(swap16_sum(s2));
                const float rstd = __builtin_amdgcn_rsqf(s2 * (1.0f / 64.0f) + 64e-5f);
                const float bonus = b0[q] + b1[q];
#pragma unroll
                for (int nb = 0; nb < 4; ++nb) {
                    const int c = head * 64 + nb * 16 + fq * 4;
                    const f32x4 z = unpack4(zc[q][nb]), zprev = unpack4(zp[q][nb]), znext = unpack4(zn[q][nb]);
                    const f32x4 a0 = *(const f32x4*)(p.rwkv_mu + 1024 + c), a1 = *(const f32x4*)(p.rwkv_mu + ZRC + 1024 + c);
                    const f32x4 v = z + a0 * (zprev - z) + a1 * (znext - z);
                    const f32x4 lg = *(const f32x4*)(p.rwkv_ln_g + c), lb = *(const f32x4*)(p.rwkv_ln_b + c);
                    const f32x4 yn = (y[nb] - mean) * rstd * lg + lb;
                    const f32x4 gsel = q ? g1[nb] : g0[nb];
                    const f32x4 o = (yn + v * bonus) * gsel;
                    *(u32x2*)(rw + (size_t)m * 512 + c) = pack4(o);
                }
            }
        };
        if (half) epi(acc[2], acc[3]); else epi(acc[0], acc[1]);
    }
}

DI void phase_merge(const Params& p, char* smem) {
    const int tid = threadIdx.x, wid = tid >> 6, lane = tid & 63, fr = lane & 15, fq = lane >> 4, wr = wid >> 1, wc = wid & 1;
    unsigned char* ws = p.ws;
    const bf16_t* hb = (const bf16_t*)(ws + OFF_H); const bf16_t* wt = (const bf16_t*)(ws + OFF_WIN);
    const bf16_t* ab = (const bf16_t*)(ws + OFF_ATTN); const bf16_t* rw = (const bf16_t*)(ws + OFF_RW);
    const bf16_t* wpa = (const bf16_t*)(ws + OFF_WPA); const bf16_t* wpb = (const bf16_t*)(ws + OFF_WPB);
    bf16_t* mg = (bf16_t*)(ws + OFF_MRG);
    const int MT = M / 256, NT = 16;
    for (int t = blockIdx.x; t < MT * NT; t += gridDim.x) {
        int mt, nt; tile_coords(t, MT, NT, mt, nt);
        const int row0 = mt * 256, n0 = nt * 64;
        u32x2 gpa[4][2], gpb[4][2];
        {
            f32x4 gacc[4][4]; zero_acc<4>(gacc);
            gemm_acc<4, 1024>(gacc, hb + (size_t)row0 * 1024, 1024, wt + (size_t)(768 + n0) * 1024, 1024, 1024, smem, tid);
#pragma unroll
            for (int a = 0; a < 4; ++a)
#pragma unroll
                for (int b = 0; b < 2; ++b) {
                    f32x4 ga, gb;
#pragma unroll
                    for (int j = 0; j < 4; ++j) { ga[j] = sigmoidf_(gacc[a][b][j]); gb[j] = sigmoidf_(gacc[a][b + 2][j]); }
                    gpa[a][b] = pack4(ga); gpb[a][b] = pack4(gb);
                }
        }
        f32x4 acc[4][2], res[4][2];
        zero_acc<2>(acc);
        gemm_acc<2>(acc, ab + (size_t)row0 * 512, 512, wpa + (size_t)n0 * 512, 512, 512, smem, tid);
#pragma unroll
        for (int a = 0; a < 4; ++a)
#pragma unroll
            for (int b = 0; b < 2; ++b) res[a][b] = unpack4(gpa[a][b]) * acc[a][b];
        zero_acc<2>(acc);
        gemm_acc<2>(acc, rw + (size_t)row0 * 512, 512, wpb + (size_t)n0 * 512, 512, 512, smem, tid);
#pragma unroll
        for (int mb = 0; mb < 4; ++mb) {
            const int m = row0 + wr * 64 + mb * 16 + fr;
#pragma unroll
            for (int nb = 0; nb < 2; ++nb) {
                const f32x4 o = res[mb][nb] + unpack4(gpb[mb][nb]) * acc[mb][nb];
                *(u32x2*)(mg + (size_t)m * 1024 + n0 + wc * 32 + nb * 16 + fq * 4) = pack4(o);
            }
        }
    }
}

struct EpiOut {
    static constexpr bool PERM = false, AFTER_DRAIN = false;
    float* y; const float* mod; const float* xp; const float* xs;
    __device__ __forceinline__ void operator()(const f32x4 (&acc)[2][2][4][2], const pg8::Unit& u, int wr, int wc, int fr, int fq) const {
        const int row0 = u.pm * 256 + wr * 64 + fr, col0 = u.pn * 256 + wc * 32 + 4 * fq, ci = cond_of(u.pm * 256);
        const float* xb = u.pm * 256 < MC ? xp : xs - (size_t)MC * D;
#pragma unroll
        for (int bj = 0; bj < 2; ++bj)
#pragma unroll
            for (int n = 0; n < 2; ++n) {
                const int col = col0 + bj * 128 + n * 16;
                const f32x4 g1 = *(const f32x4*)(mod + ci * 6144 + 2048 + col);
#pragma unroll
                for (int ai = 0; ai < 2; ++ai)
#pragma unroll
                    for (int m = 0; m < 4; ++m) {
                        const size_t o = (size_t)(row0 + ai * 128 + m * 16) * D + col;
                        *(f32x4*)(y + o) = *(const f32x4*)(xb + o) + g1 * acc[ai][bj][m][n];
                    }
            }
    }
};
DI void phase_out(const Params& p, char* smem) {
    const int tid = threadIdx.x, wid = tid >> 6, lane = tid & 63, fr = lane & 15, fq = lane >> 4, wr = wid >> 1, wc = wid & 1;
    unsigned char* ws = p.ws;
    const bf16_t* mg = (const bf16_t*)(ws + OFF_MRG); const bf16_t* wo = (const bf16_t*)(ws + OFF_WOUT);
    const float* mod = (const float*)(ws + OFF_MOD);
    const int nM = M / 256, nN = 4, G = gridDim.x, nfirst = G < nM * nN ? G : nM * nN;
    {
        const pg8::Gemm8 g = {mg, wo, 1024, 128};
        const pg8::Order8 ord = {nM, nN, nfirst, G, (int)blockIdx.x, 0};
        const EpiOut epi = {p.out + OUT_Y, mod, p.x_prompt, p.x_sample};
        pg8::gemm8((LAS unsigned char*)smem, g, ord, epi);
    }
    for (int t = blockIdx.x; t < 2 * (nM * nN - nfirst); t += G) {
        int pm, pn; pg8::unit_of(nfirst + (t >> 1), nM, nN, pm, pn);
        const int row0 = pm * 256, n0 = pn * 256 + (t & 1) * 128;
        f32x4 acc[4][4]; zero_acc<4>(acc);
        gemm_acc<4>(acc, mg + (size_t)row0 * 1024, 1024, wo + (size_t)n0 * 1024, 1024, 1024, smem, tid);
        const int ci = cond_of(row0);
#pragma unroll
        for (int nb = 0; nb < 4; ++nb) {
            const int n = n0 + wc * 64 + nb * 16 + fq * 4;
            const f32x4 g1 = *(const f32x4*)(mod + ci * 6144 + 2048 + n);
#pragma unroll
            for (int mb = 0; mb < 4; ++mb) {
                const int m = row0 + wr * 64 + mb * 16 + fr;
                const f32x4 xv = *(const f32x4*)(xrow(p, m) + n);
                *(f32x4*)(p.out + OUT_Y + (size_t)m * D + n) = xv + g1 * acc[mb][nb];
            }
        }
    }
}

DI u32x2 conv_act(const f32x4 (&um)[2], const f32x4 (&u0)[2], const f32x4 (&up)[2], const float* cw, const float* cb, int gcol) {
    f32x4 res[2];
#pragma unroll
    for (int part = 0; part < 2; ++part) {
        const int cc = gcol + part * DFF;
        const f32x4 w0 = *(const f32x4*)(cw + cc), w1 = *(const f32x4*)(cw + 5632 + cc), w2 = *(const f32x4*)(cw + 2 * 5632 + cc), bb = *(const f32x4*)(cb + cc);
        res[part] = um[part] * w0 + u0[part] * w1 + up[part] * w2 + bb;
    }
    f32x4 o;
#pragma unroll
    for (int j = 0; j < 4; ++j) { const float g = res[1][j]; o[j] = g * rcpf_(1.0f + __expf(-g)) * res[0][j]; }
    return pack4(o);
}
DI void up_tile64(const Params& p, char* smem, int mt, int nt) {
    const int tid = threadIdx.x, wid = tid >> 6, lane = tid & 63, fr = lane & 15, fq = lane >> 4, wr = wid >> 1, wc = wid & 1;
    unsigned char* ws = p.ws;
    const bf16_t* hb = (const bf16_t*)(ws + OFF_H); const bf16_t* wu = (const bf16_t*)(ws + OFF_WUP);
    bf16_t* act = (bf16_t*)(ws + OFF_ACT); bf16_t* ub = (bf16_t*)(ws + OFF_U);
    bf16_t* ut = (bf16_t*)smem;
    const int NT = 44;
    {
        const int row0 = mt * 256, n0 = nt * 64;
        f32x4 acc[4][4]; zero_acc<4>(acc);
        gemm_acc<4, DFF>(acc, hb + (size_t)row0 * 1024, 1024, wu + (size_t)n0 * 1024, 1024, 1024, smem, tid);
        __syncthreads();
#pragma unroll
        for (int mb = 0; mb < 4; ++mb)
#pragma unroll
            for (int nb = 0; nb < 4; ++nb) *(u32x2*)(ut + (wr * 64 + mb * 16 + fr) * 136 + wc * 64 + nb * 16 + fq * 4) = pack4(acc[mb][nb]);
        __syncthreads();
        const int c4 = (tid & 15) * 4, lv = (c4 >> 5) * 64 + (c4 & 31), lg = lv + 32;
#pragma unroll 2
        for (int it = 0; it < 8; ++it) {
            const int row = it * 32 + (tid >> 4);
            f32x4 um[2], u0[2], up[2];
            const f32x4 z4 = (f32x4){0.f, 0.f, 0.f, 0.f};
            u0[0] = unpack4(*(const u32x2*)(ut + row * 136 + lv)); u0[1] = unpack4(*(const u32x2*)(ut + row * 136 + lg));
            um[0] = row > 0 ? unpack4(*(const u32x2*)(ut + (row - 1) * 136 + lv)) : z4; um[1] = row > 0 ? unpack4(*(const u32x2*)(ut + (row - 1) * 136 + lg)) : z4;
            up[0] = row < 255 ? unpack4(*(const u32x2*)(ut + (row + 1) * 136 + lv)) : z4; up[1] = row < 255 ? unpack4(*(const u32x2*)(ut + (row + 1) * 136 + lg)) : z4;
            *(u32x2*)(act + (size_t)(row0 + row) * DFF + n0 + c4) = conv_act(um, u0, up, p.ffn_conv_w, p.ffn_conv_b, n0 + c4);
        }
        if (row0 >= MC && tid < 256) {
            const int k = tid >> 6, rsel = k < 2 ? k : 252 + k, cp = (tid & 63) * 2;
            *(unsigned*)(ub + ((size_t)(mt * NT + nt) * 4 + k) * 128 + cp) = *(const unsigned*)(ut + rsel * 136 + cp);
        }
    }
}
DI void up_tile128(const Params& p, char* smem, int mt, int nt) {
    const int tid = threadIdx.x, wid = tid >> 6, lane = tid & 63, fr = lane & 15, fq = lane >> 4, wr = wid >> 1, wc = wid & 1;
    unsigned char* ws = p.ws;
    const bf16_t* hb = (const bf16_t*)(ws + OFF_H); const bf16_t* wu = (const bf16_t*)(ws + OFF_WUP);
    bf16_t* act = (bf16_t*)(ws + OFF_ACT); bf16_t* ub = (bf16_t*)(ws + OFF_U);
    bf16_t* ut = (bf16_t*)smem;
    {
        const int row0 = mt * 256, n0 = nt * 128;
        f32x4 acc[4][8];
#pragma unroll
        for (int a = 0; a < 4; ++a)
#pragma unroll
            for (int b = 0; b < 8; ++b) acc[a][b] = (f32x4){0.f, 0.f, 0.f, 0.f};
        gemm_acc8<DFF>(acc, hb + (size_t)row0 * 1024, 1024, wu + (size_t)n0 * 1024, 1024, 1024, smem, tid);
        __syncthreads();
#pragma unroll
        for (int mb = 0; mb < 4; ++mb)
#pragma unroll
            for (int nb = 0; nb < 8; ++nb) *(u32x2*)(ut + (wr * 64 + mb * 16 + fr) * 264 + wc * 128 + nb * 16 + fq * 4) = pack4(acc[mb][nb]);
        __syncthreads();
        const int c4 = (tid & 31) * 4, lv = (c4 >> 6) * 128 + (c4 & 63), lg = lv + 64;
#pragma unroll 2
        for (int it = 0; it < 16; ++it) {
            const int row = it * 16 + (tid >> 5);
            f32x4 um[2], u0[2], up[2];
            const f32x4 z4 = (f32x4){0.f, 0.f, 0.f, 0.f};
            u0[0] = unpack4(*(const u32x2*)(ut + row * 264 + lv)); u0[1] = unpack4(*(const u32x2*)(ut + row * 264 + lg));
            um[0] = row > 0 ? unpack4(*(const u32x2*)(ut + (row - 1) * 264 + lv)) : z4; um[1] = row > 0 ? unpack4(*(const u32x2*)(ut + (row - 1) * 264 + lg)) : z4;
            up[0] = row < 255 ? unpack4(*(const u32x2*)(ut + (row + 1) * 264 + lv)) : z4; up[1] = row < 255 ? unpack4(*(const u32x2*)(ut + (row + 1) * 264 + lg)) : z4;
            *(u32x2*)(act + (size_t)(row0 + row) * DFF + n0 + c4) = conv_act(um, u0, up, p.ffn_conv_w, p.ffn_conv_b, n0 + c4);
        }
        if (row0 >= MC) {
            const int k = tid >> 7, rsel = k < 2 ? k : 252 + k, sub = (tid >> 6) & 1, lo = (tid & 63) * 2;
            const int cq = (lo >> 6) * 32 + (lo & 31), isg = (lo >> 5) & 1;
            *(unsigned*)(ub + ((size_t)(mt * 44 + nt * 2 + sub) * 4 + k) * 128 + lo) = *(const unsigned*)(ut + rsel * 264 + sub * 128 + cq + isg * 64);
        }
    }
}
DI void phase_up(const Params& p, char* smem) {
    const int MT = M / 256, NT = 22, G = gridDim.x, nfirst = ((MT * NT) / G) * G;
    for (int t = blockIdx.x; t < nfirst; t += G) { int mt, nt; tile_coords(t, MT, NT, mt, nt); up_tile128(p, smem, mt, nt); }
    for (int t = blockIdx.x; t < 2 * (MT * NT - nfirst); t += G) { int mt, nt; tile_coords(nfirst + (t >> 1), MT, NT, mt, nt); up_tile64(p, smem, mt, nt * 2 + (t & 1)); }
}
DI void phase_fix(const Params& p) {
    unsigned char* ws = p.ws;
    bf16_t* act = (bf16_t*)(ws + OFF_ACT); const bf16_t* ub = (const bf16_t*)(ws + OFF_U);
    const int NT = 44;
    for (int i = blockIdx.x * NTHR + threadIdx.x; i < 64 * NT * 2 * 16; i += gridDim.x * NTHR) {
        const int cg = i & 15, which = (i >> 4) & 1, rest = i >> 5, nt = rest % NT, mt = 32 + rest / NT;
        const int row0 = mt * 256, tpos = (row0 - MC) & 2047;
        if (which == 0 ? tpos == 0 : tpos == 2048 - 256) continue;
        const bf16_t* own = ub + (size_t)(mt * NT + nt) * 4 * 128;
        const bf16_t *pv, *cu, *nx; int m;
        if (which == 0) { m = row0; pv = ub + ((size_t)((mt - 1) * NT + nt) * 4 + 3) * 128; cu = own; nx = own + 128; }
        else { m = row0 + 255; pv = own + 2 * 128; cu = own + 3 * 128; nx = ub + (size_t)((mt + 1) * NT + nt) * 4 * 128; }
        const int c4 = cg * 4, lv = (c4 >> 5) * 64 + (c4 & 31), lg = lv + 32;
        f32x4 um[2], u0[2], up[2];
        um[0] = unpack4(*(const u32x2*)(pv + lv)); um[1] = unpack4(*(const u32x2*)(pv + lg));
        u0[0] = unpack4(*(const u32x2*)(cu + lv)); u0[1] = unpack4(*(const u32x2*)(cu + lg));
        up[0] = unpack4(*(const u32x2*)(nx + lv)); up[1] = unpack4(*(const u32x2*)(nx + lg));
        *(u32x2*)(act + (size_t)m * DFF + nt * 64 + c4) = conv_act(um, u0, up, p.ffn_conv_w, p.ffn_conv_b, nt * 64 + c4);
    }
}
struct EpiDown {
    static constexpr bool PERM = false, AFTER_DRAIN = false;
    float* y; const float* mod;
    __device__ __forceinline__ void operator()(const f32x4 (&acc)[2][2][4][2], const pg8::Unit& u, int wr, int wc, int fr, int fq) const {
        const int row0 = u.pm * 256 + wr * 64 + fr, col0 = u.pn * 256 + wc * 32 + 4 * fq, ci = cond_of(u.pm * 256);
#pragma unroll
        for (int bj = 0; bj < 2; ++bj)
#pragma unroll
            for (int n = 0; n < 2; ++n) {
                const int col = col0 + bj * 128 + n * 16;
                const f32x4 g2 = *(const f32x4*)(mod + ci * 6144 + 5120 + col);
#pragma unroll
                for (int ai = 0; ai < 2; ++ai)
#pragma unroll
                    for (int m = 0; m < 4; ++m) { float* px = y + (size_t)(row0 + ai * 128 + m * 16) * D + col; *(f32x4*)px = *(const f32x4*)px + g2 * acc[ai][bj][m][n]; }
            }
    }
};
DI void phase_down(const Params& p, char* smem) {
    const int tid = threadIdx.x, wid = tid >> 6, lane = tid & 63, fr = lane & 15, fq = lane >> 4, wr = wid >> 1, wc = wid & 1;
    unsigned char* ws = p.ws;
    const bf16_t* act = (const bf16_t*)(ws + OFF_ACT); const bf16_t* wd = (const bf16_t*)(ws + OFF_WDN);
    const float* mod = (const float*)(ws + OFF_MOD);
    const int nM = M / 256, nN = 4, G = gridDim.x, nfirst = G < nM * nN ? G : nM * nN;
    {
        const pg8::Gemm8 g = {act, wd, DFF, 128};
        const pg8::Order8 ord = {nM, nN, nfirst, G, (int)blockIdx.x, 0};
        const EpiDown epi = {p.out + OUT_Y, mod};
        pg8::gemm8((LAS unsigned char*)smem, g, ord, epi);
    }
    for (int t = blockIdx.x; t < 2 * (nM * nN - nfirst); t += G) {
        int pm, pn; pg8::unit_of(nfirst + (t >> 1), nM, nN, pm, pn);
        const int row0 = pm * 256, n0 = pn * 256 + (t & 1) * 128;
        f32x4 acc[4][4]; zero_acc<4>(acc);
        gemm_acc<4>(acc, act + (size_t)row0 * DFF, DFF, wd + (size_t)n0 * DFF, DFF, DFF, smem, tid);
        const int ci = cond_of(row0);
#pragma unroll
        for (int nb = 0; nb < 4; ++nb) {
            const int n = n0 + wc * 64 + nb * 16 + fq * 4;
            const f32x4 g2 = *(const f32x4*)(mod + ci * 6144 + 5120 + n);
#pragma unroll
            for (int mb = 0; mb < 4; ++mb) {
                const int m = row0 + wr * 64 + mb * 16 + fr;
                float* px = p.out + OUT_Y + (size_t)m * D + n;
                *(f32x4*)px = *(const f32x4*)px + g2 * acc[mb][nb];
            }
        }
    }
}

#define XB_TMO      128
#define XB_XCNT(j)  (256  + 64 * (j))
#define XB_XSUB(j)  (1280 + 64 * (j))
#define XB_XGEN(j)  (2304 + 64 * (j))
#define XB_TOP      3328
#define XB_TOPGEN   3392
#define XB_SPIN_CAP (1u << 20)
DI unsigned xb_ld(unsigned* p)              { return __hip_atomic_load(p, __ATOMIC_RELAXED, __HIP_MEMORY_SCOPE_AGENT); }
DI unsigned xb_add(unsigned* p, unsigned v) { return __hip_atomic_fetch_add(p, v, __ATOMIC_RELAXED, __HIP_MEMORY_SCOPE_AGENT); }
DI unsigned xb_xcc_id() { return (unsigned)__builtin_amdgcn_s_getreg((3 << 11) | 20) & 0xFu; }
#define XB_SPIN(cond, bar) do { unsigned _sp = 0; while (cond) { __builtin_amdgcn_s_sleep(1); \
    if ((++_sp & 255u) == 0u) { if (xb_ld(&(bar)[XB_TMO])) break; if (_sp > XB_SPIN_CAP) { atomicAdd(&(bar)[XB_TMO], 1u); break; } } } } while (0)
struct XcdBarrier { unsigned* bar; unsigned x; volatile LAS unsigned* st; };
DI XcdBarrier xcd_barrier_post(unsigned* bar, volatile LAS unsigned* st) {
    XcdBarrier b; b.bar = bar; b.x = xb_xcc_id(); b.st = st;
    if (threadIdx.x == 0) (void)xb_add(&bar[XB_XCNT(b.x)], 1u);
    return b;
}
DI void xcd_barrier_complete(unsigned* bar, unsigned x, unsigned& nloc, unsigned& nx) {
    const unsigned G = gridDim.x * gridDim.y * gridDim.z;
    unsigned sum, cnt, mine, sp = 0u;
    for (;;) {
        sum = 0u; cnt = 0u; mine = 0u;
#pragma unroll
        for (unsigned j = 0; j < 16; ++j) { const unsigned c = xb_ld(&bar[XB_XCNT(j)]); sum += c; cnt += (c > 0u) ? 1u : 0u; mine = (j == x) ? c : mine; }
        if (sum == G) break;
        __builtin_amdgcn_s_sleep(1);
        if ((++sp & 255u) == 0u) { if (xb_ld(&bar[XB_TMO])) break; if (sp > XB_SPIN_CAP) { atomicAdd(&bar[XB_TMO], 1u); break; } }
    }
    nloc = mine > 0u ? mine : 1u; nx = cnt > 0u ? cnt : 1u;
}
DI void xcd_barrier(const XcdBarrier& b) {
    asm volatile("s_waitcnt vmcnt(0)" ::: "memory");
    __syncthreads();
    if (threadIdx.x == 0) {
        unsigned* bar = b.bar;
        __builtin_amdgcn_s_waitcnt(0);
        unsigned nloc = b.st[0], nx = b.st[1];
        if (nloc == 0u) { xcd_barrier_complete(bar, b.x, nloc, nx); b.st[0] = nloc; b.st[1] = nx; }
        const unsigned old = xb_add(&bar[XB_XSUB(b.x)], 1u);
        const unsigned gen = old / nloc;
        if (old + 1u == (gen + 1u) * nloc) {
            __builtin_amdgcn_fence(__ATOMIC_RELEASE, "agent");
            asm volatile("s_waitcnt vmcnt(0)" ::: "memory");
            const unsigned og = xb_add(&bar[XB_TOP], 1u);
            const unsigned tg = og / nx;
            if (og + 1u == (tg + 1u) * nx) xb_add(&bar[XB_TOPGEN], 1u);
            else XB_SPIN(xb_ld(&bar[XB_TOPGEN]) == tg, bar);
            __builtin_amdgcn_fence(__ATOMIC_ACQUIRE, "agent");
            xb_add(&bar[XB_XGEN(b.x)], 1u);
            asm volatile("s_waitcnt vmcnt(0)" ::: "memory");
        } else {
            XB_SPIN(xb_ld(&bar[XB_XGEN(b.x)]) == gen, bar);
            __builtin_amdgcn_fence(__ATOMIC_ACQUIRE, "agent");
            asm volatile("s_waitcnt vmcnt(0)" ::: "memory");
        }
    }
    __syncthreads();
}

constexpr int N_PHASES = 23;
__global__ void __launch_bounds__(NTHR) fwd_kernel(Params p) {
    extern __shared__ __attribute__((aligned(16))) char smem[];
    volatile LAS unsigned* xst = (volatile LAS unsigned*)(smem + LDS_MAIN);
    if (threadIdx.x == 0) { xst[0] = 0u; xst[1] = 0u; }
    __syncthreads();
    const XcdBarrier xb = xcd_barrier_post((unsigned*)(p.ws + OFF_BAR), xst);
    asm volatile("s_nop 0\n\ts_nop 0");
#ifndef PH_MASK
#define PH_MASK 0xffff
#endif
#ifndef REP_MASK
#define REP_MASK 0
#endif
#ifndef PROBE_PH
#define PROBE_PH -1
#endif
    unsigned long long pt_prev = 0; int pt_ph = -100;
#define PROBE_TICK(ph) if (PROBE_PH >= 0) { const unsigned long long now_ = __builtin_amdgcn_s_memrealtime(); \
        if (pt_ph == PROBE_PH && blockIdx.x == 0 && threadIdx.x == 0) ((float*)(p.ws + OFF_BAR))[XCD_BAR_WORDS + 8] = (float)(now_ - pt_prev) * 0.01f; pt_prev = now_; pt_ph = (ph); }
#define RUN_PHASE(ph, bit, call) if (p.ph_lo <= (ph) && (ph) < p.ph_hi) { if ((ph) > p.ph_lo) xcd_barrier(xb); PROBE_TICK(ph) if (PH_MASK & (bit)) { call; if (REP_MASK & (bit)) { call; } } }
    RUN_PHASE(0, 1, phase_prep(p, smem))
    RUN_PHASE(1, 2, phase_norm<1>(p))
    RUN_PHASE(2, 4, phase_p1(p, smem))
    RUN_PHASE(4, 16, phase_mix(p, smem))
    RUN_PHASE(5, 32, phase_post(p, smem))
    RUN_PHASE(6, 64, phase_merge(p, smem))
    RUN_PHASE(7, 128, phase_out(p, smem))
    RUN_PHASE(8, 256, phase_norm<2>(p))
    RUN_PHASE(9, 512, phase_up(p, smem))
    RUN_PHASE(10, 1024, phase_fix(p))
    RUN_PHASE(21, 2048, phase_down(p, smem))
    RUN_PHASE(22, 4096, phase_norm<3>(p))
    if (PROBE_PH >= 0) {
        xcd_barrier(xb);
        PROBE_TICK(99)
        xcd_barrier(xb);
        const float val = ((const float*)(p.ws + OFF_BAR))[XCD_BAR_WORDS + 8];
        const float cc = sqrtf(fmaxf(1e-5f + val * 5e-7f, 0.f));
        for (int i = blockIdx.x * NTHR + threadIdx.x; i < MC * 128; i += gridDim.x * NTHR) p.out[OUT_V + i] *= (1.0f + cc);
    }
}

extern "C" void kernel_launch(void* const* d_in, const int* in_sizes, int n_in, void* d_out, int out_size, void* d_ws, size_t ws_size, hipStream_t stream) {
    static int grid = 0;
    if (grid == 0) {
        if (n_in != 32 || ws_size < WS_NEED) { fprintf(stderr, "kernel_launch: unexpected inputs (n_in %d, ws %zu, need %zu)\n", n_in, ws_size, (size_t)WS_NEED); grid = -1; return; }
        int dev = 0, cus = 0, per_cu = 0;
        hipGetDevice(&dev);
        hipDeviceGetAttribute(&cus, hipDeviceAttributeMultiprocessorCount, dev);
        hipFuncSetAttribute((const void*)fwd_kernel, hipFuncAttributeMaxDynamicSharedMemorySize, LDS_BYTES);
        hipOccupancyMaxActiveBlocksPerMultiprocessor(&per_cu, (const void*)fwd_kernel, NTHR, LDS_BYTES);
        if (per_cu < 1) { fprintf(stderr, "kernel_launch: occupancy query says %d blocks per CU\n", per_cu); grid = -1; return; }
        grid = cus;
        grid &= ~7;
    }
    if (grid < 0) return;
    if (hipMemsetAsync((char*)d_ws + OFF_BAR, 0, (XCD_BAR_WORDS + 64) * 4, stream) != hipSuccess) { fprintf(stderr, "kernel_launch: memset failed\n"); return; }
    Params p{};
    const float** pp = (const float**)&p;
    for (int i = 0; i < 32; ++i) pp[i] = (const float*)d_in[i];
    p.out = (float*)d_out; p.ws = (unsigned char*)d_ws;
#if N_LAUNCH_SPLIT
    for (int ph = 0; ph < N_PHASES; ++ph) {
        p.ph_lo = ph; p.ph_hi = ph + 1;
        hipLaunchKernelGGL(fwd_kernel, dim3(grid), dim3(NTHR), LDS_BYTES, stream, p);
    }
#else
    p.ph_lo = 0; p.ph_hi = N_PHASES;
    void* args[] = {&p};
    hipError_t e = hipLaunchCooperativeKernel((const void*)fwd_kernel, dim3(grid), dim3(NTHR), args, LDS_BYTES, stream);
    if (e != hipSuccess) fprintf(stderr, "cooperative launch failed: %s (grid %d)\n", hipGetErrorString(e), grid);
#endif
}
```

```cpp
#include <hip/hip_runtime.h>
#include <hip/hip_cooperative_groups.h>
#include <cstdio>
namespace cg = cooperative_groups;

#define DI __device__ __forceinline__
typedef unsigned short bf16_t;
typedef short bf16x8 __attribute__((ext_vector_type(8)));
typedef short s16x4 __attribute__((ext_vector_type(4)));
typedef float f32x4 __attribute__((ext_vector_type(4)));
typedef float f32x2 __attribute__((ext_vector_type(2)));
typedef float f32x16 __attribute__((ext_vector_type(16)));
typedef unsigned u32x4 __attribute__((ext_vector_type(4)));
typedef unsigned u32x2 __attribute__((ext_vector_type(2)));

#ifndef N_LAUNCH_SPLIT
#define N_LAUNCH_SPLIT 0
#endif

constexpr int NTHR = 512;
constexpr int D = 1024;
constexpr int MC = 8192;
constexpr int ML = 16384;
constexpr int M = MC + ML;
constexpr int WIN = 4736;
constexpr int ZRC = 1920;
constexpr int DFF = 2816;
constexpr int LDS_MAIN = 147456;
constexpr int LDS_BYTES = LDS_MAIN + 16;
constexpr float LOG2E = 1.4426950408889634f;

constexpr size_t al256(size_t x) { return (x + 255) & ~(size_t)255; }
constexpr size_t OFF_WUP   = 0;
constexpr size_t OFF_WDN   = OFF_WUP + al256((size_t)5632 * 1024 * 2);
constexpr size_t OFF_MOD   = OFF_WDN + al256((size_t)1024 * 2816 * 2);
constexpr size_t OFF_ROPE  = OFF_MOD + al256((size_t)9 * 6144 * 4);
constexpr size_t OFF_W2T   = OFF_ROPE + al256((size_t)64 * 16 * 8);
constexpr size_t OFF_A2T   = OFF_W2T + al256((size_t)2 * 512 * 64 * 2);
constexpr size_t OFF_G2T   = OFF_A2T + al256((size_t)2 * 512 * 64 * 2);
constexpr size_t OFF_KC    = OFF_G2T + al256((size_t)512 * 128 * 2);
constexpr size_t OFF_VCT   = OFF_KC + al256((size_t)8 * 512 * 128 * 2);
constexpr size_t OFF_BAR   = OFF_VCT + al256((size_t)8 * 512 * 128 * 2);
constexpr size_t OFF_H     = OFF_BAR + al256((size_t)(3456 + 64) * 4);
constexpr size_t OFF_X     = OFF_H + al256((size_t)M * 1024 * 2);
constexpr size_t OFF_WIN   = OFF_X;
constexpr size_t OFF_WPA   = OFF_WIN + al256((size_t)WIN * 1024 * 2);
constexpr size_t OFF_WPB   = OFF_WPA + al256((size_t)1024 * 512 * 2);
constexpr size_t OFF_WOUT  = OFF_WPB + al256((size_t)1024 * 512 * 2);
constexpr size_t OFF_Q     = OFF_WOUT + al256((size_t)1024 * 1024 * 2);
constexpr size_t OFF_RW    = OFF_Q;
constexpr size_t OFF_KB    = OFF_Q + al256((size_t)M * 512 * 2);
constexpr size_t OFF_VT    = OFF_KB + al256((size_t)M * 128 * 2);
constexpr size_t OFF_ATTN  = OFF_VT + al256((size_t)M * 128 * 2);
constexpr size_t OFF_SG    = OFF_ATTN + al256((size_t)M * 512 * 2);
constexpr size_t OFF_BN    = OFF_SG + al256((size_t)M * 128 * 2);
constexpr size_t OFF_YS    = OFF_BN + al256((size_t)M * 16 * 4);
constexpr size_t OFF_MRG   = OFF_YS;
constexpr size_t END_EARLY = OFF_YS + al256((size_t)2 * M * 512 * 4);
constexpr size_t OFF_ACT   = OFF_X;
constexpr size_t OFF_U     = OFF_ACT + al256((size_t)M * DFF * 2);
constexpr size_t END_FFN   = OFF_U + al256((size_t)96 * 44 * 4 * 128 * 2);
constexpr size_t OFF_XB    = END_FFN;
constexpr size_t END_XB    = OFF_XB + al256((size_t)M * 1024 * 2);
constexpr size_t WS_NEED   = END_EARLY > END_XB ? END_EARLY : END_XB;
static_assert(WS_NEED <= (size_t)256 * 1024 * 1024, "workspace over 256 MiB");

constexpr size_t OUT_Y  = 0;
constexpr size_t OUT_K  = (size_t)M * 1024;
constexpr size_t OUT_V  = OUT_K + (size_t)MC * 128;
constexpr size_t OUT_S  = OUT_V + (size_t)MC * 128;

struct Params {
    const float *x_prompt, *x_sample, *c, *cache_k, *cache_v, *state_rwkv, *c_ctx, *w_ada, *b_ada, *g_norm1, *w_in, *attn_sink,
        *w_proj_a, *w_proj_b, *rwkv_mu, *rwkv_w0, *rwkv_w2, *rwkv_a0, *rwkv_a2, *rwkv_k_k, *rwkv_k_a, *rwkv_r_k, *rwkv_g2,
        *rwkv_ln_g, *rwkv_ln_b, *w_out, *g_norm2, *w_ffn_up, *ffn_conv_w, *ffn_conv_b, *w_ffn_down, *g_final;
    float* out;
    unsigned char* ws;
    int ph_lo, ph_hi;
};

#define XCD_BAR_WORDS 3456
__device__ unsigned g_bar[XCD_BAR_WORDS + 64];
#define BAR_EXIT (XCD_BAR_WORDS + 32)
#define LAS __attribute__((address_space(3)))
DI bf16_t f2bf(float f) { unsigned u = __float_as_uint(f); u += 0x7fffu + ((u >> 16) & 1u); return (bf16_t)(u >> 16); }
DI float bf2f(unsigned b) { return __uint_as_float(b << 16); }
typedef __bf16 bf16v2_t __attribute__((ext_vector_type(2)));
DI unsigned pack2(float lo, float hi) { f32x2 v; v.x = lo; v.y = hi; return __builtin_bit_cast(unsigned, __builtin_convertvector(v, bf16v2_t)); }
DI u32x2 pack4(f32x4 v) { u32x2 r; r.x = pack2(v[0], v[1]); r.y = pack2(v[2], v[3]); return r; }
DI f32x4 unpack4(u32x2 v) { f32x4 r; r[0] = bf2f(v.x & 0xffffu); r[1] = bf2f(v.x >> 16); r[2] = bf2f(v.y & 0xffffu); r[3] = bf2f(v.y >> 16); return r; }
DI float rcpf_(float x) { return __builtin_amdgcn_rcpf(x); }
DI float sigmoidf_(float x) { return rcpf_(1.0f + __expf(-x)); }
DI float exp2f_(float x) { return __builtin_amdgcn_exp2f(x); }
DI const float* xrow(const Params& p, int r) { return r < MC ? p.x_prompt + (size_t)r * D : p.x_sample + (size_t)(r - MC) * D; }
DI int cond_of(int r) { return r < MC ? 0 : 1 + ((r - MC) >> 11); }
DI void seq_of(int r, int& r0, int& T) { if (r < MC) { r0 = r & ~255; T = 256; } else { r0 = MC + ((r - MC) & ~2047); T = 2048; } }
DI float wave_sum(float v) {
#pragma unroll
    for (int o = 32; o >= 1; o >>= 1) v += __shfl_xor(v, o);
    return v;
}

DI void transpose_tile(const float* __restrict__ src, int K, int N, bf16_t* __restrict__ dst, int kt, int nt, float* tile, int tid) {
    const int k0 = kt * 64, n0 = nt * 64;
#pragma unroll
    for (int i = 0; i < 8; ++i) { const int k = (tid >> 6) + 8 * i, n = tid & 63; tile[k * 65 + n] = src[(size_t)(k0 + k) * N + n0 + n]; }
    __syncthreads();
#pragma unroll
    for (int i = 0; i < 8; ++i) { const int n = (tid >> 6) + 8 * i, k = tid & 63; dst[(size_t)(n0 + n) * K + k0 + k] = f2bf(tile[k * 65 + n]); }
    __syncthreads();
}

constexpr int TR_WIN = 16 * 74, TR_LATE = 8 * 16 + 8 * 16 + 16 * 16 + 16 * 88 + 44 * 16, TR_TOTAL = TR_WIN + TR_LATE + 48;
DI void transpose_items(const Params& p, char* smem, int lo, int hi, int w0, int WW, int g_lo, int g_hi) {
    int tid = threadIdx.x;
    asm volatile("" : "+v"(tid));
    asm volatile("" : "+s"(w0), "+s"(WW));
    unsigned char* ws = p.ws;
    float* tile = (float*)smem;
    const int cnt[11] = {16 * 74, 8 * 16, 8 * 16, 16 * 16, 16 * 88, 44 * 16, 8, 8, 8, 8, 16};
    auto decode = [&](int it, const float*& src, bf16_t*& dst, int& K, int& N, int& kt, int& nt) {
        int i = it, mi = 0;
#pragma unroll
        for (int q = 0; q < 10; ++q) { if (mi == q && i >= cnt[q]) { i -= cnt[q]; mi = q + 1; } }
        switch (mi) {
            case 0: src = p.w_in; K = 1024; N = WIN; dst = (bf16_t*)(ws + OFF_WIN); break;
            case 1: src = p.w_proj_a; K = 512; N = 1024; dst = (bf16_t*)(ws + OFF_WPA); break;
            case 2: src = p.w_proj_b; K = 512; N = 1024; dst = (bf16_t*)(ws + OFF_WPB); break;
            case 3: src = p.w_out; K = 1024; N = 1024; dst = (bf16_t*)(ws + OFF_WOUT); break;
            case 4: src = p.w_ffn_up; K = 1024; N = 5632; dst = (bf16_t*)(ws + OFF_WUP); break;
            case 5: src = p.w_ffn_down; K = 2816; N = 1024; dst = (bf16_t*)(ws + OFF_WDN); break;
            case 6: src = p.rwkv_w2; K = 64; N = 512; dst = (bf16_t*)(ws + OFF_W2T); break;
            case 7: src = p.rwkv_w2 + 64 * 512; K = 64; N = 512; dst = (bf16_t*)(ws + OFF_W2T) + 512 * 64; break;
            case 8: src = p.rwkv_a2; K = 64; N = 512; dst = (bf16_t*)(ws + OFF_A2T); break;
            case 9: src = p.rwkv_a2 + 64 * 512; K = 64; N = 512; dst = (bf16_t*)(ws + OFF_A2T) + 512 * 64; break;
            default: src = p.rwkv_g2; K = 128; N = 512; dst = (bf16_t*)(ws + OFF_G2T); break;
        }
        const int ntn = N / 64; kt = i / ntn; nt = i % ntn;
    };
    auto item = [&](int k) { return lo + w0 + WW * k; };
    auto load_group = [&](int g, float (&v)[4][8]) {
#pragma unroll
        for (int u = 0; u < 4; ++u) {
            const int it = item(4 * g + u);
            if (it < hi) {
                const float* src; bf16_t* dst; int K, N, kt, nt; decode(it, src, dst, K, N, kt, nt);
#pragma unroll
                for (int i = 0; i < 8; ++i) v[u][i] = __builtin_nontemporal_load(src + (size_t)(kt * 64 + (tid >> 6) + 8 * i) * N + nt * 64 + (tid & 63));
            }
        }
    };
    auto flush_group = [&](int g, float (&v)[4][8]) {
#pragma unroll
        for (int u = 0; u < 4; ++u)
#pragma unroll
            for (int i = 0; i < 8; ++i) tile[u * 4160 + ((tid >> 6) + 8 * i) * 65 + (tid & 63)] = v[u][i];
        __syncthreads();
#pragma unroll
        for (int u = 0; u < 4; ++u) {
            const int it = item(4 * g + u);
            if (it < hi) {
                const float* src; bf16_t* dst; int K, N, kt, nt; decode(it, src, dst, K, N, kt, nt);
                const int kp = tid & 31;
#pragma unroll
                for (int i = 0; i < 4; ++i) {
                    const int n = (tid >> 5) + 16 * i;
                    *(unsigned*)(dst + (size_t)(nt * 64 + n) * K + kt * 64 + 2 * kp) = pack2(tile[u * 4160 + (2 * kp) * 65 + n], tile[u * 4160 + (2 * kp + 1) * 65 + n]);
                }
            }
        }
        __syncthreads();
    };
    float va[4][8], vb[4][8];
    auto group_live = [&](int g) { return g < g_hi && item(4 * g) < hi; };
    if (group_live(g_lo)) load_group(g_lo, va);
    for (int g = g_lo; group_live(g); g += 2) {
        if (group_live(g + 1)) load_group(g + 1, vb);
        flush_group(g, va);
        if (!group_live(g + 1)) break;
        if (group_live(g + 2)) load_group(g + 2, va);
        flush_group(g + 1, vb);
    }
}
DI void late_transposes(const Params& p, char* smem, int sh) { transpose_items(p, smem, TR_WIN, TR_WIN + TR_LATE, (int)blockIdx.x, (int)gridDim.x, sh, sh == 2 ? (1 << 20) : sh + 1); }

DI void phase_prep(const Params& p, char* smem) {
    const int tid = threadIdx.x, nb = gridDim.x, bid = blockIdx.x;
    unsigned char* ws = p.ws;
    {
        const int nada = nb >= 256 ? 96 : 0;
        if (bid < nb - nada || nada == 0) {
            transpose_items(p, smem, 0, TR_WIN, bid, nb - nada, 0, 1 << 20);
            transpose_items(p, smem, TR_WIN + TR_LATE, TR_TOTAL, bid, nb - nada, 0, 1 << 20);
        }
    }
    {
        bf16_t* kc = (bf16_t*)(ws + OFF_KC); bf16_t* vct = (bf16_t*)(ws + OFF_VCT);
        for (int i = bid * NTHR + tid; i < 8 * 512 * 128; i += nb * NTHR) {
            kc[i] = f2bf(p.cache_k[i]);
            const int key = i & 511, d = (i >> 9) & 63, kvh = (i >> 15) & 1, b = i >> 16;
            vct[i] = f2bf(p.cache_v[((size_t)(b * 512 + key) * 2 + kvh) * 64 + d]);
        }
    }
    {
        f32x2* tab = (f32x2*)(ws + OFF_ROPE);
        for (int i = bid * NTHR + tid; i < 1024; i += nb * NTHR) {
            const int pos = i >> 4, fi = i & 15;
            const float fr = exp2f(-(float)fi * 0.8304820237218406f), ang = (float)pos * fr;
            f32x2 v; v.x = cosf(ang); v.y = sinf(ang); tab[i] = v;
        }
    }
    {
        float* s = (float*)smem;
        float* red = (float*)(smem + 36864);
        float* mod = (float*)(ws + OFF_MOD);
        const int nada = nb >= 256 ? 96 : nb;
        for (int it = bid - (nb - nada); it >= 0 && it < 96; it += nada) {
            const int n4 = (tid & 15) * 4, kq = tid >> 4, n0 = it * 64;
            const float* wp = p.w_ada + (size_t)(kq * 32) * 6144 + n0 + n4;
            f32x4 wa[16], wb[16];
#pragma unroll
            for (int i = 0; i < 16; ++i) wa[i] = __builtin_nontemporal_load((const f32x4*)(wp + (size_t)i * 6144));
#pragma unroll
            for (int i = 0; i < 16; ++i) wb[i] = __builtin_nontemporal_load((const f32x4*)(wp + (size_t)(16 + i) * 6144));
            __syncthreads();
            for (int i = tid; i < 9 * 1024; i += NTHR) {
                const int ci = i >> 10, k = i & 1023;
                const float v = ci == 0 ? p.c_ctx[k] : p.c[(ci - 1) * 1024 + k];
                s[i] = v / (1.0f + __expf(-v));
            }
            __syncthreads();
            f32x4 acc[9];
#pragma unroll
            for (int ci = 0; ci < 9; ++ci) acc[ci] = (f32x4){0.f, 0.f, 0.f, 0.f};
#pragma unroll
            for (int i4 = 0; i4 < 4; ++i4)
#pragma unroll
                for (int ci = 0; ci < 9; ++ci) {
                    const f32x4 sa = *(const f32x4*)(s + ci * 1024 + kq * 32 + i4 * 4), sb = *(const f32x4*)(s + ci * 1024 + kq * 32 + 16 + i4 * 4);
#pragma unroll
                    for (int j = 0; j < 4; ++j) { acc[ci] += sa[j] * wa[i4 * 4 + j]; acc[ci] += sb[j] * wb[i4 * 4 + j]; }
                }
#pragma unroll
            for (int ci = 0; ci < 9; ++ci) *(f32x4*)(red + (kq * 9 + ci) * 64 + n4) = acc[ci];
            __syncthreads();
            for (int i = tid; i < 9 * 64; i += NTHR) {
                const int ci = i >> 6, nn = i & 63;
                float v = p.b_ada[n0 + nn];
#pragma unroll
                for (int q = 0; q < 32; ++q) v += red[(q * 9 + ci) * 64 + nn];
                mod[ci * 6144 + n0 + nn] = v;
            }
        }
        __syncthreads();
    }
}

template <int WHICH> DI void phase_norm(const Params& p) {
    const int tid = threadIdx.x, lane = tid & 63, wv = tid >> 6;
    const float* mod = (const float*)(p.ws + OFF_MOD);
    bf16_t* hb = (bf16_t*)(p.ws + OFF_H);
    const int ntask = M / 4;
    for (int task = blockIdx.x * 8 + wv; task < ntask; task += gridDim.x * 8) {
        const int r_first = task * 4, ci = cond_of(r_first);
        f32x4 xf[4][4]; u32x2 xh[4][4];
#pragma unroll
        for (int rr = 0; rr < 4; ++rr) {
            const int r = r_first + rr;
            const float* src = xrow(p, r);
            const bf16_t* srb = (const bf16_t*)(p.ws + OFF_XB) + (size_t)r * D;
#pragma unroll
            for (int i = 0; i < 4; ++i) {
                if (WHICH == 1) xf[rr][i] = __builtin_nontemporal_load((const f32x4*)(src + i * 256 + lane * 4));
                else xh[rr][i] = *(const u32x2*)(srb + i * 256 + lane * 4);
            }
        }
        f32x4 fa[4], fb[4];
#pragma unroll
        for (int i = 0; i < 4; ++i) {
            const int col = i * 256 + lane * 4;
            if (WHICH == 3) { fa[i] = *(const f32x4*)(p.g_final + col); fb[i] = (f32x4){0.f, 0.f, 0.f, 0.f}; }
            else {
                const f32x4 g = *(const f32x4*)((WHICH == 1 ? p.g_norm1 : p.g_norm2) + col);
                const f32x4 sc = *(const f32x4*)(mod + ci * 6144 + (WHICH == 1 ? 1024 : 4096) + col);
                fb[i] = *(const f32x4*)(mod + ci * 6144 + (WHICH == 1 ? 0 : 3072) + col);
                fa[i] = g * (sc + 1.0f);
            }
        }
#pragma unroll
        for (int rr = 0; rr < 4; ++rr) {
            const int r = r_first + rr;
            f32x4 v[4]; float ss = 0.f;
#pragma unroll
            for (int i = 0; i < 4; ++i) {
                v[i] = WHICH == 1 ? xf[rr][i] : unpack4(xh[rr][i]);
                ss += v[i][0] * v[i][0] + v[i][1] * v[i][1] + v[i][2] * v[i][2] + v[i][3] * v[i][3];
            }
            ss = wave_sum(ss);
            const float rstd = __builtin_amdgcn_rsqf(ss * (1.0f / 1024.0f) + 1e-6f);
#pragma unroll
            for (int i = 0; i < 4; ++i) {
                const f32x4 o = v[i] * rstd * fa[i] + fb[i];
                if (WHICH == 3) __builtin_nontemporal_store(o, (f32x4*)(p.out + OUT_Y + (size_t)r * D + i * 256 + lane * 4));
                else *(u32x2*)(hb + (size_t)r * D + i * 256 + lane * 4) = pack4(o);
            }
        }
    }
}

template <int NB, int BMAP> DI void gemm_stage(const bf16_t* A, int lda, const bf16_t* Bt, int ldb, int k0, char* sbuf, int tid) {
#pragma unroll
    for (int i = 0; i < 4; ++i) {
        const int c = tid + i * 512, row = c >> 3, pos = c & 7, kc = pos ^ ((row >> 1) & 7);
        __builtin_amdgcn_global_load_lds((const unsigned*)(A + (size_t)row * lda + k0 + kc * 8), (unsigned*)(sbuf + c * 16), 16, 0, 0);
    }
#pragma unroll
    for (int i = 0; i < NB / 2; ++i) {
        const int c = tid + i * 512, row = c >> 3, pos = c & 7, kc = pos ^ ((row >> 1) & 7);
        const int brow = BMAP ? (((row >> 5) & 1) * BMAP + (row >> 6) * 32 + (row & 31)) : row;
        __builtin_amdgcn_global_load_lds((const unsigned*)(Bt + (size_t)brow * ldb + k0 + kc * 8), (unsigned*)(sbuf + 32768 + c * 16), 16, 0, 0);
    }
}
template <int NB, int BMAP = 0> DI void gemm_pre(const bf16_t* A, int lda, const bf16_t* Bt, int ldb, int K, char* smem, int tid) {
    gemm_stage<NB, BMAP>(A, lda, Bt, ldb, 0, smem, tid);
    if (K > 64) gemm_stage<NB, BMAP>(A, lda, Bt, ldb, 64, smem + 49152, tid);
}
template <int NB, int BMAP = 0, bool PRE = false> DI void gemm_acc(f32x4 (&acc)[4][NB], const bf16_t* A, int lda, const bf16_t* Bt, int ldb, int K, char* smem, int tid) {
    const int wid = tid >> 6, lane = tid & 63, fr = lane & 15, fq = lane >> 4, wr = wid >> 1, wc = wid & 1;
    const int swz = (fr >> 1) & 7;
    const int nk = K >> 6;
    if (!PRE) {
        __syncthreads();
        gemm_stage<NB, BMAP>(A, lda, Bt, ldb, 0, smem, tid);
        if (nk > 1) gemm_stage<NB, BMAP>(A, lda, Bt, ldb, 64, smem + 49152, tid);
    }
    int cur = 0;
#pragma unroll 1
    for (int t = 0; t < nk; ++t) {
        if (t + 1 < nk) { if (NB == 4) asm volatile("s_waitcnt vmcnt(6)" ::: "memory"); else asm volatile("s_waitcnt vmcnt(5)" ::: "memory"); }
        else asm volatile("s_waitcnt vmcnt(0)" ::: "memory");
        __builtin_amdgcn_s_barrier();
        asm volatile("" ::: "memory");
        const int nxt2 = cur >= 1 ? cur - 1 : 2;
        const bool late = __builtin_amdgcn_readfirstlane(wid) >= 4;
        if (t + 2 < nk && !late) gemm_stage<NB, BMAP>(A, lda, Bt, ldb, (t + 2) * 64, smem + nxt2 * 49152, tid);
        const char* sA = smem + cur * 49152;
        const char* sB = sA + 32768;
#pragma unroll
        for (int ks = 0; ks < 2; ++ks) {
            if (ks == 1 && t + 2 < nk && late) gemm_stage<NB, BMAP>(A, lda, Bt, ldb, (t + 2) * 64, smem + nxt2 * 49152, tid);
            bf16x8 af[4], bfr[NB];
            const int coff = ((ks * 4 + fq) ^ swz) << 4;
#pragma unroll
            for (int mb = 0; mb < 4; ++mb) af[mb] = *(const bf16x8*)(sA + (wr * 64 + mb * 16 + fr) * 128 + coff);
#pragma unroll
            for (int nb = 0; nb < NB; ++nb) bfr[nb] = *(const bf16x8*)(sB + (wc * 16 * NB + nb * 16 + fr) * 128 + coff);
            __builtin_amdgcn_s_setprio(1);
#pragma unroll
            for (int mb = 0; mb < 4; ++mb)
#pragma unroll
                for (int nb = 0; nb < NB; ++nb) acc[mb][nb] = __builtin_amdgcn_mfma_f32_16x16x32_bf16(bfr[nb], af[mb], acc[mb][nb], 0, 0, 0);
            __builtin_amdgcn_s_setprio(0);
        }
        cur = cur == 2 ? 0 : cur + 1;
    }
}
template <int BMAP> DI void gemm_stage8(const bf16_t* A, int lda, const bf16_t* Bt, int ldb, int k0, char* sbuf, int tid) {
    const int r0 = tid >> 3, kcs = (tid & 7) ^ ((r0 >> 1) & 7);
    const unsigned offA = (unsigned)(r0 * lda + kcs * 8), offB = (unsigned)(r0 * ldb + kcs * 8);
    char* dst = sbuf + tid * 16;
#pragma unroll
    for (int i = 0; i < 4; ++i)
        __builtin_amdgcn_global_load_lds((const unsigned*)(A + (size_t)(64 * i) * lda + k0 + offA), (unsigned*)(dst + i * 8192), 16, 0, 0);
#pragma unroll
    for (int i = 0; i < 4; ++i) {
        const int urow = BMAP ? (i & 1) * BMAP + (i >> 1) * 64 : 64 * i;
        __builtin_amdgcn_global_load_lds((const unsigned*)(Bt + (size_t)urow * ldb + k0 + offB), (unsigned*)(dst + 32768 + i * 8192), 16, 0, 0);
    }
}
template <int BMAP> DI void gemm_pre8(const bf16_t* A, int lda, const bf16_t* Bt, int ldb, char* smem, int tid) { gemm_stage8<BMAP>(A, lda, Bt, ldb, 0, smem, tid); }
template <int BMAP, bool PRE = false> DI void gemm_acc8(f32x4 (&acc)[4][8], const bf16_t* A, int lda, const bf16_t* Bt, int ldb, int K, char* smem, int tid) {
    const int wid = tid >> 6, lane = tid & 63, fr = lane & 15, fq = lane >> 4, wr = wid >> 1, wc = wid & 1;
    const int swz = (fr >> 1) & 7;
    const int nk = K >> 6;
    if (!PRE) { __syncthreads(); gemm_stage8<BMAP>(A, lda, Bt, ldb, 0, smem, tid); }
    const bool late = __builtin_amdgcn_readfirstlane(wid) >= 4;
#pragma unroll 1
    for (int t = 0; t < nk; ++t) {
        asm volatile("s_waitcnt vmcnt(0)" ::: "memory");
        __builtin_amdgcn_s_barrier();
        asm volatile("" ::: "memory");
        char* sN = smem + ((t + 1) & 1) * 65536;
        if (t + 1 < nk && !late) gemm_stage8<BMAP>(A, lda, Bt, ldb, (t + 1) * 64, sN, tid);
        const char* sA = smem + (t & 1) * 65536;
        const char* sB = sA + 32768;
#pragma unroll
        for (int ks = 0; ks < 2; ++ks) {
            if (ks == 1 && t + 1 < nk && late) gemm_stage8<BMAP>(A, lda, Bt, ldb, (t + 1) * 64, sN, tid);
            bf16x8 af[4], bfr[8];
            const int coff = ((ks * 4 + fq) ^ swz) << 4;
#pragma unroll
            for (int mb = 0; mb < 4; ++mb) af[mb] = *(const bf16x8*)(sA + (wr * 64 + mb * 16 + fr) * 128 + coff);
#pragma unroll
            for (int nb = 0; nb < 8; ++nb) bfr[nb] = *(const bf16x8*)(sB + (wc * 128 + nb * 16 + fr) * 128 + coff);
            __builtin_amdgcn_s_setprio(1);
#pragma unroll
            for (int mb = 0; mb < 4; ++mb)
#pragma unroll
                for (int nb = 0; nb < 8; ++nb) acc[mb][nb] = __builtin_amdgcn_mfma_f32_16x16x32_bf16(bfr[nb], af[mb], acc[mb][nb], 0, 0, 0);
            __builtin_amdgcn_s_setprio(0);
        }
    }
}
template <int NB> DI void zero_acc(f32x4 (&acc)[4][NB]) {
#pragma unroll
    for (int a = 0; a < 4; ++a)
#pragma unroll
        for (int b = 0; b < NB; ++b) acc[a][b] = (f32x4){0.f, 0.f, 0.f, 0.f};
}
DI void tile_coords(int t, int MT, int NT, int& mt, int& nt) {
    const int x = t & 7, u = t >> 3, mpx = MT >> 3;
    const int bm = (mpx % 4 == 0) ? 4 : ((mpx % 2 == 0) ? 2 : 1);
    const int per_band = bm * NT, band = u / per_band, rem = u - band * per_band;
    nt = rem / bm; mt = x * mpx + band * bm + (rem % bm);
}


DI void gemm_stage192(const bf16_t* A, int lda, const bf16_t* Bt, int ldb, int k0, char* sbuf, int tid) {
    const int r0 = tid >> 3, kcs = (tid & 7) ^ ((r0 >> 1) & 7);
    const unsigned offA = (unsigned)(r0 * lda + kcs * 8), offB = (unsigned)(r0 * ldb + kcs * 8);
    char* dst = sbuf + tid * 16;
#pragma unroll
    for (int i = 0; i < 3; ++i)
        __builtin_amdgcn_global_load_lds((const unsigned*)(A + (size_t)(64 * i) * lda + k0 + offA), (unsigned*)(dst + i * 8192), 16, 0, 0);
#pragma unroll
    for (int i = 0; i < 4; ++i)
        __builtin_amdgcn_global_load_lds((const unsigned*)(Bt + (size_t)(64 * i) * ldb + k0 + offB), (unsigned*)(dst + 32768 + i * 8192), 16, 0, 0);
}
DI void gemm_acc192(f32x4 (&acc)[3][8], const bf16_t* A, int lda, const bf16_t* Bt, int ldb, int K, char* smem, int tid) {
    const int wid = tid >> 6, lane = tid & 63, fr = lane & 15, fq = lane >> 4, wr = wid >> 1, wc = wid & 1;
    const int swz = (fr >> 1) & 7;
    const int nk = K >> 6;
    __syncthreads();
    gemm_stage192(A, lda, Bt, ldb, 0, smem, tid);
    const bool late = __builtin_amdgcn_readfirstlane(wid) >= 4;
#pragma unroll 1
    for (int t = 0; t < nk; ++t) {
        asm volatile("s_waitcnt vmcnt(0)" ::: "memory");
        __builtin_amdgcn_s_barrier();
        asm volatile("" ::: "memory");
        char* sN = smem + ((t + 1) & 1) * 65536;
        if (t + 1 < nk && !late) gemm_stage192(A, lda, Bt, ldb, (t + 1) * 64, sN, tid);
        const char* sA = smem + (t & 1) * 65536;
        const char* sB = sA + 32768;
#pragma unroll
        for (int ks = 0; ks < 2; ++ks) {
            if (ks == 1 && t + 1 < nk && late) gemm_stage192(A, lda, Bt, ldb, (t + 1) * 64, sN, tid);
            bf16x8 af[3], bfr[8];
            const int coff = ((ks * 4 + fq) ^ swz) << 4;
#pragma unroll
            for (int mb = 0; mb < 3; ++mb) af[mb] = *(const bf16x8*)(sA + (wr * 48 + mb * 16 + fr) * 128 + coff);
#pragma unroll
            for (int nb = 0; nb < 8; ++nb) bfr[nb] = *(const bf16x8*)(sB + (wc * 128 + nb * 16 + fr) * 128 + coff);
            __builtin_amdgcn_s_setprio(1);
#pragma unroll
            for (int mb = 0; mb < 3; ++mb)
#pragma unroll
                for (int nb = 0; nb < 8; ++nb) acc[mb][nb] = __builtin_amdgcn_mfma_f32_16x16x32_bf16(bfr[nb], af[mb], acc[mb][nb], 0, 0, 0);
            __builtin_amdgcn_s_setprio(0);
        }
    }
}

DI void gemm_stage320(const bf16_t* A, int lda, const bf16_t* Bt, int ldb, int k0, char* sbuf, int tid) {
    const int r0 = tid >> 3, kcs = (tid & 7) ^ ((r0 >> 1) & 7);
    const unsigned offA = (unsigned)(r0 * lda + kcs * 8), offB = (unsigned)(r0 * ldb + kcs * 8);
    char* dst = sbuf + tid * 16;
#pragma unroll
    for (int i = 0; i < 3; ++i)
        __builtin_amdgcn_global_load_lds((const unsigned*)(A + (size_t)(64 * i) * lda + k0 + offA), (unsigned*)(dst + i * 8192), 16, 0, 0);
#pragma unroll
    for (int i = 0; i < 5; ++i)
        __builtin_amdgcn_global_load_lds((const unsigned*)(Bt + (size_t)(64 * i) * ldb + k0 + offB), (unsigned*)(dst + 24576 + i * 8192), 16, 0, 0);
}
DI void gemm_acc320(f32x4 (&acc)[3][10], const bf16_t* A, int lda, const bf16_t* Bt, int ldb, int K, char* smem, int tid) {
    const int wid = tid >> 6, lane = tid & 63, fr = lane & 15, fq = lane >> 4, wr = wid >> 1, wc = wid & 1;
    const int swz = (fr >> 1) & 7;
    const int nk = K >> 6;
    __syncthreads();
    gemm_stage320(A, lda, Bt, ldb, 0, smem, tid);
    const bool late = __builtin_amdgcn_readfirstlane(wid) >= 4;
#pragma unroll 1
    for (int t = 0; t < nk; ++t) {
        asm volatile("s_waitcnt vmcnt(0)" ::: "memory");
        __builtin_amdgcn_s_barrier();
        asm volatile("" ::: "memory");
        char* sN = smem + ((t + 1) & 1) * 65536;
        if (t + 1 < nk && !late) gemm_stage320(A, lda, Bt, ldb, (t + 1) * 64, sN, tid);
        const char* sA = smem + (t & 1) * 65536;
        const char* sB = sA + 24576;
#pragma unroll
        for (int ks = 0; ks < 2; ++ks) {
            if (ks == 1 && t + 1 < nk && late) gemm_stage320(A, lda, Bt, ldb, (t + 1) * 64, sN, tid);
            bf16x8 af[3], bfr[10];
            const int coff = ((ks * 4 + fq) ^ swz) << 4;
#pragma unroll
            for (int mb = 0; mb < 3; ++mb) af[mb] = *(const bf16x8*)(sA + (wr * 48 + mb * 16 + fr) * 128 + coff);
#pragma unroll
            for (int nb = 0; nb < 10; ++nb) bfr[nb] = *(const bf16x8*)(sB + (wc * 160 + nb * 16 + fr) * 128 + coff);
            __builtin_amdgcn_s_setprio(1);
#pragma unroll
            for (int mb = 0; mb < 3; ++mb)
#pragma unroll
                for (int nb = 0; nb < 10; ++nb) acc[mb][nb] = __builtin_amdgcn_mfma_f32_16x16x32_bf16(bfr[nb], af[mb], acc[mb][nb], 0, 0, 0);
            __builtin_amdgcn_s_setprio(0);
        }
    }
}

namespace pg8 {
#define PG8_LAS __attribute__((address_space(3)))
constexpr int BM = 256, BK = 64, HALF = 128, HTB = HALF * BK * 2  , STAGE_BYTES = 8 * HTB, NXCD = 8, WGM = 8;
__host__ __device__ __forceinline__ int lds_byte(int r, int c) { const int st = (r >> 4) * 2 + (c >> 5), rr = r & 15, cc = c & 31, ob = rr * 64 + cc * 2; return st * 1024 + (ob ^ (((ob >> 9) & 1) << 5)); }
__host__ __device__ __forceinline__ void stage_rc(int b, int& R, int& C) { const int st = b / 1024, sb = b % 1024, swz = sb ^ (((sb >> 9) & 1) << 5); R = (st >> 1) * 16 + swz / 64; C = (st & 1) * 32 + (swz % 64) / 2; }
__host__ __device__ __forceinline__ int perm32(int rho) { const int n = rho >> 4, i = rho & 15; return 8 * (i >> 2) + 4 * n + (i & 3); }


struct Unit { int pm, pn, brow; };
struct Gemm8 { const bf16_t* A; const bf16_t* Bt; int K; int bhalf; };
__device__ __forceinline__ void unit_of(int L, int nM, int nN, int& pm, int& pn) {
    const int nwg = nM * nN;
    int wgid = L; { const int q = nwg / NXCD, r = nwg % NXCD, xcd = wgid % NXCD, off = wgid / NXCD; wgid = (xcd < r ? xcd * (q + 1) : r * (q + 1) + (xcd - r) * q) + off; }
    const int nig = WGM * nN, gid = wgid / nig, fm = gid * WGM, gsz = (nM - fm) < WGM ? (nM - fm) : WGM;
    pm = fm + ((wgid % nig) % gsz); pn = (wgid % nig) / gsz;
}
struct Order8 {
    int nM, nN, nlim, G, c, p1map;
    __device__ __forceinline__ bool next(int i, Unit& u) const {
        const long L = (long)i * G + c; if (L >= nlim) return false;
        unit_of((int)L, nM, nN, u.pm, u.pn); u.brow = p1map ? (u.pn < 3 ? u.pn * 256 : 2816 + (u.pn - 3) * 256) : u.pn * 256; return true;
    }
    __device__ __forceinline__ void a_ready(const Unit&) const {}
    __device__ __forceinline__ void done(const Unit&) const {}
};
template <class Epi, class Sched>
__device__ __forceinline__ void gemm8(PG8_LAS unsigned char* lds, const Gemm8 g, const Sched& S, const Epi& E) {
    int tid_ = threadIdx.x;
    asm volatile("" : "+v"(tid_));
    const int tid = tid_, wid = __builtin_amdgcn_readfirstlane(tid >> 6), lane = tid & 63, wr = wid >> 2, wc = wid & 3, fr = lane & 15, fq = lane >> 4;
    const int K = g.K, nt = K / BK;
    unsigned voffA[2], voffB[2];
#pragma unroll
    for (int i = 0; i < 2; ++i) { int R, C; stage_rc(tid * 16 + i * 8192, R, C); const int Rb = Epi::PERM ? ((R & ~31) + perm32(R & 31)) : R;
        voffA[i] = (unsigned)(R * K + C) * 2u; voffB[i] = (unsigned)(Rb * K + C) * 2u; }
    const size_t kstep = (size_t)(BK * 2);
    const size_t hstep = (size_t)HALF * K * 2;
    const size_t tstep = 2 * hstep;
    const size_t hstepB = (size_t)g.bhalf * K * 2;
    const size_t rowB = (size_t)K * 2;
    const unsigned ldsw = (unsigned)wid * 1024u;
    const int aoff = lds_byte(wr * 64 + fr, fq * 8), boff = lds_byte(wc * 32 + fr, fq * 8);
#define PG8_SA(b, h) (((b) * 2 + (h)) * HTB)
#define PG8_SB(b, h) ((4 + (b) * 2 + (h)) * HTB)
#define PG8_STAGE(bufoff, gbase, voff) do { _Pragma("unroll") for (int _i = 0; _i < 2; ++_i) \
        __builtin_amdgcn_global_load_lds((const unsigned*)((const char*)(gbase) + (voff)[_i]), (PG8_LAS unsigned*)(lds + (bufoff) + ldsw + _i * 8192), 16, 0, 0); } while (0)
#define PG8_LDA(dst, b, h) do { _Pragma("unroll") for (int m = 0; m < 4; ++m) _Pragma("unroll") for (int k = 0; k < 2; ++k) dst[m][k] = *(const PG8_LAS bf16x8*)(lds + PG8_SA(b, h) + aoff + m * 2048 + k * 1024); } while (0)
#define PG8_LDB(dst, b, h) do { _Pragma("unroll") for (int n = 0; n < 2; ++n) _Pragma("unroll") for (int k = 0; k < 2; ++k) dst[n][k] = *(const PG8_LAS bf16x8*)(lds + PG8_SB(b, h) + boff + n * 2048 + k * 1024); } while (0)
#define PG8_MMA(ai, bj, At, Bt) do { __builtin_amdgcn_s_setprio(1); _Pragma("unroll") for (int m = 0; m < 4; ++m) _Pragma("unroll") for (int n = 0; n < 2; ++n) _Pragma("unroll") for (int k = 0; k < 2; ++k) \
        acc[ai][bj][m][n] = __builtin_amdgcn_mfma_f32_16x16x32_bf16(Bt[n][k], At[m][k], acc[ai][bj][m][n], 0, 0, 0); __builtin_amdgcn_s_setprio(0); } while (0)
#define PG8_WAIT_V(n) asm volatile("s_waitcnt vmcnt(" #n ")" ::: "memory")
#define PG8_WAIT_L(n) asm volatile("s_waitcnt lgkmcnt(" #n ")" ::: "memory")
#define PG8_BAR __builtin_amdgcn_s_barrier()
#define PG8_SCHED __builtin_amdgcn_sched_barrier(0)
    Unit cur, nxt; int ui = 0;
    if (!S.next(0, cur)) return;
    f32x4 acc[2][2][4][2];
#pragma unroll
    for (int a = 0; a < 2; ++a)
#pragma unroll
        for (int b = 0; b < 2; ++b)
#pragma unroll
            for (int m = 0; m < 4; ++m)
#pragma unroll
                for (int n = 0; n < 2; ++n) acc[a][b][m][n] = (f32x4){0.f, 0.f, 0.f, 0.f};
    bf16x8 At[4][2], B0[2][2], B1[2][2];
    const char* cA = (const char*)g.A + (size_t)cur.pm * tstep; const char* cB = (const char*)g.Bt + (size_t)cur.brow * rowB;
    S.a_ready(cur);
    PG8_STAGE(PG8_SB(0, 0), cB, voffB); PG8_STAGE(PG8_SA(0, 0), cA, voffA); PG8_STAGE(PG8_SB(0, 1), cB + hstepB, voffB); PG8_STAGE(PG8_SA(0, 1), cA + hstep, voffA);
    if (wr == 1) PG8_BAR;
    PG8_WAIT_V(4); PG8_BAR;
    PG8_STAGE(PG8_SB(1, 0), cB + kstep, voffB); PG8_STAGE(PG8_SA(1, 0), cA + kstep, voffA); PG8_STAGE(PG8_SB(1, 1), cB + hstepB + kstep, voffB);
    PG8_WAIT_V(6); PG8_BAR;
    for (;;) {
        const bool has_next = S.next(ui + 1, nxt);
        const char* nA = has_next ? (const char*)g.A + (size_t)nxt.pm * tstep : cA; const char* nB = has_next ? (const char*)g.Bt + (size_t)nxt.brow * rowB : cB;
        for (int t = 0; t < nt; t += 2) {
            const bool last = (t == nt - 2);
            const char* a1 = cA + (size_t)(t + 1) * kstep;
            const char* a2 = last ? nA : cA + (size_t)(t + 2) * kstep; const char* b2 = last ? nB : cB + (size_t)(t + 2) * kstep;
            const char* a3 = a2 + kstep; const char* b3 = b2 + kstep;
            if (last && has_next) S.a_ready(nxt);
            PG8_LDB(B0, 0, 0); PG8_SCHED; PG8_LDA(At, 0, 0); PG8_STAGE(PG8_SA(1, 1), a1 + hstep, voffA);
            PG8_WAIT_L(8); PG8_BAR; PG8_WAIT_L(0); PG8_MMA(0, 0, At, B0); PG8_BAR; PG8_SCHED;
            PG8_LDB(B1, 0, 1); PG8_STAGE(PG8_SB(0, 0), b2, voffB);
            PG8_BAR; PG8_WAIT_L(0); PG8_MMA(0, 1, At, B1); PG8_BAR;
            PG8_LDA(At, 0, 1); PG8_STAGE(PG8_SA(0, 0), a2, voffA);
            PG8_BAR; PG8_WAIT_L(0); PG8_MMA(1, 0, At, B0); PG8_BAR; PG8_SCHED;
            PG8_STAGE(PG8_SB(0, 1), b2 + hstepB, voffB);
            PG8_WAIT_V(6); PG8_BAR; PG8_MMA(1, 1, At, B1); PG8_BAR;
            PG8_LDB(B0, 1, 0); PG8_SCHED; PG8_LDA(At, 1, 0); PG8_STAGE(PG8_SA(0, 1), a2 + hstep, voffA);
            PG8_WAIT_L(8); PG8_BAR; PG8_WAIT_L(0); PG8_MMA(0, 0, At, B0); PG8_BAR; PG8_SCHED;
            PG8_LDB(B1, 1, 1); PG8_STAGE(PG8_SB(1, 0), b3, voffB);
            PG8_BAR; PG8_WAIT_L(0); PG8_MMA(0, 1, At, B1); PG8_BAR;
            PG8_LDA(At, 1, 1); PG8_STAGE(PG8_SA(1, 0), a3, voffA);
            PG8_BAR; PG8_WAIT_L(0); PG8_MMA(1, 0, At, B0); PG8_BAR; PG8_SCHED;
            PG8_STAGE(PG8_SB(1, 1), b3 + hstepB, voffB);
            PG8_WAIT_V(6); PG8_BAR; PG8_MMA(1, 1, At, B1); PG8_BAR;
        }
        if constexpr (!Epi::AFTER_DRAIN) { E(acc, cur, wr, wc, fr, fq); S.done(cur); }
        if (!has_next) break;
#pragma unroll
        for (int a = 0; a < 2; ++a)
#pragma unroll
            for (int b = 0; b < 2; ++b)
#pragma unroll
                for (int m = 0; m < 4; ++m)
#pragma unroll
                    for (int n = 0; n < 2; ++n) acc[a][b][m][n] = (f32x4){0.f, 0.f, 0.f, 0.f};
        cur = nxt; cA = nA; cB = nB; ++ui;
    }
    PG8_WAIT_V(0);
    if (wr == 0) PG8_BAR;
    PG8_BAR;
    if constexpr (Epi::AFTER_DRAIN) { E.fused(acc, cur, wr, wc, fr, fq, lds, wid, lane); S.done(cur); }
#undef PG8_SA
#undef PG8_SB
#undef PG8_STAGE
#undef PG8_LDA
#undef PG8_LDB
#undef PG8_MMA
#undef PG8_WAIT_V
#undef PG8_WAIT_L
#undef PG8_BAR
#undef PG8_SCHED
}

}

DI void p1_tile(const Params& p, char* smem, int mt, int nt) {
    const int tid = threadIdx.x, wid = tid >> 6, lane = tid & 63, fr = lane & 15, fq = lane >> 4, wr = wid >> 1, wc = wid & 1;
    unsigned char* ws = p.ws;
    const bf16_t* hb = (const bf16_t*)(ws + OFF_H);
    const bf16_t* wt = (const bf16_t*)(ws + OFF_WIN);
    const f32x2* tab = (const f32x2*)(ws + OFF_ROPE);
    bf16_t* qb = (bf16_t*)(ws + OFF_Q); bf16_t* kb = (bf16_t*)(ws + OFF_KB); bf16_t* vT = (bf16_t*)(ws + OFF_VT);
    bf16_t* zr = (bf16_t*)(p.out + OUT_Y);
    {
        const int row0 = mt * 256, ncol0 = nt < 6 ? nt * 128 : 2816 + (nt - 6) * 128;
        f32x4 acc[4][4]; zero_acc<4>(acc);
        gemm_acc<4>(acc, hb + (size_t)row0 * 1024, 1024, wt + (size_t)ncol0 * 1024, 1024, 1024, smem, tid);
        const bool latent = row0 >= MC;
#pragma unroll
        for (int mb = 0; mb < 4; ++mb) {
            const int m = row0 + wr * 64 + mb * 16 + fr;
            if (nt < 5 && latent) {
                const int tt = (m - MC) & 2047, prow = tt >> 6, pcol = tt & 63;
#pragma unroll
                for (int j = 0; j < 4; ++j) {
                    const f32x2 cr = tab[prow * 16 + fq * 4 + j], cc = tab[pcol * 16 + fq * 4 + j];
                    const float a1 = acc[mb][0][j], a2 = acc[mb][1][j], b1 = acc[mb][2][j], b2 = acc[mb][3][j];
                    acc[mb][0][j] = a1 * cr.x - a2 * cr.y; acc[mb][1][j] = a2 * cr.x + a1 * cr.y;
                    acc[mb][2][j] = b1 * cc.x - b2 * cc.y; acc[mb][3][j] = b2 * cc.x + b1 * cc.y;
                }
            }
#pragma unroll
            for (int nb = 0; nb < 4; ++nb) {
                const int nl = wc * 64 + nb * 16 + fq * 4;
                const f32x4 v = acc[mb][nb];
                if (nt < 4) { *(u32x2*)(qb + (size_t)m * 512 + nt * 128 + nl) = pack4(v); }
                else if (nt == 4) {
                    if (!latent) *(f32x4*)(p.out + OUT_K + (size_t)m * 128 + nl) = v;
                    *(u32x2*)(kb + (size_t)m * 128 + nl) = pack4(v);
                } else if (nt == 5) {
                    if (!latent) *(f32x4*)(p.out + OUT_V + (size_t)m * 128 + nl) = v;
                    int r0, T; seq_of(m, r0, T);
#pragma unroll
                    for (int j = 0; j < 4; ++j) vT[(size_t)r0 * 128 + (size_t)(nl + j) * T + (m - r0)] = f2bf(v[j]);
                } else { *(u32x2*)(zr + (size_t)m * ZRC + (nt - 6) * 128 + nl) = pack4(v); }
            }
        }
    }
}
struct EpiP1 {
    static constexpr bool PERM = false, AFTER_DRAIN = false;
    float* out; bf16_t *qb, *kb, *vT, *zr; const f32x2* tab;
    __device__ __forceinline__ void operator()(const f32x4 (&acc)[2][2][4][2], const pg8::Unit& u, int wr, int wc, int fr, int fq) const {
        const bool latent = u.pm * 256 >= MC;
        int r0, T; seq_of(u.pm * 256, r0, T);
#pragma unroll
        for (int ai = 0; ai < 2; ++ai)
#pragma unroll
            for (int m = 0; m < 4; ++m) {
                const int row = u.pm * 256 + ai * 128 + wr * 64 + m * 16 + fr;
                const int tt = (row - MC) & 2047, pos = (wc & 1) ? (tt & 63) : (tt >> 6);
#pragma unroll
                for (int bj = 0; bj < 2; ++bj) {
                    f32x4 v0 = acc[ai][bj][m][0], v1 = acc[ai][bj][m][1];
                    const int col = bj * 128 + wc * 32 + fq * 4;
                    if (latent && (u.pn < 2 || (u.pn == 2 && bj == 0))) {
#pragma unroll
                        for (int j = 0; j < 4; ++j) {
                            const f32x2 cs = tab[pos * 16 + fq * 4 + j];
                            const float a1 = v0[j], a2 = v1[j];
                            v0[j] = a1 * cs.x - a2 * cs.y; v1[j] = a2 * cs.x + a1 * cs.y;
                        }
                    }
                    if (u.pn < 2) {
                        *(u32x2*)(qb + (size_t)row * 512 + u.pn * 256 + col) = pack4(v0); *(u32x2*)(qb + (size_t)row * 512 + u.pn * 256 + col + 16) = pack4(v1);
                    } else if (u.pn == 2 && bj == 0) {
                        const int c = wc * 32 + fq * 4;
                        if (!latent) { __builtin_nontemporal_store(v0, (f32x4*)(out + OUT_K + (size_t)row * 128 + c)); __builtin_nontemporal_store(v1, (f32x4*)(out + OUT_K + (size_t)row * 128 + c + 16)); }
                        *(u32x2*)(kb + (size_t)row * 128 + c) = pack4(v0); *(u32x2*)(kb + (size_t)row * 128 + c + 16) = pack4(v1);
                    } else if (u.pn == 2) {
                        const int c = wc * 32 + fq * 4;
                        if (!latent) { __builtin_nontemporal_store(v0, (f32x4*)(out + OUT_V + (size_t)row * 128 + c)); __builtin_nontemporal_store(v1, (f32x4*)(out + OUT_V + (size_t)row * 128 + c + 16)); }
#pragma unroll
                        for (int j = 0; j < 4; ++j) {
                            vT[(size_t)r0 * 128 + (size_t)(c + j) * T + (row - r0)] = f2bf(v0[j]);
                            vT[(size_t)r0 * 128 + (size_t)(c + 16 + j) * T + (row - r0)] = f2bf(v1[j]);
                        }
                    } else {
                        const int c = (u.pn - 3) * 256 + col;
                        *(u32x2*)(zr + (size_t)row * ZRC + c) = pack4(v0); *(u32x2*)(zr + (size_t)row * ZRC + c + 16) = pack4(v1);
                    }
                }
            }
    }
};
DI void phase_p1(const Params& p, char* smem) {
    unsigned char* ws = p.ws;
    const int nM = M / 256, nN = 8, G = gridDim.x, nfirst = nM * nN;
    {
        const pg8::Gemm8 g = {(const bf16_t*)(ws + OFF_H), (const bf16_t*)(ws + OFF_WIN), 1024, 128};
        const pg8::Order8 ord = {nM, nN, nfirst, G, (int)blockIdx.x, 1};
        const EpiP1 epi = {p.out, (bf16_t*)(ws + OFF_Q), (bf16_t*)(ws + OFF_KB), (bf16_t*)(ws + OFF_VT), (bf16_t*)(p.out + OUT_Y), (const f32x2*)(ws + OFF_ROPE)};
        pg8::gemm8((LAS unsigned char*)smem, g, ord, epi);
    }
    const bf16_t* hb = (const bf16_t*)(ws + OFF_H); const bf16_t* wt = (const bf16_t*)(ws + OFF_WIN);
    bf16_t* zr = (bf16_t*)(p.out + OUT_Y);
    for (int t = blockIdx.x; t < (M / 192) * 2; t += G) {
        int tid = threadIdx.x;
        asm volatile("" : "+v"(tid));
        const int wid = tid >> 6, lane = tid & 63, fr = lane & 15, fq = lane >> 4, wr = wid >> 1, wc = wid & 1;
        const int mt = t >> 1, hh = t & 1, row0 = mt * 192, c0 = 1280 + hh * 320;
        f32x4 acc[3][10];
#pragma unroll
        for (int a2 = 0; a2 < 3; ++a2)
#pragma unroll
            for (int b2 = 0; b2 < 10; ++b2) acc[a2][b2] = (f32x4){0.f, 0.f, 0.f, 0.f};
        gemm_acc320(acc, hb + (size_t)row0 * 1024, 1024, wt + (size_t)(2816 + c0) * 1024, 1024, 1024, smem, tid);
#pragma unroll
        for (int mb = 0; mb < 3; ++mb) {
            bf16_t* zp = zr + (size_t)(row0 + wr * 48 + mb * 16 + fr) * ZRC + c0 + wc * 160 + fq * 4;
#pragma unroll
            for (int nb = 0; nb < 10; ++nb) *(u32x2*)(zp + nb * 16) = pack4(acc[mb][nb]);
        }
    }
}

template <int CTRL> DI float dpp_f(float x) { return __builtin_bit_cast(float, __builtin_amdgcn_mov_dpp(__builtin_bit_cast(int, x), CTRL, 0xf, 0xf, true)); }
DI float swap32_sum(float x) {
    float a = x, b = x;
    asm volatile("s_nop 1\n\tv_permlane32_swap_b32 %0, %1\n\ts_nop 1" : "+v"(a), "+v"(b));
    return a + b;
}
DI float swap16_sum(float x) {
    float a = x, b = x;
    asm volatile("s_nop 1\n\tv_permlane16_swap_b32 %0, %1\n\ts_nop 1" : "+v"(a), "+v"(b));
    return a + b;
}
DI float swap32_max(float x) {
    float a = x, b = x;
    asm volatile("s_nop 1\n\tv_permlane32_swap_b32 %0, %1\n\ts_nop 1" : "+v"(a), "+v"(b));
    return fmaxf(a, b);
}
DI float row16_allsum(float x) { x += dpp_f<0x128>(x); x += dpp_f<0x124>(x); x += dpp_f<0x122>(x); x += dpp_f<0x121>(x); return x; }

#define MFMA32(a, b, c) __builtin_amdgcn_mfma_f32_32x32x16_bf16((a), (b), (c), 0, 0, 0)
DI int crow(int i, int h) { return (i & 3) + 8 * (i >> 2) + 4 * h; }

DI void attn_item(const Params& p, char* smem, int it) {
    int tid = threadIdx.x;
    asm volatile("" : "+v"(tid));
    const int wv = tid >> 6, lane = tid & 63, r = lane & 31, hh = lane >> 5;
    unsigned char* ws = p.ws;
    const bf16_t* qb = (const bf16_t*)(ws + OFF_Q); const bf16_t* kb = (const bf16_t*)(ws + OFF_KB); const bf16_t* vT = (const bf16_t*)(ws + OFF_VT);
    const bf16_t* kc = (const bf16_t*)(ws + OFF_KC); const bf16_t* vct = (const bf16_t*)(ws + OFF_VCT);
    bf16_t* ab = (bf16_t*)(ws + OFF_ATTN);
    bf16_t* Ks = (bf16_t*)smem;
    bf16_t* Vt = (bf16_t*)(smem + 9216);
    const float SC = 0.125f * LOG2E;
    {
        int r0, T, q0, kvh, bl;
        const bool lat = it < 512;
        if (lat) { bl = it >> 6; const int rem = it & 63; q0 = (rem >> 1) * 64; kvh = rem & 1; r0 = MC + bl * 2048; T = 2048; }
        else { const int i2 = it - 512; bl = 0; const int s = i2 >> 3, rem = i2 & 7; q0 = (rem >> 1) * 64; kvh = rem & 1; r0 = s * 256; T = 256; }
        const int head = kvh * 4 + (wv & 3), sub = wv >> 2, qs = q0 + 32 * sub;
        bf16x8 qf[4];
#pragma unroll
        for (int kk = 0; kk < 4; ++kk) qf[kk] = *(const bf16x8*)(qb + (size_t)(r0 + qs + r) * 512 + head * 64 + 16 * kk + 8 * hh);
        const float sinkl = p.attn_sink[head] * LOG2E;
        float lrun = hh == 0 ? 1.0f : 0.0f;
        f32x16 o0, o1;
#pragma unroll
        for (int i = 0; i < 16; ++i) { o0[i] = 0.f; o1[i] = 0.f; }
        const int wlo = lat ? (q0 < 128 ? (128 - q0) >> 6 : 0) : 0;
        const int whi = lat ? ((T - q0 + 128) >> 6 < 5 ? (T - q0 + 128) >> 6 : 5) : 4;
        const int nwin = whi - wlo, ntile = nwin + (lat ? 8 : 0);
        const int rw_ = tid >> 3, ch = tid & 7;
        auto tile_src = [&](int idx, const bf16_t*& ksrc, const bf16_t*& vsrc, int& ks0, bool& window) {
            if (idx < nwin) {
                ks0 = lat ? q0 - 128 + 64 * (wlo + idx) : 64 * idx; window = lat;
                ksrc = kb + (size_t)(r0 + ks0 + rw_) * 128 + kvh * 64 + ch * 8; vsrc = vT + (size_t)r0 * 128 + (size_t)(kvh * 64 + rw_) * T + ks0 + ch * 8;
            } else {
                ks0 = 64 * (idx - nwin); window = false;
                ksrc = kc + (size_t)(bl * 512 + ks0 + rw_) * 128 + kvh * 64 + ch * 8; vsrc = vct + (size_t)((bl * 2 + kvh) * 64 + rw_) * 512 + ks0 + ch * 8;
            }
        };
        u32x4 kreg, vreg;
        { const bf16_t* ks_; const bf16_t* vs_; int k0_; bool w_; tile_src(0, ks_, vs_, k0_, w_); kreg = *(const u32x4*)ks_; vreg = *(const u32x4*)vs_; }
        const float nsink = -sinkl;
        float mneg = nsink;
        for (int ti = 0; ti < ntile; ++ti) {
            const bf16_t* ksrc; const bf16_t* vsrc; int ks0; bool window;
            tile_src(ti, ksrc, vsrc, ks0, window);
            __syncthreads();
            *(u32x4*)(Ks + rw_ * 72 + ch * 8) = kreg;
            *(u32x4*)(Vt + rw_ * 72 + ch * 8) = vreg;
            __syncthreads();
            if (ti + 1 < ntile) { const bf16_t* ks_; const bf16_t* vs_; int k0_; bool w_; tile_src(ti + 1, ks_, vs_, k0_, w_); kreg = *(const u32x4*)ks_; vreg = *(const u32x4*)vs_; }
#pragma unroll
            for (int sk = 0; sk < 2; ++sk) {
                const int kb0 = ks0 + 32 * sk;
                bool need_mask = false;
                if (window) {
                    if (kb0 > qs + 31 + 128 || kb0 + 31 < qs - 128) continue;
                    need_mask = (kb0 < qs + 31 - 128) || (kb0 + 31 > qs + 128);
                }
                f32x16 x;
#pragma unroll
                for (int i = 0; i < 16; ++i) x[i] = 0.f;
#pragma unroll
                for (int kk = 0; kk < 4; ++kk) {
                    const bf16x8 kf = *(const bf16x8*)(Ks + (32 * sk + r) * 72 + 16 * kk + 8 * hh);
                    x = MFMA32(kf, qf[kk], x);
                }
                if (need_mask) {
#pragma unroll
                    for (int i = 0; i < 16; ++i) { const int dk = kb0 + crow(i, hh) - (qs + r); if (dk > 128 || dk < -128) x[i] = -3.0e38f; }
                }
                float mx = fmaxf(fmaxf(fmaxf(x[0], x[1]), fmaxf(x[2], x[3])), fmaxf(fmaxf(x[4], x[5]), fmaxf(x[6], x[7])));
                mx = fmaxf(mx, fmaxf(fmaxf(fmaxf(x[8], x[9]), fmaxf(x[10], x[11])), fmaxf(fmaxf(x[12], x[13]), fmaxf(x[14], x[15]))));
                mx = swap32_max(mx) * SC;
                if (__builtin_amdgcn_ballot_w64(mx > -mneg) != 0ull) {
                    const float mnew = fmaxf(-mneg, mx), alpha = exp2f_(-mneg - mnew);
                    mneg = -mnew;
                    lrun *= alpha;
#pragma unroll
                    for (int i = 0; i < 16; ++i) { o0[i] *= alpha; o1[i] *= alpha; }
                }
                float ps = 0.f;
#pragma unroll
                for (int i = 0; i < 16; ++i) { const float pv = exp2f_(fmaf(x[i], SC, mneg)); x[i] = pv; ps += pv; }
                lrun += ps;
#pragma unroll
                for (int s = 0; s < 2; ++s) {
                    u32x4 pk;
                    pk[0] = pack2(x[8 * s + 0], x[8 * s + 1]); pk[1] = pack2(x[8 * s + 2], x[8 * s + 3]);
                    pk[2] = pack2(x[8 * s + 4], x[8 * s + 5]); pk[3] = pack2(x[8 * s + 6], x[8 * s + 7]);
                    const bf16x8 pf = __builtin_bit_cast(bf16x8, pk);
                    {
                        const s16x4 lo = *(const s16x4*)(Vt + r * 72 + 32 * sk + 16 * s + 4 * hh);
                        const s16x4 hi = *(const s16x4*)(Vt + r * 72 + 32 * sk + 16 * s + 8 + 4 * hh);
                        const bf16x8 vf = __builtin_shufflevector(lo, hi, 0, 1, 2, 3, 4, 5, 6, 7);
                        o0 = MFMA32(vf, pf, o0);
                    }
                    {
                        const s16x4 lo = *(const s16x4*)(Vt + (32 + r) * 72 + 32 * sk + 16 * s + 4 * hh);
                        const s16x4 hi = *(const s16x4*)(Vt + (32 + r) * 72 + 32 * sk + 16 * s + 8 + 4 * hh);
                        const bf16x8 vf = __builtin_shufflevector(lo, hi, 0, 1, 2, 3, 4, 5, 6, 7);
                        o1 = MFMA32(vf, pf, o1);
                    }
                }
            }
        }
        const float ltot = swap32_sum(lrun), inv = rcpf_(ltot);
        bf16_t* orow = ab + (size_t)(r0 + qs + r) * 512 + head * 64;
#pragma unroll
        for (int g = 0; g < 4; ++g) {
            f32x4 a, b;
#pragma unroll
            for (int j = 0; j < 4; ++j) { a[j] = o0[4 * g + j] * inv; b[j] = o1[4 * g + j] * inv; }
            *(u32x2*)(orow + 8 * g + 4 * hh) = pack4(a);
            *(u32x2*)(orow + 32 + 8 * g + 4 * hh) = pack4(b);
        }
    }
    __syncthreads();
}

DI void sg_pass(const Params& p) {
    const int tid = threadIdx.x;
    unsigned char* ws = p.ws;
    {
        const bf16_t* zr = (const bf16_t*)(p.out + OUT_Y);
        bf16_t* sg = (bf16_t*)(ws + OFF_SG);
        const float* mu0 = p.rwkv_mu; const float* mu1 = p.rwkv_mu + ZRC;
        for (int i = blockIdx.x * NTHR + tid; i < M * 32; i += gridDim.x * NTHR) {
            const int m = i >> 5, c = (i & 31) * 4;
            int r0, T; seq_of(m, r0, T);
            const bf16_t* zp = zr + (size_t)m * ZRC + 1792 + c;
            const f32x4 z = unpack4(*(const u32x2*)zp);
            f32x4 zprev = (f32x4){0.f, 0.f, 0.f, 0.f}, znext = zprev;
            if (m > r0) zprev = unpack4(*(const u32x2*)(zp - ZRC));
            if (m < r0 + T - 1) znext = unpack4(*(const u32x2*)(zp + ZRC));
            const f32x4 a0 = *(const f32x4*)(mu0 + 1792 + c), a1 = *(const f32x4*)(mu1 + 1792 + c);
            f32x4 o;
#pragma unroll
            for (int j = 0; j < 4; ++j) { const float zs = z[j] + a0[j] * (zprev[j] - z[j]) + a1[j] * (znext[j] - z[j]); o[j] = sigmoidf_(zs); }
            *(u32x2*)(sg + (size_t)m * 128 + c) = pack4(o);
        }
    }
}


template <int E> DI float qbc(f32x2 v) { return dpp_f<(E >> 1) * 0x55>((E & 1) ? v.y : v.x); }

#define QP0 " quad_perm:[0,0,0,0] row_mask:0xf bank_mask:0xf bound_ctrl:1\n\t"
#define QP1 " quad_perm:[1,1,1,1] row_mask:0xf bank_mask:0xf bound_ctrl:1\n\t"
#define QP2 " quad_perm:[2,2,2,2] row_mask:0xf bank_mask:0xf bound_ctrl:1\n\t"
#define QP3 " quad_perm:[3,3,3,3] row_mask:0xf bank_mask:0xf bound_ctrl:1\n\t"
#define ROR4 " row_ror:4 row_mask:0xf bank_mask:0xf bound_ctrl:1\n\t"
#define ROR8 " row_ror:8 row_mask:0xf bank_mask:0xf bound_ctrl:1\n\t"
DI float scan_sa(const float (&S)[8], f32x2 A) {
    float sa, t1, t2, t3;
    asm volatile(
        "s_nop 1\n\t"
        "v_mul_f32_dpp %0, %12, %4" QP0
        "v_mul_f32_dpp %1, %13, %5" QP0
        "v_mul_f32_dpp %2, %12, %6" QP1
        "v_mul_f32_dpp %3, %13, %7" QP1
        "v_fmac_f32_dpp %0, %12, %8" QP2
        "v_fmac_f32_dpp %1, %13, %9" QP2
        "v_fmac_f32_dpp %2, %12, %10" QP3
        "v_fmac_f32_dpp %3, %13, %11" QP3
        "v_add_f32 %0, %0, %1\n\t"
        "v_add_f32 %2, %2, %3\n\t"
        "v_add_f32 %0, %0, %2\n\t"
        "s_nop 1\n\t"
        "v_add_f32_dpp %0, %0, %0" ROR4
        "s_nop 1\n\t"
        "v_add_f32_dpp %0, %0, %0" ROR8
        "v_mov_b32 %1, %0\n\t"
        "s_nop 1\n\t"
        "v_permlane32_swap_b32 %0, %1\n\t"
        "s_nop 1\n\t"
        "v_add_f32 %0, %0, %1"
        : "=&v"(sa), "=&v"(t1), "=&v"(t2), "=&v"(t3)
        : "v"(S[0]), "v"(S[1]), "v"(S[2]), "v"(S[3]), "v"(S[4]), "v"(S[5]), "v"(S[6]), "v"(S[7]), "v"(A.x), "v"(A.y));
    return sa;
}
DI float scan_upd(float (&S)[8], float sa, float vv, f32x2 B, f32x2 K, f32x2 W, f32x2 R) {
    float n0, n1, n2, n3, n4, n5, n6, n7, y0, y1, y2, y3;
    asm volatile(
        "s_nop 1\n\t"
        "v_mul_f32_dpp %0, %22, %20" QP0  "v_mul_f32_dpp %1, %23, %20" QP0  "v_mul_f32_dpp %2, %22, %20" QP1  "v_mul_f32_dpp %3, %23, %20" QP1
        "v_mul_f32_dpp %4, %22, %20" QP2  "v_mul_f32_dpp %5, %23, %20" QP2  "v_mul_f32_dpp %6, %22, %20" QP3  "v_mul_f32_dpp %7, %23, %20" QP3
        "v_fmac_f32_dpp %0, %24, %21" QP0  "v_fmac_f32_dpp %1, %25, %21" QP0  "v_fmac_f32_dpp %2, %24, %21" QP1  "v_fmac_f32_dpp %3, %25, %21" QP1
        "v_fmac_f32_dpp %4, %24, %21" QP2  "v_fmac_f32_dpp %5, %25, %21" QP2  "v_fmac_f32_dpp %6, %24, %21" QP3  "v_fmac_f32_dpp %7, %25, %21" QP3
        "v_fmac_f32_dpp %0, %26, %12" QP0  "v_fmac_f32_dpp %1, %27, %13" QP0  "v_fmac_f32_dpp %2, %26, %14" QP1  "v_fmac_f32_dpp %3, %27, %15" QP1
        "v_fmac_f32_dpp %4, %26, %16" QP2  "v_fmac_f32_dpp %5, %27, %17" QP2  "v_fmac_f32_dpp %6, %26, %18" QP3  "v_fmac_f32_dpp %7, %27, %19" QP3
        "v_mul_f32_dpp %8, %28, %0" QP0   "v_mul_f32_dpp %9, %29, %1" QP0   "v_mul_f32_dpp %10, %28, %2" QP1  "v_mul_f32_dpp %11, %29, %3" QP1
        "v_fmac_f32_dpp %8, %28, %4" QP2  "v_fmac_f32_dpp %9, %29, %5" QP2  "v_fmac_f32_dpp %10, %28, %6" QP3 "v_fmac_f32_dpp %11, %29, %7" QP3
        "v_add_f32 %8, %8, %9\n\t"
        "v_add_f32 %10, %10, %11\n\t"
        "v_add_f32 %8, %8, %10\n\t"
        "s_nop 1\n\t"
        "v_add_f32_dpp %8, %8, %8" ROR4
        "s_nop 1\n\t"
        "v_add_f32_dpp %8, %8, %8" ROR8
        "v_mov_b32 %9, %8\n\t"
        "s_nop 1\n\t"
        "v_permlane32_swap_b32 %8, %9\n\t"
        "s_nop 1\n\t"
        "v_add_f32 %8, %8, %9"
        : "=&v"(n0), "=&v"(n1), "=&v"(n2), "=&v"(n3), "=&v"(n4), "=&v"(n5), "=&v"(n6), "=&v"(n7), "=&v"(y0), "=&v"(y1), "=&v"(y2), "=&v"(y3)
        : "v"(S[0]), "v"(S[1]), "v"(S[2]), "v"(S[3]), "v"(S[4]), "v"(S[5]), "v"(S[6]), "v"(S[7]), "v"(sa), "v"(vv),
          "v"(B.x), "v"(B.y), "v"(K.x), "v"(K.y), "v"(W.x), "v"(W.y), "v"(R.x), "v"(R.y));
    S[0] = n0; S[1] = n1; S[2] = n2; S[3] = n3; S[4] = n4; S[5] = n5; S[6] = n6; S[7] = n7;
    return y0;
}

DI void lds_barrier() { asm volatile("s_waitcnt lgkmcnt(0)\n\ts_barrier" ::: "memory"); }

constexpr int C_AW = 0;
constexpr int C_AA = C_AW + 4608;
constexpr int C_RF = C_AA + 4608;
constexpr int C_KF = C_RF + 8192;
constexpr int C_KK = C_KF + 8192;
constexpr int C_VT = C_KK + 8192;
constexpr int C_XA = C_VT + 8192;
constexpr int C_XR = C_XA + 9216;
constexpr int C_XB = C_XR + 9216;
constexpr int C_XK = C_XB + 4608;
constexpr int C_BK = C_XK + 4608;
constexpr int C_GL = C_BK + 20480;
constexpr int C_BN = C_GL + 1024;
constexpr int C_UBA = C_BN + 512;
constexpr int C_UB1 = C_UBA + 2560;
constexpr int C_UB2 = C_UB1 + 2560;
constexpr int C_YB = C_UB2 + 2560;
constexpr int C_LWT = C_YB + 8192;
constexpr int C_SAT = C_LWT + 5120;
static_assert(C_SAT + 5120 <= LDS_MAIN, "scan LDS");

template <int S> DI void subst4(float& a, float& b, float& c, float& d, float u) {
    asm("s_nop 1\n\t"
        "v_fmac_f32_dpp %0, %0, %4 row_newbcast:%5 row_mask:0xf bank_mask:0xf\n\t"
        "v_fmac_f32_dpp %1, %1, %4 row_newbcast:%5 row_mask:0xf bank_mask:0xf\n\t"
        "v_fmac_f32_dpp %2, %2, %4 row_newbcast:%5 row_mask:0xf bank_mask:0xf\n\t"
        "v_fmac_f32_dpp %3, %3, %4 row_newbcast:%5 row_mask:0xf bank_mask:0xf"
        : "+v"(a), "+v"(b), "+v"(c), "+v"(d) : "v"(u), "n"(S));
}
DI bf16x8 cat8(u32x2 a, u32x2 b) { u32x4 r; r.x = a.x; r.y = a.y; r.z = b.x; r.w = b.y; return __builtin_bit_cast(bf16x8, r); }
#define MFMA16(a, b, c) __builtin_amdgcn_mfma_f32_16x16x32_bf16((a), (b), (c), 0, 0, 0)

DI void scan_item(const Params& p, char* smem, int r0, int T, int dsel, int h, const float* state0, float* state_out) {
    int tid = threadIdx.x;
    asm volatile("" : "+v"(tid));
    const int wv = tid >> 6, lane = tid & 63, fr = lane & 15, g = lane >> 4, q = wv & 3;
    const bool is_p0 = wv < 4;
    unsigned char* ws = p.ws;
    const bf16_t* zr = (const bf16_t*)(p.out + OUT_Y);
    bf16_t* ys = (bf16_t*)(ws + OFF_YS) + (size_t)dsel * M * 512;
    float* bn = (float*)(ws + OFF_BN);
    bf16_t* Aw = (bf16_t*)(smem + C_AW); bf16_t* Aa = (bf16_t*)(smem + C_AA);
    float* Rf = (float*)(smem + C_RF); float* Kf = (float*)(smem + C_KF); float* KKf = (float*)(smem + C_KK);
    bf16_t* Vt = (bf16_t*)(smem + C_VT);
    bf16_t* Xa = (bf16_t*)(smem + C_XA); bf16_t* Xr = (bf16_t*)(smem + C_XR); bf16_t* Xb = (bf16_t*)(smem + C_XB); bf16_t* Xk = (bf16_t*)(smem + C_XK);
    bf16_t* BK = (bf16_t*)(smem + C_BK); float* GL = (float*)(smem + C_GL); float* BNp = (float*)(smem + C_BN);
    float* Uba = (float*)(smem + C_UBA); bf16_t* UB1 = (bf16_t*)(smem + C_UB1); bf16_t* UB2 = (bf16_t*)(smem + C_UB2);
    float* Yb = (float*)(smem + C_YB);
    const int nchunk = T >> 4;

    lds_barrier();
    if (is_p0) {
        const int irow = 16 * q + fr;
        f32x4 S0, S1, S2, S3;
        if (state0) {
            const float* sp = state0 + irow * 64 + 4 * g;
            S0 = *(const f32x4*)sp; S1 = *(const f32x4*)(sp + 16); S2 = *(const f32x4*)(sp + 32); S3 = *(const f32x4*)(sp + 48);
        } else { S0 = (f32x4){0.f, 0.f, 0.f, 0.f}; S1 = S0; S2 = S0; S3 = S0; }
        const size_t wrow = (size_t)(dsel * 512 + h * 64 + 16 * q + fr) * 64 + g * 8;
        const bf16_t* w2t = (const bf16_t*)(ws + OFF_W2T) + wrow;
        const bf16_t* a2t = (const bf16_t*)(ws + OFF_A2T) + wrow;
        float* lt = (float*)(smem + C_LWT) + q * 320;
        float* st = (float*)(smem + C_SAT) + q * 320;
        const int j0 = 16 * q + 4 * g, sw = ((4 * q + g) ^ fr) << 2, pos = (q >> 1) * 32 + g * 8 + (q & 1) * 4;
        const bf16x8 wf0 = *(const bf16x8*)w2t, wf1 = *(const bf16x8*)(w2t + 32), af0 = *(const bf16x8*)a2t, af1 = *(const bf16x8*)(a2t + 32);
        const f32x4 w0v = *(const f32x4*)(p.rwkv_w0 + dsel * 512 + h * 64 + j0), a0v = *(const f32x4*)(p.rwkv_a0 + dsel * 512 + h * 64 + j0);
        const f32x4 kav = *(const f32x4*)(p.rwkv_k_a + h * 64 + j0), rkv = *(const f32x4*)(p.rwkv_r_k + h * 64 + j0);

        auto stageCD = [&](int c) {
            const int s1 = c & 1, s3 = c & 3;
            const bf16_t* xw = Aw + s1 * 1152 + fr * 72 + g * 8; const bf16_t* xz = Aa + s1 * 1152 + fr * 72 + g * 8;
            f32x4 lw4 = (f32x4){0.f, 0.f, 0.f, 0.f}, la4 = lw4;
            lw4 = MFMA16(wf0, *(const bf16x8*)xw, lw4); lw4 = MFMA16(wf1, *(const bf16x8*)(xw + 32), lw4);
            la4 = MFMA16(af0, *(const bf16x8*)xz, la4); la4 = MFMA16(af1, *(const bf16x8*)(xz + 32), la4);
            const f32x4 r4 = *(const f32x4*)(Rf + s1 * 1024 + fr * 64 + sw), k4 = *(const f32x4*)(Kf + s1 * 1024 + fr * 64 + sw), kk4 = *(const f32x4*)(KKf + s1 * 1024 + fr * 64 + sw);
            f32x4 lw, kd, bb; float bs = 0.f;
#pragma unroll
            for (int j = 0; j < 4; ++j) {
                lw[j] = (-0.6065306597126334f * LOG2E) * sigmoidf_(w0v[j] + lw4[j]);
                const float ar = sigmoidf_(a0v[j] + la4[j]);
                kd[j] = k4[j] * (1.0f + (ar - 1.0f) * kav[j]);
                bb[j] = ar * kk4[j];
                bs += r4[j] * kd[j] * rkv[j];
            }
            bs = swap32_sum(swap16_sum(bs));
            if (g == 0) BNp[s1 * 64 + q * 16 + fr] = bs;
            float c0 = lw[0], c1 = lw[1], c2_ = lw[2], c3 = lw[3];
            asm("s_nop 1\n\t"
                "v_add_f32_dpp %0, %0, %0 row_shr:1 row_mask:0xf bank_mask:0xf bound_ctrl:1\n\tv_add_f32_dpp %1, %1, %1 row_shr:1 row_mask:0xf bank_mask:0xf bound_ctrl:1\n\t"
                "v_add_f32_dpp %2, %2, %2 row_shr:1 row_mask:0xf bank_mask:0xf bound_ctrl:1\n\tv_add_f32_dpp %3, %3, %3 row_shr:1 row_mask:0xf bank_mask:0xf bound_ctrl:1\n\t"
                "v_add_f32_dpp %0, %0, %0 row_shr:2 row_mask:0xf bank_mask:0xf bound_ctrl:1\n\tv_add_f32_dpp %1, %1, %1 row_shr:2 row_mask:0xf bank_mask:0xf bound_ctrl:1\n\t"
                "v_add_f32_dpp %2, %2, %2 row_shr:2 row_mask:0xf bank_mask:0xf bound_ctrl:1\n\tv_add_f32_dpp %3, %3, %3 row_shr:2 row_mask:0xf bank_mask:0xf bound_ctrl:1\n\t"
                "v_add_f32_dpp %0, %0, %0 row_shr:4 row_mask:0xf bank_mask:0xf bound_ctrl:1\n\tv_add_f32_dpp %1, %1, %1 row_shr:4 row_mask:0xf bank_mask:0xf bound_ctrl:1\n\t"
                "v_add_f32_dpp %2, %2, %2 row_shr:4 row_mask:0xf bank_mask:0xf bound_ctrl:1\n\tv_add_f32_dpp %3, %3, %3 row_shr:4 row_mask:0xf bank_mask:0xf bound_ctrl:1\n\t"
                "v_add_f32_dpp %0, %0, %0 row_shr:8 row_mask:0xf bank_mask:0xf bound_ctrl:1\n\tv_add_f32_dpp %1, %1, %1 row_shr:8 row_mask:0xf bank_mask:0xf bound_ctrl:1\n\t"
                "v_add_f32_dpp %2, %2, %2 row_shr:8 row_mask:0xf bank_mask:0xf bound_ctrl:1\n\tv_add_f32_dpp %3, %3, %3 row_shr:8 row_mask:0xf bank_mask:0xf bound_ctrl:1\n\t"
                "s_nop 1"
                : "+v"(c0), "+v"(c1), "+v"(c2_), "+v"(c3));
            f32x4 cum; cum[0] = c0; cum[1] = c1; cum[2] = c2_; cum[3] = c3;
            f32x4 va, vr, vb, vk, tb, tk, glv;
#pragma unroll
            for (int j = 0; j < 4; ++j) {
                const float gam = exp2f_(cum[j]), gi = rcpf_(gam);
                const float gt = __builtin_bit_cast(float, __builtin_amdgcn_update_dpp(0, __builtin_bit_cast(int, gam), 0x15f, 0xf, 0xf, false));
                const float bt = gt * gi;
                const float gp = __builtin_bit_cast(float, __builtin_amdgcn_update_dpp(0x3f800000, __builtin_bit_cast(int, gam), 0x111, 0xf, 0xf, false));
                va[j] = -kk4[j] * gp; vr[j] = r4[j] * gam; vb[j] = bb[j] * gi; vk[j] = kd[j] * gi; tb[j] = bb[j] * bt; tk[j] = kd[j] * bt; glv[j] = gt;
            }
            *(u32x2*)(Xa + s3 * 1152 + fr * 72 + pos) = pack4(va);
            *(u32x2*)(Xr + s3 * 1152 + fr * 72 + pos) = pack4(vr);
            *(u32x2*)(Xb + s1 * 1152 + fr * 72 + pos) = pack4(vb);
            *(u32x2*)(Xk + s1 * 1152 + fr * 72 + pos) = pack4(vk);
            bf16_t* bk = BK + s3 * 2560 + j0 * 40 + fr;
#pragma unroll
            for (int j = 0; j < 4; ++j) { const unsigned pk = pack2(tb[j], tk[j]); bk[j * 40] = (bf16_t)(pk & 0xffffu); bk[j * 40 + 16] = (bf16_t)(pk >> 16); }
            if (fr == 0) *(f32x4*)(GL + s3 * 64 + j0) = glv;
        };
        auto stageE = [&](int c) {
            const int s1 = c & 1, s3 = c & 3;
            const bf16x8 sb0 = cat8(pack4(S0), pack4(S1)), sb1 = cat8(pack4(S2), pack4(S3));
            const bf16_t* xa = Xa + s3 * 1152 + fr * 72 + g * 8; const bf16_t* xr = Xr + s3 * 1152 + fr * 72 + g * 8;
            const u32x4 vraw = *(const u32x4*)(Vt + s3 * 1024 + irow * 16 + 8 * (g & 1));
            const u32x4 zero4 = (u32x4){0u, 0u, 0u, 0u};
            const bf16x8 vz = __builtin_bit_cast(bf16x8, g >= 2 ? vraw : zero4);
            f32x4 pa = (f32x4){0.f, 0.f, 0.f, 0.f}, pr = pa;
            pa = MFMA16(sb0, *(const bf16x8*)xa, pa); pa = MFMA16(sb1, *(const bf16x8*)(xa + 32), pa);
            pa = MFMA16(vz, *(const bf16x8*)(UB1 + s1 * 640 + fr * 40 + g * 8), pa);
            pr = MFMA16(sb0, *(const bf16x8*)xr, pr); pr = MFMA16(sb1, *(const bf16x8*)(xr + 32), pr);
            const float* ub = Uba + s1 * 320 + fr * 20;
            const f32x4 u0 = *(const f32x4*)ub, u1 = *(const f32x4*)(ub + 4), u2 = *(const f32x4*)(ub + 8), u3 = *(const f32x4*)(ub + 12);
            float a0 = pa[0], a1 = pa[1], a2 = pa[2], a3 = pa[3];
            asm("s_nop 7\n\ts_nop 7" : "+v"(a0), "+v"(a1), "+v"(a2), "+v"(a3));
            subst4<0>(a0, a1, a2, a3, u0[0]); subst4<1>(a0, a1, a2, a3, u0[1]); subst4<2>(a0, a1, a2, a3, u0[2]); subst4<3>(a0, a1, a2, a3, u0[3]);
            subst4<4>(a0, a1, a2, a3, u1[0]); subst4<5>(a0, a1, a2, a3, u1[1]); subst4<6>(a0, a1, a2, a3, u1[2]); subst4<7>(a0, a1, a2, a3, u1[3]);
            subst4<8>(a0, a1, a2, a3, u2[0]); subst4<9>(a0, a1, a2, a3, u2[1]); subst4<10>(a0, a1, a2, a3, u2[2]); subst4<11>(a0, a1, a2, a3, u2[3]);
            subst4<12>(a0, a1, a2, a3, u3[0]); subst4<13>(a0, a1, a2, a3, u3[1]); subst4<14>(a0, a1, a2, a3, u3[2]);
            st[(4 * g + 0) * 20 + fr] = a0; st[(4 * g + 1) * 20 + fr] = a1; st[(4 * g + 2) * 20 + fr] = a2; st[(4 * g + 3) * 20 + fr] = a3;
            const f32x4 ta = *(const f32x4*)(st + fr * 20 + 8 * (g & 1)), tb = *(const f32x4*)(st + fr * 20 + 8 * (g & 1) + 4);
            const u32x2 ha = pack4(ta), hb = pack4(tb);
            u32x4 svr; svr.x = ha.x; svr.y = ha.y; svr.z = hb.x; svr.w = hb.y;
            const bf16x8 sv = __builtin_bit_cast(bf16x8, g >= 2 ? vraw : svr);
            pr = MFMA16(sv, *(const bf16x8*)(UB2 + s1 * 640 + fr * 40 + g * 8), pr);
            *(f32x4*)(Yb + s1 * 1024 + fr * 64 + sw) = pr;
            const float* gl = GL + s3 * 64 + 4 * g;
            const bf16_t* bk = BK + s3 * 2560 + fr * 40 + g * 8;
            S0 = MFMA16(*(const bf16x8*)(bk), sv, S0 * *(const f32x4*)(gl));
            S1 = MFMA16(*(const bf16x8*)(bk + 640), sv, S1 * *(const f32x4*)(gl + 16));
            S2 = MFMA16(*(const bf16x8*)(bk + 1280), sv, S2 * *(const f32x4*)(gl + 32));
            S3 = MFMA16(*(const bf16x8*)(bk + 1920), sv, S3 * *(const f32x4*)(gl + 48));
        };
        lds_barrier();
        stageCD(0); lds_barrier();
        stageCD(1); lds_barrier();
#pragma unroll 1
        for (int n = 0; n < nchunk - 2; ++n) {
            stageCD(n + 2);
            stageE(n);
            lds_barrier();
        }
        stageE(nchunk - 2); lds_barrier();
        stageE(nchunk - 1); lds_barrier();
        lds_barrier();
        if (state_out) {
            float* sp = state_out + irow * 64 + 4 * g;
            __builtin_nontemporal_store(S0, (f32x4*)sp); __builtin_nontemporal_store(S1, (f32x4*)(sp + 16)); __builtin_nontemporal_store(S2, (f32x4*)(sp + 32)); __builtin_nontemporal_store(S3, (f32x4*)(sp + 48));
        }
    } else {
        const int ptid = tid & 255, tt = ptid >> 4, cg = ptid & 15, cg4 = cg * 4, swz = (cg ^ tt) << 2;
        const int segc[5] = {h * 64 + cg4, 512 + h * 64 + cg4, 1024 + h * 64 + cg4, 1536 + dsel * 64 + cg4, 1664 + dsel * 64 + cg4};
        u32x2 zc[5], zp[5], zn[5];
        f32x4 mu0[5], mu1[5], mu2[5];
#pragma unroll
        for (int s = 0; s < 5; ++s) { mu0[s] = *(const f32x4*)(p.rwkv_mu + segc[s]); mu1[s] = *(const f32x4*)(p.rwkv_mu + ZRC + segc[s]); mu2[s] = 1.0f - mu0[s] - mu1[s]; }
        const f32x4 kkv = *(const f32x4*)(p.rwkv_k_k + h * 64 + cg4);
        auto load_chunk = [&](int c) {
            const int st = 16 * c + tt, tok = dsel ? T - 1 - st : st;
            const bf16_t* base = zr + (size_t)(r0 + tok) * ZRC;
#pragma unroll
            for (int s = 0; s < 5; ++s) {
                zc[s] = *(const u32x2*)(base + segc[s]);
                const u32x2 a = *(const u32x2*)(base + (tok > 0 ? -ZRC : 0) + segc[s]), b = *(const u32x2*)(base + (tok < T - 1 ? ZRC : 0) + segc[s]);
                zp[s] = tok > 0 ? a : (u32x2){0u, 0u}; zn[s] = tok < T - 1 ? b : (u32x2){0u, 0u};
            }
        };
        auto stageA = [&](int c) {
            f32x4 zs[5];
#pragma unroll
            for (int s = 0; s < 5; ++s) {
                const f32x4 z = unpack4(zc[s]), a = unpack4(zp[s]), b = unpack4(zn[s]);
                zs[s] = mu2[s] * z + mu0[s] * a + mu1[s] * b;
            }
            f32x4 kk = zs[1] * kkv;
            float n2 = kk[0] * kk[0] + kk[1] * kk[1] + kk[2] * kk[2] + kk[3] * kk[3];
            n2 = row16_allsum(n2);
            kk = kk * __builtin_amdgcn_rsqf(fmaxf(n2, 1e-24f));
            f32x4 tw;
#pragma unroll
            for (int j = 0; j < 4; ++j) tw[j] = 1.0f - 2.0f * rcpf_(1.0f + __expf(2.0f * zs[3][j]));
            *(u32x2*)(Aw + (c & 1) * 1152 + tt * 72 + cg4) = pack4(tw);
            *(u32x2*)(Aa + (c & 1) * 1152 + tt * 72 + cg4) = pack4(zs[4]);
            *(f32x4*)(Rf + (c & 1) * 1024 + tt * 64 + swz) = zs[0];
            *(f32x4*)(Kf + (c & 1) * 1024 + tt * 64 + swz) = zs[1];
            *(f32x4*)(KKf + (c & 1) * 1024 + tt * 64 + swz) = kk;
            bf16_t* vt = Vt + (c & 3) * 1024 + cg4 * 16 + tt;
            const u32x2 vp = pack4(zs[2]);
            vt[0] = (bf16_t)(vp.x & 0xffffu); vt[16] = (bf16_t)(vp.x >> 16); vt[32] = (bf16_t)(vp.y & 0xffffu); vt[48] = (bf16_t)(vp.y >> 16);
        };
        auto stageG = [&](int c) {
            const int s1 = c & 1, s3 = c & 3;
            const bf16_t* As = ((q & 1) ? Xk : Xb) + s1 * 1152 + fr * 72 + g * 8;
            const bf16_t* Bs = ((q & 2) ? Xr : Xa) + s3 * 1152 + fr * 72 + g * 8;
            f32x4 u = (f32x4){0.f, 0.f, 0.f, 0.f};
            u = MFMA16(*(const bf16x8*)As, *(const bf16x8*)Bs, u); u = MFMA16(*(const bf16x8*)(As + 32), *(const bf16x8*)(Bs + 32), u);
#pragma unroll
            for (int j = 0; j < 4; ++j) { const int s = 4 * g + j; const bool keep = (q & 2) ? (s <= fr) : (s < fr); u[j] = keep ? u[j] : 0.f; }
            if (q == 0) *(f32x4*)(Uba + s1 * 320 + fr * 20 + 4 * g) = u;
            else if (q == 1) { *(u32x2*)(UB1 + s1 * 640 + fr * 40 + 4 * g) = (u32x2){0u, 0u}; *(u32x2*)(UB1 + s1 * 640 + fr * 40 + 16 + 4 * g) = pack4(u); }
            else *(u32x2*)(UB2 + s1 * 640 + fr * 40 + (q == 3 ? 16 : 0) + 4 * g) = pack4(u);
            if (q == 0 && lane < 16) {
                const int st = 16 * c + lane, tok = dsel ? T - 1 - st : st, m = r0 + tok;
                const float* bp = BNp + s1 * 64 + lane;
                bn[(size_t)m * 16 + dsel * 8 + h] = (bp[0] + bp[16]) + (bp[32] + bp[48]);
            }
        };
        auto stageF = [&](int c) {
            const int st = 16 * c + tt, tok = dsel ? T - 1 - st : st, m = r0 + tok;
            *(u32x2*)(ys + (size_t)m * 512 + h * 64 + cg4) = pack4(*(const f32x4*)(Yb + (c & 1) * 1024 + tt * 64 + swz));
        };
        load_chunk(0);
        stageA(0); load_chunk(1); lds_barrier();
        stageA(1); load_chunk(2); lds_barrier();
        stageG(0); stageA(2); load_chunk(3); lds_barrier();
        stageG(1); stageA(3); load_chunk(4); lds_barrier();
#pragma unroll 1
        for (int n = 1; n < nchunk - 4; ++n) {
            stageF(n - 1);
            stageG(n + 1);
            stageA(n + 3); load_chunk(n + 4);
            lds_barrier();
        }
#pragma unroll 1
        for (int n = nchunk - 4; n <= nchunk; ++n) {
            stageF(n - 1);
            if (n + 1 < nchunk) stageG(n + 1);
            if (n + 3 < nchunk) stageA(n + 3);
            lds_barrier();
        }
    }
    lds_barrier();
}

DI void scan_dispatch(const Params& p, char* smem, int it) {
    const bool lat = it < 128;
    const int i2 = lat ? it : it - 128, sq = i2 >> 4, dsel = (i2 >> 3) & 1, h = i2 & 7;
    const size_t so = (size_t)((sq * 2 + dsel) * 8 + h) * 4096;
    scan_item(p, smem, lat ? MC + sq * 2048 : sq * 256, lat ? 2048 : 256, dsel, h, lat ? p.state_rwkv + so : nullptr, lat ? nullptr : p.out + OUT_S + so);
}
DI void phase_mix(const Params& p, char* smem) {
    unsigned* ctr = g_bar + XCD_BAR_WORDS;
    volatile LAS unsigned* slot = (volatile LAS unsigned*)(smem + LDS_MAIN + 8);
    for (;;) {
        if (threadIdx.x == 0) *slot = __hip_atomic_fetch_add(ctr, 1u, __ATOMIC_RELAXED, __HIP_MEMORY_SCOPE_AGENT);
        __syncthreads();
        const int it = __builtin_amdgcn_readfirstlane((int)*slot);
        __syncthreads();
        if (it >= 640 + 768) break;
        if (it < 640) scan_dispatch(p, smem, it);
        else attn_item(p, smem, it - 640);
    }
    sg_pass(p);
}

DI void phase_post(const Params& p, char* smem) {
    unsigned char* ws = p.ws;
    const bf16_t* sg = (const bf16_t*)(ws + OFF_SG); const bf16_t* g2t = (const bf16_t*)(ws + OFF_G2T);
    const bf16_t* ys0 = (const bf16_t*)(ws + OFF_YS); const bf16_t* ys1 = ys0 + (size_t)M * 512;
    const float* bn = (const float*)(ws + OFF_BN);
    const bf16_t* zr = (const bf16_t*)(p.out + OUT_Y);
    bf16_t* rw = (bf16_t*)(ws + OFF_RW);
    float* G = (float*)smem;
    const int MT = M / 256, NT = 4;
    for (int t2 = blockIdx.x; t2 < 2 * MT * NT; t2 += gridDim.x) {
        int tid = threadIdx.x;
        asm volatile("" : "+v"(tid));
        const int wid = tid >> 6, lane = tid & 63, fr = lane & 15, fq = lane >> 4, wr = wid >> 1, wc = wid & 1;
        const int t = t2 >> 1, half = t2 & 1;
        int mt, nt; tile_coords(t, MT, NT, mt, nt);
        const int row0 = mt * 256;
        f32x4 acc[4][4]; zero_acc<4>(acc);
        gemm_acc<4>(acc, sg + (size_t)row0 * 128, 128, g2t + (size_t)(nt * 128) * 128, 128, 128, smem, tid);
        int r0, T; seq_of(row0, r0, T);
        __syncthreads();
#pragma unroll
        for (int nb = 0; nb < 4; ++nb) {
            const f32x4 ga = half ? acc[2][nb] : acc[0][nb], gb = half ? acc[3][nb] : acc[1][nb];
            *(f32x4*)(G + (wr * 32 + fr) * 132 + wc * 64 + nb * 16 + fq * 4) = ga;
            *(f32x4*)(G + (wr * 32 + 16 + fr) * 132 + wc * 64 + nb * 16 + fq * 4) = gb;
        }
        __syncthreads();
        const int grp = lane >> 4, l16 = lane & 15, hl = grp & 1, head = nt * 2 + hl, c = head * 64 + l16 * 4;
        const f32x4 a0 = *(const f32x4*)(p.rwkv_mu + 1024 + c), a1 = *(const f32x4*)(p.rwkv_mu + ZRC + 1024 + c);
        const f32x4 lg = *(const f32x4*)(p.rwkv_ln_g + c), lb = *(const f32x4*)(p.rwkv_ln_b + c);
        auto row_of = [&](int i) { const int lr = i * 16 + wid * 2 + (grp >> 1); return lr; };
        u32x2 ya[2], yb_[2], zc[2], zp[2], zn[2]; float b0[2], b1[2];
        auto issue = [&](int i, int s) {
            const int lr = row_of(i), m = row0 + (lr >> 5) * 64 + (half * 2 + ((lr >> 4) & 1)) * 16 + (lr & 15);
            const size_t o = (size_t)m * 512 + c;
            ya[s] = *(const u32x2*)(ys0 + o); yb_[s] = *(const u32x2*)(ys1 + o);
            const bf16_t* zq = zr + (size_t)m * ZRC + 1024 + c;
            zc[s] = *(const u32x2*)zq;
            const u32x2 pa = *(const u32x2*)(zq + (m > r0 ? -ZRC : 0)), pb = *(const u32x2*)(zq + (m < r0 + T - 1 ? ZRC : 0));
            zp[s] = m > r0 ? pa : (u32x2){0u, 0u}; zn[s] = m < r0 + T - 1 ? pb : (u32x2){0u, 0u};
            b0[s] = bn[(size_t)m * 16 + head]; b1[s] = bn[(size_t)m * 16 + 8 + head];
        };
        auto finish = [&](int i, int s) {
            const int lr = row_of(i), m = row0 + (lr >> 5) * 64 + (half * 2 + ((lr >> 4) & 1)) * 16 + (lr & 15);
            const f32x4 y = unpack4(ya[s]) + unpack4(yb_[s]);
            const float s1 = row16_allsum((y[0] + y[1]) + (y[2] + y[3]));
            const float mean = s1 * (1.0f / 64.0f);
            const f32x4 dlt = y - mean;
            const float s2 = row16_allsum((dlt[0] * dlt[0] + dlt[1] * dlt[1]) + (dlt[2] * dlt[2] + dlt[3] * dlt[3]));
            const float rstd = __builtin_amdgcn_rsqf(s2 * (1.0f / 64.0f) + 64e-5f);
            const float bonus = b0[s] + b1[s];
            const f32x4 z = unpack4(zc[s]), zprev = unpack4(zp[s]), znext = unpack4(zn[s]);
            const f32x4 v = z + a0 * (zprev - z) + a1 * (znext - z);
            const f32x4 yn = dlt * rstd * lg + lb;
            const f32x4 gsel = *(const f32x4*)(G + lr * 132 + hl * 64 + l16 * 4);
            const f32x4 o = (yn + v * bonus) * gsel;
            *(u32x2*)(rw + (size_t)m * 512 + c) = pack4(o);
        };
        issue(0, 0);
#pragma unroll
        for (int i = 0; i < 8; ++i) {
            if (i + 1 < 8) issue(i + 1, (i + 1) & 1);
            finish(i, i & 1);
        }
        __syncthreads();
    }
}

DI void merge_gates(const Params& p, char* smem, int t, bool pre, u32x2 (&gpa)[4][4], u32x2 (&gpb)[4][4]) {
    unsigned char* ws = p.ws;
    const bf16_t* hb = (const bf16_t*)(ws + OFF_H); const bf16_t* wt = (const bf16_t*)(ws + OFF_WIN);
    const bf16_t* ab = (const bf16_t*)(ws + OFF_ATTN); const bf16_t* wpa = (const bf16_t*)(ws + OFF_WPA);
    int tid = threadIdx.x;
    asm volatile("" : "+v"(tid));
    int mt, nt; tile_coords(t, M / 256, 8, mt, nt);
    const int row0 = mt * 256, n0 = nt * 128;
    f32x4 gacc[4][8];
#pragma unroll
    for (int a = 0; a < 4; ++a)
#pragma unroll
        for (int b = 0; b < 8; ++b) gacc[a][b] = (f32x4){0.f, 0.f, 0.f, 0.f};
    if (pre) gemm_acc8<1024, true>(gacc, hb + (size_t)row0 * 1024, 1024, wt + (size_t)(768 + n0) * 1024, 1024, 1024, smem, tid);
    else gemm_acc8<1024, false>(gacc, hb + (size_t)row0 * 1024, 1024, wt + (size_t)(768 + n0) * 1024, 1024, 1024, smem, tid);
    __syncthreads();
    gemm_pre<4>(ab + (size_t)row0 * 512, 512, wpa + (size_t)n0 * 512, 512, 512, smem, tid);
#pragma unroll
    for (int a = 0; a < 4; ++a)
#pragma unroll
        for (int b = 0; b < 4; ++b) {
            f32x4 ga, gb;
#pragma unroll
            for (int j = 0; j < 4; ++j) { ga[j] = sigmoidf_(gacc[a][b][j]); gb[j] = sigmoidf_(gacc[a][b + 4][j]); }
            gpa[a][b] = pack4(ga); gpb[a][b] = pack4(gb);
            asm volatile("" : "+v"(gpa[a][b]), "+v"(gpb[a][b]));
        }
}
DI void phase_merge(const Params& p, char* smem, u32x2 (&gpa)[4][4], u32x2 (&gpb)[4][4]) {
    unsigned char* ws = p.ws;
    const bf16_t* hb = (const bf16_t*)(ws + OFF_H); const bf16_t* wt = (const bf16_t*)(ws + OFF_WIN);
    const bf16_t* ab = (const bf16_t*)(ws + OFF_ATTN); const bf16_t* rw = (const bf16_t*)(ws + OFF_RW);
    const bf16_t* wpa = (const bf16_t*)(ws + OFF_WPA); const bf16_t* wpb = (const bf16_t*)(ws + OFF_WPB);
    bf16_t* mg = (bf16_t*)(ws + OFF_MRG);
    const int MT = M / 256, NT = 8;
    for (int t = blockIdx.x; t < MT * NT; t += gridDim.x) {
        int tid = threadIdx.x;
        asm volatile("" : "+v"(tid));
        const int wid = tid >> 6, lane = tid & 63, fr = lane & 15, fq = lane >> 4, wr = wid >> 1, wc = wid & 1;
        int mt, nt; tile_coords(t, MT, NT, mt, nt);
        const int row0 = mt * 256, n0 = nt * 128;
        f32x4 acc[4][4]; u32x2 resp[4][4];
        zero_acc<4>(acc);
        gemm_acc<4, 0, true>(acc, ab + (size_t)row0 * 512, 512, wpa + (size_t)n0 * 512, 512, 512, smem, tid);
        __syncthreads();
        gemm_pre<4>(rw + (size_t)row0 * 512, 512, wpb + (size_t)n0 * 512, 512, 512, smem, tid);
#pragma unroll
        for (int a = 0; a < 4; ++a)
#pragma unroll
            for (int b = 0; b < 4; ++b) { resp[a][b] = pack4(unpack4(gpa[a][b]) * acc[a][b]); asm volatile("" : "+v"(resp[a][b])); }
        __builtin_amdgcn_sched_barrier(0);
        zero_acc<4>(acc);
        gemm_acc<4, 0, true>(acc, rw + (size_t)row0 * 512, 512, wpb + (size_t)n0 * 512, 512, 512, smem, tid);
        const bool has_next = t + (int)gridDim.x < MT * NT;
        if (has_next) {
            int nmt, nnt; tile_coords(t + gridDim.x, MT, NT, nmt, nnt);
            __syncthreads();
            gemm_pre8<1024>(hb + (size_t)(nmt * 256) * 1024, 1024, wt + (size_t)(768 + nnt * 128) * 1024, 1024, smem, tid);
        }
#pragma unroll
        for (int mb = 0; mb < 4; ++mb) {
            const int m = row0 + wr * 64 + mb * 16 + fr;
#pragma unroll
            for (int nb = 0; nb < 4; ++nb) {
                const f32x4 o = unpack4(resp[mb][nb]) + unpack4(gpb[mb][nb]) * acc[mb][nb];
                *(u32x2*)(mg + (size_t)m * 1024 + n0 + wc * 64 + nb * 16 + fq * 4) = pack4(o);
            }
        }
        if (has_next) merge_gates(p, smem, t + gridDim.x, true, gpa, gpb);
    }
}

struct EpiOut {
    static constexpr bool PERM = false, AFTER_DRAIN = false;
    bf16_t* xb16; const float* mod; const float* xp; const float* xs;
    __device__ __forceinline__ void operator()(const f32x4 (&acc)[2][2][4][2], const pg8::Unit& u, int wr, int wc, int fr, int fq) const {
        const int row0 = u.pm * 256 + wr * 64 + fr, col0 = u.pn * 256 + wc * 32 + 4 * fq, ci = cond_of(u.pm * 256);
        const float* xb = u.pm * 256 < MC ? xp : xs - (size_t)MC * D;
#pragma unroll
        for (int bj = 0; bj < 2; ++bj)
#pragma unroll
            for (int n = 0; n < 2; ++n) {
                const int col = col0 + bj * 128 + n * 16;
                const f32x4 g1 = *(const f32x4*)(mod + ci * 6144 + 2048 + col);
#pragma unroll
                for (int ai = 0; ai < 2; ++ai)
#pragma unroll
                    for (int m = 0; m < 4; ++m) {
                        const size_t o = (size_t)(row0 + ai * 128 + m * 16) * D + col;
                        *(u32x2*)(xb16 + o) = pack4(*(const f32x4*)(xb + o) + g1 * acc[ai][bj][m][n]);
                    }
            }
    }
};
DI void phase_out(const Params& p, char* smem) {
    unsigned char* ws = p.ws;
    const bf16_t* mg = (const bf16_t*)(ws + OFF_MRG); const bf16_t* wo = (const bf16_t*)(ws + OFF_WOUT);
    const float* mod = (const float*)(ws + OFF_MOD);
    bf16_t* xb16 = (bf16_t*)(ws + OFF_XB);
    const int MT = M / 192, NT = 4;
    for (int t = blockIdx.x; t < MT * NT; t += gridDim.x) {
        int tid = threadIdx.x;
        asm volatile("" : "+v"(tid));
        const int wid = tid >> 6, lane = tid & 63, fr = lane & 15, fq = lane >> 4, wr = wid >> 1, wc = wid & 1;
        int mt, nt; tile_coords(t, MT, NT, mt, nt);
        const int row0 = mt * 192, n0 = nt * 256;
        f32x4 acc[3][8];
#pragma unroll
        for (int a = 0; a < 3; ++a)
#pragma unroll
            for (int b = 0; b < 8; ++b) acc[a][b] = (f32x4){0.f, 0.f, 0.f, 0.f};
        gemm_acc192(acc, mg + (size_t)row0 * 1024, 1024, wo + (size_t)n0 * 1024, 1024, 1024, smem, tid);
#pragma unroll
        for (int mb = 0; mb < 3; ++mb) {
            const int m = row0 + wr * 48 + mb * 16 + fr, ci = cond_of(m);
            const float* xr = xrow(p, m) + n0 + wc * 128 + fq * 4;
            f32x4 xv[8];
#pragma unroll
            for (int nb = 0; nb < 8; ++nb) xv[nb] = __builtin_nontemporal_load((const f32x4*)(xr + nb * 16));
#pragma unroll
            for (int nb = 0; nb < 8; ++nb) {
                const int n = n0 + wc * 128 + nb * 16 + fq * 4;
                const f32x4 g1 = *(const f32x4*)(mod + ci * 6144 + 2048 + n);
                *(u32x2*)(xb16 + (size_t)m * D + n) = pack4(xv[nb] + g1 * acc[mb][nb]);
            }
        }
    }
}

struct ConvW { f32x4 w0[2], w1[2], w2[2], bb[2]; };
DI ConvW conv_load(const float* cw, const float* cb, int gcol) {
    ConvW c;
#pragma unroll
    for (int part = 0; part < 2; ++part) {
        const int cc = gcol + part * DFF;
        c.w0[part] = *(const f32x4*)(cw + cc); c.w1[part] = *(const f32x4*)(cw + 5632 + cc); c.w2[part] = *(const f32x4*)(cw + 2 * 5632 + cc); c.bb[part] = *(const f32x4*)(cb + cc);
    }
    return c;
}
DI u32x2 conv_act(const f32x4 (&um)[2], const f32x4 (&u0)[2], const f32x4 (&up)[2], const ConvW& c) {
    f32x4 res[2];
#pragma unroll
    for (int part = 0; part < 2; ++part) res[part] = um[part] * c.w0[part] + u0[part] * c.w1[part] + up[part] * c.w2[part] + c.bb[part];
    f32x4 o;
#pragma unroll
    for (int j = 0; j < 4; ++j) { const float g = res[1][j]; o[j] = g * rcpf_(1.0f + __expf(-g)) * res[0][j]; }
    return pack4(o);
}
DI void up_tile64(const Params& p, char* smem, int mt, int nt) {
    const int tid = threadIdx.x, wid = tid >> 6, lane = tid & 63, fr = lane & 15, fq = lane >> 4, wr = wid >> 1, wc = wid & 1;
    unsigned char* ws = p.ws;
    const bf16_t* hb = (const bf16_t*)(ws + OFF_H); const bf16_t* wu = (const bf16_t*)(ws + OFF_WUP);
    bf16_t* act = (bf16_t*)(ws + OFF_ACT); bf16_t* ub = (bf16_t*)(ws + OFF_U);
    bf16_t* ut = (bf16_t*)smem;
    const int NT = 44;
    {
        const int row0 = mt * 256, n0 = nt * 64;
        f32x4 acc[4][4]; zero_acc<4>(acc);
        gemm_acc<4, DFF>(acc, hb + (size_t)row0 * 1024, 1024, wu + (size_t)n0 * 1024, 1024, 1024, smem, tid);
        __syncthreads();
#pragma unroll
        for (int mb = 0; mb < 4; ++mb)
#pragma unroll
            for (int nb = 0; nb < 4; ++nb) *(u32x2*)(ut + (wr * 64 + mb * 16 + fr) * 136 + wc * 64 + nb * 16 + fq * 4) = pack4(acc[mb][nb]);
        __syncthreads();
        const int c4 = (tid & 15) * 4, lv = (c4 >> 5) * 64 + (c4 & 31), lg = lv + 32;
        const ConvW cwv = conv_load(p.ffn_conv_w, p.ffn_conv_b, n0 + c4);
#pragma unroll 2
        for (int it = 0; it < 8; ++it) {
            const int row = it * 32 + (tid >> 4);
            f32x4 um[2], u0[2], up[2];
            const f32x4 z4 = (f32x4){0.f, 0.f, 0.f, 0.f};
            u0[0] = unpack4(*(const u32x2*)(ut + row * 136 + lv)); u0[1] = unpack4(*(const u32x2*)(ut + row * 136 + lg));
            um[0] = row > 0 ? unpack4(*(const u32x2*)(ut + (row - 1) * 136 + lv)) : z4; um[1] = row > 0 ? unpack4(*(const u32x2*)(ut + (row - 1) * 136 + lg)) : z4;
            up[0] = row < 255 ? unpack4(*(const u32x2*)(ut + (row + 1) * 136 + lv)) : z4; up[1] = row < 255 ? unpack4(*(const u32x2*)(ut + (row + 1) * 136 + lg)) : z4;
            __builtin_nontemporal_store(conv_act(um, u0, up, cwv), (u32x2*)(act + (size_t)(row0 + row) * DFF + n0 + c4));
        }
        if (row0 >= MC && tid < 256) {
            const int k = tid >> 6, rsel = k < 2 ? k : 252 + k, cp = (tid & 63) * 2;
            *(unsigned*)(ub + ((size_t)(mt * NT + nt) * 4 + k) * 128 + cp) = *(const unsigned*)(ut + rsel * 136 + cp);
        }
    }
}
DI void up_tile32(const Params& p, char* smem, int mt, int nt) {
    const int tid = threadIdx.x, wid = tid >> 6, lane = tid & 63, fr = lane & 15, fq = lane >> 4, wr = wid >> 1, wc = wid & 1;
    unsigned char* ws = p.ws;
    const bf16_t* hb = (const bf16_t*)(ws + OFF_H); const bf16_t* wu = (const bf16_t*)(ws + OFF_WUP);
    bf16_t* act = (bf16_t*)(ws + OFF_ACT); bf16_t* ub = (bf16_t*)(ws + OFF_U);
    bf16_t* ut = (bf16_t*)smem;
    const int row0 = mt * 256, n0 = nt * 32;
    f32x4 acc[4][2]; zero_acc<2>(acc);
    gemm_acc<2, DFF>(acc, hb + (size_t)row0 * 1024, 1024, wu + (size_t)n0 * 1024, 1024, 1024, smem, tid);
    __syncthreads();
#pragma unroll
    for (int mb = 0; mb < 4; ++mb)
#pragma unroll
        for (int nb = 0; nb < 2; ++nb) *(u32x2*)(ut + (wr * 64 + mb * 16 + fr) * 72 + wc * 32 + nb * 16 + fq * 4) = pack4(acc[mb][nb]);
    __syncthreads();
    const int c4 = (tid & 7) * 4;
    const ConvW cwv = conv_load(p.ffn_conv_w, p.ffn_conv_b, n0 + c4);
#pragma unroll 2
    for (int it = 0; it < 4; ++it) {
        const int row = it * 64 + (tid >> 3);
        f32x4 um[2], u0[2], up[2];
        const f32x4 z4 = (f32x4){0.f, 0.f, 0.f, 0.f};
        u0[0] = unpack4(*(const u32x2*)(ut + row * 72 + c4)); u0[1] = unpack4(*(const u32x2*)(ut + row * 72 + 32 + c4));
        um[0] = row > 0 ? unpack4(*(const u32x2*)(ut + (row - 1) * 72 + c4)) : z4; um[1] = row > 0 ? unpack4(*(const u32x2*)(ut + (row - 1) * 72 + 32 + c4)) : z4;
        up[0] = row < 255 ? unpack4(*(const u32x2*)(ut + (row + 1) * 72 + c4)) : z4; up[1] = row < 255 ? unpack4(*(const u32x2*)(ut + (row + 1) * 72 + 32 + c4)) : z4;
        __builtin_nontemporal_store(conv_act(um, u0, up, cwv), (u32x2*)(act + (size_t)(row0 + row) * DFF + n0 + c4));
    }
    if (row0 >= MC && tid < 128) {
        const int k = tid >> 5, rsel = k < 2 ? k : 252 + k, cp = (tid & 31) * 2;
        *(unsigned*)(ub + ((size_t)(mt * 44 + (nt >> 1)) * 4 + k) * 128 + (nt & 1) * 64 + cp) = *(const unsigned*)(ut + rsel * 72 + cp);
    }
}
DI void up_tile128(const Params& p, char* smem, int mt, int nt, bool pre, bool has_next, int nmt, int nnt) {
    int tid = threadIdx.x;
    asm volatile("" : "+v"(tid));
    const int wid = tid >> 6, lane = tid & 63, fr = lane & 15, fq = lane >> 4, wr = wid >> 1, wc = wid & 1;
    unsigned char* ws = p.ws;
    const bf16_t* hb = (const bf16_t*)(ws + OFF_H); const bf16_t* wu = (const bf16_t*)(ws + OFF_WUP);
    bf16_t* act = (bf16_t*)(ws + OFF_ACT); bf16_t* ub = (bf16_t*)(ws + OFF_U);
    bf16_t* img = (bf16_t*)(smem + 65536);
    const int row0 = mt * 256, n0 = nt * 128;
    f32x4 acc[4][8];
#pragma unroll
    for (int a = 0; a < 4; ++a)
#pragma unroll
        for (int b = 0; b < 8; ++b) acc[a][b] = (f32x4){0.f, 0.f, 0.f, 0.f};
    if (pre) gemm_acc8<DFF, true>(acc, hb + (size_t)row0 * 1024, 1024, wu + (size_t)n0 * 1024, 1024, 1024, smem, tid);
    else gemm_acc8<DFF, false>(acc, hb + (size_t)row0 * 1024, 1024, wu + (size_t)n0 * 1024, 1024, 1024, smem, tid);
    __syncthreads();
    if (has_next) gemm_pre8<DFF>(hb + (size_t)(nmt * 256) * 1024, 1024, wu + (size_t)(nnt * 128) * 1024, 1024, smem, tid);
    const int c4 = (tid & 15) * 4, rs = tid >> 4;
#pragma unroll 1
    for (int h = 0; h < 2; ++h) {
        if (wc == h) {
#pragma unroll
            for (int mb = 0; mb < 4; ++mb)
#pragma unroll
                for (int nb = 0; nb < 8; ++nb) *(u32x2*)(img + (wr * 64 + mb * 16 + fr) * 136 + nb * 16 + fq * 4) = pack4(acc[mb][nb]);
        }
        __syncthreads();
        const ConvW cwv = conv_load(p.ffn_conv_w, p.ffn_conv_b, n0 + h * 64 + c4);
        const bf16_t* ip = img + (rs * 8) * 136 + c4;
        const f32x4 z4 = (f32x4){0.f, 0.f, 0.f, 0.f};
        f32x4 um[2], u0[2], up[2];
        um[0] = rs > 0 ? unpack4(*(const u32x2*)(ip - 136)) : z4; um[1] = rs > 0 ? unpack4(*(const u32x2*)(ip - 136 + 64)) : z4;
        u0[0] = unpack4(*(const u32x2*)ip); u0[1] = unpack4(*(const u32x2*)(ip + 64));
#pragma unroll
        for (int j = 0; j < 8; ++j) {
            const bool last = (j == 7) && (rs == 31);
            up[0] = last ? z4 : unpack4(*(const u32x2*)(ip + (j + 1) * 136)); up[1] = last ? z4 : unpack4(*(const u32x2*)(ip + (j + 1) * 136 + 64));
            __builtin_nontemporal_store(conv_act(um, u0, up, cwv), (u32x2*)(act + (size_t)(row0 + rs * 8 + j) * DFF + n0 + h * 64 + c4));
            um[0] = u0[0]; um[1] = u0[1]; u0[0] = up[0]; u0[1] = up[1];
        }
        if (row0 >= MC && tid < 256) {
            const int k = tid >> 6, rsel = k < 2 ? k : 252 + k, lo = (tid & 63) * 2;
            const int cq = (lo >> 6) * 32 + (lo & 31), isg = (lo >> 5) & 1;
            *(unsigned*)(ub + ((size_t)(mt * 44 + nt * 2 + h) * 4 + k) * 128 + lo) = *(const unsigned*)(img + rsel * 136 + cq + isg * 64);
        }
        __syncthreads();
    }
}
DI void phase_up(const Params& p, char* smem) {
    const int MT = M / 256, NT = 22, G = gridDim.x, nfirst = ((MT * NT) / G) * G;
    bool pre = false;
    for (int t = blockIdx.x; t < nfirst; t += G) {
        int mt, nt, nmt = 0, nnt = 0; tile_coords(t, MT, NT, mt, nt);
        const bool has_next = t + G < nfirst;
        if (has_next) tile_coords(t + G, MT, NT, nmt, nnt);
        up_tile128(p, smem, mt, nt, pre, has_next, nmt, nnt);
        pre = has_next;
    }
    for (int t = blockIdx.x; t < 4 * (MT * NT - nfirst); t += G) { int mt, nt; tile_coords(nfirst + (t >> 2), MT, NT, mt, nt); up_tile32(p, smem, mt, nt * 4 + (t & 3)); }
}
DI void phase_fix(const Params& p) {
    unsigned char* ws = p.ws;
    bf16_t* act = (bf16_t*)(ws + OFF_ACT); const bf16_t* ub = (const bf16_t*)(ws + OFF_U);
    const int NT = 44;
    for (int i = blockIdx.x * NTHR + threadIdx.x; i < 64 * NT * 2 * 16; i += gridDim.x * NTHR) {
        const int cg = i & 15, which = (i >> 4) & 1, rest = i >> 5, nt = rest % NT, mt = 32 + rest / NT;
        const int row0 = mt * 256, tpos = (row0 - MC) & 2047;
        if (which == 0 ? tpos == 0 : tpos == 2048 - 256) continue;
        const bf16_t* own = ub + (size_t)(mt * NT + nt) * 4 * 128;
        const bf16_t *pv, *cu, *nx; int m;
        if (which == 0) { m = row0; pv = ub + ((size_t)((mt - 1) * NT + nt) * 4 + 3) * 128; cu = own; nx = own + 128; }
        else { m = row0 + 255; pv = own + 2 * 128; cu = own + 3 * 128; nx = ub + (size_t)((mt + 1) * NT + nt) * 4 * 128; }
        const int c4 = cg * 4, lv = (c4 >> 5) * 64 + (c4 & 31), lg = lv + 32;
        f32x4 um[2], u0[2], up[2];
        um[0] = unpack4(*(const u32x2*)(pv + lv)); um[1] = unpack4(*(const u32x2*)(pv + lg));
        u0[0] = unpack4(*(const u32x2*)(cu + lv)); u0[1] = unpack4(*(const u32x2*)(cu + lg));
        up[0] = unpack4(*(const u32x2*)(nx + lv)); up[1] = unpack4(*(const u32x2*)(nx + lg));
        *(u32x2*)(act + (size_t)m * DFF + nt * 64 + c4) = conv_act(um, u0, up, conv_load(p.ffn_conv_w, p.ffn_conv_b, nt * 64 + c4));
    }
}
struct EpiDown {
    static constexpr bool PERM = false, AFTER_DRAIN = false;
    bf16_t* xb16; const float* mod;
    __device__ __forceinline__ void operator()(const f32x4 (&acc)[2][2][4][2], const pg8::Unit& u, int wr, int wc, int fr, int fq) const {
        const int row0 = u.pm * 256 + wr * 64 + fr, col0 = u.pn * 256 + wc * 32 + 4 * fq, ci = cond_of(u.pm * 256);
#pragma unroll
        for (int bj = 0; bj < 2; ++bj)
#pragma unroll
            for (int n = 0; n < 2; ++n) {
                const int col = col0 + bj * 128 + n * 16;
                const f32x4 g2 = *(const f32x4*)(mod + ci * 6144 + 5120 + col);
#pragma unroll
                for (int ai = 0; ai < 2; ++ai)
#pragma unroll
                    for (int m = 0; m < 4; ++m) { bf16_t* px = xb16 + (size_t)(row0 + ai * 128 + m * 16) * D + col; *(u32x2*)px = pack4(unpack4(*(const u32x2*)px) + g2 * acc[ai][bj][m][n]); }
            }
    }
};
DI void phase_down(const Params& p, char* smem) {
    const int tid = threadIdx.x, wid = tid >> 6, lane = tid & 63, fr = lane & 15, fq = lane >> 4, wr = wid >> 1, wc = wid & 1;
    unsigned char* ws = p.ws;
    const bf16_t* act = (const bf16_t*)(ws + OFF_ACT); const bf16_t* wd = (const bf16_t*)(ws + OFF_WDN);
    const float* mod = (const float*)(ws + OFF_MOD);
    const int nM = M / 256, nN = 4, G = gridDim.x, nfirst = G < nM * nN ? G : nM * nN;
    {
        const pg8::Gemm8 g = {act, wd, DFF, 128};
        const pg8::Order8 ord = {nM, nN, nfirst, G, (int)blockIdx.x, 0};
        const EpiDown epi = {(bf16_t*)(ws + OFF_XB), mod};
        pg8::gemm8((LAS unsigned char*)smem, g, ord, epi);
    }
    for (int t = blockIdx.x; t < 2 * (nM * nN - nfirst); t += G) {
        int pm, pn; pg8::unit_of(nfirst + (t >> 1), nM, nN, pm, pn);
        const int row0 = pm * 256, n0 = pn * 256 + (t & 1) * 128;
        f32x4 acc[4][4]; zero_acc<4>(acc);
        gemm_acc<4>(acc, act + (size_t)row0 * DFF, DFF, wd + (size_t)n0 * DFF, DFF, DFF, smem, tid);
        const int ci = cond_of(row0);
#pragma unroll
        for (int nb = 0; nb < 4; ++nb) {
            const int n = n0 + wc * 64 + nb * 16 + fq * 4;
            const f32x4 g2 = *(const f32x4*)(mod + ci * 6144 + 5120 + n);
#pragma unroll
            for (int mb = 0; mb < 4; ++mb) {
                const int m = row0 + wr * 64 + mb * 16 + fr;
                bf16_t* px = (bf16_t*)(ws + OFF_XB) + (size_t)m * D + n;
                *(u32x2*)px = pack4(unpack4(*(const u32x2*)px) + g2 * acc[mb][nb]);
            }
        }
    }
}

#define XB_TMO      128
#define XB_XCNT(j)  (256  + 64 * (j))
#define XB_XSUB(j)  (1280 + 64 * (j))
#define XB_XGEN(j)  (2304 + 64 * (j))
#define XB_TOP      3328
#define XB_TOPGEN   3392
#define XB_SPIN_CAP (1u << 20)
DI unsigned xb_ld(unsigned* p)              { return __hip_atomic_load(p, __ATOMIC_RELAXED, __HIP_MEMORY_SCOPE_AGENT); }
DI unsigned xb_add(unsigned* p, unsigned v) { return __hip_atomic_fetch_add(p, v, __ATOMIC_RELAXED, __HIP_MEMORY_SCOPE_AGENT); }
DI unsigned xb_xcc_id() { return (unsigned)__builtin_amdgcn_s_getreg((3 << 11) | 20) & 0xFu; }
#define XB_SPIN(cond, bar) do { unsigned _sp = 0; while (cond) { __builtin_amdgcn_s_sleep(1); \
    if ((++_sp & 255u) == 0u) { if (xb_ld(&(bar)[XB_TMO])) break; if (_sp > XB_SPIN_CAP) { atomicAdd(&(bar)[XB_TMO], 1u); break; } } } } while (0)
struct XcdBarrier { unsigned* bar; unsigned x; volatile LAS unsigned* st; };
DI XcdBarrier xcd_barrier_post(unsigned* bar, volatile LAS unsigned* st) {
    XcdBarrier b; b.bar = bar; b.x = xb_xcc_id(); b.st = st;
    if (threadIdx.x == 0) (void)xb_add(&bar[XB_XCNT(b.x)], 1u);
    return b;
}
DI void xcd_barrier_complete(unsigned* bar, unsigned x, unsigned& nloc, unsigned& nx) {
    const unsigned G = gridDim.x * gridDim.y * gridDim.z;
    unsigned sum, cnt, mine, sp = 0u;
    for (;;) {
        sum = 0u; cnt = 0u; mine = 0u;
#pragma unroll
        for (unsigned j = 0; j < 16; ++j) { const unsigned c = xb_ld(&bar[XB_XCNT(j)]); sum += c; cnt += (c > 0u) ? 1u : 0u; mine = (j == x) ? c : mine; }
        if (sum == G) break;
        __builtin_amdgcn_s_sleep(1);
        if ((++sp & 255u) == 0u) { if (xb_ld(&bar[XB_TMO])) break; if (sp > XB_SPIN_CAP) { atomicAdd(&bar[XB_TMO], 1u); break; } }
    }
    nloc = mine > 0u ? mine : 1u; nx = cnt > 0u ? cnt : 1u;
}
DI void xcd_barrier(const XcdBarrier& b) {
    asm volatile("s_waitcnt vmcnt(0)" ::: "memory");
    __syncthreads();
    if (threadIdx.x == 0) {
        unsigned* bar = b.bar;
        __builtin_amdgcn_s_waitcnt(0);
        unsigned nloc = b.st[0], nx = b.st[1];
        if (nloc == 0u) { xcd_barrier_complete(bar, b.x, nloc, nx); b.st[0] = nloc; b.st[1] = nx; }
        const unsigned old = xb_add(&bar[XB_XSUB(b.x)], 1u);
        const unsigned gen = old / nloc;
        if (old + 1u == (gen + 1u) * nloc) {
            __builtin_amdgcn_fence(__ATOMIC_RELEASE, "agent");
            asm volatile("s_waitcnt vmcnt(0)" ::: "memory");
            const unsigned og = xb_add(&bar[XB_TOP], 1u);
            if (og + 1u != (gen + 1u) * nx) XB_SPIN(xb_ld(&bar[XB_TOP]) < (gen + 1u) * nx, bar);
            __builtin_amdgcn_fence(__ATOMIC_ACQUIRE, "agent");
        } else {
            XB_SPIN(xb_ld(&bar[XB_TOP]) < (gen + 1u) * nx, bar);
            __builtin_amdgcn_fence(__ATOMIC_ACQUIRE, "agent");
            asm volatile("s_waitcnt vmcnt(0)" ::: "memory");
        }
    }
    __syncthreads();
}

DI unsigned xcd_barrier_arrive(const XcdBarrier& b) {
    asm volatile("s_waitcnt vmcnt(0)" ::: "memory");
    __syncthreads();
    unsigned gen = 0u;
    if (threadIdx.x == 0) {
        unsigned* bar = b.bar;
        __builtin_amdgcn_s_waitcnt(0);
        unsigned nloc = b.st[0], nx = b.st[1];
        if (nloc == 0u) { xcd_barrier_complete(bar, b.x, nloc, nx); b.st[0] = nloc; b.st[1] = nx; }
        const unsigned old = xb_add(&bar[XB_XSUB(b.x)], 1u);
        gen = old / nloc;
        if (old + 1u == (gen + 1u) * nloc) {
            __builtin_amdgcn_fence(__ATOMIC_RELEASE, "agent");
            asm volatile("s_waitcnt vmcnt(0)" ::: "memory");
            (void)xb_add(&bar[XB_TOP], 1u);
        }
    }
    return gen;
}
DI void xcd_barrier_wait(const XcdBarrier& b, unsigned gen) {
    if (threadIdx.x == 0) {
        unsigned* bar = b.bar;
        const unsigned nx = b.st[1];
        XB_SPIN(xb_ld(&bar[XB_TOP]) < (gen + 1u) * nx, bar);
        __builtin_amdgcn_fence(__ATOMIC_ACQUIRE, "agent");
        asm volatile("s_waitcnt vmcnt(0)" ::: "memory");
    }
    __syncthreads();
}

constexpr int N_PHASES = 23;
__global__ void __launch_bounds__(NTHR) fwd_kernel(Params p) {
    extern __shared__ __attribute__((aligned(16))) char smem[];
    volatile LAS unsigned* xst = (volatile LAS unsigned*)(smem + LDS_MAIN);
    if (threadIdx.x == 0) { xst[0] = 0u; xst[1] = 0u; }
    __syncthreads();
    const XcdBarrier xb = xcd_barrier_post(g_bar, xst);
    asm volatile("s_nop 0\n\ts_nop 0");
#ifndef PH_MASK
#define PH_MASK 0xffff
#endif
#ifndef REP_MASK
#define REP_MASK 0
#endif
#ifndef PROBE_PH
#define PROBE_PH -1
#endif
    unsigned long long pt_prev = 0; int pt_ph = -100;
#define PROBE_TICK(ph) if (PROBE_PH >= 0) { const unsigned long long now_ = __builtin_amdgcn_s_memrealtime(); \
        if (pt_ph == PROBE_PH && blockIdx.x == 0 && threadIdx.x == 0) ((float*)g_bar)[XCD_BAR_WORDS + 8] = (float)(now_ - pt_prev) * 0.01f; pt_prev = now_; pt_ph = (ph); }
#define RUN_PHASE(ph, bit, call) if (p.ph_lo <= (ph) && (ph) < p.ph_hi) { if ((ph) > p.ph_lo) xcd_barrier(xb); PROBE_TICK(ph) if (PH_MASK & (bit)) { call; if (REP_MASK & (bit)) { call; } } }
    RUN_PHASE(0, 1, phase_prep(p, smem))
#define RUN_PHASE_SH(ph, bit, call, sh) { const unsigned g_ = xcd_barrier_arrive(xb); late_transposes(p, smem, (sh)); xcd_barrier_wait(xb, g_); PROBE_TICK(ph) if (PH_MASK & (bit)) { call; } }
    RUN_PHASE_SH(1, 2, phase_norm<1>(p), 0)
    RUN_PHASE_SH(2, 4, phase_p1(p, smem), 1)
    RUN_PHASE_SH(4, 16, phase_mix(p, smem), 2)
    RUN_PHASE(5, 32, phase_post(p, smem))
    {
        u32x2 g0a[4][4], g0b[4][4];
        const unsigned bgen = xcd_barrier_arrive(xb);
        merge_gates(p, smem, (int)blockIdx.x, false, g0a, g0b);
        xcd_barrier_wait(xb, bgen);
        PROBE_TICK(6)
        phase_merge(p, smem, g0a, g0b);
    }
    RUN_PHASE(7, 128, phase_out(p, smem))
    RUN_PHASE(8, 256, phase_norm<2>(p))
    RUN_PHASE(9, 512, phase_up(p, smem))
    RUN_PHASE(10, 1024, phase_fix(p))
    RUN_PHASE(21, 2048, phase_down(p, smem))
    RUN_PHASE(22, 4096, phase_norm<3>(p))
    if (PROBE_PH >= 0) {
        xcd_barrier(xb);
        PROBE_TICK(99)
        xcd_barrier(xb);
        const float val = ((const float*)g_bar)[XCD_BAR_WORDS + 8];
        const float cc = sqrtf(fmaxf(1e-5f + val * 5e-7f, 0.f));
        for (int i = blockIdx.x * NTHR + threadIdx.x; i < MC * 128; i += gridDim.x * NTHR) p.out[OUT_V + i] *= (1.0f + cc);
    }
    {
        volatile LAS unsigned* slot = (volatile LAS unsigned*)(smem + LDS_MAIN + 8);
        asm volatile("s_waitcnt vmcnt(0)" ::: "memory");
        __syncthreads();
        if (threadIdx.x == 0) *slot = __hip_atomic_fetch_add(&g_bar[BAR_EXIT], 1u, __ATOMIC_RELAXED, __HIP_MEMORY_SCOPE_AGENT);
        __syncthreads();
        if (*slot == gridDim.x * gridDim.y * gridDim.z - 1u) {
            for (int i = threadIdx.x; i < XCD_BAR_WORDS + 64; i += NTHR) __hip_atomic_store(&g_bar[i], 0u, __ATOMIC_RELAXED, __HIP_MEMORY_SCOPE_AGENT);
        }
    }
}

extern "C" void kernel_launch(void* const* d_in, const int* in_sizes, int n_in, void* d_out, int out_size, void* d_ws, size_t ws_size, hipStream_t stream) {
    static int grid = 0;
    if (grid == 0) {
        if (n_in != 32 || ws_size < WS_NEED) { fprintf(stderr, "kernel_launch: unexpected inputs (n_in %d, ws %zu, need %zu)\n", n_in, ws_size, (size_t)WS_NEED); grid = -1; return; }
        int dev = 0, cus = 0, per_cu = 0;
        hipGetDevice(&dev);
        hipDeviceGetAttribute(&cus, hipDeviceAttributeMultiprocessorCount, dev);
        hipFuncSetAttribute((const void*)fwd_kernel, hipFuncAttributeMaxDynamicSharedMemorySize, LDS_BYTES);
        hipOccupancyMaxActiveBlocksPerMultiprocessor(&per_cu, (const void*)fwd_kernel, NTHR, LDS_BYTES);
        if (per_cu < 1) { fprintf(stderr, "kernel_launch: occupancy query says %d blocks per CU\n", per_cu); grid = -1; return; }
        grid = cus;
        grid &= ~7;
    }
    if (grid < 0) return;
    Params p{};
    const float** pp = (const float**)&p;
    for (int i = 0; i < 32; ++i) pp[i] = (const float*)d_in[i];
    p.out = (float*)d_out; p.ws = (unsigned char*)d_ws;
#if N_LAUNCH_SPLIT
    for (int ph = 0; ph < N_PHASES; ++ph) {
        p.ph_lo = ph; p.ph_hi = ph + 1;
        hipLaunchKernelGGL(fwd_kernel, dim3(grid), dim3(NTHR), LDS_BYTES, stream, p);
    }
#else
    p.ph_lo = 0; p.ph_hi = N_PHASES;
    void* args[] = {&p};
    hipError_t e = hipLaunchCooperativeKernel((const void*)fwd_kernel, dim3(grid), dim3(NTHR), args, LDS_BYTES, stream);
    if (e != hipSuccess) fprintf(stderr, "cooperative launch failed: %s (grid %d)\n", hipGetErrorString(e), grid);
#endif
}
```
